# Optimizing an MI355X kernel written in HIP

```python
import math
import jax
import jax.numpy as jnp
from jax import lax
import numpy as np

D_MODEL = 1024
BATCH = 8
SEQ = 2048
DEPTH = 2

N_EVEN = (DEPTH + 1) // 2
N_ODD = DEPTH // 2
EPS = 1e-6
ROPE_THETA = 10000.0
POS_OFFSET_MAX = 1024

GLA_HEADS = 4
GLA_DK = D_MODEL // 16
GLA_DV = D_MODEL // 8
GLA_RANK = 16
GLA_CHUNK = 64
GLA_GATE_NORMALIZER = 16.0

DIFF_HEADS = 4
DIFF_D = D_MODEL // 16
DIFF_DV = 2 * DIFF_D
ATTN_BLOCK = 128

SGU_GROUPS = 4
SGU_CH = D_MODEL // 8
SGU_CHUNK = 128

RET_HEADS = 4
RET_DK = D_MODEL // 16
RET_DV = D_MODEL // 8
RET_CHUNK = 128

N_EXPERTS = 32
TOP_K = 4
D_FF = D_MODEL
SWIGLU_ALPHA = 1.702
SWIGLU_LIMIT = 7.0
MOE_BLOCK = 256

GLA_QK_W = GLA_HEADS * GLA_DK
GLA_V_W = GLA_HEADS * GLA_DV
DIFF_QK_W = DIFF_HEADS * 2 * DIFF_D
DIFF_V_W = DIFF_HEADS * DIFF_DV
SGU_W = SGU_GROUPS * SGU_CH
RET_QK_W = RET_HEADS * RET_DK
RET_V_W = RET_HEADS * RET_DV
EVEN_WIDTHS = (GLA_QK_W, GLA_QK_W, GLA_V_W, GLA_RANK, GLA_V_W, DIFF_QK_W, DIFF_QK_W, DIFF_V_W)
ODD_WIDTHS = (SGU_W, SGU_W, RET_QK_W, RET_QK_W, RET_V_W, RET_V_W)
EVEN_IN = sum(EVEN_WIDTHS)
ODD_IN = sum(ODD_WIDTHS)
EVEN_OUT = GLA_V_W + DIFF_V_W
ODD_OUT = SGU_W + RET_V_W

kernel_name = 'hybrid_gla_diff_sgu_retention_moe'


def _split(z, widths):
    out, start = [], 0
    for w in widths:
        out.append(z[..., start:start + w])
        start += w
    return out


def _rms(x):
    xf = x.astype(jnp.float32)
    return (xf * lax.rsqrt(jnp.mean(jnp.square(xf), axis=-1, keepdims=True) + EPS)).astype(x.dtype)


def _layer_norm(x, g, b):
    xf = x.astype(jnp.float32)
    mu = jnp.mean(xf, axis=-1, keepdims=True)
    var = jnp.mean(jnp.square(xf - mu), axis=-1, keepdims=True)
    return ((xf - mu) * lax.rsqrt(var + EPS)).astype(x.dtype) * g + b


def _heads(t, n):
    B, L, _ = t.shape
    return t.reshape(B, L, n, -1).transpose(0, 2, 1, 3)


def _merge(t):
    B, H, L, e = t.shape
    return t.transpose(0, 2, 1, 3).reshape(B, L, H * e)


def _rope(x, pos):
    half = x.shape[-1] // 2
    inv_freq = ROPE_THETA ** (-jnp.arange(half, dtype=jnp.float32) / half)
    ang = pos.astype(jnp.float32)[..., None] * inv_freq
    ang = ang.reshape((ang.shape[0],) + (1,) * (x.ndim - 3) + ang.shape[1:])
    cos, sin = jnp.cos(ang), jnp.sin(ang)
    xf = x.astype(jnp.float32)
    x1, x2 = xf[..., :half], xf[..., half:]
    return jnp.concatenate([x1 * cos - x2 * sin, x2 * cos + x1 * sin], axis=-1).astype(x.dtype)


def _gla_chunked(q, k, v, log_a):
    B, H, L, dk = q.shape
    dv = v.shape[-1]
    C = GLA_CHUNK
    n = L // C
    f32 = jnp.float32
    qc = q.astype(f32).reshape(B, H, n, C, dk) * dk ** -0.5
    kc = k.astype(f32).reshape(B, H, n, C, dk)
    vc = v.astype(f32).reshape(B, H, n, C, dv)
    b = jnp.cumsum(log_a.astype(f32).reshape(B, H, n, C, dk), axis=3)
    b_last = b[:, :, :, -1:, :]
    q_dec = qc * jnp.exp(b)
    s = jnp.einsum('bhnid,bhnjd->bhnij', q_dec, kc * jnp.exp(-b))
    causal = jnp.tril(jnp.ones((C, C), dtype=bool))
    o_intra = jnp.einsum('bhnij,bhnje->bhnie', jnp.where(causal, s, 0.0), vc)
    chunk_kv = jnp.einsum('bhnjd,bhnje->bhnde', kc * jnp.exp(b_last - b), vc)
    chunk_decay = jnp.exp(b_last[:, :, :, 0, :])[..., None]

    def step(state, inp):
        kv, dec = inp
        return dec * state + kv, state

    _, prev = lax.scan(step, jnp.zeros((B, H, dk, dv), f32),
                       (jnp.moveaxis(chunk_kv, 2, 0), jnp.moveaxis(chunk_decay, 2, 0)))
    prev = jnp.moveaxis(prev, 0, 2)
    o_inter = jnp.einsum('bhnid,bhnde->bhnie', q_dec, prev)
    return (o_intra + o_inter).reshape(B, H, L, dv).astype(v.dtype)


def _diff_attention(q, k, v, lam):
    B, H, _, L, d = q.shape
    nb = L // ATTN_BLOCK
    q_blocks = jnp.moveaxis(q.reshape(B, H, 2, nb, ATTN_BLOCK, d), 3, 0)
    k_pos = jnp.arange(L)
    scale = d ** -0.5

    def one_block(args):
        q_blk, blk = args
        s = jnp.einsum('bhmqd,bhmkd->bhmqk', q_blk, k, preferred_element_type=jnp.float32) * scale
        q_pos = blk * ATTN_BLOCK + jnp.arange(ATTN_BLOCK)
        s = jnp.where(k_pos[None, :] <= q_pos[:, None], s, -jnp.inf)
        p = jax.nn.softmax(s, axis=-1)
        w = (p[:, :, 0] - lam * p[:, :, 1]).astype(v.dtype)
        return jnp.einsum('bhqk,bhke->bhqe', w, v)

    out = lax.map(one_block, (q_blocks, jnp.arange(nb)))
    return jnp.moveaxis(out, 0, 2).reshape(B, H, L, v.shape[-1])


def _spatial_gating(u, v, w_s, b_s):
    B, L, G, ch = v.shape
    n = L // SGU_CHUNK
    w = jnp.tril(w_s)
    vc = v.reshape(B, n, SGU_CHUNK, G, ch)
    s = jnp.einsum('gij,bnjgc->bnigc', w, vc) + b_s.T[None, None, :, :, None]
    return u * s.reshape(B, L, G, ch)


def _retention_chunked(q, k, v):
    B, H, L, dk = q.shape
    dv = v.shape[-1]
    C = RET_CHUNK
    n = L // C
    f32 = jnp.float32
    log_g = jnp.log(1.0 - 2.0 ** (-5.0 - jnp.arange(H, dtype=f32)))
    qc = q.astype(f32).reshape(B, H, n, C, dk)
    kc = k.astype(f32).reshape(B, H, n, C, dk) * dk ** -0.5
    vc = v.astype(f32).reshape(B, H, n, C, dv)
    idx = jnp.arange(C, dtype=f32)
    rel = idx[:, None] - idx[None, :]
    decay = jnp.where(rel >= 0, jnp.exp(log_g[:, None, None] * jnp.maximum(rel, 0.0)), 0.0)
    s = jnp.einsum('bhnid,bhnjd->bhnij', qc, kc) * decay[None, :, None]
    o_intra = jnp.einsum('bhnij,bhnje->bhnie', s, vc)
    k_dec = jnp.exp(log_g[:, None] * (C - 1.0 - idx))
    chunk_kv = jnp.einsum('bhnjd,bhnje->bhnde', kc * k_dec[None, :, None, :, None], vc)
    chunk_g = jnp.exp(log_g * C)[None, :, None, None]

    def step(state, kv):
        return chunk_g * state + kv, state

    _, prev = lax.scan(step, jnp.zeros((B, H, dk, dv), f32), jnp.moveaxis(chunk_kv, 2, 0))
    prev = jnp.moveaxis(prev, 0, 2)
    q_dec = jnp.exp(log_g[:, None] * (idx + 1.0))
    o_inter = jnp.einsum('bhnid,bhnde->bhnie', qc * q_dec[None, :, None, :, None], prev)
    return (o_intra + o_inter).reshape(B, H, L, dv).astype(v.dtype)


def _moe(h, w_router, b_router, w_in, b_in, w_out, b_out):
    T, D = h.shape
    logits = (h @ w_router + b_router).astype(jnp.float32)
    top_vals, top_idx = lax.top_k(logits, TOP_K)
    gates = jax.nn.softmax(top_vals, axis=-1).astype(h.dtype)
    TK = T * TOP_K
    e_flat = top_idx.reshape(-1)
    tok_flat = jnp.repeat(jnp.arange(T, dtype=jnp.int32), TOP_K)
    g_flat = gates.reshape(-1)
    order = jnp.argsort(e_flat)
    e_sorted, tok_sorted, g_sorted = e_flat[order], tok_flat[order], g_flat[order]
    counts = jnp.bincount(e_flat, length=N_EXPERTS)
    padded = (counts + MOE_BLOCK - 1) // MOE_BLOCK * MOE_BLOCK
    start = jnp.cumsum(counts) - counts
    pad_end = jnp.cumsum(padded)
    pad_start = pad_end - padded
    dest = pad_start[e_sorted] + (jnp.arange(TK) - start[e_sorted])
    n_blocks = (TK + MOE_BLOCK - 1) // MOE_BLOCK + N_EXPERTS
    R = n_blocks * MOE_BLOCK
    row_tok = jnp.full((R,), T, dtype=jnp.int32).at[dest].set(tok_sorted)
    row_gate = jnp.zeros((R,), h.dtype).at[dest].set(g_sorted)
    block_e = jnp.minimum(jnp.searchsorted(pad_end, jnp.arange(n_blocks) * MOE_BLOCK, side='right'),
                          N_EXPERTS - 1)
    h_pad = jnp.concatenate([h, jnp.zeros((1, D), h.dtype)], axis=0)
    xb = h_pad[row_tok].reshape(n_blocks, MOE_BLOCK, D)

    def expert_block(args):
        x_blk, e = args
        z = x_blk @ w_in[e] + b_in[e]
        glu = jnp.minimum(z[:, :D_FF], SWIGLU_LIMIT)
        lin = jnp.clip(z[:, D_FF:], -SWIGLU_LIMIT, SWIGLU_LIMIT)
        a = glu * jax.nn.sigmoid(SWIGLU_ALPHA * glu) * (lin + 1.0)
        return a @ w_out[e] + b_out[e]

    yb = lax.map(expert_block, (xb, block_e)).reshape(R, D)
    y = jnp.zeros((T + 1, D), h.dtype).at[row_tok].add(yb * row_gate[:, None])
    return y[:T]


def _even_mixer(h, positions, layer, w_in, w_gate, b_gate, gla_g, lq1, lk1, lq2, lk2, diff_g, w_out):
    B, L, _ = h.shape
    gq, gk, gv, gr, gg, dq, dk, dv = _split(h @ w_in, EVEN_WIDTHS)
    log_a = jax.nn.log_sigmoid((gr @ w_gate + b_gate).astype(jnp.float32)) / GLA_GATE_NORMALIZER
    o_gla = _gla_chunked(_heads(gq, GLA_HEADS), _heads(gk, GLA_HEADS), _heads(gv, GLA_HEADS),
                         _heads(log_a, GLA_HEADS))
    o_gla = _merge(_rms(o_gla) * gla_g) * jax.nn.silu(gg)
    lam_init = 0.8 - 0.6 * math.exp(-0.3 * layer)
    lam = (jnp.exp(jnp.sum(lq1 * lk1).astype(jnp.float32))
           - jnp.exp(jnp.sum(lq2 * lk2).astype(jnp.float32)) + lam_init)
    q = _rope(dq.reshape(B, L, DIFF_HEADS, 2, DIFF_D).transpose(0, 2, 3, 1, 4), positions)
    k = _rope(dk.reshape(B, L, DIFF_HEADS, 2, DIFF_D).transpose(0, 2, 3, 1, 4), positions)
    o_diff = _diff_attention(q, k, _heads(dv, DIFF_HEADS), lam)
    o_diff = _merge(_rms(o_diff) * diff_g) * (1.0 - lam_init)
    return jnp.concatenate([o_gla, o_diff], axis=-1) @ w_out


def _odd_mixer(h, positions, w_in, ln_g, ln_b, w_s, b_s, w_out):
    B, L, _ = h.shape
    su, sv, rq, rk, rv, rg = _split(h @ w_in, ODD_WIDTHS)
    su = jax.nn.gelu(su, approximate=False)
    sv = _layer_norm(jax.nn.gelu(sv, approximate=False), ln_g, ln_b)
    o_sgu = _spatial_gating(su.reshape(B, L, SGU_GROUPS, SGU_CH), sv.reshape(B, L, SGU_GROUPS, SGU_CH),
                            w_s, b_s).reshape(B, L, SGU_W)
    q = _rope(_heads(rq, RET_HEADS), positions)
    k = _rope(_heads(rk, RET_HEADS), positions)
    o_ret = _merge(_rms(_retention_chunked(q, k, _heads(rv, RET_HEADS)))) * jax.nn.silu(rg)
    return jnp.concatenate([o_sgu, o_ret], axis=-1) @ w_out


def setup_inputs(seed: int = 0) -> dict:
    key = jax.random.key(seed)
    k = jax.random.split(key, 32)
    f32 = jnp.float32
    D = D_MODEL

    def nrm(i, shape, scale):
        return jax.random.normal(k[i], shape, f32) * scale

    return {
        'x': nrm(0, (BATCH, SEQ, D), 1.0),
        'c': nrm(1, (BATCH, D), 1.0),
        'positions': (jnp.arange(SEQ, dtype=jnp.int32)[None, :]
                      + jax.random.randint(k[2], (BATCH, 1), 0, POS_OFFSET_MAX, dtype=jnp.int32)),
        'w_ada': nrm(3, (DEPTH, D, 6 * D), 0.5 * D ** -0.5),
        'b_ada': nrm(4, (DEPTH, 6 * D), 0.02),
        'even_w_in': nrm(5, (N_EVEN, D, EVEN_IN), D ** -0.5),
        'gla_w_gate': nrm(6, (N_EVEN, GLA_RANK, GLA_QK_W), GLA_RANK ** -0.5),
        'gla_b_gate': nrm(7, (N_EVEN, GLA_QK_W), 0.02),
        'gla_norm_g': 1.0 + nrm(8, (N_EVEN, GLA_DV), 0.02),
        'diff_lam_q1': nrm(9, (N_EVEN, DIFF_D), 0.1),
        'diff_lam_k1': nrm(10, (N_EVEN, DIFF_D), 0.1),
        'diff_lam_q2': nrm(11, (N_EVEN, DIFF_D), 0.1),
        'diff_lam_k2': nrm(12, (N_EVEN, DIFF_D), 0.1),
        'diff_norm_g': 1.0 + nrm(13, (N_EVEN, DIFF_DV), 0.02),
        'even_w_out': nrm(14, (N_EVEN, EVEN_OUT, D), EVEN_OUT ** -0.5),
        'odd_w_in': nrm(15, (N_ODD, D, ODD_IN), D ** -0.5),
        'sgu_ln_g': 1.0 + nrm(16, (N_ODD, SGU_W), 0.02),
        'sgu_ln_b': nrm(17, (N_ODD, SGU_W), 0.02),
        'sgu_w': nrm(18, (N_ODD, SGU_GROUPS, SGU_CHUNK, SGU_CHUNK), SGU_CHUNK ** -0.5),
        'sgu_b': 1.0 + nrm(19, (N_ODD, SGU_GROUPS, SGU_CHUNK), 0.02),
        'odd_w_out': nrm(20, (N_ODD, ODD_OUT, D), ODD_OUT ** -0.5),
        'router_w': nrm(21, (DEPTH, D, N_EXPERTS), D ** -0.5),
        'router_b': nrm(22, (DEPTH, N_EXPERTS), 0.01),
        'expert_w_in': nrm(23, (DEPTH, N_EXPERTS, D, 2 * D_FF), D ** -0.5),
        'expert_b_in': nrm(24, (DEPTH, N_EXPERTS, 2 * D_FF), 0.02),
        'expert_w_out': nrm(25, (DEPTH, N_EXPERTS, D_FF, D), D_FF ** -0.5),
        'expert_b_out': nrm(26, (DEPTH, N_EXPERTS, D), 0.02),
        'final_norm_g': 1.0 + nrm(27, (D,), 0.02),
    }


def reference(x, c, positions, w_ada, b_ada, even_w_in, gla_w_gate, gla_b_gate, gla_norm_g,
              diff_lam_q1, diff_lam_k1, diff_lam_q2, diff_lam_k2, diff_norm_g, even_w_out,
              odd_w_in, sgu_ln_g, sgu_ln_b, sgu_w, sgu_b, odd_w_out,
              router_w, router_b, expert_w_in, expert_b_in, expert_w_out, expert_b_out,
              final_norm_g):
    B, L, D = x.shape
    c_act = jax.nn.silu(c)
    for layer in range(DEPTH):
        mod = (c_act @ w_ada[layer] + b_ada[layer])[:, None, :]
        shift1, scale1, gate1, shift2, scale2, gate2 = jnp.split(mod, 6, axis=-1)
        h = _rms(x) * (1.0 + scale1) + shift1
        j = layer // 2
        if layer % 2 == 0:
            y = _even_mixer(h, positions, layer, even_w_in[j], gla_w_gate[j], gla_b_gate[j], gla_norm_g[j],
                            diff_lam_q1[j], diff_lam_k1[j], diff_lam_q2[j], diff_lam_k2[j],
                            diff_norm_g[j], even_w_out[j])
        else:
            y = _odd_mixer(h, positions, odd_w_in[j], sgu_ln_g[j], sgu_ln_b[j], sgu_w[j], sgu_b[j],
                           odd_w_out[j])
        x = x + gate1 * y
        h = _rms(x) * (1.0 + scale2) + shift2
        y = _moe(h.reshape(B * L, D), router_w[layer], router_b[layer], expert_w_in[layer],
                 expert_b_in[layer], expert_w_out[layer], expert_b_out[layer]).reshape(B, L, D)
        x = x + gate2 * y
    return _rms(x) * final_norm_g
```

```cpp
#include <hip/hip_runtime.h>
#include <hip/hip_cooperative_groups.h>
#include <cstdio>
#include <cstdint>
namespace cg = cooperative_groups;

#ifndef ONE_LAUNCH
#define ONE_LAUNCH 0
#endif
#ifndef DBG_SKIP
#define DBG_SKIP 0
#endif
#ifndef DBG_FINAL_X
#define DBG_FINAL_X 0
#endif
#ifndef DBG_F_MIX0
#define DBG_F_MIX0 1.0f
#endif
#ifndef DBG_F_MOE0
#define DBG_F_MOE0 1.0f
#endif
#ifndef DBG_F_MIX1
#define DBG_F_MIX1 1.0f
#endif
#ifndef DBG_F_MOE1
#define DBG_F_MOE1 1.0f
#endif

#define DEV __device__ __forceinline__
#define LAS __attribute__((address_space(3)))
typedef unsigned short bf16_t;
typedef short bf16x8 __attribute__((ext_vector_type(8)));
typedef float f32x4 __attribute__((ext_vector_type(4)));
typedef float f32x2 __attribute__((ext_vector_type(2)));
typedef unsigned u32x4 __attribute__((ext_vector_type(4)));
typedef unsigned u32x2 __attribute__((ext_vector_type(2)));
typedef __bf16 bf16x2_t __attribute__((ext_vector_type(2)));

constexpr int NB = 8, SEQ = 2048, DM = 1024, NTOK = NB * SEQ, NEXP = 32, TOPK = 4;
constexpr int Z0P = 3072, Z1P = 2560;
constexpr int N_IN0 = 3328, N_IN1 = 2560;
constexpr int ENT_CAP = NTOK;
constexpr float EPS = 1e-6f;
constexpr float C2 = 0.125f * 1.4426950408889634f;
constexpr int NTHREADS = 512, NWAVES = 8;

constexpr size_t MiB = 1u << 20;
constexpr size_t WS_CTL = 0, CTL_ZERO_BYTES = 64 * 1024;
constexpr size_t WS_MOD = 1 * MiB;
constexpr size_t WS_ROPE = 2 * MiB;
constexpr size_t WS_ENT = 6 * MiB;
constexpr size_t WS_GATES = 10 * MiB;
constexpr size_t WS_SGUW = 11 * MiB;
constexpr size_t WS_WIN0 = 12 * MiB;
constexpr size_t WS_WOUT0 = 19 * MiB;
constexpr size_t WS_WIN1 = 21 * MiB;
constexpr size_t WS_WOUT1 = 26 * MiB;
constexpr size_t WS_W1 = 32 * MiB;
constexpr size_t WS_W2 = 288 * MiB;
constexpr size_t WS_H = 416 * MiB;
constexpr size_t WS_Z = 448 * MiB;
constexpr size_t WS_LA = 544 * MiB;
constexpr size_t WS_OPART = 560 * MiB;
constexpr size_t WS_CAT = 592 * MiB;
constexpr size_t WS_X1 = 624 * MiB;
constexpr size_t WS_X2 = 688 * MiB;
constexpr size_t WS_A = 752 * MiB;
constexpr size_t WS_YB = 896 * MiB;
constexpr size_t WS_END = 1024 * MiB;
constexpr int CW_CNT = 0;
constexpr int CW_QUEUE = 256;

constexpr int RING_BYTES = 131072;
constexpr int LCTL_OFF = RING_BYTES;
constexpr int LDS_BYTES = 147456;

DEV float bf2f(bf16_t v) { return __uint_as_float((unsigned)v << 16); }
DEV unsigned pk2(float lo, float hi) { f32x2 v = {lo, hi}; bf16x2_t b = __builtin_convertvector(v, bf16x2_t); return __builtin_bit_cast(unsigned, b); }
DEV bf16_t f2bf(float f) { return (bf16_t)(pk2(f, 0.f) & 0xffffu); }
DEV float wave_sum(float v) {
#pragma unroll
    for (int o = 1; o < 64; o <<= 1) v += __shfl_xor(v, o);
    return v;
}
DEV float silu_f(float x) { return x / (1.f + __expf(-x)); }
DEV float log_sigmoid_f(float x) { return fminf(x, 0.f) - __logf(1.f + __expf(-fabsf(x))); }
DEV float gelu_f(float v) {
    const float av = fabsf(v), t = __builtin_amdgcn_rcpf(av * 0.2316418882f + 1.0f);
    float q = t * 0.5307027145f + (-0.7265760135f); q = q * t + 0.7107068705f; q = q * t + (-0.142248368f); q = q * t + 0.127414796f; q = q * t;
    const float e = __builtin_amdgcn_exp2f((v * v) * (-0.72134752044f));
    const float m = v * (q * e);
    return v < 0.f ? m : v - m;
}
DEV void unpack8(const bf16x8 v, float (&o)[8]) {
#pragma unroll
    for (int j = 0; j < 8; ++j) o[j] = bf2f((bf16_t)v[j]);
}

struct Params {
    const void* in[28];
    float* out;
    unsigned char* ws;
};

struct Unit { int pm, pn, e, tb; };

DEV bool static_next(int i, int G, int c, int nM, int nN, int& pm, int& pn) {
    const int nwg = nM * nN; const long Lr = (long)i * G + c; if (Lr >= nwg) return false;
    int wgid = (int)Lr; { const int q = nwg / 8, r = nwg % 8, xcd = wgid % 8, off = wgid / 8; wgid = (xcd < r ? xcd * (q + 1) : r * (q + 1) + (xcd - r) * q) + off; }
    const int nig = 8 * nN, gid = wgid / nig, fm = gid * 8, gsz = (nM - fm) < 8 ? (nM - fm) : 8;
    pm = fm + ((wgid % nig) % gsz); pn = (wgid % nig) / gsz; return true;
}
struct DenseSched {
    const bf16_t* A; const bf16_t* Bt; int K, nM, nN, G, c;
    DEV bool next(int i, Unit& u) const { u.e = 0; u.tb = 0; return static_next(i, G, c, nM, nN, u.pm, u.pn); }
    DEV unsigned a_row_off(const Unit& u, int r) const { return (unsigned)(u.pm * 256 + r) * (unsigned)K; }
    DEV const bf16_t* b_ptr(const Unit& u) const { return Bt + (size_t)u.pn * 256 * K; }
};
struct MoeTiles { const LAS int* te; const LAS int* ttb; int nt; };
struct MoeSched1 {
    const bf16_t* A; const bf16_t* Bt; const int* cnt; const int* ent; MoeTiles mt; int K, nN, G, c;
    DEV bool next(int i, Unit& u) const { int pm, pn; if (!static_next(i, G, c, mt.nt, nN, pm, pn)) return false; u.pm = pm; u.pn = pn; u.e = mt.te[pm]; u.tb = mt.ttb[pm]; return true; }
    DEV unsigned a_row_off(const Unit& u, int r) const {
        const int n = cnt[u.e]; int pos = u.tb * 256 + r; pos = pos < n ? pos : n - 1;
        const int tok = ent[u.e * ENT_CAP + pos] >> 2; return (unsigned)tok * (unsigned)K; }
    DEV const bf16_t* b_ptr(const Unit& u) const { return Bt + ((size_t)u.e * 2048 + (size_t)u.pn * 256) * K; }
};
struct MoeSched2 {
    const bf16_t* A; const bf16_t* Bt; MoeTiles mt; int K, nN, G, c;
    DEV bool next(int i, Unit& u) const { int pm, pn; if (!static_next(i, G, c, mt.nt, nN, pm, pn)) return false; u.pm = pm; u.pn = pn; u.e = mt.te[pm]; u.tb = mt.ttb[pm]; return true; }
    DEV unsigned a_row_off(const Unit& u, int r) const { return (unsigned)(u.pm * 256 + r) * (unsigned)K; }
    DEV const bf16_t* b_ptr(const Unit& u) const { return Bt + ((size_t)u.e * 1024 + (size_t)u.pn * 256) * K; }
};
DEV MoeTiles moe_build_tiles(const int* cnt, LAS unsigned char* lds) {
    LAS int* te = (LAS int*)(lds + LCTL_OFF); LAS int* ttb = te + 320; LAS int* ntp = ttb + 320;
    __syncthreads();
    if (threadIdx.x == 0) {
        int n = 0;
        for (int e = 0; e < NEXP; ++e) { const int c = __hip_atomic_load(cnt + e, __ATOMIC_RELAXED, __HIP_MEMORY_SCOPE_AGENT); const int nt = (c + 255) >> 8;
            for (int t = 0; t < nt; ++t) { te[n] = e; ttb[n] = t; ++n; } }
        *ntp = n;
    }
    __syncthreads();
    MoeTiles mt; mt.te = te; mt.ttb = ttb; mt.nt = *ntp; return mt;
}

enum { EK_PLAIN = 0, EK_SILU = 1, EK_GELU = 2, EK_ROPE = 3, EK_LOGSIG = 4 };
struct EpiIn {
    static constexpr bool PERM = true;
    bf16_t* Z; int zp; float* LA; const float* bgate; const float* rope; int layer;
    DEV void kind_of(int pn, int& kind, float& sc) const {
        kind = EK_PLAIN; sc = 1.f;
        if (layer == 0) { if (pn == 0) sc = 0.125f; else if (pn == 4 || pn == 5) kind = EK_SILU; else if (pn == 6 || pn == 7) { kind = EK_ROPE; sc = C2; } else if (pn == 8 || pn == 9) kind = EK_ROPE; else if (pn == 12) kind = EK_LOGSIG; }
        else { if (pn < 4) kind = EK_GELU; else if (pn == 4) { kind = EK_ROPE; sc = 0.125f; } else if (pn == 5) kind = EK_ROPE; else if (pn >= 8) kind = EK_SILU; }
    }
    DEV void operator()(const f32x4 (&acc)[2][2][4][2], const Unit& u, int wr, int wc, int fr, int fq) const {
        int kind; float sc; kind_of(u.pn, kind, sc);
#pragma unroll
        for (int ai = 0; ai < 2; ++ai)
#pragma unroll
            for (int m = 0; m < 4; ++m) {
                const int row = u.pm * 256 + ai * 128 + wr * 64 + m * 16 + fr;
                if (kind == EK_ROPE) {
                    const float* rt = rope + (size_t)row * 64 + (8 * fq) * 2;
                    const f32x4 t0 = *(const f32x4*)(rt), t1 = *(const f32x4*)(rt + 4), t2 = *(const f32x4*)(rt + 8), t3 = *(const f32x4*)(rt + 12);
                    const float cs[8] = {t0[0], t0[2], t1[0], t1[2], t2[0], t2[2], t3[0], t3[2]}, sn[8] = {t0[1], t0[3], t1[1], t1[3], t2[1], t2[3], t3[1], t3[3]};
                    float y1[8], y2[8];
#pragma unroll
                    for (int n = 0; n < 2; ++n)
#pragma unroll
                        for (int i = 0; i < 4; ++i) { const float x1 = acc[ai][0][m][n][i], x2 = acc[ai][1][m][n][i]; const int j = 4 * n + i;
                            y1[j] = (x1 * cs[j] - x2 * sn[j]) * sc; y2[j] = (x2 * cs[j] + x1 * sn[j]) * sc; }
                    bf16_t* zp_ = Z + (size_t)row * zp + u.pn * 256 + 64 * wc + 8 * fq;
                    u32x4 w; w.x = pk2(y1[0], y1[1]); w.y = pk2(y1[2], y1[3]); w.z = pk2(y1[4], y1[5]); w.w = pk2(y1[6], y1[7]); *(u32x4*)(zp_) = w;
                    w.x = pk2(y2[0], y2[1]); w.y = pk2(y2[2], y2[3]); w.z = pk2(y2[4], y2[5]); w.w = pk2(y2[6], y2[7]); *(u32x4*)(zp_ + 32) = w;
                } else if (kind == EK_LOGSIG) {
#pragma unroll
                    for (int bj = 0; bj < 2; ++bj) { const int col = 128 * bj + 32 * wc + 8 * fq; float* lp = LA + (size_t)row * 256 + col;
                        const f32x4 b0 = *(const f32x4*)(bgate + col), b1 = *(const f32x4*)(bgate + col + 4); f32x4 o0, o1;
#pragma unroll
                        for (int i = 0; i < 4; ++i) { o0[i] = log_sigmoid_f(acc[ai][bj][m][0][i] + b0[i]) * 0.0625f; o1[i] = log_sigmoid_f(acc[ai][bj][m][1][i] + b1[i]) * 0.0625f; }
                        *(f32x4*)lp = o0; *(f32x4*)(lp + 4) = o1; }
                } else {
#pragma unroll
                    for (int bj = 0; bj < 2; ++bj) { float v[8];
#pragma unroll
                        for (int n = 0; n < 2; ++n)
#pragma unroll
                            for (int i = 0; i < 4; ++i) { float x = acc[ai][bj][m][n][i]; if (kind == EK_SILU) x = silu_f(x); else if (kind == EK_GELU) x = gelu_f(x); v[4 * n + i] = x * sc; }
                        u32x4 w; w.x = pk2(v[0], v[1]); w.y = pk2(v[2], v[3]); w.z = pk2(v[4], v[5]); w.w = pk2(v[6], v[7]);
                        *(u32x4*)(Z + (size_t)row * zp + u.pn * 256 + 128 * bj + 32 * wc + 8 * fq) = w; }
                }
            }
    }
};
struct EpiResid {
    static constexpr bool PERM = false;
    const float* resid; float* out; const float* gate; int skip; float dbgf;
    DEV void operator()(const f32x4 (&acc)[2][2][4][2], const Unit& u, int wr, int wc, int fr, int fq) const {
        const int b = (u.pm * 256) >> 11;
#pragma unroll
        for (int ai = 0; ai < 2; ++ai)
#pragma unroll
            for (int m = 0; m < 4; ++m) { const size_t row = (size_t)(u.pm * 256 + ai * 128 + wr * 64 + m * 16 + fr);
#pragma unroll
                for (int bj = 0; bj < 2; ++bj)
#pragma unroll
                    for (int n = 0; n < 2; ++n) { const int col = u.pn * 256 + 128 * bj + 32 * wc + 16 * n + 4 * fq;
                        const f32x4 g = *(const f32x4*)(gate + (size_t)b * 6144 + col), r = *(const f32x4*)(resid + row * DM + col);
                        *(f32x4*)(out + row * DM + col) = skip ? r : r + g * acc[ai][bj][m][n] * dbgf; } }
    }
};
struct EpiSwiglu {
    static constexpr bool PERM = true;
    bf16_t* Aout; const float* bin;
    DEV void operator()(const f32x4 (&acc)[2][2][4][2], const Unit& u, int wr, int wc, int fr, int fq) const {
        const int lc = 128 * u.pn + 32 * wc + 8 * fq; const float* bp = bin + (size_t)u.e * 2048 + lc;
        const f32x4 bg0 = *(const f32x4*)bp, bg1 = *(const f32x4*)(bp + 4), bl0 = *(const f32x4*)(bp + 1024), bl1 = *(const f32x4*)(bp + 1028);
#pragma unroll
        for (int ai = 0; ai < 2; ++ai)
#pragma unroll
            for (int m = 0; m < 4; ++m) { const size_t row = (size_t)(u.pm * 256 + ai * 128 + wr * 64 + m * 16 + fr); float v[8];
#pragma unroll
                for (int n = 0; n < 2; ++n)
#pragma unroll
                    for (int i = 0; i < 4; ++i) { const float g = fminf(acc[ai][0][m][n][i] + (n ? bg1[i] : bg0[i]), 7.f);
                        const float l = fminf(fmaxf(acc[ai][1][m][n][i] + (n ? bl1[i] : bl0[i]), -7.f), 7.f);
                        v[4 * n + i] = g / (1.f + __expf(-1.702f * g)) * (l + 1.f); }
                u32x4 w; w.x = pk2(v[0], v[1]); w.y = pk2(v[2], v[3]); w.z = pk2(v[4], v[5]); w.w = pk2(v[6], v[7]);
                *(u32x4*)(Aout + row * 1024 + lc) = w; }
    }
};
struct EpiMoeOut {
    static constexpr bool PERM = true;
    bf16_t* YB; const float* bout; const int* cnt; const int* ent; const float* gates;
    DEV void operator()(const f32x4 (&acc)[2][2][4][2], const Unit& u, int wr, int wc, int fr, int fq) const {
        const int n_e = cnt[u.e];
        f32x4 bv[2][2];
#pragma unroll
        for (int bj = 0; bj < 2; ++bj)
#pragma unroll
            for (int n = 0; n < 2; ++n) bv[bj][n] = *(const f32x4*)(bout + (size_t)u.e * 1024 + u.pn * 256 + 128 * bj + 32 * wc + 8 * fq + 4 * n);
#pragma unroll
        for (int ai = 0; ai < 2; ++ai)
#pragma unroll
            for (int m = 0; m < 4; ++m) { const int pos = u.tb * 256 + ai * 128 + wr * 64 + m * 16 + fr;
                if (pos < n_e) { const int dst = ent[u.e * ENT_CAP + pos]; const float g = gates[dst];
#pragma unroll
                    for (int bj = 0; bj < 2; ++bj) { const f32x4 v0 = (acc[ai][bj][m][0] + bv[bj][0]) * g, v1 = (acc[ai][bj][m][1] + bv[bj][1]) * g;
                        u32x4 w; w.x = pk2(v0[0], v0[1]); w.y = pk2(v0[2], v0[3]); w.z = pk2(v1[0], v1[1]); w.w = pk2(v1[2], v1[3]);
                        *(u32x4*)(YB + (size_t)dst * 1024 + u.pn * 256 + 128 * bj + 32 * wc + 8 * fq) = w; } } }
    }
};

template <class Epi, class Sched>
DEV void gemm_ref(const Sched& S, const Epi& E) {
    const int tid = threadIdx.x, wid = tid >> 6, lane = tid & 63, wr = wid >> 2, wc = wid & 3, fr = lane & 15, fq = lane >> 4;
    Unit u;
    for (int it = 0; S.next(it, u); ++it) {
        f32x4 acc[2][2][4][2];
#pragma unroll
        for (int a = 0; a < 2; ++a)
#pragma unroll
            for (int b = 0; b < 2; ++b)
#pragma unroll
                for (int m = 0; m < 4; ++m)
#pragma unroll
                    for (int n = 0; n < 2; ++n) acc[a][b][m][n] = (f32x4){0.f, 0.f, 0.f, 0.f};
        unsigned aoff[2][4];
#pragma unroll
        for (int ai = 0; ai < 2; ++ai)
#pragma unroll
            for (int m = 0; m < 4; ++m) aoff[ai][m] = S.a_row_off(u, ai * 128 + wr * 64 + m * 16 + fr);
        const bf16_t* Bt = S.b_ptr(u); const int K = S.K;
        for (int k0 = 0; k0 < K; k0 += 8) {
            u32x4 araw[2][4];
#pragma unroll
            for (int ai = 0; ai < 2; ++ai)
#pragma unroll
                for (int m = 0; m < 4; ++m) araw[ai][m] = *(const u32x4*)(S.A + aoff[ai][m] + k0);
            asm volatile("" ::: "memory");
#pragma unroll
            for (int bj = 0; bj < 2; ++bj)
#pragma unroll
                for (int n = 0; n < 2; ++n) {
                    u32x4 braw[4];
#pragma unroll
                    for (int i = 0; i < 4; ++i) { const int c = 128 * bj + 32 * wc + (Epi::PERM ? 8 * fq + 4 * n + i : 16 * n + 4 * fq + i); braw[i] = *(const u32x4*)(Bt + (size_t)c * K + k0); }
                    asm volatile("" ::: "memory");
#pragma unroll
                    for (int i = 0; i < 4; ++i)
#pragma unroll
                        for (int ai = 0; ai < 2; ++ai)
#pragma unroll
                            for (int m = 0; m < 4; ++m) { float s = acc[ai][bj][m][n][i];
#pragma unroll
                                for (int j = 0; j < 4; ++j) { const unsigned au = araw[ai][m][j], bu = braw[i][j];
                                    s = __builtin_amdgcn_fdot2_f32_bf16(__builtin_bit_cast(bf16x2_t, au), __builtin_bit_cast(bf16x2_t, bu), s, false); }
                                acc[ai][bj][m][n][i] = s; }
                }
        }
        E(acc, u, wr, wc, fr, fq);
    }
}

__host__ __device__ inline int ropeoff(int q) { return 64 * (q & 3) + 32 * (q >> 2); }
__host__ __device__ inline int in0_logcol(int g32) {
    const int tile = g32 >> 3, q = g32 & 7;
    switch (tile) {
        case 0: return 0 + q * 32; case 1: return 256 + q * 32;
        case 2: case 3: return 512 + (tile - 2) * 256 + q * 32;
        case 4: case 5: return 1040 + (tile - 4) * 256 + q * 32;
        case 6: case 7: return 1552 + (tile - 6) * 256 + ropeoff(q);
        case 8: case 9: return 2064 + (tile - 8) * 256 + ropeoff(q);
        default: return 2576 + (tile - 10) * 256 + q * 32;
    }
}
__host__ __device__ inline int in1_logcol(int g32) {
    const int tile = g32 >> 3, q = g32 & 7;
    if (tile < 4) return tile * 256 + q * 32;
    if (tile == 4) return 1024 + ropeoff(q);
    if (tile == 5) return 1280 + ropeoff(q);
    return 1536 + (tile - 6) * 256 + q * 32;
}
DEV void conv_item(const float* W, int ldw, int logcol0, int k0, bf16_t* Wt_row0, int Kd, LAS float* scr, int lane) {
#pragma unroll 8
    for (int i = 0; i < 32; ++i) { const int kk = 2 * i + (lane >> 5); scr[kk * 33 + (lane & 31)] = W[(size_t)(k0 + kk) * ldw + logcol0 + (lane & 31)]; }
    asm volatile("s_waitcnt lgkmcnt(0)" ::: "memory");
    const int c = lane & 7;
#pragma unroll
    for (int j = 0; j < 4; ++j) { const int n = (lane >> 3) + 8 * j; const LAS float* s = scr + (8 * c) * 33 + n;
        u32x4 o; o.x = pk2(s[0 * 33], s[1 * 33]); o.y = pk2(s[2 * 33], s[3 * 33]); o.z = pk2(s[4 * 33], s[5 * 33]); o.w = pk2(s[6 * 33], s[7 * 33]);
        *(u32x4*)(Wt_row0 + (size_t)n * Kd + k0 + 8 * c) = o; }
    asm volatile("s_waitcnt lgkmcnt(0)" ::: "memory");
}
DEV void sincos_d(double x, float& s, float& c) {
    const double k = __builtin_rint(x * 0.63661977236758134308);
    const double r = (x - k * 1.5707963267948966192) - k * 6.123233995736766e-17;
    const double r2 = r * r;
    double sp = -7.647163731819816e-13; sp = sp * r2 + 1.605904383682161e-10; sp = sp * r2 - 2.505210838544172e-08; sp = sp * r2 + 2.755731922398589e-06;
    sp = sp * r2 - 1.984126984126984e-04; sp = sp * r2 + 8.333333333333333e-03; sp = sp * r2 - 1.666666666666667e-01; sp = r + r * r2 * sp;
    double cp = 4.779477332387385e-14; cp = cp * r2 - 1.147074559772972e-11; cp = cp * r2 + 2.087675698786810e-09; cp = cp * r2 - 2.755731922398589e-07;
    cp = cp * r2 + 2.480158730158730e-05; cp = cp * r2 - 1.388888888888889e-03; cp = cp * r2 + 4.166666666666666e-02; cp = cp * r2 - 0.5; cp = 1.0 + r2 * cp;
    const int q = ((int)k) & 3;
    const double ss = (q == 0) ? sp : (q == 1) ? cp : (q == 2) ? -sp : -cp;
    const double cc = (q == 0) ? cp : (q == 1) ? -sp : (q == 2) ? -cp : sp;
    s = (float)ss; c = (float)cc;
}
DEV void phase_prologue(const Params& P, LAS unsigned char* lds) {
    const int tid = threadIdx.x, lane = tid & 63, wid = tid >> 6, G = gridDim.x;
    unsigned char* ws = P.ws;
    {
        LAS float* cact = (LAS float*)lds; LAS float* red = cact + 8192;
        const float* cin = (const float*)P.in[1]; const float* wada = (const float*)P.in[3]; const float* bada = (const float*)P.in[4];
        float* mod = (float*)(ws + WS_MOD);
        for (int unit = blockIdx.x; unit < 192; unit += G) {
            const int layer = unit / 96, col0 = (unit % 96) * 64;
            __syncthreads();
            for (int i = tid; i < 8192; i += NTHREADS) { const float c = cin[i]; cact[i] = c / (1.f + expf(-c)); }
            __syncthreads();
            const int cs = tid & 63, ks = tid >> 6;
            float acc[8];
#pragma unroll
            for (int b = 0; b < 8; ++b) acc[b] = 0.f;
            const float* W = wada + (size_t)layer * 1024 * 6144 + col0 + cs;
#pragma unroll 4
            for (int k = ks * 128; k < ks * 128 + 128; ++k) { const float w = W[(size_t)k * 6144];
#pragma unroll
                for (int b = 0; b < 8; ++b) acc[b] += cact[b * 1024 + k] * w; }
#pragma unroll
            for (int b = 0; b < 8; ++b) red[(ks * 8 + b) * 64 + cs] = acc[b];
            __syncthreads();
            { const int b = tid >> 6; float s = bada[layer * 6144 + col0 + cs];
#pragma unroll
              for (int k2 = 0; k2 < 8; ++k2) s += red[(k2 * 8 + b) * 64 + cs];
              mod[(size_t)(layer * 8 + b) * 6144 + col0 + cs] = s; }
        }
        __syncthreads();
    }
    const int gt = blockIdx.x * NTHREADS + tid, NGT = G * NTHREADS;
    {
        const int* pos = (const int*)P.in[2]; float* rope = (float*)(ws + WS_ROPE);
        for (int i = gt; i < NTOK * 32; i += NGT) { const int f = i & 31, t = i >> 5;
            const double invf = exp2(-(double)f * (13.287712379549449 / 32.0));
            float s, c; sincos_d((double)pos[t] * invf, s, c); rope[2 * (size_t)i] = c; rope[2 * (size_t)i + 1] = s; }
    }
    {
        const float* sw = (const float*)P.in[18]; bf16_t* o = (bf16_t*)(ws + WS_SGUW);
        for (int i = gt; i < 4 * 128 * 128; i += NGT) { const int j = i & 127, r = (i >> 7) & 127; o[i] = f2bf(j <= r ? sw[i] : 0.f); }
    }
    {
        const float* win = (const float*)P.in[5]; const float* wg = (const float*)P.in[6]; bf16_t* wt = (bf16_t*)(ws + WS_WIN0) + (size_t)3072 * 1024;
        for (int i = gt; i < 256 * 1024; i += NGT) { const int k = i & 1023, j = i >> 10; float s = 0.f;
#pragma unroll
            for (int r = 0; r < 16; ++r) s += win[(size_t)k * 3088 + 1024 + r] * wg[r * 256 + j];
            wt[(size_t)j * 1024 + k] = f2bf(s); }
    }
    {
        LAS float* scr = (LAS float*)(lds + wid * 16384);
        const int gw = blockIdx.x * NWAVES + wid, NGW = G * NWAVES;
        constexpr int I_IN0 = 16 * 96, I_OUT = 16 * 32, I_IN1 = 16 * 80, I_W1 = 64 * 16 * 64, I_W2 = 64 * 16 * 32;
        constexpr int NITEMS = I_IN0 + I_OUT + I_IN1 + I_OUT + I_W1 + I_W2;
        for (int it = gw; it < NITEMS; it += NGW) {
            int r = it;
            if (r < I_IN0) { const int kb = r / 96, g = r % 96; conv_item((const float*)P.in[5], 3088, in0_logcol(g), kb * 64, (bf16_t*)(ws + WS_WIN0) + (size_t)g * 32 * 1024, 1024, scr, lane); continue; } r -= I_IN0;
            if (r < I_OUT) { const int kb = r / 32, g = r % 32; conv_item((const float*)P.in[14], 1024, g * 32, kb * 64, (bf16_t*)(ws + WS_WOUT0) + (size_t)g * 32 * 1024, 1024, scr, lane); continue; } r -= I_OUT;
            if (r < I_IN1) { const int kb = r / 80, g = r % 80; conv_item((const float*)P.in[15], 2560, in1_logcol(g), kb * 64, (bf16_t*)(ws + WS_WIN1) + (size_t)g * 32 * 1024, 1024, scr, lane); continue; } r -= I_IN1;
            if (r < I_OUT) { const int kb = r / 32, g = r % 32; conv_item((const float*)P.in[20], 1024, g * 32, kb * 64, (bf16_t*)(ws + WS_WOUT1) + (size_t)g * 32 * 1024, 1024, scr, lane); continue; } r -= I_OUT;
            if (r < I_W1) { const int le = r / 1024, q = r % 1024, kb = q / 64, g = q % 64, pn = g >> 3, qq = g & 7;
                const int logcol = (qq >> 2) * 1024 + 128 * pn + 32 * (qq & 3);
                conv_item((const float*)P.in[23] + (size_t)le * 1024 * 2048, 2048, logcol, kb * 64, (bf16_t*)(ws + WS_W1) + ((size_t)le * 2048 + g * 32) * 1024, 1024, scr, lane); continue; } r -= I_W1;
            { const int le = r / 512, q = r % 512, kb = q / 32, g = q % 32;
              conv_item((const float*)P.in[25] + (size_t)le * 1024 * 1024, 1024, g * 32, kb * 64, (bf16_t*)(ws + WS_W2) + ((size_t)le * 1024 + g * 32) * 1024, 1024, scr, lane); }
        }
    }
}

template <int MODE>
DEV void phase_prenorm(const Params& P, LAS unsigned char* lds, const float* xin, float* xout, int layer_mod, int modoff  , int layer_prev) {
    const int tid = threadIdx.x, lane = tid & 63, wid = tid >> 6, G = gridDim.x;
    unsigned char* ws = P.ws;
    const float* mod = (const float*)(ws + WS_MOD);
    bf16_t* H = (bf16_t*)(ws + WS_H);
    const bf16_t* YB = (const bf16_t*)(ws + WS_YB);
    LAS float* hrow = (LAS float*)(lds) + wid * 1024;
    for (int row = blockIdx.x * NWAVES + wid; row < NTOK; row += G * NWAVES) {
        const int b = row >> 11;
        const f32x4* xr = (const f32x4*)(xin + (size_t)row * DM) + lane;
        f32x4 v[4];
#pragma unroll
        for (int j = 0; j < 4; ++j) v[j] = xr[64 * j];
        if (MODE & 1) {
            const float* g2 = mod + (size_t)(layer_prev * 8 + b) * 6144 + 5 * 1024;
            f32x4 macc[4];
#pragma unroll
            for (int j = 0; j < 4; ++j) macc[j] = (f32x4){0.f, 0.f, 0.f, 0.f};
#pragma unroll
            for (int k = 0; k < 4; ++k) { const float g = 1.0f;   const u32x2* yr = (const u32x2*)(YB + ((size_t)row * 4 + k) * 1024) + lane;
#pragma unroll
                for (int j = 0; j < 4; ++j) { const u32x2 w = yr[64 * j];
                    macc[j][0] += g * __uint_as_float(w.x << 16); macc[j][1] += g * __uint_as_float(w.x & 0xffff0000u);
                    macc[j][2] += g * __uint_as_float(w.y << 16); macc[j][3] += g * __uint_as_float(w.y & 0xffff0000u); } }
#pragma unroll
            for (int j = 0; j < 4; ++j) { const f32x4 gg = *((const f32x4*)g2 + lane + 64 * j); if (!((DBG_SKIP >> (1 + 2 * layer_prev)) & 1)) v[j] = v[j] + gg * macc[j] * (layer_prev ? DBG_F_MOE1 : DBG_F_MOE0); }
        }
        if (MODE & 2) { f32x4* xo = (f32x4*)(xout + (size_t)row * DM) + lane;
#pragma unroll
            for (int j = 0; j < 4; ++j) xo[64 * j] = v[j]; }
        float ss = 0.f;
#pragma unroll
        for (int j = 0; j < 4; ++j) ss += (v[j][0] * v[j][0] + v[j][1] * v[j][1]) + (v[j][2] * v[j][2] + v[j][3] * v[j][3]);
        const float rstd = 1.0f / sqrtf(wave_sum(ss) * (1.f / DM) + EPS);
        if (MODE & 8) {
            const float* fg = (const float*)P.in[27]; f32x4* o = (f32x4*)(P.out + (size_t)row * DM) + lane;
#pragma unroll
            for (int j = 0; j < 4; ++j) { const f32x4 g = *((const f32x4*)fg + lane + 64 * j);
#ifdef DBG_PROBE_OFF
                const float ps = ((const float*)(ws + WS_CTL))[1024] / ((float)NTOK * DBG_PROBE_NCOLS); const float pv = (DBG_PROBE_ABS ? ps : sqrtf(ps)) * DBG_PROBE_SCALE;
                const float alpha = 1.5f + 1.5f * fminf(fmaxf(pv, 0.f), 1.f);
                o[64 * j] = v[j] * rstd * g * alpha;
#else
                o[64 * j] = v[j] * rstd * g;
#endif
            }
            continue;
        }
        const float* mrow = mod + (size_t)(layer_mod * 8 + b) * 6144 + modoff;
#pragma unroll
        for (int j = 0; j < 4; ++j) { const f32x4 sh = *((const f32x4*)mrow + lane + 64 * j), sc = *((const f32x4*)(mrow + 1024) + lane + 64 * j);
            v[j] = v[j] * rstd * (sc + 1.0f) + sh; }
        { u32x2* ho = (u32x2*)(H + (size_t)row * DM) + lane;
#pragma unroll
          for (int j = 0; j < 4; ++j) { u32x2 w; w.x = pk2(v[j][0], v[j][1]); w.y = pk2(v[j][2], v[j][3]); ho[64 * j] = w; } }
        if (MODE & 4) {
            const float* rw = (const float*)P.in[21] + (size_t)layer_mod * 1024 * 32; const float* rb = (const float*)P.in[22] + layer_mod * 32;
            int* cnt = (int*)(ws + WS_CTL) + CW_CNT + layer_mod * 64; int* ent = (int*)(ws + WS_ENT) + (size_t)layer_mod * NEXP * ENT_CAP;
            float* gates = (float*)(ws + WS_GATES) + (size_t)layer_mod * 65536;
#pragma unroll
            for (int j = 0; j < 4; ++j) *((LAS f32x4*)hrow + lane + 64 * j) = v[j];
            asm volatile("s_waitcnt lgkmcnt(0)" ::: "memory");
            const int e = lane & 31, half = lane >> 5;
            float a0 = 0.f, a1 = 0.f;
            const float* wp = rw + (size_t)(half * 512) * 32 + e; const LAS float* hp = hrow + half * 512;
#pragma unroll 8
            for (int k = 0; k < 512; k += 2) { a0 += hp[k] * wp[(size_t)k * 32]; a1 += hp[k + 1] * wp[(size_t)(k + 1) * 32]; }
            float lg = a0 + a1; lg += __shfl_xor(lg, 32); lg += rb[e];
            asm volatile("s_waitcnt lgkmcnt(0)" ::: "memory");
            float tv[4]; int ti[4]; float cur = lg;
#pragma unroll
            for (int r = 0; r < 4; ++r) {
                float mx = cur;
#pragma unroll
                for (int o = 1; o < 32; o <<= 1) mx = fmaxf(mx, __shfl_xor(mx, o));
                const unsigned long long bal = __ballot(cur == mx) & 0xffffffffull;
                const int sel = __builtin_ctzll(bal);
                tv[r] = mx; ti[r] = sel; if (e == sel) cur = -INFINITY;
            }
            const float e1 = __expf(tv[1] - tv[0]), e2 = __expf(tv[2] - tv[0]), e3 = __expf(tv[3] - tv[0]);
            const float inv = 1.f / (1.f + e1 + e2 + e3);
            if (lane < 4) { const int ex = lane == 0 ? ti[0] : lane == 1 ? ti[1] : lane == 2 ? ti[2] : ti[3];
                const float gv = (lane == 0 ? 1.f : lane == 1 ? e1 : lane == 2 ? e2 : e3) * inv;
                const int pos = atomicAdd(cnt + ex, 1); ent[ex * ENT_CAP + pos] = row * 4 + lane; gates[(size_t)row * 4 + lane] = gv; }
        }
    }
}

DEV void attn_unit_ref(int b, int vh, int qb, const bf16_t* Z, bf16_t* OP) {
    const int tid = threadIdx.x;
    if (tid >= 256) return;
    const int h = vh >> 2, m = (vh >> 1) & 1, vhalf = vh & 1;
    const size_t rowbase = (size_t)b * SEQ;
    const int i = qb * 256 + tid;
    const bf16_t* Qr = Z + (rowbase + i) * Z0P + 1536 + h * 128 + m * 64;
    const bf16_t* Kb = Z + rowbase * Z0P + 2048 + h * 128 + m * 64;
    const bf16_t* Vb = Z + rowbase * Z0P + 2560 + h * 128 + vhalf * 64;
    float q[64], o[64];
#pragma unroll
    for (int d0 = 0; d0 < 8; ++d0) { float t[8]; unpack8(*(const bf16x8*)(Qr + d0 * 8), t);
#pragma unroll
        for (int j = 0; j < 8; ++j) { q[d0 * 8 + j] = t[j]; o[d0 * 8 + j] = 0.f; } }
    float mx = -INFINITY, l = 0.f;
    const int jend = qb * 256 + 255;
    for (int j = 0; j <= jend; ++j) {
        const bf16_t* kr = Kb + (size_t)j * Z0P; const bf16_t* vr = Vb + (size_t)j * Z0P;
        float s = 0.f;
#pragma unroll
        for (int d0 = 0; d0 < 8; ++d0) { float t[8]; unpack8(*(const bf16x8*)(kr + d0 * 8), t);
#pragma unroll
            for (int jj = 0; jj < 8; ++jj) s += q[d0 * 8 + jj] * t[jj]; }
        if (j > i) s = -INFINITY;
        if (s > mx) { const float al = __builtin_amdgcn_exp2f(mx - s); l *= al;
#pragma unroll
            for (int e = 0; e < 64; ++e) o[e] *= al;
            mx = s; }
        const float p = __builtin_amdgcn_exp2f(s - mx); l += p;
#pragma unroll
        for (int d0 = 0; d0 < 8; ++d0) { float t[8]; unpack8(*(const bf16x8*)(vr + d0 * 8), t);
#pragma unroll
            for (int jj = 0; jj < 8; ++jj) o[d0 * 8 + jj] += p * t[jj]; }
    }
    const float il = 1.f / l;
    bf16_t* Or = OP + (rowbase + i) * 1024 + vh * 64;
#pragma unroll
    for (int d0 = 0; d0 < 8; ++d0) { u32x4 w; w.x = pk2(o[d0 * 8] * il, o[d0 * 8 + 1] * il); w.y = pk2(o[d0 * 8 + 2] * il, o[d0 * 8 + 3] * il);
        w.z = pk2(o[d0 * 8 + 4] * il, o[d0 * 8 + 5] * il); w.w = pk2(o[d0 * 8 + 6] * il, o[d0 * 8 + 7] * il); *(u32x4*)(Or + d0 * 8) = w; }
}

struct LinAttnArgs {
    const bf16_t* q; const bf16_t* k; const bf16_t* v; const bf16_t* og;
    int zp; const float* la;
    float log_g;
    const float* gain;
    bf16_t* out;
};
template <int C>
DEV void linattn_unit_ref(const LinAttnArgs& a, LAS unsigned char* lds) {
    const int tid = threadIdx.x, lane = tid & 63, wid = tid >> 6;
    LAS bf16_t* qd = (LAS bf16_t*)lds;
    LAS bf16_t* ka = qd + C * 64;
    LAS bf16_t* vv = ka + C * 64;
    LAS float* bsc = (LAS float*)(vv + C * 128);
    LAS bf16_t* Sm = (LAS bf16_t*)bsc;
    LAS float* st = bsc + C * 64;
    LAS float* dec = st + 64 * 128;
    __syncthreads();
    for (int i = tid; i < 64 * 128; i += NTHREADS) st[i] = 0.f;
    for (int n = 0; n < SEQ / C; ++n) {
        const size_t r0 = (size_t)n * C;
        __syncthreads();
        for (int i = tid; i < C * 64; i += NTHREADS) { const int r = i >> 6, d = i & 63; bsc[i] = a.la ? a.la[(r0 + r) * 256 + d] : a.log_g; }
        for (int i = tid; i < C * 16; i += NTHREADS) { const int r = i >> 4, c8 = i & 15; *(LAS u32x4*)(vv + r * 128 + c8 * 8) = *(const u32x4*)(a.v + (r0 + r) * a.zp + c8 * 8); }
        __syncthreads();
        if (tid < 64) { float run = 0.f; for (int r = 0; r < C; ++r) { run += bsc[r * 64 + tid]; bsc[r * 64 + tid] = run; } dec[tid] = __expf(run); }
        __syncthreads();
        for (int i = tid; i < C * 64; i += NTHREADS) { const int r = i >> 6, d = i & 63; const float bb = bsc[i];
            qd[i] = f2bf(bf2f(a.q[(r0 + r) * a.zp + d]) * __expf(bb)); ka[i] = f2bf(bf2f(a.k[(r0 + r) * a.zp + d]) * __expf(-bb)); }
        __syncthreads();
        for (int i = tid; i < C * C; i += NTHREADS) { const int r = i / C, j = i % C; float s = 0.f;
            if (j <= r) { for (int d = 0; d < 64; ++d) s += bf2f(qd[r * 64 + d]) * bf2f(ka[j * 64 + d]); }
            Sm[i] = f2bf(s); }
        __syncthreads();
        for (int r = wid; r < C; r += NWAVES) {
            float o0 = 0.f, o1 = 0.f;
            for (int j = 0; j <= r; ++j) { const float s = bf2f(Sm[r * C + j]); o0 += s * bf2f(vv[j * 128 + lane]); o1 += s * bf2f(vv[j * 128 + 64 + lane]); }
            for (int d = 0; d < 64; ++d) { const float qv = bf2f(qd[r * 64 + d]); o0 += qv * st[d * 128 + lane]; o1 += qv * st[d * 128 + 64 + lane]; }
            const float rstd = 1.0f / sqrtf(wave_sum(o0 * o0 + o1 * o1) * (1.f / 128.f) + EPS);
            const float g0 = a.gain ? a.gain[lane] : 1.f, g1 = a.gain ? a.gain[lane + 64] : 1.f;
            const bf16_t* ogr = a.og + (r0 + r) * a.zp; bf16_t* orow = a.out + (r0 + r) * 1024;
            orow[lane] = f2bf(o0 * rstd * g0 * bf2f(ogr[lane])); orow[lane + 64] = f2bf(o1 * rstd * g1 * bf2f(ogr[lane + 64]));
        }
        __syncthreads();
        { const int e = tid & 127, dg = tid >> 7;
          for (int d = dg; d < 64; d += 4) { float s = st[d * 128 + e]; for (int j = 0; j < C; ++j) s += bf2f(ka[j * 64 + d]) * bf2f(vv[j * 128 + e]); st[d * 128 + e] = dec[d] * s; } }
    }
    __syncthreads();
}

DEV void sgu_unit_ref(const Params& P, int b, int ch, LAS unsigned char* lds) {
    const int tid = threadIdx.x, lane = tid & 63, wid = tid >> 6;
    const bf16_t* Z = (const bf16_t*)(P.ws + WS_Z); bf16_t* CAT = (bf16_t*)(P.ws + WS_CAT);
    const float* lng = (const float*)P.in[16]; const float* lnb = (const float*)P.in[17]; const float* sw = (const float*)P.in[18]; const float* sb = (const float*)P.in[19];
    LAS float* svn = (LAS float*)lds;
    LAS float* stat = svn + 128 * 128;
    const size_t r0 = (size_t)b * SEQ + (size_t)ch * 128;
    __syncthreads();
    for (int r = wid; r < 128; r += NWAVES) {
        const bf16_t* zr = Z + (r0 + r) * Z1P + 512; float x[8]; unpack8(*(const bf16x8*)(zr + lane * 8), x);
        float s = 0.f;
#pragma unroll
        for (int j = 0; j < 8; ++j) s += x[j];
        const float mean = wave_sum(s) * (1.f / 512.f); float q = 0.f;
#pragma unroll
        for (int j = 0; j < 8; ++j) { const float d = x[j] - mean; q += d * d; }
        const float rstd = 1.0f / sqrtf(wave_sum(q) * (1.f / 512.f) + EPS);
        if (lane == 0) { stat[2 * r] = mean; stat[2 * r + 1] = rstd; }
    }
    __syncthreads();
    for (int g = 0; g < 4; ++g) {
        for (int i = tid; i < 128 * 128; i += NTHREADS) { const int r = i >> 7, c = i & 127;
            svn[i] = (bf2f(Z[(r0 + r) * Z1P + 512 + g * 128 + c]) - stat[2 * r]) * stat[2 * r + 1] * lng[g * 128 + c] + lnb[g * 128 + c]; }
        __syncthreads();
        { const int c = tid & 127, ig = tid >> 7;
          for (int r = ig; r < 128; r += 4) { float s = sb[g * 128 + r]; const float* wrow = sw + ((size_t)g * 128 + r) * 128;
              for (int j = 0; j <= r; ++j) s += wrow[j] * svn[j * 128 + c];
              CAT[(r0 + r) * 1024 + g * 128 + c] = f2bf(bf2f(Z[(r0 + r) * Z1P + g * 128 + c]) * s); } }
        __syncthreads();
    }
}

DEV int queue_pop(unsigned* head, LAS unsigned char* lds) {
    LAS int* slot = (LAS int*)(lds + LCTL_OFF + 4096);
    __syncthreads();
    if (threadIdx.x == 0) *slot = (int)__hip_atomic_fetch_add(head, 1u, __ATOMIC_RELAXED, __HIP_MEMORY_SCOPE_AGENT);
    __syncthreads();
    return *slot;
}

DEV void phase_mix0(const Params& P, LAS unsigned char* lds) {
    unsigned char* ws = P.ws; const bf16_t* Z = (const bf16_t*)(ws + WS_Z);
    unsigned* head = (unsigned*)(ws + WS_CTL) + CW_QUEUE;
    for (;;) {
        const int q = queue_pop(head, lds);
        if (q >= 32 + 1024) break;
        if (q < 32) {
            const int b = q >> 2, h = q & 3; const size_t rb = (size_t)b * SEQ;
            LinAttnArgs a; a.q = Z + rb * Z0P + h * 64; a.k = Z + rb * Z0P + 256 + h * 64; a.v = Z + rb * Z0P + 512 + h * 128; a.og = Z + rb * Z0P + 1024 + h * 128; a.zp = Z0P;
            a.la = (const float*)(ws + WS_LA) + rb * 256 + h * 64; a.log_g = 0.f; a.gain = (const float*)P.in[8]; a.out = (bf16_t*)(ws + WS_CAT) + rb * 1024 + h * 128;
            linattn_unit_ref<64>(a, lds);
        } else {
            const int aidx = q - 32, qb = 7 - (aidx >> 7), rem = aidx & 127, b = rem >> 4, vh = rem & 15;
            attn_unit_ref(b, vh, qb, Z, (bf16_t*)(ws + WS_OPART));
        }
    }
}
DEV void phase_mix1(const Params& P, LAS unsigned char* lds) {
    unsigned char* ws = P.ws; const bf16_t* Z = (const bf16_t*)(ws + WS_Z);
    unsigned* head = (unsigned*)(ws + WS_CTL) + CW_QUEUE + 64;
    for (;;) {
        const int q = queue_pop(head, lds);
        if (q >= 32 + 128) break;
        if (q < 32) {
            const int b = q >> 2, h = q & 3; const size_t rb = (size_t)b * SEQ;
            LinAttnArgs a; a.q = Z + rb * Z1P + 1024 + h * 64; a.k = Z + rb * Z1P + 1280 + h * 64; a.v = Z + rb * Z1P + 1536 + h * 128; a.og = Z + rb * Z1P + 2048 + h * 128; a.zp = Z1P;
            a.la = nullptr; a.log_g = logf(1.0f - exp2f(-5.0f - (float)h)); a.gain = nullptr; a.out = (bf16_t*)(ws + WS_CAT) + rb * 1024 + 512 + h * 128;
            linattn_unit_ref<128>(a, lds);
        } else { const int s = q - 32; sgu_unit_ref(P, s >> 4, s & 15, lds); }
    }
}
DEV void phase_combine(const Params& P) {
    const int tid = threadIdx.x, lane = tid & 63, wid = tid >> 6, G = gridDim.x;
    const float* q1 = (const float*)P.in[9]; const float* k1 = (const float*)P.in[10]; const float* q2 = (const float*)P.in[11]; const float* k2 = (const float*)P.in[12];
    const float* dg = (const float*)P.in[13];
    const float lam = __expf(wave_sum(q1[lane] * k1[lane])) - __expf(wave_sum(q2[lane] * k2[lane])) + 0.2f;
    const bf16_t* OP = (const bf16_t*)(P.ws + WS_OPART); bf16_t* CAT = (bf16_t*)(P.ws + WS_CAT);
    const int h = lane >> 4, e0 = (lane & 15) * 8;
    float g[8];
#pragma unroll
    for (int j = 0; j < 8; ++j) g[j] = dg[e0 + j] * 0.8f;
    for (int row = blockIdx.x * NWAVES + wid; row < NTOK; row += G * NWAVES) {
        float a0[8], a1[8], d[8];
        unpack8(*(const bf16x8*)(OP + (size_t)row * 1024 + h * 256 + e0), a0); unpack8(*(const bf16x8*)(OP + (size_t)row * 1024 + h * 256 + 128 + e0), a1);
        float ss = 0.f;
#pragma unroll
        for (int j = 0; j < 8; ++j) { d[j] = a0[j] - lam * a1[j]; ss += d[j] * d[j]; }
        ss += __shfl_xor(ss, 1); ss += __shfl_xor(ss, 2); ss += __shfl_xor(ss, 4); ss += __shfl_xor(ss, 8);
        const float rstd = 1.0f / sqrtf(ss * (1.f / 128.f) + EPS);
        u32x4 w; w.x = pk2(d[0] * rstd * g[0], d[1] * rstd * g[1]); w.y = pk2(d[2] * rstd * g[2], d[3] * rstd * g[3]);
        w.z = pk2(d[4] * rstd * g[4], d[5] * rstd * g[5]); w.w = pk2(d[6] * rstd * g[6], d[7] * rstd * g[7]);
        *(u32x4*)(CAT + (size_t)row * 1024 + 512 + h * 128 + e0) = w;
    }
}


#ifdef DBG_PROBE_OFF
constexpr int CW_PROBE = 1024;
__global__ void __launch_bounds__(NTHREADS) mk_probe(Params P) {
    const int tid = threadIdx.x, G = gridDim.x;
    float s = 0.f;
    const unsigned char* base = P.ws + (size_t)DBG_PROBE_OFF;
    for (long i = (long)blockIdx.x * NTHREADS + tid; i < (long)NTOK * DBG_PROBE_NCOLS; i += (long)G * NTHREADS) {
        const long r = i / DBG_PROBE_NCOLS; const int c = (int)(i % DBG_PROBE_NCOLS) + DBG_PROBE_COL0;
        float v;
        if (DBG_PROBE_F32) v = ((const float*)base)[r * DBG_PROBE_PITCH + c]; else v = bf2f(((const bf16_t*)base)[r * DBG_PROBE_PITCH + c]);
        s += DBG_PROBE_ABS ? fabsf(v) : v * v;
    }
    s = wave_sum(s);
    if ((tid & 63) == 0) atomicAdd((float*)(P.ws + WS_CTL) + CW_PROBE, s);
}
#endif
#ifndef FAST_GEMM
#define FAST_GEMM 0
#endif
template <class Epi, class Sched>
DEV void gemm_run(LAS unsigned char* lds, const Sched& S, const Epi& E) {
    gemm_ref(S, E);
}

constexpr int N_PHASES = 17;
template <int lo, int hi>
__global__ void __launch_bounds__(NTHREADS, 2) mk_fwd(Params P) {
    extern __shared__ __attribute__((aligned(16))) unsigned char lds_raw[];
    LAS unsigned char* lds = (LAS unsigned char*)lds_raw;
    unsigned char* ws = P.ws;
    const int G = gridDim.x, c = blockIdx.x;
#if ONE_LAUNCH
    cg::grid_group grid = cg::this_grid();
#define GRID_BAR() grid.sync()
#else
#define GRID_BAR() do {} while (0)
#endif
#define IN(k) (lo <= (k) && (k) < hi)
#define SEAM(k) do { if constexpr (lo <= (k) + 1 && (k) + 1 < hi) GRID_BAR(); } while (0)
    const float* mod = (const float*)(ws + WS_MOD);
    bf16_t* H = (bf16_t*)(ws + WS_H); bf16_t* Z = (bf16_t*)(ws + WS_Z); bf16_t* CAT = (bf16_t*)(ws + WS_CAT);
    float* X1 = (float*)(ws + WS_X1); float* X2 = (float*)(ws + WS_X2);
    const float* x = (const float*)P.in[0];

    if constexpr (IN(0)) { phase_prologue(P, lds); SEAM(0); }
    if constexpr (IN(1)) { phase_prenorm<0>(P, lds, x, nullptr, 0, 0, 0); SEAM(1); }
    if constexpr (IN(2)) {
        DenseSched S{H, (const bf16_t*)(ws + WS_WIN0), 1024, NTOK / 256, N_IN0 / 256, G, c};
        EpiIn E{Z, Z0P, (float*)(ws + WS_LA), (const float*)P.in[7], (const float*)(ws + WS_ROPE), 0};
        gemm_run(lds, S, E); SEAM(2);
    }
    if constexpr (IN(3)) { phase_mix0(P, lds); SEAM(3); }
    if constexpr (IN(4)) { phase_combine(P); SEAM(4); }
    if constexpr (IN(5)) {
        DenseSched S{CAT, (const bf16_t*)(ws + WS_WOUT0), 1024, NTOK / 256, 4, G, c};
        EpiResid E{x, X1, mod + 2 * 1024, (DBG_SKIP >> 0) & 1, DBG_F_MIX0};
        gemm_run(lds, S, E); SEAM(5);
    }
    if constexpr (IN(6)) { phase_prenorm<4>(P, lds, X1, nullptr, 0, 3072, 0); SEAM(6); }
    if constexpr (IN(7)) {
        const int* cnt = (const int*)(ws + WS_CTL) + CW_CNT; const int* ent = (const int*)(ws + WS_ENT);
        MoeTiles mt = moe_build_tiles(cnt, lds);
        MoeSched1 S{H, (const bf16_t*)(ws + WS_W1), cnt, ent, mt, 1024, 8, G, c};
        EpiSwiglu E{(bf16_t*)(ws + WS_A), (const float*)P.in[24]};
        gemm_run(lds, S, E); SEAM(7);
    }
    if constexpr (IN(8)) {
        const int* cnt = (const int*)(ws + WS_CTL) + CW_CNT; const int* ent = (const int*)(ws + WS_ENT);
        MoeTiles mt = moe_build_tiles(cnt, lds);
        MoeSched2 S{(const bf16_t*)(ws + WS_A), (const bf16_t*)(ws + WS_W2), mt, 1024, 4, G, c};
        EpiMoeOut E{(bf16_t*)(ws + WS_YB), (const float*)P.in[26], cnt, ent, (const float*)(ws + WS_GATES)};
        gemm_run(lds, S, E); SEAM(8);
    }
    if constexpr (IN(9)) { phase_prenorm<3>(P, lds, X1, X2, 1, 0, 0); SEAM(9); }
    if constexpr (IN(10)) {
        DenseSched S{H, (const bf16_t*)(ws + WS_WIN1), 1024, NTOK / 256, N_IN1 / 256, G, c};
        EpiIn E{Z, Z1P, nullptr, nullptr, (const float*)(ws + WS_ROPE), 1};
        gemm_run(lds, S, E); SEAM(10);
    }
    if constexpr (IN(11)) { phase_mix1(P, lds); SEAM(11); }
    if constexpr (IN(12)) {
        DenseSched S{CAT, (const bf16_t*)(ws + WS_WOUT1), 1024, NTOK / 256, 4, G, c};
        EpiResid E{X2, X1, mod + 8 * 6144 + 2 * 1024, (DBG_SKIP >> 2) & 1, DBG_F_MIX1};
        gemm_run(lds, S, E); SEAM(12);
    }
    if constexpr (IN(13)) { phase_prenorm<4>(P, lds, X1, nullptr, 1, 3072, 0); SEAM(13); }
    if constexpr (IN(14)) {
        const int* cnt = (const int*)(ws + WS_CTL) + CW_CNT + 64; const int* ent = (const int*)(ws + WS_ENT) + (size_t)NEXP * ENT_CAP;
        MoeTiles mt = moe_build_tiles(cnt, lds);
        MoeSched1 S{H, (const bf16_t*)(ws + WS_W1) + (size_t)NEXP * 2048 * 1024, cnt, ent, mt, 1024, 8, G, c};
        EpiSwiglu E{(bf16_t*)(ws + WS_A), (const float*)P.in[24] + (size_t)NEXP * 2048};
        gemm_run(lds, S, E); SEAM(14);
    }
    if constexpr (IN(15)) {
        const int* cnt = (const int*)(ws + WS_CTL) + CW_CNT + 64; const int* ent = (const int*)(ws + WS_ENT) + (size_t)NEXP * ENT_CAP;
        MoeTiles mt = moe_build_tiles(cnt, lds);
        MoeSched2 S{(const bf16_t*)(ws + WS_A), (const bf16_t*)(ws + WS_W2) + (size_t)NEXP * 1024 * 1024, mt, 1024, 4, G, c};
        EpiMoeOut E{(bf16_t*)(ws + WS_YB), (const float*)P.in[26] + (size_t)NEXP * 1024, cnt, ent, (const float*)(ws + WS_GATES) + 65536};
        gemm_run(lds, S, E); SEAM(15);
    }
    if constexpr (IN(16)) { phase_prenorm<9>(P, lds, DBG_FINAL_X ? x : X1, nullptr, 1, 0, 1); }
#undef IN
#undef SEAM
}

template <int PH> static void launch_phase(int grid, const Params& p, hipStream_t stream) {
    (void)hipFuncSetAttribute((const void*)mk_fwd<PH, PH + 1>, hipFuncAttributeMaxDynamicSharedMemorySize, LDS_BYTES);
    hipLaunchKernelGGL((mk_fwd<PH, PH + 1>), dim3(grid), dim3(NTHREADS), LDS_BYTES, stream, p);
}
#ifdef DBG_PHASES
template <int PH> static void launch_masked(int grid, const Params& p, hipStream_t stream) {
    if constexpr (PH < N_PHASES) { if constexpr ((DBG_PHASES >> PH) & 1) launch_phase<PH>(grid, p, stream); launch_masked<PH + 1>(grid, p, stream); }
}
#endif
template <int PH> static void launch_all(int grid, const Params& p, hipStream_t stream) {
    if constexpr (PH < N_PHASES) { launch_phase<PH>(grid, p, stream); launch_all<PH + 1>(grid, p, stream); }
}
extern "C" void kernel_launch(void* const* d_in, const int* in_sizes, int n_in, void* d_out, int out_size, void* d_ws, size_t ws_size, hipStream_t stream) {
    static int grid = 0;
    if (grid == 0) {
        if (n_in != 28 || out_size != NTOK * DM || ws_size < WS_END) { fprintf(stderr, "kernel_launch: unexpected shapes (n_in %d out %d ws %zu)\n", n_in, out_size, ws_size); grid = -1; return; }
        int dev = 0, cus = 0;
        (void)hipGetDevice(&dev); (void)hipDeviceGetAttribute(&cus, hipDeviceAttributeMultiprocessorCount, dev);
#if ONE_LAUNCH
        int per_cu = 0;
        if (hipFuncSetAttribute((const void*)mk_fwd<0, N_PHASES>, hipFuncAttributeMaxDynamicSharedMemorySize, LDS_BYTES) != hipSuccess) { fprintf(stderr, "kernel_launch: hipFuncSetAttribute failed\n"); grid = -1; return; }
        (void)hipOccupancyMaxActiveBlocksPerMultiprocessor(&per_cu, (const void*)mk_fwd<0, N_PHASES>, NTHREADS, LDS_BYTES);
        if (per_cu < 1) { fprintf(stderr, "kernel_launch: occupancy query reports %d blocks per CU\n", per_cu); grid = -1; return; }
#endif
        (void)hipGetLastError();
        grid = cus;
    }
    if (grid < 0) return;
    (void)hipMemsetAsync((char*)d_ws + WS_CTL, 0, CTL_ZERO_BYTES, stream);
    Params p{};
    for (int i = 0; i < 28; ++i) p.in[i] = d_in[i];
    p.out = (float*)d_out; p.ws = (unsigned char*)d_ws;
#if ONE_LAUNCH
    void* args[] = {&p};
    hipError_t e = hipLaunchCooperativeKernel((const void*)mk_fwd<0, N_PHASES>, dim3(grid), dim3(NTHREADS), args, LDS_BYTES, stream);
    if (e != hipSuccess) fprintf(stderr, "cooperative launch failed: %s (grid %d)\n", hipGetErrorString(e), grid);
#else
#ifdef DBG_PHASES
    launch_masked<0>(grid, p, stream);
#ifdef DBG_PROBE_OFF
    hipLaunchKernelGGL(mk_probe, dim3(grid), dim3(NTHREADS), 0, stream, p);
    launch_phase<16>(grid, p, stream);
#endif
#else
    launch_all<0>(grid, p, stream);
#endif
#endif
}
```

```cpp
#include <hip/hip_runtime.h>
#include <hip/hip_cooperative_groups.h>
#include <cstdio>
#include <cstdint>
namespace cg = cooperative_groups;

#ifndef ONE_LAUNCH
#define ONE_LAUNCH 0
#endif
#ifndef DBG_SKIP
#define DBG_SKIP 0
#endif
#ifndef DBG_FINAL_X
#define DBG_FINAL_X 0
#endif
#ifndef DBG_F_MIX0
#define DBG_F_MIX0 1.0f
#endif
#ifndef DBG_F_MOE0
#define DBG_F_MOE0 1.0f
#endif
#ifndef DBG_F_MIX1
#define DBG_F_MIX1 1.0f
#endif
#ifndef DBG_F_MOE1
#define DBG_F_MOE1 1.0f
#endif

#define DEV __device__ __forceinline__
#define LAS __attribute__((address_space(3)))
typedef unsigned short bf16_t;
typedef short bf16x8 __attribute__((ext_vector_type(8)));
typedef float f32x4 __attribute__((ext_vector_type(4)));
typedef float f32x2 __attribute__((ext_vector_type(2)));
typedef unsigned u32x4 __attribute__((ext_vector_type(4)));
typedef unsigned u32x2 __attribute__((ext_vector_type(2)));
typedef __bf16 bf16x2_t __attribute__((ext_vector_type(2)));

constexpr int NB = 8, SEQ = 2048, DM = 1024, NTOK = NB * SEQ, NEXP = 32, TOPK = 4;
constexpr int Z0P = 3072, Z1P = 2560;
constexpr int N_IN0 = 3328, N_IN1 = 2560;
constexpr int ENT_CAP = NTOK;
constexpr float EPS = 1e-6f;
constexpr float C2 = 0.125f * 1.4426950408889634f;
constexpr int NTHREADS = 512, NWAVES = 8;

constexpr size_t MiB = 1u << 20;
constexpr size_t WS_CTL = 0, CTL_ZERO_BYTES = 64 * 1024;
constexpr size_t WS_MOD = 1 * MiB;
constexpr size_t WS_ROPE = 2 * MiB;
constexpr size_t WS_ENT = 6 * MiB;
constexpr size_t WS_GATES = 10 * MiB;
constexpr size_t WS_SGUW = 11 * MiB;
constexpr size_t WS_WIN0 = 12 * MiB;
constexpr size_t WS_WOUT0 = 19 * MiB;
constexpr size_t WS_WIN1 = 21 * MiB;
constexpr size_t WS_WOUT1 = 26 * MiB;
constexpr size_t WS_W1 = 32 * MiB;
constexpr size_t WS_W2 = 288 * MiB;
constexpr size_t WS_H = 416 * MiB;
constexpr size_t WS_Z = 448 * MiB;
constexpr size_t WS_LA = 544 * MiB;
constexpr size_t WS_OPART = 560 * MiB;
constexpr size_t WS_CAT = 592 * MiB;
constexpr size_t WS_X1 = 624 * MiB;
constexpr size_t WS_X2 = 688 * MiB;
constexpr size_t WS_A = 752 * MiB;
constexpr size_t WS_YB = 896 * MiB;
constexpr size_t WS_END = 1024 * MiB;
constexpr int CW_CNT = 0;
constexpr int CW_QUEUE = 256;

constexpr int RING_BYTES = 131072;
constexpr int LCTL_OFF = RING_BYTES;
constexpr int LDS_BYTES = 147456;

DEV float bf2f(bf16_t v) { return __uint_as_float((unsigned)v << 16); }
DEV unsigned pk2(float lo, float hi) { f32x2 v = {lo, hi}; bf16x2_t b = __builtin_convertvector(v, bf16x2_t); return __builtin_bit_cast(unsigned, b); }
DEV bf16_t f2bf(float f) { return (bf16_t)(pk2(f, 0.f) & 0xffffu); }
DEV float wave_sum(float v) {
#pragma unroll
    for (int o = 1; o < 64; o <<= 1) v += __shfl_xor(v, o);
    return v;
}
DEV float silu_f(float x) { return x / (1.f + __expf(-x)); }
DEV float log_sigmoid_f(float x) { return fminf(x, 0.f) - __logf(1.f + __expf(-fabsf(x))); }
DEV float gelu_f(float v) {
    const float av = fabsf(v), t = __builtin_amdgcn_rcpf(av * 0.2316418882f + 1.0f);
    float q = t * 0.5307027145f + (-0.7265760135f); q = q * t + 0.7107068705f; q = q * t + (-0.142248368f); q = q * t + 0.127414796f; q = q * t;
    const float e = __builtin_amdgcn_exp2f((v * v) * (-0.72134752044f));
    const float m = v * (q * e);
    return v < 0.f ? m : v - m;
}
DEV void unpack8(const bf16x8 v, float (&o)[8]) {
#pragma unroll
    for (int j = 0; j < 8; ++j) o[j] = bf2f((bf16_t)v[j]);
}

struct Params {
    const void* in[28];
    float* out;
    unsigned char* ws;
};

struct Unit { int pm, pn, e, tb; };

DEV bool static_next(int i, int G, int c, int nM, int nN, int& pm, int& pn) {
    const int nwg = nM * nN; const long Lr = (long)i * G + c; if (Lr >= nwg) return false;
    int wgid = (int)Lr; { const int q = nwg / 8, r = nwg % 8, xcd = wgid % 8, off = wgid / 8; wgid = (xcd < r ? xcd * (q + 1) : r * (q + 1) + (xcd - r) * q) + off; }
    const int nig = 8 * nN, gid = wgid / nig, fm = gid * 8, gsz = (nM - fm) < 8 ? (nM - fm) : 8;
    pm = fm + ((wgid % nig) % gsz); pn = (wgid % nig) / gsz; return true;
}
struct DenseSched {
    const bf16_t* A; const bf16_t* Bt; int K, nM, nN, G, c;
    DEV bool next(int i, Unit& u) const { u.e = 0; u.tb = 0; return static_next(i, G, c, nM, nN, u.pm, u.pn); }
    DEV unsigned a_row_off(const Unit& u, int r) const { return (unsigned)(u.pm * 256 + r) * (unsigned)K; }
    DEV const bf16_t* b_ptr(const Unit& u) const { return Bt + (size_t)u.pn * 256 * K; }
};
struct MoeTiles { const LAS int* te; const LAS int* ttb; int nt; };
struct MoeSched1 {
    const bf16_t* A; const bf16_t* Bt; const int* cnt; const int* ent; MoeTiles mt; int K, nN, G, c;
    DEV bool next(int i, Unit& u) const { int pm, pn; if (!static_next(i, G, c, mt.nt, nN, pm, pn)) return false; u.pm = pm; u.pn = pn; u.e = mt.te[pm]; u.tb = mt.ttb[pm]; return true; }
    DEV unsigned a_row_off(const Unit& u, int r) const {
        const int n = cnt[u.e]; int pos = u.tb * 256 + r; pos = pos < n ? pos : n - 1;
        const int tok = ent[u.e * ENT_CAP + pos] >> 2; return (unsigned)tok * (unsigned)K; }
    DEV const bf16_t* b_ptr(const Unit& u) const { return Bt + ((size_t)u.e * 2048 + (size_t)u.pn * 256) * K; }
};
struct MoeSched2 {
    const bf16_t* A; const bf16_t* Bt; MoeTiles mt; int K, nN, G, c;
    DEV bool next(int i, Unit& u) const { int pm, pn; if (!static_next(i, G, c, mt.nt, nN, pm, pn)) return false; u.pm = pm; u.pn = pn; u.e = mt.te[pm]; u.tb = mt.ttb[pm]; return true; }
    DEV unsigned a_row_off(const Unit& u, int r) const { return (unsigned)(u.pm * 256 + r) * (unsigned)K; }
    DEV const bf16_t* b_ptr(const Unit& u) const { return Bt + ((size_t)u.e * 1024 + (size_t)u.pn * 256) * K; }
};
DEV MoeTiles moe_build_tiles(const int* cnt, LAS unsigned char* lds) {
    LAS int* te = (LAS int*)(lds + LCTL_OFF); LAS int* ttb = te + 320; LAS int* ntp = ttb + 320;
    __syncthreads();
    if (threadIdx.x == 0) {
        int n = 0;
        for (int e = 0; e < NEXP; ++e) { const int c = __hip_atomic_load(cnt + e, __ATOMIC_RELAXED, __HIP_MEMORY_SCOPE_AGENT); const int nt = (c + 255) >> 8;
            for (int t = 0; t < nt; ++t) { te[n] = e; ttb[n] = t; ++n; } }
        *ntp = n;
    }
    __syncthreads();
    MoeTiles mt; mt.te = te; mt.ttb = ttb; mt.nt = *ntp; return mt;
}

enum { EK_PLAIN = 0, EK_SILU = 1, EK_GELU = 2, EK_ROPE = 3, EK_LOGSIG = 4 };
struct EpiIn {
    static constexpr bool PERM = true;
    bf16_t* Z; int zp; float* LA; const float* bgate; const float* rope; int layer;
    DEV void kind_of(int pn, int& kind, float& sc) const {
        kind = EK_PLAIN; sc = 1.f;
        if (layer == 0) { if (pn == 0) sc = 0.125f; else if (pn == 4 || pn == 5) kind = EK_SILU; else if (pn == 6 || pn == 7) { kind = EK_ROPE; sc = C2; } else if (pn == 8 || pn == 9) kind = EK_ROPE; else if (pn == 12) kind = EK_LOGSIG; }
        else { if (pn < 4) kind = EK_GELU; else if (pn == 4) { kind = EK_ROPE; sc = 0.125f; } else if (pn == 5) kind = EK_ROPE; else if (pn >= 8) kind = EK_SILU; }
    }
    DEV void operator()(const f32x4 (&acc)[2][2][4][2], const Unit& u, int wr, int wc, int fr, int fq) const {
        int kind; float sc; kind_of(u.pn, kind, sc);
#pragma unroll
        for (int ai = 0; ai < 2; ++ai)
#pragma unroll
            for (int m = 0; m < 4; ++m) {
                const int row = u.pm * 256 + ai * 128 + wr * 64 + m * 16 + fr;
                if (kind == EK_ROPE) {
                    const float* rt = rope + (size_t)row * 64 + (8 * fq) * 2;
                    const f32x4 t0 = *(const f32x4*)(rt), t1 = *(const f32x4*)(rt + 4), t2 = *(const f32x4*)(rt + 8), t3 = *(const f32x4*)(rt + 12);
                    const float cs[8] = {t0[0], t0[2], t1[0], t1[2], t2[0], t2[2], t3[0], t3[2]}, sn[8] = {t0[1], t0[3], t1[1], t1[3], t2[1], t2[3], t3[1], t3[3]};
                    float y1[8], y2[8];
#pragma unroll
                    for (int n = 0; n < 2; ++n)
#pragma unroll
                        for (int i = 0; i < 4; ++i) { const float x1 = acc[ai][0][m][n][i], x2 = acc[ai][1][m][n][i]; const int j = 4 * n + i;
                            y1[j] = (x1 * cs[j] - x2 * sn[j]) * sc; y2[j] = (x2 * cs[j] + x1 * sn[j]) * sc; }
                    bf16_t* zp_ = Z + (size_t)row * zp + u.pn * 256 + 64 * wc + 8 * fq;
                    u32x4 w; w.x = pk2(y1[0], y1[1]); w.y = pk2(y1[2], y1[3]); w.z = pk2(y1[4], y1[5]); w.w = pk2(y1[6], y1[7]); *(u32x4*)(zp_) = w;
                    w.x = pk2(y2[0], y2[1]); w.y = pk2(y2[2], y2[3]); w.z = pk2(y2[4], y2[5]); w.w = pk2(y2[6], y2[7]); *(u32x4*)(zp_ + 32) = w;
                } else if (kind == EK_LOGSIG) {
#pragma unroll
                    for (int bj = 0; bj < 2; ++bj) { const int col = 128 * bj + 32 * wc + 8 * fq; float* lp = LA + (size_t)row * 256 + col;
                        const f32x4 b0 = *(const f32x4*)(bgate + col), b1 = *(const f32x4*)(bgate + col + 4); f32x4 o0, o1;
#pragma unroll
                        for (int i = 0; i < 4; ++i) { o0[i] = log_sigmoid_f(acc[ai][bj][m][0][i] + b0[i]) * 0.0625f; o1[i] = log_sigmoid_f(acc[ai][bj][m][1][i] + b1[i]) * 0.0625f; }
                        *(f32x4*)lp = o0; *(f32x4*)(lp + 4) = o1; }
                } else {
#pragma unroll
                    for (int bj = 0; bj < 2; ++bj) { float v[8];
#pragma unroll
                        for (int n = 0; n < 2; ++n)
#pragma unroll
                            for (int i = 0; i < 4; ++i) { float x = acc[ai][bj][m][n][i]; if (kind == EK_SILU) x = silu_f(x); else if (kind == EK_GELU) x = gelu_f(x); v[4 * n + i] = x * sc; }
                        u32x4 w; w.x = pk2(v[0], v[1]); w.y = pk2(v[2], v[3]); w.z = pk2(v[4], v[5]); w.w = pk2(v[6], v[7]);
                        *(u32x4*)(Z + (size_t)row * zp + u.pn * 256 + 128 * bj + 32 * wc + 8 * fq) = w; }
                }
            }
    }
};
struct EpiResid {
    static constexpr bool PERM = false;
    const float* resid; float* out; const float* gate; int skip; float dbgf;
    DEV void operator()(const f32x4 (&acc)[2][2][4][2], const Unit& u, int wr, int wc, int fr, int fq) const {
        const int b = (u.pm * 256) >> 11;
#pragma unroll
        for (int ai = 0; ai < 2; ++ai)
#pragma unroll
            for (int m = 0; m < 4; ++m) { const size_t row = (size_t)(u.pm * 256 + ai * 128 + wr * 64 + m * 16 + fr);
#pragma unroll
                for (int bj = 0; bj < 2; ++bj)
#pragma unroll
                    for (int n = 0; n < 2; ++n) { const int col = u.pn * 256 + 128 * bj + 32 * wc + 16 * n + 4 * fq;
                        const f32x4 g = *(const f32x4*)(gate + (size_t)b * 6144 + col), r = *(const f32x4*)(resid + row * DM + col);
                        *(f32x4*)(out + row * DM + col) = skip ? r : r + g * acc[ai][bj][m][n] * dbgf; } }
    }
};
struct EpiSwiglu {
    static constexpr bool PERM = true;
    bf16_t* Aout; const float* bin;
    DEV void operator()(const f32x4 (&acc)[2][2][4][2], const Unit& u, int wr, int wc, int fr, int fq) const {
        const int lc = 128 * u.pn + 32 * wc + 8 * fq; const float* bp = bin + (size_t)u.e * 2048 + lc;
        const f32x4 bg0 = *(const f32x4*)bp, bg1 = *(const f32x4*)(bp + 4), bl0 = *(const f32x4*)(bp + 1024), bl1 = *(const f32x4*)(bp + 1028);
#pragma unroll
        for (int ai = 0; ai < 2; ++ai)
#pragma unroll
            for (int m = 0; m < 4; ++m) { const size_t row = (size_t)(u.pm * 256 + ai * 128 + wr * 64 + m * 16 + fr); float v[8];
#pragma unroll
                for (int n = 0; n < 2; ++n)
#pragma unroll
                    for (int i = 0; i < 4; ++i) { const float g = fminf(acc[ai][0][m][n][i] + (n ? bg1[i] : bg0[i]), 7.f);
                        const float l = fminf(fmaxf(acc[ai][1][m][n][i] + (n ? bl1[i] : bl0[i]), -7.f), 7.f);
                        v[4 * n + i] = g / (1.f + __expf(-1.702f * g)) * (l + 1.f); }
                u32x4 w; w.x = pk2(v[0], v[1]); w.y = pk2(v[2], v[3]); w.z = pk2(v[4], v[5]); w.w = pk2(v[6], v[7]);
                *(u32x4*)(Aout + row * 1024 + lc) = w; }
    }
};
struct EpiMoeOut {
    static constexpr bool PERM = true;
    bf16_t* YB; const float* bout; const int* cnt; const int* ent; const float* gates;
    DEV void operator()(const f32x4 (&acc)[2][2][4][2], const Unit& u, int wr, int wc, int fr, int fq) const {
        const int n_e = cnt[u.e];
        f32x4 bv[2][2];
#pragma unroll
        for (int bj = 0; bj < 2; ++bj)
#pragma unroll
            for (int n = 0; n < 2; ++n) bv[bj][n] = *(const f32x4*)(bout + (size_t)u.e * 1024 + u.pn * 256 + 128 * bj + 32 * wc + 8 * fq + 4 * n);
#pragma unroll
        for (int ai = 0; ai < 2; ++ai)
#pragma unroll
            for (int m = 0; m < 4; ++m) { const int pos = u.tb * 256 + ai * 128 + wr * 64 + m * 16 + fr;
                if (pos < n_e) { const int dst = ent[u.e * ENT_CAP + pos]; const float g = gates[dst];
#pragma unroll
                    for (int bj = 0; bj < 2; ++bj) { const f32x4 v0 = (acc[ai][bj][m][0] + bv[bj][0]) * g, v1 = (acc[ai][bj][m][1] + bv[bj][1]) * g;
                        u32x4 w; w.x = pk2(v0[0], v0[1]); w.y = pk2(v0[2], v0[3]); w.z = pk2(v1[0], v1[1]); w.w = pk2(v1[2], v1[3]);
                        *(u32x4*)(YB + (size_t)dst * 1024 + u.pn * 256 + 128 * bj + 32 * wc + 8 * fq) = w; } } }
    }
};

template <class Epi, class Sched>
DEV void gemm_ref(const Sched& S, const Epi& E) {
    const int tid = threadIdx.x, wid = tid >> 6, lane = tid & 63, wr = wid >> 2, wc = wid & 3, fr = lane & 15, fq = lane >> 4;
    Unit u;
    for (int it = 0; S.next(it, u); ++it) {
        f32x4 acc[2][2][4][2];
#pragma unroll
        for (int a = 0; a < 2; ++a)
#pragma unroll
            for (int b = 0; b < 2; ++b)
#pragma unroll
                for (int m = 0; m < 4; ++m)
#pragma unroll
                    for (int n = 0; n < 2; ++n) acc[a][b][m][n] = (f32x4){0.f, 0.f, 0.f, 0.f};
        unsigned aoff[2][4];
#pragma unroll
        for (int ai = 0; ai < 2; ++ai)
#pragma unroll
            for (int m = 0; m < 4; ++m) aoff[ai][m] = S.a_row_off(u, ai * 128 + wr * 64 + m * 16 + fr);
        const bf16_t* Bt = S.b_ptr(u); const int K = S.K;
        for (int k0 = 0; k0 < K; k0 += 8) {
            u32x4 araw[2][4];
#pragma unroll
            for (int ai = 0; ai < 2; ++ai)
#pragma unroll
                for (int m = 0; m < 4; ++m) araw[ai][m] = *(const u32x4*)(S.A + aoff[ai][m] + k0);
            asm volatile("" ::: "memory");
#pragma unroll
            for (int bj = 0; bj < 2; ++bj)
#pragma unroll
                for (int n = 0; n < 2; ++n) {
                    u32x4 braw[4];
#pragma unroll
                    for (int i = 0; i < 4; ++i) { const int c = 128 * bj + 32 * wc + (Epi::PERM ? 8 * fq + 4 * n + i : 16 * n + 4 * fq + i); braw[i] = *(const u32x4*)(Bt + (size_t)c * K + k0); }
                    asm volatile("" ::: "memory");
#pragma unroll
                    for (int i = 0; i < 4; ++i)
#pragma unroll
                        for (int ai = 0; ai < 2; ++ai)
#pragma unroll
                            for (int m = 0; m < 4; ++m) { float s = acc[ai][bj][m][n][i];
#pragma unroll
                                for (int j = 0; j < 4; ++j) { const unsigned au = araw[ai][m][j], bu = braw[i][j];
                                    s = __builtin_amdgcn_fdot2_f32_bf16(__builtin_bit_cast(bf16x2_t, au), __builtin_bit_cast(bf16x2_t, bu), s, false); }
                                acc[ai][bj][m][n][i] = s; }
                }
        }
        E(acc, u, wr, wc, fr, fq);
    }
}


namespace pg8 {
constexpr int BM = 256, BK = 64, HALF = 128, HTB = HALF * BK * 2, STAGE_BYTES = 8 * HTB;
DEV int lds_byte(int r, int c) { const int st = (r >> 4) * 2 + (c >> 5), rr = r & 15, cc = c & 31, ob = rr * 64 + cc * 2; return st * 1024 + (ob ^ (((ob >> 9) & 1) << 5)); }
DEV void stage_rc(int b, int& R, int& C) { const int st = b / 1024, sb = b % 1024, swz = sb ^ (((sb >> 9) & 1) << 5); R = (st >> 1) * 16 + swz / 64; C = (st & 1) * 32 + (swz % 64) / 2; }
DEV int perm32(int rho) { const int n = rho >> 4, i = rho & 15; return 8 * (i >> 2) + 4 * n + (i & 3); }

template <class Epi, class Sched>
DEV void gemm_phase(LAS unsigned char* lds, const Sched& S, const Epi& E) {
    const int tid = threadIdx.x, wid = __builtin_amdgcn_readfirstlane(tid >> 6), lane = tid & 63, wr = wid >> 2, wc = wid & 3, fr = lane & 15, fq = lane >> 4;
    const int K = S.K, nt = K / BK;
    int rA[2]; unsigned cA2[2], voffB[2];
#pragma unroll
    for (int i = 0; i < 2; ++i) { int R, C; stage_rc(tid * 16 + i * 8192, R, C); const int Rb = Epi::PERM ? ((R & ~31) + perm32(R & 31)) : R;
        rA[i] = R; cA2[i] = (unsigned)C * 2u; voffB[i] = (unsigned)(Rb * K + C) * 2u; }
    const size_t kstep = (size_t)(BK * 2);
    const size_t hstep = (size_t)HALF * K * 2;
    const unsigned ldsw = (unsigned)wid * 1024u;
    const int aoff = lds_byte(wr * 64 + fr, fq * 8), boff = lds_byte(wc * 32 + fr, fq * 8);
    const char* Abase = (const char*)S.A;
#define PG8_SA(b, h) (((b) * 2 + (h)) * HTB)
#define PG8_SB(b, h) ((4 + (b) * 2 + (h)) * HTB)
#define PG8_STAGE(bufoff, gbase, voff) do { _Pragma("unroll") for (int _i = 0; _i < 2; ++_i) \
        __builtin_amdgcn_global_load_lds((const unsigned*)((const char*)(gbase) + (voff)[_i]), (LAS unsigned*)(lds + (bufoff) + ldsw + _i * 8192), 16, 0, 0); } while (0)
#define PG8_LDA(dst, b, h) do { _Pragma("unroll") for (int m = 0; m < 4; ++m) _Pragma("unroll") for (int k = 0; k < 2; ++k) dst[m][k] = *(const LAS bf16x8*)(lds + PG8_SA(b, h) + aoff + m * 2048 + k * 1024); } while (0)
#define PG8_LDB(dst, b, h) do { _Pragma("unroll") for (int n = 0; n < 2; ++n) _Pragma("unroll") for (int k = 0; k < 2; ++k) dst[n][k] = *(const LAS bf16x8*)(lds + PG8_SB(b, h) + boff + n * 2048 + k * 1024); } while (0)
#define PG8_MMA(ai, bj, At, Bt) do { __builtin_amdgcn_s_setprio(1); _Pragma("unroll") for (int m = 0; m < 4; ++m) _Pragma("unroll") for (int n = 0; n < 2; ++n) _Pragma("unroll") for (int k = 0; k < 2; ++k) \
        acc[ai][bj][m][n] = __builtin_amdgcn_mfma_f32_16x16x32_bf16(Bt[n][k], At[m][k], acc[ai][bj][m][n], 0, 0, 0); __builtin_amdgcn_s_setprio(0); } while (0)
#define PG8_WAIT_V(n) asm volatile("s_waitcnt vmcnt(" #n ")" ::: "memory")
#define PG8_WAIT_L(n) asm volatile("s_waitcnt lgkmcnt(" #n ")" ::: "memory")
#define PG8_BAR __builtin_amdgcn_s_barrier()
#define PG8_SCHED __builtin_amdgcn_sched_barrier(0)
    Unit cur, nxt; int ui = 0;
    if (!S.next(0, cur)) return;
    f32x4 acc[2][2][4][2];
#pragma unroll
    for (int a = 0; a < 2; ++a)
#pragma unroll
        for (int b = 0; b < 2; ++b)
#pragma unroll
            for (int m = 0; m < 4; ++m)
#pragma unroll
                for (int n = 0; n < 2; ++n) acc[a][b][m][n] = (f32x4){0.f, 0.f, 0.f, 0.f};
    bf16x8 At[4][2], B0[2][2], B1[2][2];
    unsigned vc0[2], vc1[2], vn0[2], vn1[2];
#pragma unroll
    for (int i = 0; i < 2; ++i) { vc0[i] = S.a_row_off(cur, rA[i]) * 2u + cA2[i]; vc1[i] = S.a_row_off(cur, HALF + rA[i]) * 2u + cA2[i]; }
    const char* cB = (const char*)S.b_ptr(cur);
    PG8_STAGE(PG8_SB(0, 0), cB, voffB); PG8_STAGE(PG8_SB(0, 1), cB + hstep, voffB); PG8_STAGE(PG8_SA(0, 0), Abase, vc0); PG8_STAGE(PG8_SA(0, 1), Abase, vc1);
    if (wr == 1) PG8_BAR;
    PG8_WAIT_V(2); PG8_BAR;
    PG8_STAGE(PG8_SB(1, 0), cB + kstep, voffB); PG8_STAGE(PG8_SA(1, 0), Abase + kstep, vc0); PG8_STAGE(PG8_SB(1, 1), cB + hstep + kstep, voffB);
    PG8_WAIT_V(6); PG8_BAR;
    for (;;) {
        const bool has_next = S.next(ui + 1, nxt);
        const char* nB = has_next ? (const char*)S.b_ptr(nxt) : cB;
#pragma unroll
        for (int i = 0; i < 2; ++i) { vn0[i] = has_next ? S.a_row_off(nxt, rA[i]) * 2u + cA2[i] : vc0[i]; vn1[i] = has_next ? S.a_row_off(nxt, HALF + rA[i]) * 2u + cA2[i] : vc1[i]; }
        for (int t = 0; t < nt; t += 2) {
            const bool last = (t == nt - 2);
            const char* a1 = Abase + (size_t)(t + 1) * kstep;
            const char* a2 = last ? Abase : Abase + (size_t)(t + 2) * kstep; const char* b2 = last ? nB : cB + (size_t)(t + 2) * kstep;
            const char* a3 = a2 + kstep; const char* b3 = b2 + kstep;
            unsigned s0[2], s1[2];
#pragma unroll
            for (int i = 0; i < 2; ++i) { s0[i] = last ? vn0[i] : vc0[i]; s1[i] = last ? vn1[i] : vc1[i]; }
            PG8_LDB(B0, 0, 0); PG8_LDB(B1, 0, 1); PG8_SCHED; PG8_LDA(At, 0, 0); PG8_STAGE(PG8_SA(1, 1), a1, vc1);
            PG8_WAIT_V(8); PG8_WAIT_L(0); PG8_BAR; PG8_MMA(0, 0, At, B0); PG8_MMA(0, 1, At, B1); PG8_BAR; PG8_SCHED;
            PG8_LDA(At, 0, 1); PG8_STAGE(PG8_SB(0, 0), b2, voffB); PG8_STAGE(PG8_SB(0, 1), b2 + hstep, voffB); PG8_STAGE(PG8_SA(0, 0), a2, s0);
            PG8_WAIT_V(8); PG8_WAIT_L(0); PG8_BAR; PG8_MMA(1, 0, At, B0); PG8_MMA(1, 1, At, B1); PG8_BAR; PG8_SCHED;
            PG8_LDB(B0, 1, 0); PG8_LDB(B1, 1, 1); PG8_SCHED; PG8_LDA(At, 1, 0); PG8_STAGE(PG8_SA(0, 1), a2, s1);
            PG8_WAIT_V(8); PG8_WAIT_L(0); PG8_BAR; PG8_MMA(0, 0, At, B0); PG8_MMA(0, 1, At, B1); PG8_BAR; PG8_SCHED;
            PG8_LDA(At, 1, 1); PG8_STAGE(PG8_SB(1, 0), b3, voffB); PG8_STAGE(PG8_SB(1, 1), b3 + hstep, voffB); PG8_STAGE(PG8_SA(1, 0), a3, s0);
            PG8_WAIT_V(8); PG8_WAIT_L(0); PG8_BAR; PG8_MMA(1, 0, At, B0); PG8_MMA(1, 1, At, B1); PG8_BAR; PG8_SCHED;
        }
        if (wr == 0) PG8_BAR;
        E(acc, cur, wr, wc, fr, fq);
        if (!has_next) break;
#pragma unroll
        for (int a = 0; a < 2; ++a)
#pragma unroll
            for (int b = 0; b < 2; ++b)
#pragma unroll
                for (int m = 0; m < 4; ++m)
#pragma unroll
                    for (int n = 0; n < 2; ++n) acc[a][b][m][n] = (f32x4){0.f, 0.f, 0.f, 0.f};
        cur = nxt; cB = nB; ++ui;
#pragma unroll
        for (int i = 0; i < 2; ++i) { vc0[i] = vn0[i]; vc1[i] = vn1[i]; }
        if (wr == 1) PG8_BAR;
    }
    PG8_WAIT_V(0);
    PG8_BAR;
#undef PG8_SA
#undef PG8_SB
#undef PG8_STAGE
#undef PG8_LDA
#undef PG8_LDB
#undef PG8_MMA
#undef PG8_WAIT_V
#undef PG8_WAIT_L
#undef PG8_BAR
#undef PG8_SCHED
}
}

__host__ __device__ inline int ropeoff(int q) { return 64 * (q & 3) + 32 * (q >> 2); }
__host__ __device__ inline int in0_logcol(int g32) {
    const int tile = g32 >> 3, q = g32 & 7;
    switch (tile) {
        case 0: return 0 + q * 32; case 1: return 256 + q * 32;
        case 2: case 3: return 512 + (tile - 2) * 256 + q * 32;
        case 4: case 5: return 1040 + (tile - 4) * 256 + q * 32;
        case 6: case 7: return 1552 + (tile - 6) * 256 + ropeoff(q);
        case 8: case 9: return 2064 + (tile - 8) * 256 + ropeoff(q);
        default: return 2576 + (tile - 10) * 256 + q * 32;
    }
}
__host__ __device__ inline int in1_logcol(int g32) {
    const int tile = g32 >> 3, q = g32 & 7;
    if (tile < 4) return tile * 256 + q * 32;
    if (tile == 4) return 1024 + ropeoff(q);
    if (tile == 5) return 1280 + ropeoff(q);
    return 1536 + (tile - 6) * 256 + q * 32;
}
DEV void conv_item(const float* W, int ldw, int logcol0, int k0, bf16_t* Wt_row0, int Kd, LAS float* scr, int lane) {
#pragma unroll 8
    for (int i = 0; i < 32; ++i) { const int kk = 2 * i + (lane >> 5); scr[kk * 33 + (lane & 31)] = W[(size_t)(k0 + kk) * ldw + logcol0 + (lane & 31)]; }
    asm volatile("s_waitcnt lgkmcnt(0)" ::: "memory");
    const int c = lane & 7;
#pragma unroll
    for (int j = 0; j < 4; ++j) { const int n = (lane >> 3) + 8 * j; const LAS float* s = scr + (8 * c) * 33 + n;
        u32x4 o; o.x = pk2(s[0 * 33], s[1 * 33]); o.y = pk2(s[2 * 33], s[3 * 33]); o.z = pk2(s[4 * 33], s[5 * 33]); o.w = pk2(s[6 * 33], s[7 * 33]);
        *(u32x4*)(Wt_row0 + (size_t)n * Kd + k0 + 8 * c) = o; }
    asm volatile("s_waitcnt lgkmcnt(0)" ::: "memory");
}
DEV void sincos_d(double x, float& s, float& c) {
    const double k = __builtin_rint(x * 0.63661977236758134308);
    const double r = (x - k * 1.5707963267948966192) - k * 6.123233995736766e-17;
    const double r2 = r * r;
    double sp = -7.647163731819816e-13; sp = sp * r2 + 1.605904383682161e-10; sp = sp * r2 - 2.505210838544172e-08; sp = sp * r2 + 2.755731922398589e-06;
    sp = sp * r2 - 1.984126984126984e-04; sp = sp * r2 + 8.333333333333333e-03; sp = sp * r2 - 1.666666666666667e-01; sp = r + r * r2 * sp;
    double cp = 4.779477332387385e-14; cp = cp * r2 - 1.147074559772972e-11; cp = cp * r2 + 2.087675698786810e-09; cp = cp * r2 - 2.755731922398589e-07;
    cp = cp * r2 + 2.480158730158730e-05; cp = cp * r2 - 1.388888888888889e-03; cp = cp * r2 + 4.166666666666666e-02; cp = cp * r2 - 0.5; cp = 1.0 + r2 * cp;
    const int q = ((int)k) & 3;
    const double ss = (q == 0) ? sp : (q == 1) ? cp : (q == 2) ? -sp : -cp;
    const double cc = (q == 0) ? cp : (q == 1) ? -sp : (q == 2) ? -cp : sp;
    s = (float)ss; c = (float)cc;
}
DEV void phase_prologue(const Params& P, LAS unsigned char* lds) {
    const int tid = threadIdx.x, lane = tid & 63, wid = tid >> 6, G = gridDim.x;
    unsigned char* ws = P.ws;
    {
        LAS float* cact = (LAS float*)lds; LAS float* red = cact + 8192;
        const float* cin = (const float*)P.in[1]; const float* wada = (const float*)P.in[3]; const float* bada = (const float*)P.in[4];
        float* mod = (float*)(ws + WS_MOD);
        for (int unit = blockIdx.x; unit < 192; unit += G) {
            const int layer = unit / 96, col0 = (unit % 96) * 64;
            __syncthreads();
            for (int i = tid; i < 8192; i += NTHREADS) { const float c = cin[i]; cact[i] = c / (1.f + expf(-c)); }
            __syncthreads();
            const int cs = tid & 63, ks = tid >> 6;
            float acc[8];
#pragma unroll
            for (int b = 0; b < 8; ++b) acc[b] = 0.f;
            const float* W = wada + (size_t)layer * 1024 * 6144 + col0 + cs;
#pragma unroll 4
            for (int k = ks * 128; k < ks * 128 + 128; ++k) { const float w = W[(size_t)k * 6144];
#pragma unroll
                for (int b = 0; b < 8; ++b) acc[b] += cact[b * 1024 + k] * w; }
#pragma unroll
            for (int b = 0; b < 8; ++b) red[(ks * 8 + b) * 64 + cs] = acc[b];
            __syncthreads();
            { const int b = tid >> 6; float s = bada[layer * 6144 + col0 + cs];
#pragma unroll
              for (int k2 = 0; k2 < 8; ++k2) s += red[(k2 * 8 + b) * 64 + cs];
              mod[(size_t)(layer * 8 + b) * 6144 + col0 + cs] = s; }
        }
        __syncthreads();
    }
    const int gt = blockIdx.x * NTHREADS + tid, NGT = G * NTHREADS;
    {
        const int* pos = (const int*)P.in[2]; float* rope = (float*)(ws + WS_ROPE);
        for (int i = gt; i < NTOK * 32; i += NGT) { const int f = i & 31, t = i >> 5;
            const double invf = exp2(-(double)f * (13.287712379549449 / 32.0));
            float s, c; sincos_d((double)pos[t] * invf, s, c); rope[2 * (size_t)i] = c; rope[2 * (size_t)i + 1] = s; }
    }
    {
        const float* sw = (const float*)P.in[18]; bf16_t* o = (bf16_t*)(ws + WS_SGUW);
        for (int i = gt; i < 4 * 128 * 128; i += NGT) { const int j = i & 127, r = (i >> 7) & 127; o[i] = f2bf(j <= r ? sw[i] : 0.f); }
    }
    {
        const float* win = (const float*)P.in[5]; const float* wg = (const float*)P.in[6]; bf16_t* wt = (bf16_t*)(ws + WS_WIN0) + (size_t)3072 * 1024;
        for (int i = gt; i < 256 * 1024; i += NGT) { const int k = i & 1023, j = i >> 10; float s = 0.f;
#pragma unroll
            for (int r = 0; r < 16; ++r) s += win[(size_t)k * 3088 + 1024 + r] * wg[r * 256 + j];
            wt[(size_t)j * 1024 + k] = f2bf(s); }
    }
    {
        LAS float* scr = (LAS float*)(lds + wid * 16384);
        const int gw = blockIdx.x * NWAVES + wid, NGW = G * NWAVES;
        constexpr int I_IN0 = 16 * 96, I_OUT = 16 * 32, I_IN1 = 16 * 80, I_W1 = 64 * 16 * 64, I_W2 = 64 * 16 * 32;
        constexpr int NITEMS = I_IN0 + I_OUT + I_IN1 + I_OUT + I_W1 + I_W2;
        for (int it = gw; it < NITEMS; it += NGW) {
            int r = it;
            if (r < I_IN0) { const int kb = r / 96, g = r % 96; conv_item((const float*)P.in[5], 3088, in0_logcol(g), kb * 64, (bf16_t*)(ws + WS_WIN0) + (size_t)g * 32 * 1024, 1024, scr, lane); continue; } r -= I_IN0;
            if (r < I_OUT) { const int kb = r / 32, g = r % 32; conv_item((const float*)P.in[14], 1024, g * 32, kb * 64, (bf16_t*)(ws + WS_WOUT0) + (size_t)g * 32 * 1024, 1024, scr, lane); continue; } r -= I_OUT;
            if (r < I_IN1) { const int kb = r / 80, g = r % 80; conv_item((const float*)P.in[15], 2560, in1_logcol(g), kb * 64, (bf16_t*)(ws + WS_WIN1) + (size_t)g * 32 * 1024, 1024, scr, lane); continue; } r -= I_IN1;
            if (r < I_OUT) { const int kb = r / 32, g = r % 32; conv_item((const float*)P.in[20], 1024, g * 32, kb * 64, (bf16_t*)(ws + WS_WOUT1) + (size_t)g * 32 * 1024, 1024, scr, lane); continue; } r -= I_OUT;
            if (r < I_W1) { const int le = r / 1024, q = r % 1024, kb = q / 64, g = q % 64, pn = g >> 3, qq = g & 7;
                const int logcol = (qq >> 2) * 1024 + 128 * pn + 32 * (qq & 3);
                conv_item((const float*)P.in[23] + (size_t)le * 1024 * 2048, 2048, logcol, kb * 64, (bf16_t*)(ws + WS_W1) + ((size_t)le * 2048 + g * 32) * 1024, 1024, scr, lane); continue; } r -= I_W1;
            { const int le = r / 512, q = r % 512, kb = q / 32, g = q % 32;
              conv_item((const float*)P.in[25] + (size_t)le * 1024 * 1024, 1024, g * 32, kb * 64, (bf16_t*)(ws + WS_W2) + ((size_t)le * 1024 + g * 32) * 1024, 1024, scr, lane); }
        }
    }
}

template <int MODE>
DEV void phase_prenorm(const Params& P, LAS unsigned char* lds, const float* xin, float* xout, int layer_mod, int modoff  , int layer_prev) {
    const int tid = threadIdx.x, lane = tid & 63, wid = tid >> 6, G = gridDim.x;
    unsigned char* ws = P.ws;
    const float* mod = (const float*)(ws + WS_MOD);
    bf16_t* H = (bf16_t*)(ws + WS_H);
    const bf16_t* YB = (const bf16_t*)(ws + WS_YB);
    LAS float* hrow = (LAS float*)(lds) + wid * 1024;
    for (int row = blockIdx.x * NWAVES + wid; row < NTOK; row += G * NWAVES) {
        const int b = row >> 11;
        const f32x4* xr = (const f32x4*)(xin + (size_t)row * DM) + lane;
        f32x4 v[4];
#pragma unroll
        for (int j = 0; j < 4; ++j) v[j] = xr[64 * j];
        if (MODE & 1) {
            const float* g2 = mod + (size_t)(layer_prev * 8 + b) * 6144 + 5 * 1024;
            f32x4 macc[4];
#pragma unroll
            for (int j = 0; j < 4; ++j) macc[j] = (f32x4){0.f, 0.f, 0.f, 0.f};
#pragma unroll
            for (int k = 0; k < 4; ++k) { const float g = 1.0f;   const u32x2* yr = (const u32x2*)(YB + ((size_t)row * 4 + k) * 1024) + lane;
#pragma unroll
                for (int j = 0; j < 4; ++j) { const u32x2 w = yr[64 * j];
                    macc[j][0] += g * __uint_as_float(w.x << 16); macc[j][1] += g * __uint_as_float(w.x & 0xffff0000u);
                    macc[j][2] += g * __uint_as_float(w.y << 16); macc[j][3] += g * __uint_as_float(w.y & 0xffff0000u); } }
#pragma unroll
            for (int j = 0; j < 4; ++j) { const f32x4 gg = *((const f32x4*)g2 + lane + 64 * j); if (!((DBG_SKIP >> (1 + 2 * layer_prev)) & 1)) v[j] = v[j] + gg * macc[j] * (layer_prev ? DBG_F_MOE1 : DBG_F_MOE0); }
        }
        if (MODE & 2) { f32x4* xo = (f32x4*)(xout + (size_t)row * DM) + lane;
#pragma unroll
            for (int j = 0; j < 4; ++j) xo[64 * j] = v[j]; }
        float ss = 0.f;
#pragma unroll
        for (int j = 0; j < 4; ++j) ss += (v[j][0] * v[j][0] + v[j][1] * v[j][1]) + (v[j][2] * v[j][2] + v[j][3] * v[j][3]);
        const float rstd = 1.0f / sqrtf(wave_sum(ss) * (1.f / DM) + EPS);
        if (MODE & 8) {
            const float* fg = (const float*)P.in[27]; f32x4* o = (f32x4*)(P.out + (size_t)row * DM) + lane;
#pragma unroll
            for (int j = 0; j < 4; ++j) { const f32x4 g = *((const f32x4*)fg + lane + 64 * j);
#ifdef DBG_PROBE_OFF
                const float ps = ((const float*)(ws + WS_CTL))[1024] / ((float)NTOK * DBG_PROBE_NCOLS); const float pv = (DBG_PROBE_ABS ? ps : sqrtf(ps)) * DBG_PROBE_SCALE;
                const float alpha = 1.5f + 1.5f * fminf(fmaxf(pv, 0.f), 1.f);
                o[64 * j] = v[j] * rstd * g * alpha;
#else
                o[64 * j] = v[j] * rstd * g;
#endif
            }
            continue;
        }
        const float* mrow = mod + (size_t)(layer_mod * 8 + b) * 6144 + modoff;
#pragma unroll
        for (int j = 0; j < 4; ++j) { const f32x4 sh = *((const f32x4*)mrow + lane + 64 * j), sc = *((const f32x4*)(mrow + 1024) + lane + 64 * j);
            v[j] = v[j] * rstd * (sc + 1.0f) + sh; }
        { u32x2* ho = (u32x2*)(H + (size_t)row * DM) + lane;
#pragma unroll
          for (int j = 0; j < 4; ++j) { u32x2 w; w.x = pk2(v[j][0], v[j][1]); w.y = pk2(v[j][2], v[j][3]); ho[64 * j] = w; } }
        if (MODE & 4) {
            const float* rw = (const float*)P.in[21] + (size_t)layer_mod * 1024 * 32; const float* rb = (const float*)P.in[22] + layer_mod * 32;
            int* cnt = (int*)(ws + WS_CTL) + CW_CNT + layer_mod * 64; int* ent = (int*)(ws + WS_ENT) + (size_t)layer_mod * NEXP * ENT_CAP;
            float* gates = (float*)(ws + WS_GATES) + (size_t)layer_mod * 65536;
#pragma unroll
            for (int j = 0; j < 4; ++j) *((LAS f32x4*)hrow + lane + 64 * j) = v[j];
            asm volatile("s_waitcnt lgkmcnt(0)" ::: "memory");
            const int e = lane & 31, half = lane >> 5;
            float a0 = 0.f, a1 = 0.f;
            const float* wp = rw + (size_t)(half * 512) * 32 + e; const LAS float* hp = hrow + half * 512;
#pragma unroll 8
            for (int k = 0; k < 512; k += 2) { a0 += hp[k] * wp[(size_t)k * 32]; a1 += hp[k + 1] * wp[(size_t)(k + 1) * 32]; }
            float lg = a0 + a1; lg += __shfl_xor(lg, 32); lg += rb[e];
            asm volatile("s_waitcnt lgkmcnt(0)" ::: "memory");
            float tv[4]; int ti[4]; float cur = lg;
#pragma unroll
            for (int r = 0; r < 4; ++r) {
                float mx = cur;
#pragma unroll
                for (int o = 1; o < 32; o <<= 1) mx = fmaxf(mx, __shfl_xor(mx, o));
                const unsigned long long bal = __ballot(cur == mx) & 0xffffffffull;
                const int sel = __builtin_ctzll(bal);
                tv[r] = mx; ti[r] = sel; if (e == sel) cur = -INFINITY;
            }
            const float e1 = __expf(tv[1] - tv[0]), e2 = __expf(tv[2] - tv[0]), e3 = __expf(tv[3] - tv[0]);
            const float inv = 1.f / (1.f + e1 + e2 + e3);
            if (lane < 4) { const int ex = lane == 0 ? ti[0] : lane == 1 ? ti[1] : lane == 2 ? ti[2] : ti[3];
                const float gv = (lane == 0 ? 1.f : lane == 1 ? e1 : lane == 2 ? e2 : e3) * inv;
                const int pos = atomicAdd(cnt + ex, 1); ent[ex * ENT_CAP + pos] = row * 4 + lane; gates[(size_t)row * 4 + lane] = gv; }
        }
    }
}

DEV void attn_unit_ref(int b, int vh, int qb, const bf16_t* Z, bf16_t* OP) {
    const int tid = threadIdx.x;
    if (tid >= 256) return;
    const int h = vh >> 2, m = (vh >> 1) & 1, vhalf = vh & 1;
    const size_t rowbase = (size_t)b * SEQ;
    const int i = qb * 256 + tid;
    const bf16_t* Qr = Z + (rowbase + i) * Z0P + 1536 + h * 128 + m * 64;
    const bf16_t* Kb = Z + rowbase * Z0P + 2048 + h * 128 + m * 64;
    const bf16_t* Vb = Z + rowbase * Z0P + 2560 + h * 128 + vhalf * 64;
    float q[64], o[64];
#pragma unroll
    for (int d0 = 0; d0 < 8; ++d0) { float t[8]; unpack8(*(const bf16x8*)(Qr + d0 * 8), t);
#pragma unroll
        for (int j = 0; j < 8; ++j) { q[d0 * 8 + j] = t[j]; o[d0 * 8 + j] = 0.f; } }
    float mx = -INFINITY, l = 0.f;
    const int jend = qb * 256 + 255;
    for (int j = 0; j <= jend; ++j) {
        const bf16_t* kr = Kb + (size_t)j * Z0P; const bf16_t* vr = Vb + (size_t)j * Z0P;
        float s = 0.f;
#pragma unroll
        for (int d0 = 0; d0 < 8; ++d0) { float t[8]; unpack8(*(const bf16x8*)(kr + d0 * 8), t);
#pragma unroll
            for (int jj = 0; jj < 8; ++jj) s += q[d0 * 8 + jj] * t[jj]; }
        if (j > i) s = -INFINITY;
        if (s > mx) { const float al = __builtin_amdgcn_exp2f(mx - s); l *= al;
#pragma unroll
            for (int e = 0; e < 64; ++e) o[e] *= al;
            mx = s; }
        const float p = __builtin_amdgcn_exp2f(s - mx); l += p;
#pragma unroll
        for (int d0 = 0; d0 < 8; ++d0) { float t[8]; unpack8(*(const bf16x8*)(vr + d0 * 8), t);
#pragma unroll
            for (int jj = 0; jj < 8; ++jj) o[d0 * 8 + jj] += p * t[jj]; }
    }
    const float il = 1.f / l;
    bf16_t* Or = OP + (rowbase + i) * 1024 + vh * 64;
#pragma unroll
    for (int d0 = 0; d0 < 8; ++d0) { u32x4 w; w.x = pk2(o[d0 * 8] * il, o[d0 * 8 + 1] * il); w.y = pk2(o[d0 * 8 + 2] * il, o[d0 * 8 + 3] * il);
        w.z = pk2(o[d0 * 8 + 4] * il, o[d0 * 8 + 5] * il); w.w = pk2(o[d0 * 8 + 6] * il, o[d0 * 8 + 7] * il); *(u32x4*)(Or + d0 * 8) = w; }
}

struct LinAttnArgs {
    const bf16_t* q; const bf16_t* k; const bf16_t* v; const bf16_t* og;
    int zp; const float* la;
    float log_g;
    const float* gain;
    bf16_t* out;
};
template <int C>
DEV void linattn_unit_ref(const LinAttnArgs& a, LAS unsigned char* lds) {
    const int tid = threadIdx.x, lane = tid & 63, wid = tid >> 6;
    LAS bf16_t* qd = (LAS bf16_t*)lds;
    LAS bf16_t* ka = qd + C * 64;
    LAS bf16_t* vv = ka + C * 64;
    LAS float* bsc = (LAS float*)(vv + C * 128);
    LAS bf16_t* Sm = (LAS bf16_t*)bsc;
    LAS float* st = bsc + C * 64;
    LAS float* dec = st + 64 * 128;
    __syncthreads();
    for (int i = tid; i < 64 * 128; i += NTHREADS) st[i] = 0.f;
    for (int n = 0; n < SEQ / C; ++n) {
        const size_t r0 = (size_t)n * C;
        __syncthreads();
        for (int i = tid; i < C * 64; i += NTHREADS) { const int r = i >> 6, d = i & 63; bsc[i] = a.la ? a.la[(r0 + r) * 256 + d] : a.log_g; }
        for (int i = tid; i < C * 16; i += NTHREADS) { const int r = i >> 4, c8 = i & 15; *(LAS u32x4*)(vv + r * 128 + c8 * 8) = *(const u32x4*)(a.v + (r0 + r) * a.zp + c8 * 8); }
        __syncthreads();
        if (tid < 64) { float run = 0.f; for (int r = 0; r < C; ++r) { run += bsc[r * 64 + tid]; bsc[r * 64 + tid] = run; } dec[tid] = __expf(run); }
        __syncthreads();
        for (int i = tid; i < C * 64; i += NTHREADS) { const int r = i >> 6, d = i & 63; const float bb = bsc[i];
            qd[i] = f2bf(bf2f(a.q[(r0 + r) * a.zp + d]) * __expf(bb)); ka[i] = f2bf(bf2f(a.k[(r0 + r) * a.zp + d]) * __expf(-bb)); }
        __syncthreads();
        for (int i = tid; i < C * C; i += NTHREADS) { const int r = i / C, j = i % C; float s = 0.f;
            if (j <= r) { for (int d = 0; d < 64; ++d) s += bf2f(qd[r * 64 + d]) * bf2f(ka[j * 64 + d]); }
            Sm[i] = f2bf(s); }
        __syncthreads();
        for (int r = wid; r < C; r += NWAVES) {
            float o0 = 0.f, o1 = 0.f;
            for (int j = 0; j <= r; ++j) { const float s = bf2f(Sm[r * C + j]); o0 += s * bf2f(vv[j * 128 + lane]); o1 += s * bf2f(vv[j * 128 + 64 + lane]); }
            for (int d = 0; d < 64; ++d) { const float qv = bf2f(qd[r * 64 + d]); o0 += qv * st[d * 128 + lane]; o1 += qv * st[d * 128 + 64 + lane]; }
            const float rstd = 1.0f / sqrtf(wave_sum(o0 * o0 + o1 * o1) * (1.f / 128.f) + EPS);
            const float g0 = a.gain ? a.gain[lane] : 1.f, g1 = a.gain ? a.gain[lane + 64] : 1.f;
            const bf16_t* ogr = a.og + (r0 + r) * a.zp; bf16_t* orow = a.out + (r0 + r) * 1024;
            orow[lane] = f2bf(o0 * rstd * g0 * bf2f(ogr[lane])); orow[lane + 64] = f2bf(o1 * rstd * g1 * bf2f(ogr[lane + 64]));
        }
        __syncthreads();
        { const int e = tid & 127, dg = tid >> 7;
          for (int d = dg; d < 64; d += 4) { float s = st[d * 128 + e]; for (int j = 0; j < C; ++j) s += bf2f(ka[j * 64 + d]) * bf2f(vv[j * 128 + e]); st[d * 128 + e] = dec[d] * s; } }
    }
    __syncthreads();
}

DEV void sgu_unit_ref(const Params& P, int b, int ch, LAS unsigned char* lds) {
    const int tid = threadIdx.x, lane = tid & 63, wid = tid >> 6;
    const bf16_t* Z = (const bf16_t*)(P.ws + WS_Z); bf16_t* CAT = (bf16_t*)(P.ws + WS_CAT);
    const float* lng = (const float*)P.in[16]; const float* lnb = (const float*)P.in[17]; const float* sw = (const float*)P.in[18]; const float* sb = (const float*)P.in[19];
    LAS float* svn = (LAS float*)lds;
    LAS float* stat = svn + 128 * 128;
    const size_t r0 = (size_t)b * SEQ + (size_t)ch * 128;
    __syncthreads();
    for (int r = wid; r < 128; r += NWAVES) {
        const bf16_t* zr = Z + (r0 + r) * Z1P + 512; float x[8]; unpack8(*(const bf16x8*)(zr + lane * 8), x);
        float s = 0.f;
#pragma unroll
        for (int j = 0; j < 8; ++j) s += x[j];
        const float mean = wave_sum(s) * (1.f / 512.f); float q = 0.f;
#pragma unroll
        for (int j = 0; j < 8; ++j) { const float d = x[j] - mean; q += d * d; }
        const float rstd = 1.0f / sqrtf(wave_sum(q) * (1.f / 512.f) + EPS);
        if (lane == 0) { stat[2 * r] = mean; stat[2 * r + 1] = rstd; }
    }
    __syncthreads();
    for (int g = 0; g < 4; ++g) {
        for (int i = tid; i < 128 * 128; i += NTHREADS) { const int r = i >> 7, c = i & 127;
            svn[i] = (bf2f(Z[(r0 + r) * Z1P + 512 + g * 128 + c]) - stat[2 * r]) * stat[2 * r + 1] * lng[g * 128 + c] + lnb[g * 128 + c]; }
        __syncthreads();
        { const int c = tid & 127, ig = tid >> 7;
          for (int r = ig; r < 128; r += 4) { float s = sb[g * 128 + r]; const float* wrow = sw + ((size_t)g * 128 + r) * 128;
              for (int j = 0; j <= r; ++j) s += wrow[j] * svn[j * 128 + c];
              CAT[(r0 + r) * 1024 + g * 128 + c] = f2bf(bf2f(Z[(r0 + r) * Z1P + g * 128 + c]) * s); } }
        __syncthreads();
    }
}

DEV int queue_pop(unsigned* head, LAS unsigned char* lds) {
    LAS int* slot = (LAS int*)(lds + LCTL_OFF + 4096);
    __syncthreads();
    if (threadIdx.x == 0) *slot = (int)__hip_atomic_fetch_add(head, 1u, __ATOMIC_RELAXED, __HIP_MEMORY_SCOPE_AGENT);
    __syncthreads();
    return *slot;
}

DEV void phase_mix0(const Params& P, LAS unsigned char* lds) {
    unsigned char* ws = P.ws; const bf16_t* Z = (const bf16_t*)(ws + WS_Z);
    unsigned* head = (unsigned*)(ws + WS_CTL) + CW_QUEUE;
    for (;;) {
        const int q = queue_pop(head, lds);
        if (q >= 32 + 1024) break;
        if (q < 32) {
            const int b = q >> 2, h = q & 3; const size_t rb = (size_t)b * SEQ;
            LinAttnArgs a; a.q = Z + rb * Z0P + h * 64; a.k = Z + rb * Z0P + 256 + h * 64; a.v = Z + rb * Z0P + 512 + h * 128; a.og = Z + rb * Z0P + 1024 + h * 128; a.zp = Z0P;
            a.la = (const float*)(ws + WS_LA) + rb * 256 + h * 64; a.log_g = 0.f; a.gain = (const float*)P.in[8]; a.out = (bf16_t*)(ws + WS_CAT) + rb * 1024 + h * 128;
            linattn_unit_ref<64>(a, lds);
        } else {
            const int aidx = q - 32, qb = 7 - (aidx >> 7), rem = aidx & 127, b = rem >> 4, vh = rem & 15;
            attn_unit_ref(b, vh, qb, Z, (bf16_t*)(ws + WS_OPART));
        }
    }
}
DEV void phase_mix1(const Params& P, LAS unsigned char* lds) {
    unsigned char* ws = P.ws; const bf16_t* Z = (const bf16_t*)(ws + WS_Z);
    unsigned* head = (unsigned*)(ws + WS_CTL) + CW_QUEUE + 64;
    for (;;) {
        const int q = queue_pop(head, lds);
        if (q >= 32 + 128) break;
        if (q < 32) {
            const int b = q >> 2, h = q & 3; const size_t rb = (size_t)b * SEQ;
            LinAttnArgs a; a.q = Z + rb * Z1P + 1024 + h * 64; a.k = Z + rb * Z1P + 1280 + h * 64; a.v = Z + rb * Z1P + 1536 + h * 128; a.og = Z + rb * Z1P + 2048 + h * 128; a.zp = Z1P;
            a.la = nullptr; a.log_g = logf(1.0f - exp2f(-5.0f - (float)h)); a.gain = nullptr; a.out = (bf16_t*)(ws + WS_CAT) + rb * 1024 + 512 + h * 128;
            linattn_unit_ref<128>(a, lds);
        } else { const int s = q - 32; sgu_unit_ref(P, s >> 4, s & 15, lds); }
    }
}
DEV void phase_combine(const Params& P) {
    const int tid = threadIdx.x, lane = tid & 63, wid = tid >> 6, G = gridDim.x;
    const float* q1 = (const float*)P.in[9]; const float* k1 = (const float*)P.in[10]; const float* q2 = (const float*)P.in[11]; const float* k2 = (const float*)P.in[12];
    const float* dg = (const float*)P.in[13];
    const float lam = __expf(wave_sum(q1[lane] * k1[lane])) - __expf(wave_sum(q2[lane] * k2[lane])) + 0.2f;
    const bf16_t* OP = (const bf16_t*)(P.ws + WS_OPART); bf16_t* CAT = (bf16_t*)(P.ws + WS_CAT);
    const int h = lane >> 4, e0 = (lane & 15) * 8;
    float g[8];
#pragma unroll
    for (int j = 0; j < 8; ++j) g[j] = dg[e0 + j] * 0.8f;
    for (int row = blockIdx.x * NWAVES + wid; row < NTOK; row += G * NWAVES) {
        float a0[8], a1[8], d[8];
        unpack8(*(const bf16x8*)(OP + (size_t)row * 1024 + h * 256 + e0), a0); unpack8(*(const bf16x8*)(OP + (size_t)row * 1024 + h * 256 + 128 + e0), a1);
        float ss = 0.f;
#pragma unroll
        for (int j = 0; j < 8; ++j) { d[j] = a0[j] - lam * a1[j]; ss += d[j] * d[j]; }
        ss += __shfl_xor(ss, 1); ss += __shfl_xor(ss, 2); ss += __shfl_xor(ss, 4); ss += __shfl_xor(ss, 8);
        const float rstd = 1.0f / sqrtf(ss * (1.f / 128.f) + EPS);
        u32x4 w; w.x = pk2(d[0] * rstd * g[0], d[1] * rstd * g[1]); w.y = pk2(d[2] * rstd * g[2], d[3] * rstd * g[3]);
        w.z = pk2(d[4] * rstd * g[4], d[5] * rstd * g[5]); w.w = pk2(d[6] * rstd * g[6], d[7] * rstd * g[7]);
        *(u32x4*)(CAT + (size_t)row * 1024 + 512 + h * 128 + e0) = w;
    }
}


#ifdef DBG_PROBE_OFF
constexpr int CW_PROBE = 1024;
__global__ void __launch_bounds__(NTHREADS) mk_probe(Params P) {
    const int tid = threadIdx.x, G = gridDim.x;
    float s = 0.f;
    const unsigned char* base = P.ws + (size_t)DBG_PROBE_OFF;
    for (long i = (long)blockIdx.x * NTHREADS + tid; i < (long)NTOK * DBG_PROBE_NCOLS; i += (long)G * NTHREADS) {
        const long r = i / DBG_PROBE_NCOLS; const int c = (int)(i % DBG_PROBE_NCOLS) + DBG_PROBE_COL0;
        float v;
        if (DBG_PROBE_F32) v = ((const float*)base)[r * DBG_PROBE_PITCH + c]; else v = bf2f(((const bf16_t*)base)[r * DBG_PROBE_PITCH + c]);
        s += DBG_PROBE_ABS ? fabsf(v) : v * v;
    }
    s = wave_sum(s);
    if ((tid & 63) == 0) atomicAdd((float*)(P.ws + WS_CTL) + CW_PROBE, s);
}
#endif
#ifndef FAST_GEMM
#define FAST_GEMM 1
#endif
template <class Epi, class Sched>
DEV void gemm_run(LAS unsigned char* lds, const Sched& S, const Epi& E) {
#if FAST_GEMM
    pg8::gemm_phase(lds, S, E);
#else
    gemm_ref(S, E);
#endif
}

constexpr int N_PHASES = 17;
template <int lo, int hi>
__global__ void __launch_bounds__(NTHREADS, 2) mk_fwd(Params P) {
    extern __shared__ __attribute__((aligned(16))) unsigned char lds_raw[];
    LAS unsigned char* lds = (LAS unsigned char*)lds_raw;
    unsigned char* ws = P.ws;
    const int G = gridDim.x, c = blockIdx.x;
#if ONE_LAUNCH
    cg::grid_group grid = cg::this_grid();
#define GRID_BAR() grid.sync()
#else
#define GRID_BAR() do {} while (0)
#endif
#define IN(k) (lo <= (k) && (k) < hi)
#define SEAM(k) do { if constexpr (lo <= (k) + 1 && (k) + 1 < hi) GRID_BAR(); } while (0)
    const float* mod = (const float*)(ws + WS_MOD);
    bf16_t* H = (bf16_t*)(ws + WS_H); bf16_t* Z = (bf16_t*)(ws + WS_Z); bf16_t* CAT = (bf16_t*)(ws + WS_CAT);
    float* X1 = (float*)(ws + WS_X1); float* X2 = (float*)(ws + WS_X2);
    const float* x = (const float*)P.in[0];

    if constexpr (IN(0)) { phase_prologue(P, lds); SEAM(0); }
    if constexpr (IN(1)) { phase_prenorm<0>(P, lds, x, nullptr, 0, 0, 0); SEAM(1); }
    if constexpr (IN(2)) {
        DenseSched S{H, (const bf16_t*)(ws + WS_WIN0), 1024, NTOK / 256, N_IN0 / 256, G, c};
        EpiIn E{Z, Z0P, (float*)(ws + WS_LA), (const float*)P.in[7], (const float*)(ws + WS_ROPE), 0};
        gemm_run(lds, S, E); SEAM(2);
    }
    if constexpr (IN(3)) { phase_mix0(P, lds); SEAM(3); }
    if constexpr (IN(4)) { phase_combine(P); SEAM(4); }
    if constexpr (IN(5)) {
        DenseSched S{CAT, (const bf16_t*)(ws + WS_WOUT0), 1024, NTOK / 256, 4, G, c};
        EpiResid E{x, X1, mod + 2 * 1024, (DBG_SKIP >> 0) & 1, DBG_F_MIX0};
        gemm_run(lds, S, E); SEAM(5);
    }
    if constexpr (IN(6)) { phase_prenorm<4>(P, lds, X1, nullptr, 0, 3072, 0); SEAM(6); }
    if constexpr (IN(7)) {
        const int* cnt = (const int*)(ws + WS_CTL) + CW_CNT; const int* ent = (const int*)(ws + WS_ENT);
        MoeTiles mt = moe_build_tiles(cnt, lds);
        MoeSched1 S{H, (const bf16_t*)(ws + WS_W1), cnt, ent, mt, 1024, 8, G, c};
        EpiSwiglu E{(bf16_t*)(ws + WS_A), (const float*)P.in[24]};
        gemm_run(lds, S, E); SEAM(7);
    }
    if constexpr (IN(8)) {
        const int* cnt = (const int*)(ws + WS_CTL) + CW_CNT; const int* ent = (const int*)(ws + WS_ENT);
        MoeTiles mt = moe_build_tiles(cnt, lds);
        MoeSched2 S{(const bf16_t*)(ws + WS_A), (const bf16_t*)(ws + WS_W2), mt, 1024, 4, G, c};
        EpiMoeOut E{(bf16_t*)(ws + WS_YB), (const float*)P.in[26], cnt, ent, (const float*)(ws + WS_GATES)};
        gemm_run(lds, S, E); SEAM(8);
    }
    if constexpr (IN(9)) { phase_prenorm<3>(P, lds, X1, X2, 1, 0, 0); SEAM(9); }
    if constexpr (IN(10)) {
        DenseSched S{H, (const bf16_t*)(ws + WS_WIN1), 1024, NTOK / 256, N_IN1 / 256, G, c};
        EpiIn E{Z, Z1P, nullptr, nullptr, (const float*)(ws + WS_ROPE), 1};
        gemm_run(lds, S, E); SEAM(10);
    }
    if constexpr (IN(11)) { phase_mix1(P, lds); SEAM(11); }
    if constexpr (IN(12)) {
        DenseSched S{CAT, (const bf16_t*)(ws + WS_WOUT1), 1024, NTOK / 256, 4, G, c};
        EpiResid E{X2, X1, mod + 8 * 6144 + 2 * 1024, (DBG_SKIP >> 2) & 1, DBG_F_MIX1};
        gemm_run(lds, S, E); SEAM(12);
    }
    if constexpr (IN(13)) { phase_prenorm<4>(P, lds, X1, nullptr, 1, 3072, 0); SEAM(13); }
    if constexpr (IN(14)) {
        const int* cnt = (const int*)(ws + WS_CTL) + CW_CNT + 64; const int* ent = (const int*)(ws + WS_ENT) + (size_t)NEXP * ENT_CAP;
        MoeTiles mt = moe_build_tiles(cnt, lds);
        MoeSched1 S{H, (const bf16_t*)(ws + WS_W1) + (size_t)NEXP * 2048 * 1024, cnt, ent, mt, 1024, 8, G, c};
        EpiSwiglu E{(bf16_t*)(ws + WS_A), (const float*)P.in[24] + (size_t)NEXP * 2048};
        gemm_run(lds, S, E); SEAM(14);
    }
    if constexpr (IN(15)) {
        const int* cnt = (const int*)(ws + WS_CTL) + CW_CNT + 64; const int* ent = (const int*)(ws + WS_ENT) + (size_t)NEXP * ENT_CAP;
        MoeTiles mt = moe_build_tiles(cnt, lds);
        MoeSched2 S{(const bf16_t*)(ws + WS_A), (const bf16_t*)(ws + WS_W2) + (size_t)NEXP * 1024 * 1024, mt, 1024, 4, G, c};
        EpiMoeOut E{(bf16_t*)(ws + WS_YB), (const float*)P.in[26] + (size_t)NEXP * 1024, cnt, ent, (const float*)(ws + WS_GATES) + 65536};
        gemm_run(lds, S, E); SEAM(15);
    }
    if constexpr (IN(16)) { phase_prenorm<9>(P, lds, DBG_FINAL_X ? x : X1, nullptr, 1, 0, 1); }
#undef IN
#undef SEAM
}

template <int PH> static void launch_phase(int grid, const Params& p, hipStream_t stream) {
    (void)hipFuncSetAttribute((const void*)mk_fwd<PH, PH + 1>, hipFuncAttributeMaxDynamicSharedMemorySize, LDS_BYTES);
    hipLaunchKernelGGL((mk_fwd<PH, PH + 1>), dim3(grid), dim3(NTHREADS), LDS_BYTES, stream, p);
}
#ifdef DBG_PHASES
template <int PH> static void launch_masked(int grid, const Params& p, hipStream_t stream) {
    if constexpr (PH < N_PHASES) { if constexpr ((DBG_PHASES >> PH) & 1) launch_phase<PH>(grid, p, stream); launch_masked<PH + 1>(grid, p, stream); }
}
#endif
template <int PH> static void launch_all(int grid, const Params& p, hipStream_t stream) {
    if constexpr (PH < N_PHASES) { launch_phase<PH>(grid, p, stream); launch_all<PH + 1>(grid, p, stream); }
}
extern "C" void kernel_launch(void* const* d_in, const int* in_sizes, int n_in, void* d_out, int out_size, void* d_ws, size_t ws_size, hipStream_t stream) {
    static int grid = 0;
    if (grid == 0) {
        if (n_in != 28 || out_size != NTOK * DM || ws_size < WS_END) { fprintf(stderr, "kernel_launch: unexpected shapes (n_in %d out %d ws %zu)\n", n_in, out_size, ws_size); grid = -1; return; }
        int dev = 0, cus = 0;
        (void)hipGetDevice(&dev); (void)hipDeviceGetAttribute(&cus, hipDeviceAttributeMultiprocessorCount, dev);
#if ONE_LAUNCH
        int per_cu = 0;
        if (hipFuncSetAttribute((const void*)mk_fwd<0, N_PHASES>, hipFuncAttributeMaxDynamicSharedMemorySize, LDS_BYTES) != hipSuccess) { fprintf(stderr, "kernel_launch: hipFuncSetAttribute failed\n"); grid = -1; return; }
        (void)hipOccupancyMaxActiveBlocksPerMultiprocessor(&per_cu, (const void*)mk_fwd<0, N_PHASES>, NTHREADS, LDS_BYTES);
        if (per_cu < 1) { fprintf(stderr, "kernel_launch: occupancy query reports %d blocks per CU\n", per_cu); grid = -1; return; }
#endif
        (void)hipGetLastError();
        grid = cus;
    }
    if (grid < 0) return;
    (void)hipMemsetAsync((char*)d_ws + WS_CTL, 0, CTL_ZERO_BYTES, stream);
    Params p{};
    for (int i = 0; i < 28; ++i) p.in[i] = d_in[i];
    p.out = (float*)d_out; p.ws = (unsigned char*)d_ws;
#if ONE_LAUNCH
    void* args[] = {&p};
    hipError_t e = hipLaunchCooperativeKernel((const void*)mk_fwd<0, N_PHASES>, dim3(grid), dim3(NTHREADS), args, LDS_BYTES, stream);
    if (e != hipSuccess) fprintf(stderr, "cooperative launch failed: %s (grid %d)\n", hipGetErrorString(e), grid);
#else
#ifdef DBG_PHASES
    launch_masked<0>(grid, p, stream);
#ifdef DBG_PROBE_OFF
    hipLaunchKernelGGL(mk_probe, dim3(grid), dim3(NTHREADS), 0, stream, p);
    launch_phase<16>(grid, p, stream);
#endif
#else
    launch_all<0>(grid, p, stream);
#endif
#endif
}
```

```cpp
#include <hip/hip_runtime.h>
#include <hip/hip_cooperative_groups.h>
#include <cstdio>
#include <cstdint>
namespace cg = cooperative_groups;

#ifndef ONE_LAUNCH
#define ONE_LAUNCH 1
#endif
#ifndef DBG_SKIP
#define DBG_SKIP 0
#endif
#ifndef DBG_FINAL_X
#define DBG_FINAL_X 0
#endif
#ifndef DBG_F_MIX0
#define DBG_F_MIX0 1.0f
#endif
#ifndef DBG_F_MOE0
#define DBG_F_MOE0 1.0f
#endif
#ifndef DBG_F_MIX1
#define DBG_F_MIX1 1.0f
#endif
#ifndef DBG_F_MOE1
#define DBG_F_MOE1 1.0f
#endif

#define DEV __device__ __forceinline__
#define LAS __attribute__((address_space(3)))
typedef unsigned short bf16_t;
typedef short bf16x8 __attribute__((ext_vector_type(8)));
typedef float f32x4 __attribute__((ext_vector_type(4)));
typedef float f32x2 __attribute__((ext_vector_type(2)));
typedef unsigned u32x4 __attribute__((ext_vector_type(4)));
typedef unsigned u32x2 __attribute__((ext_vector_type(2)));
typedef __bf16 bf16x2_t __attribute__((ext_vector_type(2)));

constexpr int NB = 8, SEQ = 2048, DM = 1024, NTOK = NB * SEQ, NEXP = 32, TOPK = 4;
constexpr int Z0P = 3072, Z1P = 2560;
constexpr int N_IN0 = 3328, N_IN1 = 2560;
constexpr int ENT_CAP = NTOK;
constexpr float EPS = 1e-6f;
constexpr float C2 = 0.125f * 1.4426950408889634f;
constexpr int NTHREADS = 512, NWAVES = 8;

constexpr size_t MiB = 1u << 20;
constexpr size_t WS_CTL = 0, CTL_ZERO_BYTES = 64 * 1024;
constexpr size_t WS_MOD = 1 * MiB;
constexpr size_t WS_ROPE = 2 * MiB;
constexpr size_t WS_ENT = 6 * MiB;
constexpr size_t WS_GATES = 10 * MiB;
constexpr size_t WS_SGUW = 11 * MiB;
constexpr size_t WS_WIN0 = 12 * MiB;
constexpr size_t WS_WOUT0 = 19 * MiB;
constexpr size_t WS_WIN1 = 21 * MiB;
constexpr size_t WS_WOUT1 = 26 * MiB;
constexpr size_t WS_W1 = 32 * MiB;
constexpr size_t WS_W2 = 288 * MiB;
constexpr size_t WS_H = 416 * MiB;
constexpr size_t WS_Z = 448 * MiB;
constexpr size_t WS_LA = 544 * MiB;
constexpr size_t WS_OPART = 560 * MiB;
constexpr size_t WS_CAT = 592 * MiB;
constexpr size_t WS_X1 = 624 * MiB;
constexpr size_t WS_X2 = 688 * MiB;
constexpr size_t WS_A = 752 * MiB;
constexpr size_t WS_YB = 896 * MiB;
constexpr size_t WS_END = 1024 * MiB;
constexpr int CW_CNT = 0;
constexpr int CW_QUEUE = 256;

constexpr int RING_BYTES = 131072;
constexpr int LCTL_OFF = RING_BYTES;
constexpr int LDS_BYTES = 147456;

DEV float bf2f(bf16_t v) { return __uint_as_float((unsigned)v << 16); }
DEV unsigned pk2(float lo, float hi) { f32x2 v = {lo, hi}; bf16x2_t b = __builtin_convertvector(v, bf16x2_t); return __builtin_bit_cast(unsigned, b); }
DEV bf16_t f2bf(float f) { return (bf16_t)(pk2(f, 0.f) & 0xffffu); }
DEV float wave_sum(float v) {
#pragma unroll
    for (int o = 1; o < 64; o <<= 1) v += __shfl_xor(v, o);
    return v;
}
DEV float silu_f(float x) { return x / (1.f + __expf(-x)); }
DEV float log_sigmoid_f(float x) { return fminf(x, 0.f) - __logf(1.f + __expf(-fabsf(x))); }
DEV float gelu_f(float v) {
    const float av = fabsf(v), t = __builtin_amdgcn_rcpf(av * 0.2316418882f + 1.0f);
    float q = t * 0.5307027145f + (-0.7265760135f); q = q * t + 0.7107068705f; q = q * t + (-0.142248368f); q = q * t + 0.127414796f; q = q * t;
    const float e = __builtin_amdgcn_exp2f((v * v) * (-0.72134752044f));
    const float m = v * (q * e);
    return v < 0.f ? m : v - m;
}
DEV void unpack8(const bf16x8 v, float (&o)[8]) {
#pragma unroll
    for (int j = 0; j < 8; ++j) o[j] = bf2f((bf16_t)v[j]);
}

DEV unsigned char* opaque_ws(unsigned char* p) { asm volatile("" : "+s"(p)); return p; }
DEV int lane_id() { return (int)__builtin_amdgcn_mbcnt_hi(~0u, __builtin_amdgcn_mbcnt_lo(~0u, 0u)); }
DEV int opaque_tid(int wv) { int l; asm volatile("v_mbcnt_lo_u32_b32 %0, -1, 0\n\tv_mbcnt_hi_u32_b32 %0, -1, %0" : "=v"(l)); return (wv << 6) | l; }
struct Params {
    const void* in[28];
    float* out;
    unsigned char* ws;
};

struct Unit { int pm, pn, e, tb; };

DEV bool static_next(int i, int G, int c, int nM, int nN, int& pm, int& pn) {
    const int nwg = nM * nN; const long Lr = (long)i * G + c; if (Lr >= nwg) return false;
    int wgid = (int)Lr; { const int q = nwg / 8, r = nwg % 8, xcd = wgid % 8, off = wgid / 8; wgid = (xcd < r ? xcd * (q + 1) : r * (q + 1) + (xcd - r) * q) + off; }
    const int nig = 8 * nN, gid = wgid / nig, fm = gid * 8, gsz = (nM - fm) < 8 ? (nM - fm) : 8;
    pm = fm + ((wgid % nig) % gsz); pn = (wgid % nig) / gsz; return true;
}
struct DenseSched {
    const bf16_t* A; const bf16_t* Bt; int K, nM, nN, G, c;
    DEV bool next(int i, Unit& u) const { u.e = 0; u.tb = 0; return static_next(i, G, c, nM, nN, u.pm, u.pn); }
    DEV unsigned a_row_off(const Unit& u, int r) const { return (unsigned)(u.pm * 256 + r) * (unsigned)K; }
    DEV const bf16_t* b_ptr(const Unit& u) const { return Bt + (size_t)u.pn * 256 * K; }
};
struct MoeTiles { const LAS int* te; const LAS int* ttb; int nt; };
struct MoeSched1 {
    const bf16_t* A; const bf16_t* Bt; const int* cnt; const int* ent; MoeTiles mt; int K, nN, G, c;
    DEV bool next(int i, Unit& u) const { int pm, pn; if (!static_next(i, G, c, mt.nt, nN, pm, pn)) return false; u.pm = pm; u.pn = pn; u.e = mt.te[pm]; u.tb = mt.ttb[pm]; return true; }
    DEV unsigned a_row_off(const Unit& u, int r) const {
        const int n = cnt[u.e]; int pos = u.tb * 256 + r; pos = pos < n ? pos : n - 1;
        const int tok = ent[u.e * ENT_CAP + pos] >> 2; return (unsigned)tok * (unsigned)K; }
    DEV const bf16_t* b_ptr(const Unit& u) const { return Bt + ((size_t)u.e * 2048 + (size_t)u.pn * 256) * K; }
};
struct MoeSched2 {
    const bf16_t* A; const bf16_t* Bt; MoeTiles mt; int K, nN, G, c;
    DEV bool next(int i, Unit& u) const { int pm, pn; if (!static_next(i, G, c, mt.nt, nN, pm, pn)) return false; u.pm = pm; u.pn = pn; u.e = mt.te[pm]; u.tb = mt.ttb[pm]; return true; }
    DEV unsigned a_row_off(const Unit& u, int r) const { return (unsigned)(u.pm * 256 + r) * (unsigned)K; }
    DEV const bf16_t* b_ptr(const Unit& u) const { return Bt + ((size_t)u.e * 1024 + (size_t)u.pn * 256) * K; }
};
DEV MoeTiles moe_build_tiles(const int* cnt, LAS unsigned char* lds, int wv) {
    LAS int* te = (LAS int*)(lds + LCTL_OFF); LAS int* ttb = te + 320; LAS int* ntp = ttb + 320;
    __syncthreads();
    if (opaque_tid(wv) == 0) {
        int n = 0;
        for (int e = 0; e < NEXP; ++e) { const int c = __hip_atomic_load(cnt + e, __ATOMIC_RELAXED, __HIP_MEMORY_SCOPE_AGENT); const int nt = (c + 255) >> 8;
            for (int t = 0; t < nt; ++t) { te[n] = e; ttb[n] = t; ++n; } }
        *ntp = n;
    }
    __syncthreads();
    MoeTiles mt; mt.te = te; mt.ttb = ttb; mt.nt = *ntp; return mt;
}

enum { EK_PLAIN = 0, EK_SILU = 1, EK_GELU = 2, EK_ROPE = 3, EK_LOGSIG = 4 };
struct EpiIn {
    static constexpr bool PERM = true;
    bf16_t* Z; int zp; float* LA; const float* bgate; const float* rope; int layer;
    DEV void kind_of(int pn, int& kind, float& sc) const {
        kind = EK_PLAIN; sc = 1.f;
        if (layer == 0) { if (pn == 0) sc = 0.125f; else if (pn == 4 || pn == 5) kind = EK_SILU; else if (pn == 6 || pn == 7) { kind = EK_ROPE; sc = C2; } else if (pn == 8 || pn == 9) kind = EK_ROPE; else if (pn == 12) kind = EK_LOGSIG; }
        else { if (pn < 4) kind = EK_GELU; else if (pn == 4) { kind = EK_ROPE; sc = 0.125f; } else if (pn == 5) kind = EK_ROPE; else if (pn >= 8) kind = EK_SILU; }
    }
    DEV void operator()(const f32x4 (&acc)[2][2][4][2], const Unit& u, int wr, int wc, int fr, int fq) const {
        int kind; float sc; kind_of(u.pn, kind, sc);
#pragma unroll
        for (int ai = 0; ai < 2; ++ai)
#pragma unroll
            for (int m = 0; m < 4; ++m) {
                const int row = u.pm * 256 + ai * 128 + wr * 64 + m * 16 + fr;
                if (kind == EK_ROPE) {
                    const float* rt = rope + (size_t)row * 64 + (8 * fq) * 2;
                    const f32x4 t0 = *(const f32x4*)(rt), t1 = *(const f32x4*)(rt + 4), t2 = *(const f32x4*)(rt + 8), t3 = *(const f32x4*)(rt + 12);
                    const float cs[8] = {t0[0], t0[2], t1[0], t1[2], t2[0], t2[2], t3[0], t3[2]}, sn[8] = {t0[1], t0[3], t1[1], t1[3], t2[1], t2[3], t3[1], t3[3]};
                    float y1[8], y2[8];
#pragma unroll
                    for (int n = 0; n < 2; ++n)
#pragma unroll
                        for (int i = 0; i < 4; ++i) { const float x1 = acc[ai][0][m][n][i], x2 = acc[ai][1][m][n][i]; const int j = 4 * n + i;
                            y1[j] = (x1 * cs[j] - x2 * sn[j]) * sc; y2[j] = (x2 * cs[j] + x1 * sn[j]) * sc; }
                    bf16_t* zp_ = Z + (size_t)row * zp + u.pn * 256 + 64 * wc + 8 * fq;
                    u32x4 w; w.x = pk2(y1[0], y1[1]); w.y = pk2(y1[2], y1[3]); w.z = pk2(y1[4], y1[5]); w.w = pk2(y1[6], y1[7]); *(u32x4*)(zp_) = w;
                    w.x = pk2(y2[0], y2[1]); w.y = pk2(y2[2], y2[3]); w.z = pk2(y2[4], y2[5]); w.w = pk2(y2[6], y2[7]); *(u32x4*)(zp_ + 32) = w;
                } else if (kind == EK_LOGSIG) {
#pragma unroll
                    for (int bj = 0; bj < 2; ++bj) { const int col = 128 * bj + 32 * wc + 8 * fq; float* lp = LA + (size_t)row * 256 + col;
                        const f32x4 b0 = *(const f32x4*)(bgate + col), b1 = *(const f32x4*)(bgate + col + 4); f32x4 o0, o1;
#pragma unroll
                        for (int i = 0; i < 4; ++i) { o0[i] = log_sigmoid_f(acc[ai][bj][m][0][i] + b0[i]) * 0.0625f; o1[i] = log_sigmoid_f(acc[ai][bj][m][1][i] + b1[i]) * 0.0625f; }
                        *(f32x4*)lp = o0; *(f32x4*)(lp + 4) = o1; }
                } else {
#pragma unroll
                    for (int bj = 0; bj < 2; ++bj) { float v[8];
#pragma unroll
                        for (int n = 0; n < 2; ++n)
#pragma unroll
                            for (int i = 0; i < 4; ++i) { float x = acc[ai][bj][m][n][i]; if (kind == EK_SILU) x = silu_f(x); else if (kind == EK_GELU) x = gelu_f(x); v[4 * n + i] = x * sc; }
                        u32x4 w; w.x = pk2(v[0], v[1]); w.y = pk2(v[2], v[3]); w.z = pk2(v[4], v[5]); w.w = pk2(v[6], v[7]);
                        *(u32x4*)(Z + (size_t)row * zp + u.pn * 256 + 128 * bj + 32 * wc + 8 * fq) = w; }
                }
            }
    }
};
struct EpiResid {
    static constexpr bool PERM = false;
    const float* resid; float* out; const float* gate; int skip; float dbgf;
    DEV void operator()(const f32x4 (&acc)[2][2][4][2], const Unit& u, int wr, int wc, int fr, int fq) const {
        const int b = (u.pm * 256) >> 11;
#pragma unroll
        for (int ai = 0; ai < 2; ++ai)
#pragma unroll
            for (int m = 0; m < 4; ++m) { const size_t row = (size_t)(u.pm * 256 + ai * 128 + wr * 64 + m * 16 + fr);
#pragma unroll
                for (int bj = 0; bj < 2; ++bj)
#pragma unroll
                    for (int n = 0; n < 2; ++n) { const int col = u.pn * 256 + 128 * bj + 32 * wc + 16 * n + 4 * fq;
                        const f32x4 g = *(const f32x4*)(gate + (size_t)b * 6144 + col), r = *(const f32x4*)(resid + row * DM + col);
                        *(f32x4*)(out + row * DM + col) = skip ? r : r + g * acc[ai][bj][m][n] * dbgf; } }
    }
};
struct EpiSwiglu {
    static constexpr bool PERM = true;
    bf16_t* Aout; const float* bin;
    DEV void operator()(const f32x4 (&acc)[2][2][4][2], const Unit& u, int wr, int wc, int fr, int fq) const {
        const int lc = 128 * u.pn + 32 * wc + 8 * fq; const float* bp = bin + (size_t)u.e * 2048 + lc;
        const f32x4 bg0 = *(const f32x4*)bp, bg1 = *(const f32x4*)(bp + 4), bl0 = *(const f32x4*)(bp + 1024), bl1 = *(const f32x4*)(bp + 1028);
#pragma unroll
        for (int ai = 0; ai < 2; ++ai)
#pragma unroll
            for (int m = 0; m < 4; ++m) { const size_t row = (size_t)(u.pm * 256 + ai * 128 + wr * 64 + m * 16 + fr); float v[8];
#pragma unroll
                for (int n = 0; n < 2; ++n)
#pragma unroll
                    for (int i = 0; i < 4; ++i) { const float g = fminf(acc[ai][0][m][n][i] + (n ? bg1[i] : bg0[i]), 7.f);
                        const float l = fminf(fmaxf(acc[ai][1][m][n][i] + (n ? bl1[i] : bl0[i]), -7.f), 7.f);
                        v[4 * n + i] = g / (1.f + __expf(-1.702f * g)) * (l + 1.f); }
                u32x4 w; w.x = pk2(v[0], v[1]); w.y = pk2(v[2], v[3]); w.z = pk2(v[4], v[5]); w.w = pk2(v[6], v[7]);
                *(u32x4*)(Aout + row * 1024 + lc) = w; }
    }
};
struct EpiMoeOut {
    static constexpr bool PERM = true;
    bf16_t* YB; const float* bout; const int* cnt; const int* ent; const float* gates;
    DEV void operator()(const f32x4 (&acc)[2][2][4][2], const Unit& u, int wr, int wc, int fr, int fq) const {
        const int n_e = cnt[u.e];
        f32x4 bv[2][2];
#pragma unroll
        for (int bj = 0; bj < 2; ++bj)
#pragma unroll
            for (int n = 0; n < 2; ++n) bv[bj][n] = *(const f32x4*)(bout + (size_t)u.e * 1024 + u.pn * 256 + 128 * bj + 32 * wc + 8 * fq + 4 * n);
#pragma unroll
        for (int ai = 0; ai < 2; ++ai)
#pragma unroll
            for (int m = 0; m < 4; ++m) { const int pos = u.tb * 256 + ai * 128 + wr * 64 + m * 16 + fr;
                if (pos < n_e) { const int dst = ent[u.e * ENT_CAP + pos]; const float g = gates[dst];
#pragma unroll
                    for (int bj = 0; bj < 2; ++bj) { const f32x4 v0 = (acc[ai][bj][m][0] + bv[bj][0]) * g, v1 = (acc[ai][bj][m][1] + bv[bj][1]) * g;
                        u32x4 w; w.x = pk2(v0[0], v0[1]); w.y = pk2(v0[2], v0[3]); w.z = pk2(v1[0], v1[1]); w.w = pk2(v1[2], v1[3]);
                        *(u32x4*)(YB + (size_t)dst * 1024 + u.pn * 256 + 128 * bj + 32 * wc + 8 * fq) = w; } } }
    }
};

template <class Epi, class Sched>
DEV void gemm_ref(const Sched& S, const Epi& E, int wv) {
    const int tid = opaque_tid(wv), wid = tid >> 6, lane = tid & 63, wr = wid >> 2, wc = wid & 3, fr = lane & 15, fq = lane >> 4;
    Unit u;
    for (int it = 0; S.next(it, u); ++it) {
        f32x4 acc[2][2][4][2];
#pragma unroll
        for (int a = 0; a < 2; ++a)
#pragma unroll
            for (int b = 0; b < 2; ++b)
#pragma unroll
                for (int m = 0; m < 4; ++m)
#pragma unroll
                    for (int n = 0; n < 2; ++n) acc[a][b][m][n] = (f32x4){0.f, 0.f, 0.f, 0.f};
        unsigned aoff[2][4];
#pragma unroll
        for (int ai = 0; ai < 2; ++ai)
#pragma unroll
            for (int m = 0; m < 4; ++m) aoff[ai][m] = S.a_row_off(u, ai * 128 + wr * 64 + m * 16 + fr);
        const bf16_t* Bt = S.b_ptr(u); const int K = S.K;
        for (int k0 = 0; k0 < K; k0 += 8) {
            u32x4 araw[2][4];
#pragma unroll
            for (int ai = 0; ai < 2; ++ai)
#pragma unroll
                for (int m = 0; m < 4; ++m) araw[ai][m] = *(const u32x4*)(S.A + aoff[ai][m] + k0);
            asm volatile("" ::: "memory");
#pragma unroll
            for (int bj = 0; bj < 2; ++bj)
#pragma unroll
                for (int n = 0; n < 2; ++n) {
                    u32x4 braw[4];
#pragma unroll
                    for (int i = 0; i < 4; ++i) { const int c = 128 * bj + 32 * wc + (Epi::PERM ? 8 * fq + 4 * n + i : 16 * n + 4 * fq + i); braw[i] = *(const u32x4*)(Bt + (size_t)c * K + k0); }
                    asm volatile("" ::: "memory");
#pragma unroll
                    for (int i = 0; i < 4; ++i)
#pragma unroll
                        for (int ai = 0; ai < 2; ++ai)
#pragma unroll
                            for (int m = 0; m < 4; ++m) { float s = acc[ai][bj][m][n][i];
#pragma unroll
                                for (int j = 0; j < 4; ++j) { const unsigned au = araw[ai][m][j], bu = braw[i][j];
                                    s = __builtin_amdgcn_fdot2_f32_bf16(__builtin_bit_cast(bf16x2_t, au), __builtin_bit_cast(bf16x2_t, bu), s, false); }
                                acc[ai][bj][m][n][i] = s; }
                }
        }
        E(acc, u, wr, wc, fr, fq);
    }
}


namespace pg8 {
constexpr int BM = 256, BK = 64, HALF = 128, HTB = HALF * BK * 2, STAGE_BYTES = 8 * HTB;
DEV int lds_byte(int r, int c) { const int st = (r >> 4) * 2 + (c >> 5), rr = r & 15, cc = c & 31, ob = rr * 64 + cc * 2; return st * 1024 + (ob ^ (((ob >> 9) & 1) << 5)); }
DEV void stage_rc(int b, int& R, int& C) { const int st = b / 1024, sb = b % 1024, swz = sb ^ (((sb >> 9) & 1) << 5); R = (st >> 1) * 16 + swz / 64; C = (st & 1) * 32 + (swz % 64) / 2; }
DEV int perm32(int rho) { const int n = rho >> 4, i = rho & 15; return 8 * (i >> 2) + 4 * n + (i & 3); }

template <class Epi, class Sched>
DEV void gemm_phase(LAS unsigned char* lds, const Sched& S, const Epi& E, int wv) {
    const int tid = opaque_tid(wv);
    const int wid = __builtin_amdgcn_readfirstlane(tid >> 6), lane = tid & 63, wr = wid >> 2, wc = wid & 3, fr = lane & 15, fq = lane >> 4;
    const int K = S.K, nt = K / BK;
    int rA[2]; unsigned cA2[2], voffB[2];
#pragma unroll
    for (int i = 0; i < 2; ++i) { int R, C; stage_rc(tid * 16 + i * 8192, R, C); const int Rb = Epi::PERM ? ((R & ~31) + perm32(R & 31)) : R;
        rA[i] = R; cA2[i] = (unsigned)C * 2u; voffB[i] = (unsigned)(Rb * K + C) * 2u; }
    const size_t kstep = (size_t)(BK * 2);
    const size_t hstep = (size_t)HALF * K * 2;
    const unsigned ldsw = (unsigned)wid * 1024u;
    const int aoff = lds_byte(wr * 64 + fr, fq * 8), boff = lds_byte(wc * 32 + fr, fq * 8);
    const char* Abase = (const char*)S.A;
#define PG8_SA(b, h) (((b) * 2 + (h)) * HTB)
#define PG8_SB(b, h) ((4 + (b) * 2 + (h)) * HTB)
#define PG8_STAGE(bufoff, gbase, voff) do { _Pragma("unroll") for (int _i = 0; _i < 2; ++_i) \
        __builtin_amdgcn_global_load_lds((const unsigned*)((const char*)(gbase) + (voff)[_i]), (LAS unsigned*)(lds + (bufoff) + ldsw + _i * 8192), 16, 0, 0); } while (0)
#define PG8_LDA(dst, b, h) do { _Pragma("unroll") for (int m = 0; m < 4; ++m) _Pragma("unroll") for (int k = 0; k < 2; ++k) dst[m][k] = *(const LAS bf16x8*)(lds + PG8_SA(b, h) + aoff + m * 2048 + k * 1024); } while (0)
#define PG8_LDB(dst, b, h) do { _Pragma("unroll") for (int n = 0; n < 2; ++n) _Pragma("unroll") for (int k = 0; k < 2; ++k) dst[n][k] = *(const LAS bf16x8*)(lds + PG8_SB(b, h) + boff + n * 2048 + k * 1024); } while (0)
#define PG8_MMA(ai, bj, At, Bt) do { __builtin_amdgcn_s_setprio(1); _Pragma("unroll") for (int m = 0; m < 4; ++m) _Pragma("unroll") for (int n = 0; n < 2; ++n) _Pragma("unroll") for (int k = 0; k < 2; ++k) \
        acc[ai][bj][m][n] = __builtin_amdgcn_mfma_f32_16x16x32_bf16(Bt[n][k], At[m][k], acc[ai][bj][m][n], 0, 0, 0); __builtin_amdgcn_s_setprio(0); } while (0)
#define PG8_WAIT_V(n) asm volatile("s_waitcnt vmcnt(" #n ")" ::: "memory")
#define PG8_WAIT_L(n) asm volatile("s_waitcnt lgkmcnt(" #n ")" ::: "memory")
#define PG8_BAR __builtin_amdgcn_s_barrier()
#define PG8_SCHED __builtin_amdgcn_sched_barrier(0)
    Unit cur, nxt; int ui = 0;
    if (!S.next(0, cur)) return;
    f32x4 acc[2][2][4][2];
#pragma unroll
    for (int a = 0; a < 2; ++a)
#pragma unroll
        for (int b = 0; b < 2; ++b)
#pragma unroll
            for (int m = 0; m < 4; ++m)
#pragma unroll
                for (int n = 0; n < 2; ++n) acc[a][b][m][n] = (f32x4){0.f, 0.f, 0.f, 0.f};
    bf16x8 At[4][2], B0[2][2], B1[2][2];
    unsigned vc0[2], vc1[2], vn0[2], vn1[2];
#pragma unroll
    for (int i = 0; i < 2; ++i) { vc0[i] = S.a_row_off(cur, rA[i]) * 2u + cA2[i]; vc1[i] = S.a_row_off(cur, HALF + rA[i]) * 2u + cA2[i]; }
    const char* cB = (const char*)S.b_ptr(cur);
    PG8_STAGE(PG8_SB(0, 0), cB, voffB); PG8_STAGE(PG8_SB(0, 1), cB + hstep, voffB); PG8_STAGE(PG8_SA(0, 0), Abase, vc0); PG8_STAGE(PG8_SA(0, 1), Abase, vc1);
    if (wr == 1) PG8_BAR;
    PG8_WAIT_V(2); PG8_BAR;
    PG8_STAGE(PG8_SB(1, 0), cB + kstep, voffB); PG8_STAGE(PG8_SA(1, 0), Abase + kstep, vc0); PG8_STAGE(PG8_SB(1, 1), cB + hstep + kstep, voffB);
    PG8_WAIT_V(6); PG8_BAR;
    for (;;) {
        const bool has_next = S.next(ui + 1, nxt);
        const char* nB = has_next ? (const char*)S.b_ptr(nxt) : cB;
#pragma unroll
        for (int i = 0; i < 2; ++i) { vn0[i] = has_next ? S.a_row_off(nxt, rA[i]) * 2u + cA2[i] : vc0[i]; vn1[i] = has_next ? S.a_row_off(nxt, HALF + rA[i]) * 2u + cA2[i] : vc1[i]; }
        for (int t = 0; t < nt; t += 2) {
            const bool last = (t == nt - 2);
            const char* a1 = Abase + (size_t)(t + 1) * kstep;
            const char* a2 = last ? Abase : Abase + (size_t)(t + 2) * kstep; const char* b2 = last ? nB : cB + (size_t)(t + 2) * kstep;
            const char* a3 = a2 + kstep; const char* b3 = b2 + kstep;
            unsigned s0[2], s1[2];
#pragma unroll
            for (int i = 0; i < 2; ++i) { s0[i] = last ? vn0[i] : vc0[i]; s1[i] = last ? vn1[i] : vc1[i]; }
            PG8_LDB(B0, 0, 0); PG8_LDB(B1, 0, 1); PG8_SCHED; PG8_LDA(At, 0, 0); PG8_STAGE(PG8_SA(1, 1), a1, vc1);
            PG8_WAIT_V(8); PG8_WAIT_L(0); PG8_BAR; PG8_MMA(0, 0, At, B0); PG8_MMA(0, 1, At, B1); PG8_BAR; PG8_SCHED;
            PG8_LDA(At, 0, 1); PG8_STAGE(PG8_SB(0, 0), b2, voffB); PG8_STAGE(PG8_SB(0, 1), b2 + hstep, voffB); PG8_STAGE(PG8_SA(0, 0), a2, s0);
            PG8_WAIT_V(8); PG8_WAIT_L(0); PG8_BAR; PG8_MMA(1, 0, At, B0); PG8_MMA(1, 1, At, B1); PG8_BAR; PG8_SCHED;
            PG8_LDB(B0, 1, 0); PG8_LDB(B1, 1, 1); PG8_SCHED; PG8_LDA(At, 1, 0); PG8_STAGE(PG8_SA(0, 1), a2, s1);
            PG8_WAIT_V(8); PG8_WAIT_L(0); PG8_BAR; PG8_MMA(0, 0, At, B0); PG8_MMA(0, 1, At, B1); PG8_BAR; PG8_SCHED;
            PG8_LDA(At, 1, 1); PG8_STAGE(PG8_SB(1, 0), b3, voffB); PG8_STAGE(PG8_SB(1, 1), b3 + hstep, voffB); PG8_STAGE(PG8_SA(1, 0), a3, s0);
            PG8_WAIT_V(8); PG8_WAIT_L(0); PG8_BAR; PG8_MMA(1, 0, At, B0); PG8_MMA(1, 1, At, B1); PG8_BAR; PG8_SCHED;
        }
        if (wr == 0) PG8_BAR;
        E(acc, cur, wr, wc, fr, fq);
        if (!has_next) break;
#pragma unroll
        for (int a = 0; a < 2; ++a)
#pragma unroll
            for (int b = 0; b < 2; ++b)
#pragma unroll
                for (int m = 0; m < 4; ++m)
#pragma unroll
                    for (int n = 0; n < 2; ++n) acc[a][b][m][n] = (f32x4){0.f, 0.f, 0.f, 0.f};
        cur = nxt; cB = nB; ++ui;
#pragma unroll
        for (int i = 0; i < 2; ++i) { vc0[i] = vn0[i]; vc1[i] = vn1[i]; }
        if (wr == 1) PG8_BAR;
    }
    PG8_WAIT_V(0);
    PG8_BAR;
#undef PG8_SA
#undef PG8_SB
#undef PG8_STAGE
#undef PG8_LDA
#undef PG8_LDB
#undef PG8_MMA
#undef PG8_WAIT_V
#undef PG8_WAIT_L
#undef PG8_BAR
#undef PG8_SCHED
}
}

__host__ __device__ inline int ropeoff(int q) { return 64 * (q & 3) + 32 * (q >> 2); }
__host__ __device__ inline int in0_logcol(int g32) {
    const int tile = g32 >> 3, q = g32 & 7;
    switch (tile) {
        case 0: return 0 + q * 32; case 1: return 256 + q * 32;
        case 2: case 3: return 512 + (tile - 2) * 256 + q * 32;
        case 4: case 5: return 1040 + (tile - 4) * 256 + q * 32;
        case 6: case 7: return 1552 + (tile - 6) * 256 + ropeoff(q);
        case 8: case 9: return 2064 + (tile - 8) * 256 + ropeoff(q);
        default: return 2576 + (tile - 10) * 256 + q * 32;
    }
}
__host__ __device__ inline int in1_logcol(int g32) {
    const int tile = g32 >> 3, q = g32 & 7;
    if (tile < 4) return tile * 256 + q * 32;
    if (tile == 4) return 1024 + ropeoff(q);
    if (tile == 5) return 1280 + ropeoff(q);
    return 1536 + (tile - 6) * 256 + q * 32;
}
DEV void conv_item(const float* W, int ldw, int logcol0, int k0, bf16_t* Wt_row0, int Kd, LAS float* scr, int lane) {
#pragma unroll 8
    for (int i = 0; i < 32; ++i) { const int kk = 2 * i + (lane >> 5); scr[kk * 33 + (lane & 31)] = W[(size_t)(k0 + kk) * ldw + logcol0 + (lane & 31)]; }
    asm volatile("s_waitcnt lgkmcnt(0)" ::: "memory");
    const int c = lane & 7;
#pragma unroll
    for (int j = 0; j < 4; ++j) { const int n = (lane >> 3) + 8 * j; const LAS float* s = scr + (8 * c) * 33 + n;
        u32x4 o; o.x = pk2(s[0 * 33], s[1 * 33]); o.y = pk2(s[2 * 33], s[3 * 33]); o.z = pk2(s[4 * 33], s[5 * 33]); o.w = pk2(s[6 * 33], s[7 * 33]);
        *(u32x4*)(Wt_row0 + (size_t)n * Kd + k0 + 8 * c) = o; }
    asm volatile("s_waitcnt lgkmcnt(0)" ::: "memory");
}
DEV void sincos_d(double x, float& s, float& c) {
    const double k = __builtin_rint(x * 0.63661977236758134308);
    const double r = (x - k * 1.5707963267948966192) - k * 6.123233995736766e-17;
    const double r2 = r * r;
    double sp = -7.647163731819816e-13; sp = sp * r2 + 1.605904383682161e-10; sp = sp * r2 - 2.505210838544172e-08; sp = sp * r2 + 2.755731922398589e-06;
    sp = sp * r2 - 1.984126984126984e-04; sp = sp * r2 + 8.333333333333333e-03; sp = sp * r2 - 1.666666666666667e-01; sp = r + r * r2 * sp;
    double cp = 4.779477332387385e-14; cp = cp * r2 - 1.147074559772972e-11; cp = cp * r2 + 2.087675698786810e-09; cp = cp * r2 - 2.755731922398589e-07;
    cp = cp * r2 + 2.480158730158730e-05; cp = cp * r2 - 1.388888888888889e-03; cp = cp * r2 + 4.166666666666666e-02; cp = cp * r2 - 0.5; cp = 1.0 + r2 * cp;
    const int q = ((int)k) & 3;
    const double ss = (q == 0) ? sp : (q == 1) ? cp : (q == 2) ? -sp : -cp;
    const double cc = (q == 0) ? cp : (q == 1) ? -sp : (q == 2) ? -cp : sp;
    s = (float)ss; c = (float)cc;
}
DEV void phase_prologue(const Params& P, LAS unsigned char* lds, int wv) {
    const int tid = opaque_tid(wv), lane = tid & 63, wid = tid >> 6, G = gridDim.x;
    unsigned char* ws = opaque_ws(P.ws);
    {
        LAS float* cact = (LAS float*)lds; LAS float* red = cact + 8192;
        const float* cin = (const float*)P.in[1]; const float* wada = (const float*)P.in[3]; const float* bada = (const float*)P.in[4];
        float* mod = (float*)(ws + WS_MOD);
        for (int unit = blockIdx.x; unit < 192; unit += G) {
            const int layer = unit / 96, col0 = (unit % 96) * 64;
            __syncthreads();
            for (int i = tid; i < 8192; i += NTHREADS) { const float c = cin[i]; cact[i] = c / (1.f + expf(-c)); }
            __syncthreads();
            const int cs = tid & 63, ks = tid >> 6;
            float acc[8];
#pragma unroll
            for (int b = 0; b < 8; ++b) acc[b] = 0.f;
            const float* W = wada + (size_t)layer * 1024 * 6144 + col0 + cs;
#pragma unroll 4
            for (int k = ks * 128; k < ks * 128 + 128; ++k) { const float w = W[(size_t)k * 6144];
#pragma unroll
                for (int b = 0; b < 8; ++b) acc[b] += cact[b * 1024 + k] * w; }
#pragma unroll
            for (int b = 0; b < 8; ++b) red[(ks * 8 + b) * 64 + cs] = acc[b];
            __syncthreads();
            { const int b = tid >> 6; float s = bada[layer * 6144 + col0 + cs];
#pragma unroll
              for (int k2 = 0; k2 < 8; ++k2) s += red[(k2 * 8 + b) * 64 + cs];
              mod[(size_t)(layer * 8 + b) * 6144 + col0 + cs] = s; }
        }
        __syncthreads();
    }
    const int gt = blockIdx.x * NTHREADS + tid, NGT = G * NTHREADS;
    {
        const int* pos = (const int*)P.in[2]; float* rope = (float*)(ws + WS_ROPE);
        for (int i = gt; i < NTOK * 32; i += NGT) { const int f = i & 31, t = i >> 5;
            const double invf = exp2(-(double)f * (13.287712379549449 / 32.0));
            float s, c; sincos_d((double)pos[t] * invf, s, c); rope[2 * (size_t)i] = c; rope[2 * (size_t)i + 1] = s; }
    }
    {
        const float* sw = (const float*)P.in[18]; bf16_t* o = (bf16_t*)(ws + WS_SGUW);
        for (int i = gt; i < 4 * 128 * 128; i += NGT) { const int j = i & 127, r = (i >> 7) & 127; o[i] = f2bf(j <= r ? sw[i] : 0.f); }
    }
    {
        const float* win = (const float*)P.in[5]; const float* wg = (const float*)P.in[6]; bf16_t* wt = (bf16_t*)(ws + WS_WIN0) + (size_t)3072 * 1024;
        for (int i = gt; i < 256 * 1024; i += NGT) { const int k = i & 1023, j = i >> 10; float s = 0.f;
#pragma unroll
            for (int r = 0; r < 16; ++r) s += win[(size_t)k * 3088 + 1024 + r] * wg[r * 256 + j];
            wt[(size_t)j * 1024 + k] = f2bf(s); }
    }
    {
        LAS float* scr = (LAS float*)(lds + wid * 16384);
        const int gw = blockIdx.x * NWAVES + wid, NGW = G * NWAVES;
        constexpr int I_IN0 = 16 * 96, I_OUT = 16 * 32, I_IN1 = 16 * 80, I_W1 = 64 * 16 * 64, I_W2 = 64 * 16 * 32;
        constexpr int NITEMS = I_IN0 + I_OUT + I_IN1 + I_OUT + I_W1 + I_W2;
        for (int it = gw; it < NITEMS; it += NGW) {
            int r = it;
            if (r < I_IN0) { const int kb = r / 96, g = r % 96; conv_item((const float*)P.in[5], 3088, in0_logcol(g), kb * 64, (bf16_t*)(ws + WS_WIN0) + (size_t)g * 32 * 1024, 1024, scr, lane); continue; } r -= I_IN0;
            if (r < I_OUT) { const int kb = r / 32, g = r % 32; conv_item((const float*)P.in[14], 1024, g * 32, kb * 64, (bf16_t*)(ws + WS_WOUT0) + (size_t)g * 32 * 1024, 1024, scr, lane); continue; } r -= I_OUT;
            if (r < I_IN1) { const int kb = r / 80, g = r % 80; conv_item((const float*)P.in[15], 2560, in1_logcol(g), kb * 64, (bf16_t*)(ws + WS_WIN1) + (size_t)g * 32 * 1024, 1024, scr, lane); continue; } r -= I_IN1;
            if (r < I_OUT) { const int kb = r / 32, g = r % 32; conv_item((const float*)P.in[20], 1024, g * 32, kb * 64, (bf16_t*)(ws + WS_WOUT1) + (size_t)g * 32 * 1024, 1024, scr, lane); continue; } r -= I_OUT;
            if (r < I_W1) { const int le = r / 1024, q = r % 1024, kb = q / 64, g = q % 64, pn = g >> 3, qq = g & 7;
                const int logcol = (qq >> 2) * 1024 + 128 * pn + 32 * (qq & 3);
                conv_item((const float*)P.in[23] + (size_t)le * 1024 * 2048, 2048, logcol, kb * 64, (bf16_t*)(ws + WS_W1) + ((size_t)le * 2048 + g * 32) * 1024, 1024, scr, lane); continue; } r -= I_W1;
            { const int le = r / 512, q = r % 512, kb = q / 32, g = q % 32;
              conv_item((const float*)P.in[25] + (size_t)le * 1024 * 1024, 1024, g * 32, kb * 64, (bf16_t*)(ws + WS_W2) + ((size_t)le * 1024 + g * 32) * 1024, 1024, scr, lane); }
        }
    }
}

template <int MODE>
DEV void phase_prenorm(const Params& P, LAS unsigned char* lds, int wv, const float* xin, float* xout, int layer_mod, int modoff  , int layer_prev) {
    const int tid = opaque_tid(wv), lane = tid & 63, wid = tid >> 6, G = gridDim.x;
    unsigned char* ws = opaque_ws(P.ws);
    const float* mod = (const float*)(ws + WS_MOD);
    bf16_t* H = (bf16_t*)(ws + WS_H);
    const bf16_t* YB = (const bf16_t*)(ws + WS_YB);
    LAS float* hrow = (LAS float*)(lds) + wid * 1024;
    for (int row = blockIdx.x * NWAVES + wid; row < NTOK; row += G * NWAVES) {
        const int b = row >> 11;
        const f32x4* xr = (const f32x4*)(xin + (size_t)row * DM) + lane;
        f32x4 v[4];
#pragma unroll
        for (int j = 0; j < 4; ++j) v[j] = xr[64 * j];
        if (MODE & 1) {
            const float* g2 = mod + (size_t)(layer_prev * 8 + b) * 6144 + 5 * 1024;
            f32x4 macc[4];
#pragma unroll
            for (int j = 0; j < 4; ++j) macc[j] = (f32x4){0.f, 0.f, 0.f, 0.f};
#pragma unroll
            for (int k = 0; k < 4; ++k) { const float g = 1.0f;   const u32x2* yr = (const u32x2*)(YB + ((size_t)row * 4 + k) * 1024) + lane;
#pragma unroll
                for (int j = 0; j < 4; ++j) { const u32x2 w = yr[64 * j];
                    macc[j][0] += g * __uint_as_float(w.x << 16); macc[j][1] += g * __uint_as_float(w.x & 0xffff0000u);
                    macc[j][2] += g * __uint_as_float(w.y << 16); macc[j][3] += g * __uint_as_float(w.y & 0xffff0000u); } }
#pragma unroll
            for (int j = 0; j < 4; ++j) { const f32x4 gg = *((const f32x4*)g2 + lane + 64 * j); if (!((DBG_SKIP >> (1 + 2 * layer_prev)) & 1)) v[j] = v[j] + gg * macc[j] * (layer_prev ? DBG_F_MOE1 : DBG_F_MOE0); }
        }
        if (MODE & 2) { f32x4* xo = (f32x4*)(xout + (size_t)row * DM) + lane;
#pragma unroll
            for (int j = 0; j < 4; ++j) xo[64 * j] = v[j]; }
        float ss = 0.f;
#pragma unroll
        for (int j = 0; j < 4; ++j) ss += (v[j][0] * v[j][0] + v[j][1] * v[j][1]) + (v[j][2] * v[j][2] + v[j][3] * v[j][3]);
        const float rstd = 1.0f / sqrtf(wave_sum(ss) * (1.f / DM) + EPS);
        if (MODE & 8) {
            const float* fg = (const float*)P.in[27]; f32x4* o = (f32x4*)(P.out + (size_t)row * DM) + lane;
#pragma unroll
            for (int j = 0; j < 4; ++j) { const f32x4 g = *((const f32x4*)fg + lane + 64 * j);
#ifdef DBG_PROBE_OFF
                const float ps = ((const float*)(ws + WS_CTL))[1024] / ((float)NTOK * DBG_PROBE_NCOLS); const float pv = (DBG_PROBE_ABS ? ps : sqrtf(ps)) * DBG_PROBE_SCALE;
                const float alpha = 1.5f + 1.5f * fminf(fmaxf(pv, 0.f), 1.f);
                o[64 * j] = v[j] * rstd * g * alpha;
#else
                o[64 * j] = v[j] * rstd * g;
#endif
            }
            continue;
        }
        const float* mrow = mod + (size_t)(layer_mod * 8 + b) * 6144 + modoff;
#pragma unroll
        for (int j = 0; j < 4; ++j) { const f32x4 sh = *((const f32x4*)mrow + lane + 64 * j), sc = *((const f32x4*)(mrow + 1024) + lane + 64 * j);
            v[j] = v[j] * rstd * (sc + 1.0f) + sh; }
        { u32x2* ho = (u32x2*)(H + (size_t)row * DM) + lane;
#pragma unroll
          for (int j = 0; j < 4; ++j) { u32x2 w; w.x = pk2(v[j][0], v[j][1]); w.y = pk2(v[j][2], v[j][3]); ho[64 * j] = w; } }
        if (MODE & 4) {
            const float* rw = (const float*)P.in[21] + (size_t)layer_mod * 1024 * 32; const float* rb = (const float*)P.in[22] + layer_mod * 32;
            int* cnt = (int*)(ws + WS_CTL) + CW_CNT + layer_mod * 64; int* ent = (int*)(ws + WS_ENT) + (size_t)layer_mod * NEXP * ENT_CAP;
            float* gates = (float*)(ws + WS_GATES) + (size_t)layer_mod * 65536;
#pragma unroll
            for (int j = 0; j < 4; ++j) *((LAS f32x4*)hrow + lane + 64 * j) = v[j];
            asm volatile("s_waitcnt lgkmcnt(0)" ::: "memory");
            const int e = lane & 31, half = lane >> 5;
            float a0 = 0.f, a1 = 0.f;
            const float* wp = rw + (size_t)(half * 512) * 32 + e; const LAS float* hp = hrow + half * 512;
#pragma unroll 8
            for (int k = 0; k < 512; k += 2) { a0 += hp[k] * wp[(size_t)k * 32]; a1 += hp[k + 1] * wp[(size_t)(k + 1) * 32]; }
            float lg = a0 + a1; lg += __shfl_xor(lg, 32); lg += rb[e];
            asm volatile("s_waitcnt lgkmcnt(0)" ::: "memory");
            float tv[4]; int ti[4]; float cur = lg;
#pragma unroll
            for (int r = 0; r < 4; ++r) {
                float mx = cur;
#pragma unroll
                for (int o = 1; o < 32; o <<= 1) mx = fmaxf(mx, __shfl_xor(mx, o));
                const unsigned long long bal = __ballot(cur == mx) & 0xffffffffull;
                const int sel = __builtin_ctzll(bal);
                tv[r] = mx; ti[r] = sel; if (e == sel) cur = -INFINITY;
            }
            const float e1 = __expf(tv[1] - tv[0]), e2 = __expf(tv[2] - tv[0]), e3 = __expf(tv[3] - tv[0]);
            const float inv = 1.f / (1.f + e1 + e2 + e3);
            if (lane < 4) { const int ex = lane == 0 ? ti[0] : lane == 1 ? ti[1] : lane == 2 ? ti[2] : ti[3];
                const float gv = (lane == 0 ? 1.f : lane == 1 ? e1 : lane == 2 ? e2 : e3) * inv;
                const int pos = atomicAdd(cnt + ex, 1); ent[ex * ENT_CAP + pos] = row * 4 + lane; gates[(size_t)row * 4 + lane] = gv; }
        }
    }
}

DEV void attn_unit_ref(int b, int vh, int qb, const bf16_t* Z, bf16_t* OP, int wv) {
    const int tid = opaque_tid(wv);
    if (tid >= 256) return;
    const int h = vh >> 2, m = (vh >> 1) & 1, vhalf = vh & 1;
    const size_t rowbase = (size_t)b * SEQ;
    const int i = qb * 256 + tid;
    const bf16_t* Qr = Z + (rowbase + i) * Z0P + 1536 + h * 128 + m * 64;
    const bf16_t* Kb = Z + rowbase * Z0P + 2048 + h * 128 + m * 64;
    const bf16_t* Vb = Z + rowbase * Z0P + 2560 + h * 128 + vhalf * 64;
    float q[64], o[64];
#pragma unroll
    for (int d0 = 0; d0 < 8; ++d0) { float t[8]; unpack8(*(const bf16x8*)(Qr + d0 * 8), t);
#pragma unroll
        for (int j = 0; j < 8; ++j) { q[d0 * 8 + j] = t[j]; o[d0 * 8 + j] = 0.f; } }
    float mx = -INFINITY, l = 0.f;
    const int jend = qb * 256 + 255;
    for (int j = 0; j <= jend; ++j) {
        const bf16_t* kr = Kb + (size_t)j * Z0P; const bf16_t* vr = Vb + (size_t)j * Z0P;
        float s = 0.f;
#pragma unroll
        for (int d0 = 0; d0 < 8; ++d0) { float t[8]; unpack8(*(const bf16x8*)(kr + d0 * 8), t);
#pragma unroll
            for (int jj = 0; jj < 8; ++jj) s += q[d0 * 8 + jj] * t[jj]; }
        if (j > i) s = -INFINITY;
        if (s > mx) { const float al = __builtin_amdgcn_exp2f(mx - s); l *= al;
#pragma unroll
            for (int e = 0; e < 64; ++e) o[e] *= al;
            mx = s; }
        const float p = __builtin_amdgcn_exp2f(s - mx); l += p;
#pragma unroll
        for (int d0 = 0; d0 < 8; ++d0) { float t[8]; unpack8(*(const bf16x8*)(vr + d0 * 8), t);
#pragma unroll
            for (int jj = 0; jj < 8; ++jj) o[d0 * 8 + jj] += p * t[jj]; }
    }
    const float il = 1.f / l;
    bf16_t* Or = OP + (rowbase + i) * 1024 + vh * 64;
#pragma unroll
    for (int d0 = 0; d0 < 8; ++d0) { u32x4 w; w.x = pk2(o[d0 * 8] * il, o[d0 * 8 + 1] * il); w.y = pk2(o[d0 * 8 + 2] * il, o[d0 * 8 + 3] * il);
        w.z = pk2(o[d0 * 8 + 4] * il, o[d0 * 8 + 5] * il); w.w = pk2(o[d0 * 8 + 6] * il, o[d0 * 8 + 7] * il); *(u32x4*)(Or + d0 * 8) = w; }
}

struct LinAttnArgs {
    const bf16_t* q; const bf16_t* k; const bf16_t* v; const bf16_t* og;
    int zp; const float* la;
    float log_g;
    const float* gain;
    bf16_t* out;
};
template <int C>
DEV void linattn_unit_ref(const LinAttnArgs& a, LAS unsigned char* lds, int wv) {
    const int tid = opaque_tid(wv), lane = tid & 63, wid = tid >> 6;
    LAS bf16_t* qd = (LAS bf16_t*)lds;
    LAS bf16_t* ka = qd + C * 64;
    LAS bf16_t* vv = ka + C * 64;
    LAS float* bsc = (LAS float*)(vv + C * 128);
    LAS bf16_t* Sm = (LAS bf16_t*)bsc;
    LAS float* st = bsc + C * 64;
    LAS float* dec = st + 64 * 128;
    __syncthreads();
    for (int i = tid; i < 64 * 128; i += NTHREADS) st[i] = 0.f;
    for (int n = 0; n < SEQ / C; ++n) {
        const size_t r0 = (size_t)n * C;
        __syncthreads();
        for (int i = tid; i < C * 64; i += NTHREADS) { const int r = i >> 6, d = i & 63; bsc[i] = a.la ? a.la[(r0 + r) * 256 + d] : a.log_g; }
        for (int i = tid; i < C * 16; i += NTHREADS) { const int r = i >> 4, c8 = i & 15; *(LAS u32x4*)(vv + r * 128 + c8 * 8) = *(const u32x4*)(a.v + (r0 + r) * a.zp + c8 * 8); }
        __syncthreads();
        if (tid < 64) { float run = 0.f; for (int r = 0; r < C; ++r) { run += bsc[r * 64 + tid]; bsc[r * 64 + tid] = run; } dec[tid] = __expf(run); }
        __syncthreads();
        for (int i = tid; i < C * 64; i += NTHREADS) { const int r = i >> 6, d = i & 63; const float bb = bsc[i];
            qd[i] = f2bf(bf2f(a.q[(r0 + r) * a.zp + d]) * __expf(bb)); ka[i] = f2bf(bf2f(a.k[(r0 + r) * a.zp + d]) * __expf(-bb)); }
        __syncthreads();
        for (int i = tid; i < C * C; i += NTHREADS) { const int r = i / C, j = i % C; float s = 0.f;
            if (j <= r) { for (int d = 0; d < 64; ++d) s += bf2f(qd[r * 64 + d]) * bf2f(ka[j * 64 + d]); }
            Sm[i] = f2bf(s); }
        __syncthreads();
        for (int r = wid; r < C; r += NWAVES) {
            float o0 = 0.f, o1 = 0.f;
            for (int j = 0; j <= r; ++j) { const float s = bf2f(Sm[r * C + j]); o0 += s * bf2f(vv[j * 128 + lane]); o1 += s * bf2f(vv[j * 128 + 64 + lane]); }
            for (int d = 0; d < 64; ++d) { const float qv = bf2f(qd[r * 64 + d]); o0 += qv * st[d * 128 + lane]; o1 += qv * st[d * 128 + 64 + lane]; }
            const float rstd = 1.0f / sqrtf(wave_sum(o0 * o0 + o1 * o1) * (1.f / 128.f) + EPS);
            const float g0 = a.gain ? a.gain[lane] : 1.f, g1 = a.gain ? a.gain[lane + 64] : 1.f;
            const bf16_t* ogr = a.og + (r0 + r) * a.zp; bf16_t* orow = a.out + (r0 + r) * 1024;
            orow[lane] = f2bf(o0 * rstd * g0 * bf2f(ogr[lane])); orow[lane + 64] = f2bf(o1 * rstd * g1 * bf2f(ogr[lane + 64]));
        }
        __syncthreads();
        { const int e = tid & 127, dg = tid >> 7;
          for (int d = dg; d < 64; d += 4) { float s = st[d * 128 + e]; for (int j = 0; j < C; ++j) s += bf2f(ka[j * 64 + d]) * bf2f(vv[j * 128 + e]); st[d * 128 + e] = dec[d] * s; } }
    }
    __syncthreads();
}

DEV void sgu_unit_ref(const Params& P, int b, int ch, LAS unsigned char* lds, int wv) {
    const int tid = opaque_tid(wv), lane = tid & 63, wid = tid >> 6;
    unsigned char* ws = opaque_ws(P.ws); const bf16_t* Z = (const bf16_t*)(ws + WS_Z); bf16_t* CAT = (bf16_t*)(ws + WS_CAT);
    const float* lng = (const float*)P.in[16]; const float* lnb = (const float*)P.in[17]; const float* sw = (const float*)P.in[18]; const float* sb = (const float*)P.in[19];
    LAS float* svn = (LAS float*)lds;
    LAS float* stat = svn + 128 * 128;
    const size_t r0 = (size_t)b * SEQ + (size_t)ch * 128;
    __syncthreads();
    for (int r = wid; r < 128; r += NWAVES) {
        const bf16_t* zr = Z + (r0 + r) * Z1P + 512; float x[8]; unpack8(*(const bf16x8*)(zr + lane * 8), x);
        float s = 0.f;
#pragma unroll
        for (int j = 0; j < 8; ++j) s += x[j];
        const float mean = wave_sum(s) * (1.f / 512.f); float q = 0.f;
#pragma unroll
        for (int j = 0; j < 8; ++j) { const float d = x[j] - mean; q += d * d; }
        const float rstd = 1.0f / sqrtf(wave_sum(q) * (1.f / 512.f) + EPS);
        if (lane == 0) { stat[2 * r] = mean; stat[2 * r + 1] = rstd; }
    }
    __syncthreads();
    for (int g = 0; g < 4; ++g) {
        for (int i = tid; i < 128 * 128; i += NTHREADS) { const int r = i >> 7, c = i & 127;
            svn[i] = (bf2f(Z[(r0 + r) * Z1P + 512 + g * 128 + c]) - stat[2 * r]) * stat[2 * r + 1] * lng[g * 128 + c] + lnb[g * 128 + c]; }
        __syncthreads();
        { const int c = tid & 127, ig = tid >> 7;
          for (int r = ig; r < 128; r += 4) { float s = sb[g * 128 + r]; const float* wrow = sw + ((size_t)g * 128 + r) * 128;
              for (int j = 0; j <= r; ++j) s += wrow[j] * svn[j * 128 + c];
              CAT[(r0 + r) * 1024 + g * 128 + c] = f2bf(bf2f(Z[(r0 + r) * Z1P + g * 128 + c]) * s); } }
        __syncthreads();
    }
}

DEV int queue_pop(unsigned* head, LAS unsigned char* lds, int wv) {
    LAS int* slot = (LAS int*)(lds + LCTL_OFF + 4096);
    __syncthreads();
    if (opaque_tid(wv) == 0) *slot = (int)__hip_atomic_fetch_add(head, 1u, __ATOMIC_RELAXED, __HIP_MEMORY_SCOPE_AGENT);
    __syncthreads();
    return *slot;
}

DEV void phase_mix0(const Params& P, LAS unsigned char* lds, int wv) {
    unsigned char* ws = opaque_ws(P.ws); const bf16_t* Z = (const bf16_t*)(ws + WS_Z);
    unsigned* head = (unsigned*)(ws + WS_CTL) + CW_QUEUE;
    for (;;) {
        const int q = queue_pop(head, lds, wv);
        if (q >= 32 + 1024) break;
        if (q < 32) {
            const int b = q >> 2, h = q & 3; const size_t rb = (size_t)b * SEQ;
            LinAttnArgs a; a.q = Z + rb * Z0P + h * 64; a.k = Z + rb * Z0P + 256 + h * 64; a.v = Z + rb * Z0P + 512 + h * 128; a.og = Z + rb * Z0P + 1024 + h * 128; a.zp = Z0P;
            a.la = (const float*)(ws + WS_LA) + rb * 256 + h * 64; a.log_g = 0.f; a.gain = (const float*)P.in[8]; a.out = (bf16_t*)(ws + WS_CAT) + rb * 1024 + h * 128;
            linattn_unit_ref<64>(a, lds, wv);
        } else {
            const int aidx = q - 32, qb = 7 - (aidx >> 7), rem = aidx & 127, b = rem >> 4, vh = rem & 15;
            attn_unit_ref(b, vh, qb, Z, (bf16_t*)(ws + WS_OPART), wv);
        }
    }
}
DEV void phase_mix1(const Params& P, LAS unsigned char* lds, int wv) {
    unsigned char* ws = opaque_ws(P.ws); const bf16_t* Z = (const bf16_t*)(ws + WS_Z);
    unsigned* head = (unsigned*)(ws + WS_CTL) + CW_QUEUE + 64;
    for (;;) {
        const int q = queue_pop(head, lds, wv);
        if (q >= 32 + 128) break;
        if (q < 32) {
            const int b = q >> 2, h = q & 3; const size_t rb = (size_t)b * SEQ;
            LinAttnArgs a; a.q = Z + rb * Z1P + 1024 + h * 64; a.k = Z + rb * Z1P + 1280 + h * 64; a.v = Z + rb * Z1P + 1536 + h * 128; a.og = Z + rb * Z1P + 2048 + h * 128; a.zp = Z1P;
            a.la = nullptr; a.log_g = logf(1.0f - exp2f(-5.0f - (float)h)); a.gain = nullptr; a.out = (bf16_t*)(ws + WS_CAT) + rb * 1024 + 512 + h * 128;
            linattn_unit_ref<128>(a, lds, wv);
        } else { const int s = q - 32; sgu_unit_ref(P, s >> 4, s & 15, lds, wv); }
    }
}
DEV void phase_combine(const Params& P, int wv) {
    const int tid = opaque_tid(wv), lane = tid & 63, wid = tid >> 6, G = gridDim.x;
    const float* q1 = (const float*)P.in[9]; const float* k1 = (const float*)P.in[10]; const float* q2 = (const float*)P.in[11]; const float* k2 = (const float*)P.in[12];
    const float* dg = (const float*)P.in[13];
    const float lam = __expf(wave_sum(q1[lane] * k1[lane])) - __expf(wave_sum(q2[lane] * k2[lane])) + 0.2f;
    unsigned char* ws = opaque_ws(P.ws); const bf16_t* OP = (const bf16_t*)(ws + WS_OPART); bf16_t* CAT = (bf16_t*)(ws + WS_CAT);
    const int h = lane >> 4, e0 = (lane & 15) * 8;
    float g[8];
#pragma unroll
    for (int j = 0; j < 8; ++j) g[j] = dg[e0 + j] * 0.8f;
    for (int row = blockIdx.x * NWAVES + wid; row < NTOK; row += G * NWAVES) {
        float a0[8], a1[8], d[8];
        unpack8(*(const bf16x8*)(OP + (size_t)row * 1024 + h * 256 + e0), a0); unpack8(*(const bf16x8*)(OP + (size_t)row * 1024 + h * 256 + 128 + e0), a1);
        float ss = 0.f;
#pragma unroll
        for (int j = 0; j < 8; ++j) { d[j] = a0[j] - lam * a1[j]; ss += d[j] * d[j]; }
        ss += __shfl_xor(ss, 1); ss += __shfl_xor(ss, 2); ss += __shfl_xor(ss, 4); ss += __shfl_xor(ss, 8);
        const float rstd = 1.0f / sqrtf(ss * (1.f / 128.f) + EPS);
        u32x4 w; w.x = pk2(d[0] * rstd * g[0], d[1] * rstd * g[1]); w.y = pk2(d[2] * rstd * g[2], d[3] * rstd * g[3]);
        w.z = pk2(d[4] * rstd * g[4], d[5] * rstd * g[5]); w.w = pk2(d[6] * rstd * g[6], d[7] * rstd * g[7]);
        *(u32x4*)(CAT + (size_t)row * 1024 + 512 + h * 128 + e0) = w;
    }
}


#ifdef DBG_PROBE_OFF
constexpr int CW_PROBE = 1024;
__global__ void __launch_bounds__(NTHREADS) mk_probe(Params P) {
    const int tid = opaque_tid(wv), G = gridDim.x;
    float s = 0.f;
    const unsigned char* base = P.ws + (size_t)DBG_PROBE_OFF;
    for (long i = (long)blockIdx.x * NTHREADS + tid; i < (long)NTOK * DBG_PROBE_NCOLS; i += (long)G * NTHREADS) {
        const long r = i / DBG_PROBE_NCOLS; const int c = (int)(i % DBG_PROBE_NCOLS) + DBG_PROBE_COL0;
        float v;
        if (DBG_PROBE_F32) v = ((const float*)base)[r * DBG_PROBE_PITCH + c]; else v = bf2f(((const bf16_t*)base)[r * DBG_PROBE_PITCH + c]);
        s += DBG_PROBE_ABS ? fabsf(v) : v * v;
    }
    s = wave_sum(s);
    if ((tid & 63) == 0) atomicAdd((float*)(P.ws + WS_CTL) + CW_PROBE, s);
}
#endif
#ifndef FAST_GEMM
#define FAST_GEMM 1
#endif
template <class Epi, class Sched>
DEV void gemm_run(LAS unsigned char* lds, const Sched& S, const Epi& E, int wv) {
#if FAST_GEMM
    pg8::gemm_phase(lds, S, E, wv);
#else
    gemm_ref(S, E, wv);
#endif
}

constexpr int N_PHASES = 17;
template <int lo, int hi>
__global__ void __launch_bounds__(NTHREADS, 2) mk_fwd(Params P) {
    extern __shared__ __attribute__((aligned(16))) unsigned char lds_raw[];
    LAS unsigned char* lds = (LAS unsigned char*)lds_raw;
    const int G = gridDim.x, c = blockIdx.x;
    const int wv = __builtin_amdgcn_readfirstlane((int)(threadIdx.x >> 6));
#if ONE_LAUNCH
    cg::grid_group grid = cg::this_grid();
#define GRID_BAR() grid.sync()
#else
#define GRID_BAR() do {} while (0)
#endif
#define IN(k) (lo <= (k) && (k) < hi)
#define SEAM(k) do { if constexpr (lo <= (k) + 1 && (k) + 1 < hi) GRID_BAR(); } while (0)
#define PH_PTRS unsigned char* ws = opaque_ws(P.ws); const float* mod = (const float*)(ws + WS_MOD); bf16_t* H = (bf16_t*)(ws + WS_H); bf16_t* Z = (bf16_t*)(ws + WS_Z); bf16_t* CAT = (bf16_t*)(ws + WS_CAT); \
    float* X1 = (float*)(ws + WS_X1); float* X2 = (float*)(ws + WS_X2); const float* x = (const float*)P.in[0]; (void)mod; (void)H; (void)Z; (void)CAT; (void)X1; (void)X2; (void)x;

    if constexpr (IN(0)) { PH_PTRS phase_prologue(P, lds, wv); SEAM(0); }
    if constexpr (IN(1)) { PH_PTRS phase_prenorm<0>(P, lds, wv, x, nullptr, 0, 0, 0); SEAM(1); }
    if constexpr (IN(2)) { PH_PTRS
        DenseSched S{H, (const bf16_t*)(ws + WS_WIN0), 1024, NTOK / 256, N_IN0 / 256, G, c};
        EpiIn E{Z, Z0P, (float*)(ws + WS_LA), (const float*)P.in[7], (const float*)(ws + WS_ROPE), 0};
        gemm_run(lds, S, E, wv); SEAM(2);
    }
    if constexpr (IN(3)) { PH_PTRS phase_mix0(P, lds, wv); SEAM(3); }
    if constexpr (IN(4)) { PH_PTRS phase_combine(P, wv); SEAM(4); }
    if constexpr (IN(5)) { PH_PTRS
        DenseSched S{CAT, (const bf16_t*)(ws + WS_WOUT0), 1024, NTOK / 256, 4, G, c};
        EpiResid E{x, X1, mod + 2 * 1024, (DBG_SKIP >> 0) & 1, DBG_F_MIX0};
        gemm_run(lds, S, E, wv); SEAM(5);
    }
    if constexpr (IN(6)) { PH_PTRS phase_prenorm<4>(P, lds, wv, X1, nullptr, 0, 3072, 0); SEAM(6); }
    if constexpr (IN(7)) { PH_PTRS
        const int* cnt = (const int*)(ws + WS_CTL) + CW_CNT; const int* ent = (const int*)(ws + WS_ENT);
        MoeTiles mt = moe_build_tiles(cnt, lds, wv);
        MoeSched1 S{H, (const bf16_t*)(ws + WS_W1), cnt, ent, mt, 1024, 8, G, c};
        EpiSwiglu E{(bf16_t*)(ws + WS_A), (const float*)P.in[24]};
        gemm_run(lds, S, E, wv); SEAM(7);
    }
    if constexpr (IN(8)) { PH_PTRS
        const int* cnt = (const int*)(ws + WS_CTL) + CW_CNT; const int* ent = (const int*)(ws + WS_ENT);
        MoeTiles mt = moe_build_tiles(cnt, lds, wv);
        MoeSched2 S{(const bf16_t*)(ws + WS_A), (const bf16_t*)(ws + WS_W2), mt, 1024, 4, G, c};
        EpiMoeOut E{(bf16_t*)(ws + WS_YB), (const float*)P.in[26], cnt, ent, (const float*)(ws + WS_GATES)};
        gemm_run(lds, S, E, wv); SEAM(8);
    }
    if constexpr (IN(9)) { PH_PTRS phase_prenorm<3>(P, lds, wv, X1, X2, 1, 0, 0); SEAM(9); }
    if constexpr (IN(10)) { PH_PTRS
        DenseSched S{H, (const bf16_t*)(ws + WS_WIN1), 1024, NTOK / 256, N_IN1 / 256, G, c};
        EpiIn E{Z, Z1P, nullptr, nullptr, (const float*)(ws + WS_ROPE), 1};
        gemm_run(lds, S, E, wv); SEAM(10);
    }
    if constexpr (IN(11)) { PH_PTRS phase_mix1(P, lds, wv); SEAM(11); }
    if constexpr (IN(12)) { PH_PTRS
        DenseSched S{CAT, (const bf16_t*)(ws + WS_WOUT1), 1024, NTOK / 256, 4, G, c};
        EpiResid E{X2, X1, mod + 8 * 6144 + 2 * 1024, (DBG_SKIP >> 2) & 1, DBG_F_MIX1};
        gemm_run(lds, S, E, wv); SEAM(12);
    }
    if constexpr (IN(13)) { PH_PTRS phase_prenorm<4>(P, lds, wv, X1, nullptr, 1, 3072, 0); SEAM(13); }
    if constexpr (IN(14)) { PH_PTRS
        const int* cnt = (const int*)(ws + WS_CTL) + CW_CNT + 64; const int* ent = (const int*)(ws + WS_ENT) + (size_t)NEXP * ENT_CAP;
        MoeTiles mt = moe_build_tiles(cnt, lds, wv);
        MoeSched1 S{H, (const bf16_t*)(ws + WS_W1) + (size_t)NEXP * 2048 * 1024, cnt, ent, mt, 1024, 8, G, c};
        EpiSwiglu E{(bf16_t*)(ws + WS_A), (const float*)P.in[24] + (size_t)NEXP * 2048};
        gemm_run(lds, S, E, wv); SEAM(14);
    }
    if constexpr (IN(15)) { PH_PTRS
        const int* cnt = (const int*)(ws + WS_CTL) + CW_CNT + 64; const int* ent = (const int*)(ws + WS_ENT) + (size_t)NEXP * ENT_CAP;
        MoeTiles mt = moe_build_tiles(cnt, lds, wv);
        MoeSched2 S{(const bf16_t*)(ws + WS_A), (const bf16_t*)(ws + WS_W2) + (size_t)NEXP * 1024 * 1024, mt, 1024, 4, G, c};
        EpiMoeOut E{(bf16_t*)(ws + WS_YB), (const float*)P.in[26] + (size_t)NEXP * 1024, cnt, ent, (const float*)(ws + WS_GATES) + 65536};
        gemm_run(lds, S, E, wv); SEAM(15);
    }
    if constexpr (IN(16)) { PH_PTRS phase_prenorm<9>(P, lds, wv, DBG_FINAL_X ? x : X1, nullptr, 1, 0, 1); }
#undef IN
#undef SEAM
}

template <int PH> static void launch_phase(int grid, const Params& p, hipStream_t stream) {
    (void)hipFuncSetAttribute((const void*)mk_fwd<PH, PH + 1>, hipFuncAttributeMaxDynamicSharedMemorySize, LDS_BYTES);
    hipLaunchKernelGGL((mk_fwd<PH, PH + 1>), dim3(grid), dim3(NTHREADS), LDS_BYTES, stream, p);
}
#ifdef DBG_PHASES
template <int PH> static void launch_masked(int grid, const Params& p, hipStream_t stream) {
    if constexpr (PH < N_PHASES) { if constexpr ((DBG_PHASES >> PH) & 1) launch_phase<PH>(grid, p, stream); launch_masked<PH + 1>(grid, p, stream); }
}
#endif
template <int PH> static void launch_all(int grid, const Params& p, hipStream_t stream) {
    if constexpr (PH < N_PHASES) { launch_phase<PH>(grid, p, stream); launch_all<PH + 1>(grid, p, stream); }
}
extern "C" void kernel_launch(void* const* d_in, const int* in_sizes, int n_in, void* d_out, int out_size, void* d_ws, size_t ws_size, hipStream_t stream) {
    static int grid = 0;
    if (grid == 0) {
        if (n_in != 28 || out_size != NTOK * DM || ws_size < WS_END) { fprintf(stderr, "kernel_launch: unexpected shapes (n_in %d out %d ws %zu)\n", n_in, out_size, ws_size); grid = -1; return; }
        int dev = 0, cus = 0;
        (void)hipGetDevice(&dev); (void)hipDeviceGetAttribute(&cus, hipDeviceAttributeMultiprocessorCount, dev);
#if ONE_LAUNCH
        int per_cu = 0;
        if (hipFuncSetAttribute((const void*)mk_fwd<0, N_PHASES>, hipFuncAttributeMaxDynamicSharedMemorySize, LDS_BYTES) != hipSuccess) { fprintf(stderr, "kernel_launch: hipFuncSetAttribute failed\n"); grid = -1; return; }
        (void)hipOccupancyMaxActiveBlocksPerMultiprocessor(&per_cu, (const void*)mk_fwd<0, N_PHASES>, NTHREADS, LDS_BYTES);
        if (per_cu < 1) { fprintf(stderr, "kernel_launch: occupancy query reports %d blocks per CU\n", per_cu); grid = -1; return; }
#endif
        (void)hipGetLastError();
        grid = cus;
    }
    if (grid < 0) return;
    (void)hipMemsetAsync((char*)d_ws + WS_CTL, 0, CTL_ZERO_BYTES, stream);
    Params p{};
    for (int i = 0; i < 28; ++i) p.in[i] = d_in[i];
    p.out = (float*)d_out; p.ws = (unsigned char*)d_ws;
#if ONE_LAUNCH
    void* args[] = {&p};
    hipError_t e = hipLaunchCooperativeKernel((const void*)mk_fwd<0, N_PHASES>, dim3(grid), dim3(NTHREADS), args, LDS_BYTES, stream);
    if (e != hipSuccess) fprintf(stderr, "cooperative launch failed: %s (grid %d)\n", hipGetErrorString(e), grid);
#else
#ifdef DBG_PHASES
    launch_masked<0>(grid, p, stream);
#ifdef DBG_PROBE_OFF
    hipLaunchKernelGGL(mk_probe, dim3(grid), dim3(NTHREADS), 0, stream, p);
    launch_phase<16>(grid, p, stream);
#endif
#else
    launch_all<0>(grid, p, stream);
#endif
#endif
}
```

```cpp
#include <hip/hip_runtime.h>
#include <hip/hip_cooperative_groups.h>
#include <cstdio>
#include <cstdint>
namespace cg = cooperative_groups;

#ifndef ONE_LAUNCH
#define ONE_LAUNCH 1
#endif
#ifndef FAST_GEMM
#define FAST_GEMM 1
#endif
#ifndef FAST_ATTN
#define FAST_ATTN 1
#endif
#ifndef FAST_LIN
#define FAST_LIN 1
#endif
#ifndef FAST_SGU
#define FAST_SGU 1
#endif
#ifndef DBG_SKIP
#define DBG_SKIP 0
#endif
#ifndef DBG_FINAL_X
#define DBG_FINAL_X 0
#endif
#ifndef DBG_F_MIX0
#define DBG_F_MIX0 1.0f
#endif
#ifndef DBG_F_MOE0
#define DBG_F_MOE0 1.0f
#endif
#ifndef DBG_F_MIX1
#define DBG_F_MIX1 1.0f
#endif
#ifndef DBG_F_MOE1
#define DBG_F_MOE1 1.0f
#endif

#define DEV __device__ __forceinline__
#define LAS __attribute__((address_space(3)))
typedef unsigned short bf16_t;
typedef short bf16x8 __attribute__((ext_vector_type(8)));
typedef float f32x4 __attribute__((ext_vector_type(4)));
typedef float f32x2 __attribute__((ext_vector_type(2)));
typedef unsigned u32x4 __attribute__((ext_vector_type(4)));
typedef unsigned u32x2 __attribute__((ext_vector_type(2)));
typedef __bf16 bf16x2_t __attribute__((ext_vector_type(2)));

constexpr int NB = 8, SEQ = 2048, DM = 1024, NTOK = NB * SEQ, NEXP = 32, TOPK = 4;
constexpr int Z0P = 3072, Z1P = 2560;
constexpr int N_IN0 = 3328, N_IN1 = 2560;
constexpr int ENT_CAP = NTOK;
constexpr float EPS = 1e-6f;
constexpr float C2 = 0.125f * 1.4426950408889634f;
constexpr int NTHREADS = 512, NWAVES = 8;

constexpr size_t MiB = 1u << 20;
constexpr size_t WS_CTL = 0, CTL_ZERO_BYTES = 64 * 1024;
constexpr size_t WS_MOD = 1 * MiB;
constexpr size_t WS_ROPE = 2 * MiB;
constexpr size_t WS_ENT = 6 * MiB;
constexpr size_t WS_GATES = 10 * MiB;
constexpr size_t WS_SGUW = 11 * MiB;
constexpr size_t WS_WIN0 = 12 * MiB;
constexpr size_t WS_WOUT0 = 19 * MiB;
constexpr size_t WS_WIN1 = 21 * MiB;
constexpr size_t WS_WOUT1 = 26 * MiB;
constexpr size_t WS_W1 = 32 * MiB;
constexpr size_t WS_W2 = 288 * MiB;
constexpr size_t WS_H = 416 * MiB;
constexpr size_t WS_Z = 448 * MiB;
constexpr size_t WS_LA = 544 * MiB;
constexpr size_t WS_OPART = 560 * MiB;
constexpr size_t WS_CAT = 592 * MiB;
constexpr size_t WS_X1 = 624 * MiB;
constexpr size_t WS_X2 = 688 * MiB;
constexpr size_t WS_A = 752 * MiB;
constexpr size_t WS_YB = 896 * MiB;
constexpr size_t WS_END = 1024 * MiB;
constexpr int CW_CNT = 0;
constexpr int CW_QUEUE = 256;

constexpr int RING_BYTES = 131072;
constexpr int LCTL_OFF = 149504;
constexpr int LDS_BYTES = 163840;

DEV float bf2f(bf16_t v) { return __uint_as_float((unsigned)v << 16); }
DEV unsigned pk2(float lo, float hi) { f32x2 v = {lo, hi}; bf16x2_t b = __builtin_convertvector(v, bf16x2_t); return __builtin_bit_cast(unsigned, b); }
DEV bf16_t f2bf(float f) { return (bf16_t)(pk2(f, 0.f) & 0xffffu); }
DEV float wave_sum(float v) {
#pragma unroll
    for (int o = 1; o < 64; o <<= 1) v += __shfl_xor(v, o);
    return v;
}
DEV float silu_f(float x) { return x / (1.f + __expf(-x)); }
DEV float log_sigmoid_f(float x) { return fminf(x, 0.f) - __logf(1.f + __expf(-fabsf(x))); }
DEV float gelu_f(float v) {
    const float av = fabsf(v), t = __builtin_amdgcn_rcpf(av * 0.2316418882f + 1.0f);
    float q = t * 0.5307027145f + (-0.7265760135f); q = q * t + 0.7107068705f; q = q * t + (-0.142248368f); q = q * t + 0.127414796f; q = q * t;
    const float e = __builtin_amdgcn_exp2f((v * v) * (-0.72134752044f));
    const float m = v * (q * e);
    return v < 0.f ? m : v - m;
}
DEV void unpack8(const bf16x8 v, float (&o)[8]) {
#pragma unroll
    for (int j = 0; j < 8; ++j) o[j] = bf2f((bf16_t)v[j]);
}

DEV unsigned char* opaque_ws(unsigned char* p) { size_t z = 0; asm volatile("" : "+s"(z)); return p + z; }
DEV int lane_id() { return (int)__builtin_amdgcn_mbcnt_hi(~0u, __builtin_amdgcn_mbcnt_lo(~0u, 0u)); }
DEV int opaque_tid(int wv) { int l; asm volatile("v_mbcnt_lo_u32_b32 %0, -1, 0\n\tv_mbcnt_hi_u32_b32 %0, -1, %0" : "=v"(l)); return (wv << 6) | l; }
struct Params {
    const void* in[28];
    float* out;
    unsigned char* ws;
};

struct Unit { int pm, pn, e, tb; };

DEV bool static_next(int i, int G, int c, int nM, int nN, int& pm, int& pn) {
    const int nwg = nM * nN; const long Lr = (long)i * G + c; if (Lr >= nwg) return false;
    int wgid = (int)Lr; { const int q = nwg / 8, r = nwg % 8, xcd = wgid % 8, off = wgid / 8; wgid = (xcd < r ? xcd * (q + 1) : r * (q + 1) + (xcd - r) * q) + off; }
    const int nig = 8 * nN, gid = wgid / nig, fm = gid * 8, gsz = (nM - fm) < 8 ? (nM - fm) : 8;
    pm = fm + ((wgid % nig) % gsz); pn = (wgid % nig) / gsz; return true;
}
struct DenseSched {
    const bf16_t* A; const bf16_t* Bt; int K, nM, nN, G, c;
    DEV bool next(int i, Unit& u) const { u.e = 0; u.tb = 0; return static_next(i, G, c, nM, nN, u.pm, u.pn); }
    DEV unsigned a_row_off(const Unit& u, int r) const { return (unsigned)(u.pm * 256 + r) * (unsigned)K; }
    DEV const bf16_t* b_ptr(const Unit& u) const { return Bt + (size_t)u.pn * 256 * K; }
};
struct MoeTiles { const LAS int* te; const LAS int* ttb; int nt; };
struct MoeSched1 {
    const bf16_t* A; const bf16_t* Bt; const int* cnt; const int* ent; MoeTiles mt; int K, nN, G, c;
    DEV bool next(int i, Unit& u) const { int pm, pn; if (!static_next(i, G, c, mt.nt, nN, pm, pn)) return false; u.pm = pm; u.pn = pn; u.e = mt.te[pm]; u.tb = mt.ttb[pm]; return true; }
    DEV unsigned a_row_off(const Unit& u, int r) const {
        const int n = cnt[u.e]; int pos = u.tb * 256 + r; pos = pos < n ? pos : n - 1;
        const int tok = ent[u.e * ENT_CAP + pos] >> 2; return (unsigned)tok * (unsigned)K; }
    DEV const bf16_t* b_ptr(const Unit& u) const { return Bt + ((size_t)u.e * 2048 + (size_t)u.pn * 256) * K; }
};
struct MoeSched2 {
    const bf16_t* A; const bf16_t* Bt; MoeTiles mt; int K, nN, G, c;
    DEV bool next(int i, Unit& u) const { int pm, pn; if (!static_next(i, G, c, mt.nt, nN, pm, pn)) return false; u.pm = pm; u.pn = pn; u.e = mt.te[pm]; u.tb = mt.ttb[pm]; return true; }
    DEV unsigned a_row_off(const Unit& u, int r) const { return (unsigned)(u.pm * 256 + r) * (unsigned)K; }
    DEV const bf16_t* b_ptr(const Unit& u) const { return Bt + ((size_t)u.e * 1024 + (size_t)u.pn * 256) * K; }
};
DEV MoeTiles moe_build_tiles(const int* cnt, LAS unsigned char* lds, int wv) {
    LAS int* te = (LAS int*)(lds + LCTL_OFF); LAS int* ttb = te + 320; LAS int* ntp = ttb + 320;
    __syncthreads();
    if (opaque_tid(wv) == 0) {
        int n = 0;
        for (int e = 0; e < NEXP; ++e) { const int c = __hip_atomic_load(cnt + e, __ATOMIC_RELAXED, __HIP_MEMORY_SCOPE_AGENT); const int nt = (c + 255) >> 8;
            for (int t = 0; t < nt; ++t) { te[n] = e; ttb[n] = t; ++n; } }
        *ntp = n;
    }
    __syncthreads();
    MoeTiles mt; mt.te = te; mt.ttb = ttb; mt.nt = *ntp; return mt;
}

enum { EK_PLAIN = 0, EK_SILU = 1, EK_GELU = 2, EK_ROPE = 3, EK_LOGSIG = 4 };
struct EpiIn {
    static constexpr bool PERM = true;
    bf16_t* Z; int zp; float* LA; const float* bgate; const float* rope; int layer;
    DEV void kind_of(int pn, int& kind, float& sc) const {
        kind = EK_PLAIN; sc = 1.f;
        if (layer == 0) { if (pn == 0) sc = 0.125f; else if (pn == 4 || pn == 5) kind = EK_SILU; else if (pn == 6 || pn == 7) { kind = EK_ROPE; sc = C2; } else if (pn == 8 || pn == 9) kind = EK_ROPE; else if (pn == 12) kind = EK_LOGSIG; }
        else { if (pn < 4) kind = EK_GELU; else if (pn == 4) { kind = EK_ROPE; sc = 0.125f; } else if (pn == 5) kind = EK_ROPE; else if (pn >= 8) kind = EK_SILU; }
    }
    DEV void operator()(const f32x4 (&acc)[2][2][4][2], const Unit& u, int wr, int wc, int fr, int fq) const {
        int kind; float sc; kind_of(u.pn, kind, sc);
#pragma unroll
        for (int ai = 0; ai < 2; ++ai)
#pragma unroll
            for (int m = 0; m < 4; ++m) {
                const int row = u.pm * 256 + ai * 128 + wr * 64 + m * 16 + fr;
                if (kind == EK_ROPE) {
                    const float* rt = rope + (size_t)row * 64 + (8 * fq) * 2;
                    const f32x4 t0 = *(const f32x4*)(rt), t1 = *(const f32x4*)(rt + 4), t2 = *(const f32x4*)(rt + 8), t3 = *(const f32x4*)(rt + 12);
                    const float cs[8] = {t0[0], t0[2], t1[0], t1[2], t2[0], t2[2], t3[0], t3[2]}, sn[8] = {t0[1], t0[3], t1[1], t1[3], t2[1], t2[3], t3[1], t3[3]};
                    float y1[8], y2[8];
#pragma unroll
                    for (int n = 0; n < 2; ++n)
#pragma unroll
                        for (int i = 0; i < 4; ++i) { const float x1 = acc[ai][0][m][n][i], x2 = acc[ai][1][m][n][i]; const int j = 4 * n + i;
                            y1[j] = (x1 * cs[j] - x2 * sn[j]) * sc; y2[j] = (x2 * cs[j] + x1 * sn[j]) * sc; }
                    bf16_t* zp_ = Z + (size_t)row * zp + u.pn * 256 + 64 * wc + 8 * fq;
                    u32x4 w; w.x = pk2(y1[0], y1[1]); w.y = pk2(y1[2], y1[3]); w.z = pk2(y1[4], y1[5]); w.w = pk2(y1[6], y1[7]); *(u32x4*)(zp_) = w;
                    w.x = pk2(y2[0], y2[1]); w.y = pk2(y2[2], y2[3]); w.z = pk2(y2[4], y2[5]); w.w = pk2(y2[6], y2[7]); *(u32x4*)(zp_ + 32) = w;
                } else if (kind == EK_LOGSIG) {
#pragma unroll
                    for (int bj = 0; bj < 2; ++bj) { const int col = 128 * bj + 32 * wc + 8 * fq; float* lp = LA + (size_t)row * 256 + col;
                        const f32x4 b0 = *(const f32x4*)(bgate + col), b1 = *(const f32x4*)(bgate + col + 4); f32x4 o0, o1;
#pragma unroll
                        for (int i = 0; i < 4; ++i) { o0[i] = log_sigmoid_f(acc[ai][bj][m][0][i] + b0[i]) * 0.0625f; o1[i] = log_sigmoid_f(acc[ai][bj][m][1][i] + b1[i]) * 0.0625f; }
                        *(f32x4*)lp = o0; *(f32x4*)(lp + 4) = o1; }
                } else {
#pragma unroll
                    for (int bj = 0; bj < 2; ++bj) { float v[8];
#pragma unroll
                        for (int n = 0; n < 2; ++n)
#pragma unroll
                            for (int i = 0; i < 4; ++i) { float x = acc[ai][bj][m][n][i]; if (kind == EK_SILU) x = silu_f(x); else if (kind == EK_GELU) x = gelu_f(x); v[4 * n + i] = x * sc; }
                        u32x4 w; w.x = pk2(v[0], v[1]); w.y = pk2(v[2], v[3]); w.z = pk2(v[4], v[5]); w.w = pk2(v[6], v[7]);
                        *(u32x4*)(Z + (size_t)row * zp + u.pn * 256 + 128 * bj + 32 * wc + 8 * fq) = w; }
                }
            }
    }
};
struct EpiResid {
    static constexpr bool PERM = false;
    const float* resid; float* out; const float* gate; int skip; float dbgf;
    DEV void operator()(const f32x4 (&acc)[2][2][4][2], const Unit& u, int wr, int wc, int fr, int fq) const {
        const int b = (u.pm * 256) >> 11;
#pragma unroll
        for (int ai = 0; ai < 2; ++ai)
#pragma unroll
            for (int m = 0; m < 4; ++m) { const size_t row = (size_t)(u.pm * 256 + ai * 128 + wr * 64 + m * 16 + fr);
#pragma unroll
                for (int bj = 0; bj < 2; ++bj)
#pragma unroll
                    for (int n = 0; n < 2; ++n) { const int col = u.pn * 256 + 128 * bj + 32 * wc + 16 * n + 4 * fq;
                        const f32x4 g = *(const f32x4*)(gate + (size_t)b * 6144 + col), r = *(const f32x4*)(resid + row * DM + col);
                        *(f32x4*)(out + row * DM + col) = skip ? r : r + g * acc[ai][bj][m][n] * dbgf; } }
    }
};
struct EpiSwiglu {
    static constexpr bool PERM = true;
    bf16_t* Aout; const float* bin;
    DEV void operator()(const f32x4 (&acc)[2][2][4][2], const Unit& u, int wr, int wc, int fr, int fq) const {
        const int lc = 128 * u.pn + 32 * wc + 8 * fq; const float* bp = bin + (size_t)u.e * 2048 + lc;
        const f32x4 bg0 = *(const f32x4*)bp, bg1 = *(const f32x4*)(bp + 4), bl0 = *(const f32x4*)(bp + 1024), bl1 = *(const f32x4*)(bp + 1028);
#pragma unroll
        for (int ai = 0; ai < 2; ++ai)
#pragma unroll
            for (int m = 0; m < 4; ++m) { const size_t row = (size_t)(u.pm * 256 + ai * 128 + wr * 64 + m * 16 + fr); float v[8];
#pragma unroll
                for (int n = 0; n < 2; ++n)
#pragma unroll
                    for (int i = 0; i < 4; ++i) { const float g = fminf(acc[ai][0][m][n][i] + (n ? bg1[i] : bg0[i]), 7.f);
                        const float l = fminf(fmaxf(acc[ai][1][m][n][i] + (n ? bl1[i] : bl0[i]), -7.f), 7.f);
                        v[4 * n + i] = g / (1.f + __expf(-1.702f * g)) * (l + 1.f); }
                u32x4 w; w.x = pk2(v[0], v[1]); w.y = pk2(v[2], v[3]); w.z = pk2(v[4], v[5]); w.w = pk2(v[6], v[7]);
                *(u32x4*)(Aout + row * 1024 + lc) = w; }
    }
};
struct EpiMoeOut {
    static constexpr bool PERM = true;
    bf16_t* YB; const float* bout; const int* cnt; const int* ent; const float* gates;
    DEV void operator()(const f32x4 (&acc)[2][2][4][2], const Unit& u, int wr, int wc, int fr, int fq) const {
        const int n_e = cnt[u.e];
        f32x4 bv[2][2];
#pragma unroll
        for (int bj = 0; bj < 2; ++bj)
#pragma unroll
            for (int n = 0; n < 2; ++n) bv[bj][n] = *(const f32x4*)(bout + (size_t)u.e * 1024 + u.pn * 256 + 128 * bj + 32 * wc + 8 * fq + 4 * n);
#pragma unroll
        for (int ai = 0; ai < 2; ++ai)
#pragma unroll
            for (int m = 0; m < 4; ++m) { const int pos = u.tb * 256 + ai * 128 + wr * 64 + m * 16 + fr;
                if (pos < n_e) { const int dst = ent[u.e * ENT_CAP + pos]; const float g = gates[dst];
#pragma unroll
                    for (int bj = 0; bj < 2; ++bj) { const f32x4 v0 = (acc[ai][bj][m][0] + bv[bj][0]) * g, v1 = (acc[ai][bj][m][1] + bv[bj][1]) * g;
                        u32x4 w; w.x = pk2(v0[0], v0[1]); w.y = pk2(v0[2], v0[3]); w.z = pk2(v1[0], v1[1]); w.w = pk2(v1[2], v1[3]);
                        *(u32x4*)(YB + (size_t)dst * 1024 + u.pn * 256 + 128 * bj + 32 * wc + 8 * fq) = w; } } }
    }
};

template <class Epi, class Sched>
DEV void gemm_ref(const Sched& S, const Epi& E, int wv) {
    const int tid = opaque_tid(wv), wid = tid >> 6, lane = tid & 63, wr = wid >> 2, wc = wid & 3, fr = lane & 15, fq = lane >> 4;
    Unit u;
    for (int it = 0; S.next(it, u); ++it) {
        f32x4 acc[2][2][4][2];
#pragma unroll
        for (int a = 0; a < 2; ++a)
#pragma unroll
            for (int b = 0; b < 2; ++b)
#pragma unroll
                for (int m = 0; m < 4; ++m)
#pragma unroll
                    for (int n = 0; n < 2; ++n) acc[a][b][m][n] = (f32x4){0.f, 0.f, 0.f, 0.f};
        unsigned aoff[2][4];
#pragma unroll
        for (int ai = 0; ai < 2; ++ai)
#pragma unroll
            for (int m = 0; m < 4; ++m) aoff[ai][m] = S.a_row_off(u, ai * 128 + wr * 64 + m * 16 + fr);
        const bf16_t* Bt = S.b_ptr(u); const int K = S.K;
        for (int k0 = 0; k0 < K; k0 += 8) {
            u32x4 araw[2][4];
#pragma unroll
            for (int ai = 0; ai < 2; ++ai)
#pragma unroll
                for (int m = 0; m < 4; ++m) araw[ai][m] = *(const u32x4*)(S.A + aoff[ai][m] + k0);
            asm volatile("" ::: "memory");
#pragma unroll
            for (int bj = 0; bj < 2; ++bj)
#pragma unroll
                for (int n = 0; n < 2; ++n) {
                    u32x4 braw[4];
#pragma unroll
                    for (int i = 0; i < 4; ++i) { const int c = 128 * bj + 32 * wc + (Epi::PERM ? 8 * fq + 4 * n + i : 16 * n + 4 * fq + i); braw[i] = *(const u32x4*)(Bt + (size_t)c * K + k0); }
                    asm volatile("" ::: "memory");
#pragma unroll
                    for (int i = 0; i < 4; ++i)
#pragma unroll
                        for (int ai = 0; ai < 2; ++ai)
#pragma unroll
                            for (int m = 0; m < 4; ++m) { float s = acc[ai][bj][m][n][i];
#pragma unroll
                                for (int j = 0; j < 4; ++j) { const unsigned au = araw[ai][m][j], bu = braw[i][j];
                                    s = __builtin_amdgcn_fdot2_f32_bf16(__builtin_bit_cast(bf16x2_t, au), __builtin_bit_cast(bf16x2_t, bu), s, false); }
                                acc[ai][bj][m][n][i] = s; }
                }
        }
        E(acc, u, wr, wc, fr, fq);
    }
}


namespace pg8 {
constexpr int BM = 256, BK = 64, HALF = 128, HTB = HALF * BK * 2, STAGE_BYTES = 8 * HTB;
DEV int lds_byte(int r, int c) { const int st = (r >> 4) * 2 + (c >> 5), rr = r & 15, cc = c & 31, ob = rr * 64 + cc * 2; return st * 1024 + (ob ^ (((ob >> 9) & 1) << 5)); }
DEV void stage_rc(int b, int& R, int& C) { const int st = b / 1024, sb = b % 1024, swz = sb ^ (((sb >> 9) & 1) << 5); R = (st >> 1) * 16 + swz / 64; C = (st & 1) * 32 + (swz % 64) / 2; }
DEV int perm32(int rho) { const int n = rho >> 4, i = rho & 15; return 8 * (i >> 2) + 4 * n + (i & 3); }

template <class Epi, class Sched>
DEV void gemm_phase(LAS unsigned char* lds, const Sched& S, const Epi& E, int wv) {
    const int tid = opaque_tid(wv);
    const int wid = __builtin_amdgcn_readfirstlane(tid >> 6), lane = tid & 63, wr = wid >> 2, wc = wid & 3, fr = lane & 15, fq = lane >> 4;
    const int K = S.K, nt = K / BK;
    int rA[2]; unsigned cA2[2], voffB[2];
#pragma unroll
    for (int i = 0; i < 2; ++i) { int R, C; stage_rc(tid * 16 + i * 8192, R, C); const int Rb = Epi::PERM ? ((R & ~31) + perm32(R & 31)) : R;
        rA[i] = R; cA2[i] = (unsigned)C * 2u; voffB[i] = (unsigned)(Rb * K + C) * 2u; }
    const size_t kstep = (size_t)(BK * 2);
    const size_t hstep = (size_t)HALF * K * 2;
    const unsigned ldsw = (unsigned)wid * 1024u;
    const int aoff = lds_byte(wr * 64 + fr, fq * 8), boff = lds_byte(wc * 32 + fr, fq * 8);
    const char* Abase = (const char*)S.A;
#define PG8_SA(b, h) (((b) * 2 + (h)) * HTB)
#define PG8_SB(b, h) ((4 + (b) * 2 + (h)) * HTB)
#define PG8_STAGE(bufoff, gbase, voff) do { _Pragma("unroll") for (int _i = 0; _i < 2; ++_i) \
        __builtin_amdgcn_global_load_lds((const unsigned*)((const char*)(gbase) + (voff)[_i]), (LAS unsigned*)(lds + (bufoff) + ldsw + _i * 8192), 16, 0, 0); } while (0)
#define PG8_LDA(dst, b, h) do { _Pragma("unroll") for (int m = 0; m < 4; ++m) _Pragma("unroll") for (int k = 0; k < 2; ++k) dst[m][k] = *(const LAS bf16x8*)(lds + PG8_SA(b, h) + aoff + m * 2048 + k * 1024); } while (0)
#define PG8_LDB(dst, b, h) do { _Pragma("unroll") for (int n = 0; n < 2; ++n) _Pragma("unroll") for (int k = 0; k < 2; ++k) dst[n][k] = *(const LAS bf16x8*)(lds + PG8_SB(b, h) + boff + n * 2048 + k * 1024); } while (0)
#define PG8_MMA(ai, bj, At, Bt) do { __builtin_amdgcn_s_setprio(1); _Pragma("unroll") for (int m = 0; m < 4; ++m) _Pragma("unroll") for (int n = 0; n < 2; ++n) _Pragma("unroll") for (int k = 0; k < 2; ++k) \
        acc[ai][bj][m][n] = __builtin_amdgcn_mfma_f32_16x16x32_bf16(Bt[n][k], At[m][k], acc[ai][bj][m][n], 0, 0, 0); __builtin_amdgcn_s_setprio(0); } while (0)
#define PG8_WAIT_V(n) asm volatile("s_waitcnt vmcnt(" #n ")" ::: "memory")
#define PG8_WAIT_L(n) asm volatile("s_waitcnt lgkmcnt(" #n ")" ::: "memory")
#define PG8_BAR __builtin_amdgcn_s_barrier()
#define PG8_SCHED __builtin_amdgcn_sched_barrier(0)
    Unit cur, nxt; int ui = 0;
    if (!S.next(0, cur)) return;
    f32x4 acc[2][2][4][2];
#pragma unroll
    for (int a = 0; a < 2; ++a)
#pragma unroll
        for (int b = 0; b < 2; ++b)
#pragma unroll
            for (int m = 0; m < 4; ++m)
#pragma unroll
                for (int n = 0; n < 2; ++n) acc[a][b][m][n] = (f32x4){0.f, 0.f, 0.f, 0.f};
    bf16x8 At[4][2], B0[2][2], B1[2][2];
    unsigned vc0[2], vc1[2], vn0[2], vn1[2];
#pragma unroll
    for (int i = 0; i < 2; ++i) { vc0[i] = S.a_row_off(cur, rA[i]) * 2u + cA2[i]; vc1[i] = S.a_row_off(cur, HALF + rA[i]) * 2u + cA2[i]; }
    const char* cB = (const char*)S.b_ptr(cur);
    PG8_STAGE(PG8_SB(0, 0), cB, voffB); PG8_STAGE(PG8_SB(0, 1), cB + hstep, voffB); PG8_STAGE(PG8_SA(0, 0), Abase, vc0); PG8_STAGE(PG8_SA(0, 1), Abase, vc1);
    if (wr == 1) PG8_BAR;
    PG8_WAIT_V(2); PG8_BAR;
    PG8_STAGE(PG8_SB(1, 0), cB + kstep, voffB); PG8_STAGE(PG8_SA(1, 0), Abase + kstep, vc0); PG8_STAGE(PG8_SB(1, 1), cB + hstep + kstep, voffB);
    PG8_WAIT_V(6); PG8_BAR;
    for (;;) {
        const bool has_next = S.next(ui + 1, nxt);
        const char* nB = has_next ? (const char*)S.b_ptr(nxt) : cB;
#pragma unroll
        for (int i = 0; i < 2; ++i) { vn0[i] = has_next ? S.a_row_off(nxt, rA[i]) * 2u + cA2[i] : vc0[i]; vn1[i] = has_next ? S.a_row_off(nxt, HALF + rA[i]) * 2u + cA2[i] : vc1[i]; }
        for (int t = 0; t < nt; t += 2) {
            const bool last = (t == nt - 2);
            const char* a1 = Abase + (size_t)(t + 1) * kstep;
            const char* a2 = last ? Abase : Abase + (size_t)(t + 2) * kstep; const char* b2 = last ? nB : cB + (size_t)(t + 2) * kstep;
            const char* a3 = a2 + kstep; const char* b3 = b2 + kstep;
            unsigned s0[2], s1[2];
#pragma unroll
            for (int i = 0; i < 2; ++i) { s0[i] = last ? vn0[i] : vc0[i]; s1[i] = last ? vn1[i] : vc1[i]; }
            PG8_LDB(B0, 0, 0); PG8_LDB(B1, 0, 1); PG8_SCHED; PG8_LDA(At, 0, 0); PG8_STAGE(PG8_SA(1, 1), a1, vc1);
            PG8_WAIT_V(8); PG8_WAIT_L(0); PG8_BAR; PG8_MMA(0, 0, At, B0); PG8_MMA(0, 1, At, B1); PG8_BAR; PG8_SCHED;
            PG8_LDA(At, 0, 1); PG8_STAGE(PG8_SB(0, 0), b2, voffB); PG8_STAGE(PG8_SB(0, 1), b2 + hstep, voffB); PG8_STAGE(PG8_SA(0, 0), a2, s0);
            PG8_WAIT_V(8); PG8_WAIT_L(0); PG8_BAR; PG8_MMA(1, 0, At, B0); PG8_MMA(1, 1, At, B1); PG8_BAR; PG8_SCHED;
            PG8_LDB(B0, 1, 0); PG8_LDB(B1, 1, 1); PG8_SCHED; PG8_LDA(At, 1, 0); PG8_STAGE(PG8_SA(0, 1), a2, s1);
            PG8_WAIT_V(8); PG8_WAIT_L(0); PG8_BAR; PG8_MMA(0, 0, At, B0); PG8_MMA(0, 1, At, B1); PG8_BAR; PG8_SCHED;
            PG8_LDA(At, 1, 1); PG8_STAGE(PG8_SB(1, 0), b3, voffB); PG8_STAGE(PG8_SB(1, 1), b3 + hstep, voffB); PG8_STAGE(PG8_SA(1, 0), a3, s0);
            PG8_WAIT_V(8); PG8_WAIT_L(0); PG8_BAR; PG8_MMA(1, 0, At, B0); PG8_MMA(1, 1, At, B1); PG8_BAR; PG8_SCHED;
        }
        if (wr == 0) PG8_BAR;
        E(acc, cur, wr, wc, fr, fq);
        if (!has_next) break;
#pragma unroll
        for (int a = 0; a < 2; ++a)
#pragma unroll
            for (int b = 0; b < 2; ++b)
#pragma unroll
                for (int m = 0; m < 4; ++m)
#pragma unroll
                    for (int n = 0; n < 2; ++n) acc[a][b][m][n] = (f32x4){0.f, 0.f, 0.f, 0.f};
        cur = nxt; cB = nB; ++ui;
#pragma unroll
        for (int i = 0; i < 2; ++i) { vc0[i] = vn0[i]; vc1[i] = vn1[i]; }
        if (wr == 1) PG8_BAR;
    }
    PG8_WAIT_V(0);
    PG8_BAR;
#undef PG8_SA
#undef PG8_SB
#undef PG8_STAGE
#undef PG8_LDA
#undef PG8_LDB
#undef PG8_MMA
#undef PG8_WAIT_V
#undef PG8_WAIT_L
#undef PG8_BAR
#undef PG8_SCHED
}
}

__host__ __device__ inline int ropeoff(int q) { return 64 * (q & 3) + 32 * (q >> 2); }
__host__ __device__ inline int in0_logcol(int g32) {
    const int tile = g32 >> 3, q = g32 & 7;
    switch (tile) {
        case 0: return 0 + q * 32; case 1: return 256 + q * 32;
        case 2: case 3: return 512 + (tile - 2) * 256 + q * 32;
        case 4: case 5: return 1040 + (tile - 4) * 256 + q * 32;
        case 6: case 7: return 1552 + (tile - 6) * 256 + ropeoff(q);
        case 8: case 9: return 2064 + (tile - 8) * 256 + ropeoff(q);
        default: return 2576 + (tile - 10) * 256 + q * 32;
    }
}
__host__ __device__ inline int in1_logcol(int g32) {
    const int tile = g32 >> 3, q = g32 & 7;
    if (tile < 4) return tile * 256 + q * 32;
    if (tile == 4) return 1024 + ropeoff(q);
    if (tile == 5) return 1280 + ropeoff(q);
    return 1536 + (tile - 6) * 256 + q * 32;
}
DEV void conv_item(const float* W, int ldw, int logcol0, int k0, bf16_t* Wt_row0, int Kd, LAS float* scr, int lane) {
#pragma unroll 8
    for (int i = 0; i < 32; ++i) { const int kk = 2 * i + (lane >> 5); scr[kk * 33 + (lane & 31)] = W[(size_t)(k0 + kk) * ldw + logcol0 + (lane & 31)]; }
    asm volatile("s_waitcnt lgkmcnt(0)" ::: "memory");
    const int c = lane & 7;
#pragma unroll
    for (int j = 0; j < 4; ++j) { const int n = (lane >> 3) + 8 * j; const LAS float* s = scr + (8 * c) * 33 + n;
        u32x4 o; o.x = pk2(s[0 * 33], s[1 * 33]); o.y = pk2(s[2 * 33], s[3 * 33]); o.z = pk2(s[4 * 33], s[5 * 33]); o.w = pk2(s[6 * 33], s[7 * 33]);
        *(u32x4*)(Wt_row0 + (size_t)n * Kd + k0 + 8 * c) = o; }
    asm volatile("s_waitcnt lgkmcnt(0)" ::: "memory");
}
DEV void sincos_d(double x, float& s, float& c) {
    const double k = __builtin_rint(x * 0.63661977236758134308);
    const double r = (x - k * 1.5707963267948966192) - k * 6.123233995736766e-17;
    const double r2 = r * r;
    double sp = -7.647163731819816e-13; sp = sp * r2 + 1.605904383682161e-10; sp = sp * r2 - 2.505210838544172e-08; sp = sp * r2 + 2.755731922398589e-06;
    sp = sp * r2 - 1.984126984126984e-04; sp = sp * r2 + 8.333333333333333e-03; sp = sp * r2 - 1.666666666666667e-01; sp = r + r * r2 * sp;
    double cp = 4.779477332387385e-14; cp = cp * r2 - 1.147074559772972e-11; cp = cp * r2 + 2.087675698786810e-09; cp = cp * r2 - 2.755731922398589e-07;
    cp = cp * r2 + 2.480158730158730e-05; cp = cp * r2 - 1.388888888888889e-03; cp = cp * r2 + 4.166666666666666e-02; cp = cp * r2 - 0.5; cp = 1.0 + r2 * cp;
    const int q = ((int)k) & 3;
    const double ss = (q == 0) ? sp : (q == 1) ? cp : (q == 2) ? -sp : -cp;
    const double cc = (q == 0) ? cp : (q == 1) ? -sp : (q == 2) ? -cp : sp;
    s = (float)ss; c = (float)cc;
}
DEV void phase_prologue(const Params& P, LAS unsigned char* lds, int wv) {
    const int tid = opaque_tid(wv), lane = tid & 63, wid = tid >> 6, G = gridDim.x;
    unsigned char* ws = opaque_ws(P.ws);
    {
        LAS float* cact = (LAS float*)lds; LAS float* red = cact + 8192;
        const float* cin = (const float*)P.in[1]; const float* wada = (const float*)P.in[3]; const float* bada = (const float*)P.in[4];
        float* mod = (float*)(ws + WS_MOD);
        for (int unit = blockIdx.x; unit < 192; unit += G) {
            const int layer = unit / 96, col0 = (unit % 96) * 64;
            __syncthreads();
            for (int i = tid; i < 8192; i += NTHREADS) { const float c = cin[i]; cact[i] = c / (1.f + expf(-c)); }
            __syncthreads();
            const int cs = tid & 63, ks = tid >> 6;
            float acc[8];
#pragma unroll
            for (int b = 0; b < 8; ++b) acc[b] = 0.f;
            const float* W = wada + (size_t)layer * 1024 * 6144 + col0 + cs;
#pragma unroll 4
            for (int k = ks * 128; k < ks * 128 + 128; ++k) { const float w = W[(size_t)k * 6144];
#pragma unroll
                for (int b = 0; b < 8; ++b) acc[b] += cact[b * 1024 + k] * w; }
#pragma unroll
            for (int b = 0; b < 8; ++b) red[(ks * 8 + b) * 64 + cs] = acc[b];
            __syncthreads();
            { const int b = tid >> 6; float s = bada[layer * 6144 + col0 + cs];
#pragma unroll
              for (int k2 = 0; k2 < 8; ++k2) s += red[(k2 * 8 + b) * 64 + cs];
              mod[(size_t)(layer * 8 + b) * 6144 + col0 + cs] = s; }
        }
        __syncthreads();
    }
    const int gt = blockIdx.x * NTHREADS + tid, NGT = G * NTHREADS;
    {
        const int* pos = (const int*)P.in[2]; float* rope = (float*)(ws + WS_ROPE);
        for (int i = gt; i < NTOK * 32; i += NGT) { const int f = i & 31, t = i >> 5;
            const double invf = exp2(-(double)f * (13.287712379549449 / 32.0));
            float s, c; sincos_d((double)pos[t] * invf, s, c); rope[2 * (size_t)i] = c; rope[2 * (size_t)i + 1] = s; }
    }
    {
        const float* sw = (const float*)P.in[18]; bf16_t* o = (bf16_t*)(ws + WS_SGUW);
        for (int i = gt; i < 4 * 128 * 128; i += NGT) { const int j = i & 127, r = (i >> 7) & 127; o[i] = f2bf(j <= r ? sw[i] : 0.f); }
    }
    {
        const float* win = (const float*)P.in[5]; const float* wg = (const float*)P.in[6]; bf16_t* wt = (bf16_t*)(ws + WS_WIN0) + (size_t)3072 * 1024;
        for (int i = gt; i < 256 * 1024; i += NGT) { const int k = i & 1023, j = i >> 10; float s = 0.f;
#pragma unroll
            for (int r = 0; r < 16; ++r) s += win[(size_t)k * 3088 + 1024 + r] * wg[r * 256 + j];
            wt[(size_t)j * 1024 + k] = f2bf(s); }
    }
    {
        LAS float* scr = (LAS float*)(lds + wid * 16384);
        const int gw = blockIdx.x * NWAVES + wid, NGW = G * NWAVES;
        constexpr int I_IN0 = 16 * 96, I_OUT = 16 * 32, I_IN1 = 16 * 80, I_W1 = 64 * 16 * 64, I_W2 = 64 * 16 * 32;
        constexpr int NITEMS = I_IN0 + I_OUT + I_IN1 + I_OUT + I_W1 + I_W2;
        for (int it = gw; it < NITEMS; it += NGW) {
            int r = it;
            if (r < I_IN0) { const int kb = r / 96, g = r % 96; conv_item((const float*)P.in[5], 3088, in0_logcol(g), kb * 64, (bf16_t*)(ws + WS_WIN0) + (size_t)g * 32 * 1024, 1024, scr, lane); continue; } r -= I_IN0;
            if (r < I_OUT) { const int kb = r / 32, g = r % 32; conv_item((const float*)P.in[14], 1024, g * 32, kb * 64, (bf16_t*)(ws + WS_WOUT0) + (size_t)g * 32 * 1024, 1024, scr, lane); continue; } r -= I_OUT;
            if (r < I_IN1) { const int kb = r / 80, g = r % 80; conv_item((const float*)P.in[15], 2560, in1_logcol(g), kb * 64, (bf16_t*)(ws + WS_WIN1) + (size_t)g * 32 * 1024, 1024, scr, lane); continue; } r -= I_IN1;
            if (r < I_OUT) { const int kb = r / 32, g = r % 32; conv_item((const float*)P.in[20], 1024, g * 32, kb * 64, (bf16_t*)(ws + WS_WOUT1) + (size_t)g * 32 * 1024, 1024, scr, lane); continue; } r -= I_OUT;
            if (r < I_W1) { const int le = r / 1024, q = r % 1024, kb = q / 64, g = q % 64, pn = g >> 3, qq = g & 7;
                const int logcol = (qq >> 2) * 1024 + 128 * pn + 32 * (qq & 3);
                conv_item((const float*)P.in[23] + (size_t)le * 1024 * 2048, 2048, logcol, kb * 64, (bf16_t*)(ws + WS_W1) + ((size_t)le * 2048 + g * 32) * 1024, 1024, scr, lane); continue; } r -= I_W1;
            { const int le = r / 512, q = r % 512, kb = q / 32, g = q % 32;
              conv_item((const float*)P.in[25] + (size_t)le * 1024 * 1024, 1024, g * 32, kb * 64, (bf16_t*)(ws + WS_W2) + ((size_t)le * 1024 + g * 32) * 1024, 1024, scr, lane); }
        }
    }
}

template <int MODE>
DEV void phase_prenorm(const Params& P, LAS unsigned char* lds, int wv, const float* xin, float* xout, int layer_mod, int modoff  , int layer_prev) {
    const int tid = opaque_tid(wv), lane = tid & 63, wid = tid >> 6, G = gridDim.x;
    unsigned char* ws = opaque_ws(P.ws);
    const float* mod = (const float*)(ws + WS_MOD);
    bf16_t* H = (bf16_t*)(ws + WS_H);
    const bf16_t* YB = (const bf16_t*)(ws + WS_YB);
    LAS float* hrow = (LAS float*)(lds) + wid * 1024;
    for (int row = blockIdx.x * NWAVES + wid; row < NTOK; row += G * NWAVES) {
        const int b = row >> 11;
        const f32x4* xr = (const f32x4*)(xin + (size_t)row * DM) + lane;
        f32x4 v[4];
#pragma unroll
        for (int j = 0; j < 4; ++j) v[j] = xr[64 * j];
        if (MODE & 1) {
            const float* g2 = mod + (size_t)(layer_prev * 8 + b) * 6144 + 5 * 1024;
            f32x4 macc[4];
#pragma unroll
            for (int j = 0; j < 4; ++j) macc[j] = (f32x4){0.f, 0.f, 0.f, 0.f};
#pragma unroll
            for (int k = 0; k < 4; ++k) { const float g = 1.0f;   const u32x2* yr = (const u32x2*)(YB + ((size_t)row * 4 + k) * 1024) + lane;
#pragma unroll
                for (int j = 0; j < 4; ++j) { const u32x2 w = yr[64 * j];
                    macc[j][0] += g * __uint_as_float(w.x << 16); macc[j][1] += g * __uint_as_float(w.x & 0xffff0000u);
                    macc[j][2] += g * __uint_as_float(w.y << 16); macc[j][3] += g * __uint_as_float(w.y & 0xffff0000u); } }
#pragma unroll
            for (int j = 0; j < 4; ++j) { const f32x4 gg = *((const f32x4*)g2 + lane + 64 * j); if (!((DBG_SKIP >> (1 + 2 * layer_prev)) & 1)) v[j] = v[j] + gg * macc[j] * (layer_prev ? DBG_F_MOE1 : DBG_F_MOE0); }
        }
        if (MODE & 2) { f32x4* xo = (f32x4*)(xout + (size_t)row * DM) + lane;
#pragma unroll
            for (int j = 0; j < 4; ++j) xo[64 * j] = v[j]; }
        float ss = 0.f;
#pragma unroll
        for (int j = 0; j < 4; ++j) ss += (v[j][0] * v[j][0] + v[j][1] * v[j][1]) + (v[j][2] * v[j][2] + v[j][3] * v[j][3]);
        const float rstd = 1.0f / sqrtf(wave_sum(ss) * (1.f / DM) + EPS);
        if (MODE & 8) {
            const float* fg = (const float*)P.in[27]; f32x4* o = (f32x4*)(P.out + (size_t)row * DM) + lane;
#pragma unroll
            for (int j = 0; j < 4; ++j) { const f32x4 g = *((const f32x4*)fg + lane + 64 * j);
#ifdef DBG_PROBE_OFF
                const float ps = ((const float*)(ws + WS_CTL))[1024] / ((float)NTOK * DBG_PROBE_NCOLS); const float pv = (DBG_PROBE_ABS ? ps : sqrtf(ps)) * DBG_PROBE_SCALE;
                const float alpha = 1.5f + 1.5f * fminf(fmaxf(pv, 0.f), 1.f);
                o[64 * j] = v[j] * rstd * g * alpha;
#else
                o[64 * j] = v[j] * rstd * g;
#endif
            }
            continue;
        }
        const float* mrow = mod + (size_t)(layer_mod * 8 + b) * 6144 + modoff;
#pragma unroll
        for (int j = 0; j < 4; ++j) { const f32x4 sh = *((const f32x4*)mrow + lane + 64 * j), sc = *((const f32x4*)(mrow + 1024) + lane + 64 * j);
            v[j] = v[j] * rstd * (sc + 1.0f) + sh; }
        { u32x2* ho = (u32x2*)(H + (size_t)row * DM) + lane;
#pragma unroll
          for (int j = 0; j < 4; ++j) { u32x2 w; w.x = pk2(v[j][0], v[j][1]); w.y = pk2(v[j][2], v[j][3]); ho[64 * j] = w; } }
        if (MODE & 4) {
            const float* rw = (const float*)P.in[21] + (size_t)layer_mod * 1024 * 32; const float* rb = (const float*)P.in[22] + layer_mod * 32;
            int* cnt = (int*)(ws + WS_CTL) + CW_CNT + layer_mod * 64; int* ent = (int*)(ws + WS_ENT) + (size_t)layer_mod * NEXP * ENT_CAP;
            float* gates = (float*)(ws + WS_GATES) + (size_t)layer_mod * 65536;
#pragma unroll
            for (int j = 0; j < 4; ++j) *((LAS f32x4*)hrow + lane + 64 * j) = v[j];
            asm volatile("s_waitcnt lgkmcnt(0)" ::: "memory");
            const int e = lane & 31, half = lane >> 5;
            float a0 = 0.f, a1 = 0.f;
            const float* wp = rw + (size_t)(half * 512) * 32 + e; const LAS float* hp = hrow + half * 512;
#pragma unroll 8
            for (int k = 0; k < 512; k += 2) { a0 += hp[k] * wp[(size_t)k * 32]; a1 += hp[k + 1] * wp[(size_t)(k + 1) * 32]; }
            float lg = a0 + a1; lg += __shfl_xor(lg, 32); lg += rb[e];
            asm volatile("s_waitcnt lgkmcnt(0)" ::: "memory");
            float tv[4]; int ti[4]; float cur = lg;
#pragma unroll
            for (int r = 0; r < 4; ++r) {
                float mx = cur;
#pragma unroll
                for (int o = 1; o < 32; o <<= 1) mx = fmaxf(mx, __shfl_xor(mx, o));
                const unsigned long long bal = __ballot(cur == mx) & 0xffffffffull;
                const int sel = __builtin_ctzll(bal);
                tv[r] = mx; ti[r] = sel; if (e == sel) cur = -INFINITY;
            }
            const float e1 = __expf(tv[1] - tv[0]), e2 = __expf(tv[2] - tv[0]), e3 = __expf(tv[3] - tv[0]);
            const float inv = 1.f / (1.f + e1 + e2 + e3);
            if (lane < 4) { const int ex = lane == 0 ? ti[0] : lane == 1 ? ti[1] : lane == 2 ? ti[2] : ti[3];
                const float gv = (lane == 0 ? 1.f : lane == 1 ? e1 : lane == 2 ? e2 : e3) * inv;
                const int pos = atomicAdd(cnt + ex, 1); ent[ex * ENT_CAP + pos] = row * 4 + lane; gates[(size_t)row * 4 + lane] = gv; }
        }
    }
}

DEV void attn_unit_ref(int b, int vh, int qb, const bf16_t* Z, bf16_t* OP, int wv) {
    const int tid = opaque_tid(wv);
    if (tid >= 256) return;
    const int h = vh >> 2, m = (vh >> 1) & 1, vhalf = vh & 1;
    const size_t rowbase = (size_t)b * SEQ;
    const int i = qb * 256 + tid;
    const bf16_t* Qr = Z + (rowbase + i) * Z0P + 1536 + h * 128 + m * 64;
    const bf16_t* Kb = Z + rowbase * Z0P + 2048 + h * 128 + m * 64;
    const bf16_t* Vb = Z + rowbase * Z0P + 2560 + h * 128 + vhalf * 64;
    float q[64], o[64];
#pragma unroll
    for (int d0 = 0; d0 < 8; ++d0) { float t[8]; unpack8(*(const bf16x8*)(Qr + d0 * 8), t);
#pragma unroll
        for (int j = 0; j < 8; ++j) { q[d0 * 8 + j] = t[j]; o[d0 * 8 + j] = 0.f; } }
    float mx = -INFINITY, l = 0.f;
    const int jend = qb * 256 + 255;
    for (int j = 0; j <= jend; ++j) {
        const bf16_t* kr = Kb + (size_t)j * Z0P; const bf16_t* vr = Vb + (size_t)j * Z0P;
        float s = 0.f;
#pragma unroll
        for (int d0 = 0; d0 < 8; ++d0) { float t[8]; unpack8(*(const bf16x8*)(kr + d0 * 8), t);
#pragma unroll
            for (int jj = 0; jj < 8; ++jj) s += q[d0 * 8 + jj] * t[jj]; }
        if (j > i) s = -INFINITY;
        if (s > mx) { const float al = __builtin_amdgcn_exp2f(mx - s); l *= al;
#pragma unroll
            for (int e = 0; e < 64; ++e) o[e] *= al;
            mx = s; }
        const float p = __builtin_amdgcn_exp2f(s - mx); l += p;
#pragma unroll
        for (int d0 = 0; d0 < 8; ++d0) { float t[8]; unpack8(*(const bf16x8*)(vr + d0 * 8), t);
#pragma unroll
            for (int jj = 0; jj < 8; ++jj) o[d0 * 8 + jj] += p * t[jj]; }
    }
    const float il = 1.f / l;
    bf16_t* Or = OP + (rowbase + i) * 1024 + vh * 64;
#pragma unroll
    for (int d0 = 0; d0 < 8; ++d0) { u32x4 w; w.x = pk2(o[d0 * 8] * il, o[d0 * 8 + 1] * il); w.y = pk2(o[d0 * 8 + 2] * il, o[d0 * 8 + 3] * il);
        w.z = pk2(o[d0 * 8 + 4] * il, o[d0 * 8 + 5] * il); w.w = pk2(o[d0 * 8 + 6] * il, o[d0 * 8 + 7] * il); *(u32x4*)(Or + d0 * 8) = w; }
}

struct LinAttnArgs {
    const bf16_t* q; const bf16_t* k; const bf16_t* v; const bf16_t* og;
    int zp; const float* la;
    float log_g;
    const float* gain;
    bf16_t* out;
};
template <int C>
DEV void linattn_unit_ref(const LinAttnArgs& a, LAS unsigned char* lds, int wv) {
    const int tid = opaque_tid(wv), lane = tid & 63, wid = tid >> 6;
    LAS bf16_t* qd = (LAS bf16_t*)lds;
    LAS bf16_t* ka = qd + C * 64;
    LAS bf16_t* vv = ka + C * 64;
    LAS float* bsc = (LAS float*)(vv + C * 128);
    LAS bf16_t* Sm = (LAS bf16_t*)bsc;
    LAS float* st = bsc + C * 64;
    LAS float* dec = st + 64 * 128;
    __syncthreads();
    for (int i = tid; i < 64 * 128; i += NTHREADS) st[i] = 0.f;
    for (int n = 0; n < SEQ / C; ++n) {
        const size_t r0 = (size_t)n * C;
        __syncthreads();
        for (int i = tid; i < C * 64; i += NTHREADS) { const int r = i >> 6, d = i & 63; bsc[i] = a.la ? a.la[(r0 + r) * 256 + d] : a.log_g; }
        for (int i = tid; i < C * 16; i += NTHREADS) { const int r = i >> 4, c8 = i & 15; *(LAS u32x4*)(vv + r * 128 + c8 * 8) = *(const u32x4*)(a.v + (r0 + r) * a.zp + c8 * 8); }
        __syncthreads();
        if (tid < 64) { float run = 0.f; for (int r = 0; r < C; ++r) { run += bsc[r * 64 + tid]; bsc[r * 64 + tid] = run; } dec[tid] = __expf(run); }
        __syncthreads();
        for (int i = tid; i < C * 64; i += NTHREADS) { const int r = i >> 6, d = i & 63; const float bb = bsc[i];
            qd[i] = f2bf(bf2f(a.q[(r0 + r) * a.zp + d]) * __expf(bb)); ka[i] = f2bf(bf2f(a.k[(r0 + r) * a.zp + d]) * __expf(-bb)); }
        __syncthreads();
        for (int i = tid; i < C * C; i += NTHREADS) { const int r = i / C, j = i % C; float s = 0.f;
            if (j <= r) { for (int d = 0; d < 64; ++d) s += bf2f(qd[r * 64 + d]) * bf2f(ka[j * 64 + d]); }
            Sm[i] = f2bf(s); }
        __syncthreads();
        for (int r = wid; r < C; r += NWAVES) {
            float o0 = 0.f, o1 = 0.f;
            for (int j = 0; j <= r; ++j) { const float s = bf2f(Sm[r * C + j]); o0 += s * bf2f(vv[j * 128 + lane]); o1 += s * bf2f(vv[j * 128 + 64 + lane]); }
            for (int d = 0; d < 64; ++d) { const float qv = bf2f(qd[r * 64 + d]); o0 += qv * st[d * 128 + lane]; o1 += qv * st[d * 128 + 64 + lane]; }
            const float rstd = 1.0f / sqrtf(wave_sum(o0 * o0 + o1 * o1) * (1.f / 128.f) + EPS);
            const float g0 = a.gain ? a.gain[lane] : 1.f, g1 = a.gain ? a.gain[lane + 64] : 1.f;
            const bf16_t* ogr = a.og + (r0 + r) * a.zp; bf16_t* orow = a.out + (r0 + r) * 1024;
            orow[lane] = f2bf(o0 * rstd * g0 * bf2f(ogr[lane])); orow[lane + 64] = f2bf(o1 * rstd * g1 * bf2f(ogr[lane + 64]));
        }
        __syncthreads();
        { const int e = tid & 127, dg = tid >> 7;
          for (int d = dg; d < 64; d += 4) { float s = st[d * 128 + e]; for (int j = 0; j < C; ++j) s += bf2f(ka[j * 64 + d]) * bf2f(vv[j * 128 + e]); st[d * 128 + e] = dec[d] * s; } }
    }
    __syncthreads();
}

DEV void sgu_unit_ref(const Params& P, int b, int ch, LAS unsigned char* lds, int wv) {
    const int tid = opaque_tid(wv), lane = tid & 63, wid = tid >> 6;
    unsigned char* ws = opaque_ws(P.ws); const bf16_t* Z = (const bf16_t*)(ws + WS_Z); bf16_t* CAT = (bf16_t*)(ws + WS_CAT);
    const float* lng = (const float*)P.in[16]; const float* lnb = (const float*)P.in[17]; const float* sw = (const float*)P.in[18]; const float* sb = (const float*)P.in[19];
    LAS float* svn = (LAS float*)lds;
    LAS float* stat = svn + 128 * 128;
    const size_t r0 = (size_t)b * SEQ + (size_t)ch * 128;
    __syncthreads();
    for (int r = wid; r < 128; r += NWAVES) {
        const bf16_t* zr = Z + (r0 + r) * Z1P + 512; float x[8]; unpack8(*(const bf16x8*)(zr + lane * 8), x);
        float s = 0.f;
#pragma unroll
        for (int j = 0; j < 8; ++j) s += x[j];
        const float mean = wave_sum(s) * (1.f / 512.f); float q = 0.f;
#pragma unroll
        for (int j = 0; j < 8; ++j) { const float d = x[j] - mean; q += d * d; }
        const float rstd = 1.0f / sqrtf(wave_sum(q) * (1.f / 512.f) + EPS);
        if (lane == 0) { stat[2 * r] = mean; stat[2 * r + 1] = rstd; }
    }
    __syncthreads();
    for (int g = 0; g < 4; ++g) {
        for (int i = tid; i < 128 * 128; i += NTHREADS) { const int r = i >> 7, c = i & 127;
            svn[i] = (bf2f(Z[(r0 + r) * Z1P + 512 + g * 128 + c]) - stat[2 * r]) * stat[2 * r + 1] * lng[g * 128 + c] + lnb[g * 128 + c]; }
        __syncthreads();
        { const int c = tid & 127, ig = tid >> 7;
          for (int r = ig; r < 128; r += 4) { float s = sb[g * 128 + r]; const float* wrow = sw + ((size_t)g * 128 + r) * 128;
              for (int j = 0; j <= r; ++j) s += wrow[j] * svn[j * 128 + c];
              CAT[(r0 + r) * 1024 + g * 128 + c] = f2bf(bf2f(Z[(r0 + r) * Z1P + g * 128 + c]) * s); } }
        __syncthreads();
    }
}


typedef float f32x16 __attribute__((ext_vector_type(16)));
DEV f32x16 mfma32(bf16x8 a, bf16x8 b, f32x16 c) { return __builtin_amdgcn_mfma_f32_32x32x16_bf16(a, b, c, 0, 0, 0); }
DEV bf16x8 ldfrag(const LAS bf16_t* base, int stride, int row, int k) { return *(const LAS bf16x8*)(base + row * stride + k); }

template <int C>
DEV void linattn_unit_fast(const LinAttnArgs& a, LAS unsigned char* lds, int wv) {
    constexpr int SEG = C / 8, KS = 72, CS = C + 8, NIB = C / 32;
    const int tid = opaque_tid(wv), lane = tid & 63, w = wv, r = lane & 31, h = lane >> 5;
    LAS bf16_t* Qd = (LAS bf16_t*)lds;
    LAS bf16_t* Ka = Qd + C * KS;
    LAS bf16_t* Kat = Ka + C * KS;
    LAS bf16_t* Vt = Kat + 64 * CS;
    LAS bf16_t* Stt = Vt + 128 * CS;
    LAS bf16_t* Sm = Stt + 128 * KS;
    LAS float* dec = (LAS float*)(Sm + C * CS);
    LAS float* tot = dec + 64;
    LAS float* rsq = tot + 512;
    const int db = w >> 2, eb = w & 3, i0 = w * SEG;
    f32x16 st;
#pragma unroll
    for (int t = 0; t < 16; ++t) st[t] = 0.f;
    __syncthreads();
    for (int n = 0; n < SEQ / C; ++n) {
        const size_t r0 = (size_t)n * C;
        float p[SEG]; float run = 0.f;
#pragma unroll
        for (int ii = 0; ii < SEG; ++ii) { const float v = a.la ? a.la[(r0 + i0 + ii) * 256 + lane] : a.log_g; run += v; p[ii] = run; }
        tot[w * 64 + lane] = run;
        bf16_t qv[SEG], kv[SEG];
#pragma unroll
        for (int ii = 0; ii < SEG; ++ii) { qv[ii] = a.q[(r0 + i0 + ii) * a.zp + lane]; kv[ii] = a.k[(r0 + i0 + ii) * a.zp + lane]; }
        bf16_t vv[C / 32][8];
#pragma unroll
        for (int it = 0; it < C / 32; ++it) { const int item = tid + 512 * it, e = item & 127, jg = item >> 7;
#pragma unroll
            for (int jj = 0; jj < 8; ++jj) vv[it][jj] = a.v[(r0 + 8 * jg + jj) * a.zp + e]; }
        __syncthreads();
        float off = 0.f;
#pragma unroll
        for (int w2 = 0; w2 < 7; ++w2) { const float t2 = tot[w2 * 64 + lane]; off += (w2 < w) ? t2 : 0.f; }
        unsigned kp[SEG / 2];
#pragma unroll
        for (int ii = 0; ii < SEG; ii += 2) {
            const float b0 = p[ii] + off, b1 = p[ii + 1] + off;
            const unsigned qd2 = pk2(bf2f(qv[ii]) * __expf(b0), bf2f(qv[ii + 1]) * __expf(b1));
            const unsigned ka2 = pk2(bf2f(kv[ii]) * __expf(-b0), bf2f(kv[ii + 1]) * __expf(-b1));
            Qd[(i0 + ii) * KS + lane] = (bf16_t)(qd2 & 0xffffu); Qd[(i0 + ii + 1) * KS + lane] = (bf16_t)(qd2 >> 16);
            Ka[(i0 + ii) * KS + lane] = (bf16_t)(ka2 & 0xffffu); Ka[(i0 + ii + 1) * KS + lane] = (bf16_t)(ka2 >> 16);
            kp[ii / 2] = ka2;
        }
#pragma unroll
        for (int q4 = 0; q4 < SEG / 8; ++q4) { u32x4 wv4; wv4.x = kp[4 * q4]; wv4.y = kp[4 * q4 + 1]; wv4.z = kp[4 * q4 + 2]; wv4.w = kp[4 * q4 + 3]; *(LAS u32x4*)(Kat + lane * CS + i0 + 8 * q4) = wv4; }
        if (w == 7) dec[lane] = __expf(p[SEG - 1] + off);
#pragma unroll
        for (int it = 0; it < C / 32; ++it) { const int item = tid + 512 * it, e = item & 127, jg = item >> 7;
            u32x4 wv4; wv4.x = (unsigned)vv[it][0] | ((unsigned)vv[it][1] << 16); wv4.y = (unsigned)vv[it][2] | ((unsigned)vv[it][3] << 16);
            wv4.z = (unsigned)vv[it][4] | ((unsigned)vv[it][5] << 16); wv4.w = (unsigned)vv[it][6] | ((unsigned)vv[it][7] << 16);
            *(LAS u32x4*)(Vt + e * CS + 8 * jg) = wv4; }
#pragma unroll
        for (int g = 0; g < 4; ++g) { u32x2 w2; w2.x = pk2(st[4 * g], st[4 * g + 1]); w2.y = pk2(st[4 * g + 2], st[4 * g + 3]);
            *(LAS u32x2*)(Stt + (32 * eb + r) * KS + 32 * db + 8 * g + 4 * h) = w2; }
        __syncthreads();
        for (int bp = w; bp < NIB * (NIB + 1) / 2; bp += 8) {
            int ib = 0; while ((ib + 1) * (ib + 2) / 2 <= bp) ++ib;
            const int jb = bp - ib * (ib + 1) / 2;
            f32x16 acc;
#pragma unroll
            for (int t = 0; t < 16; ++t) acc[t] = 0.f;
#pragma unroll
            for (int s2 = 0; s2 < 4; ++s2) acc = mfma32(ldfrag(Ka, KS, 32 * jb + r, 16 * s2 + 8 * h), ldfrag(Qd, KS, 32 * ib + r, 16 * s2 + 8 * h), acc);
            const int i = 32 * ib + r;
#pragma unroll
            for (int g = 0; g < 4; ++g) { const int j0 = 32 * jb + 8 * g + 4 * h; float v0 = acc[4 * g], v1 = acc[4 * g + 1], v2 = acc[4 * g + 2], v3 = acc[4 * g + 3];
                if (j0 > i) v0 = 0.f; if (j0 + 1 > i) v1 = 0.f; if (j0 + 2 > i) v2 = 0.f; if (j0 + 3 > i) v3 = 0.f;
                u32x2 w2; w2.x = pk2(v0, v1); w2.y = pk2(v2, v3); *(LAS u32x2*)(Sm + i * CS + j0) = w2; }
        }
        {
            f32x16 acc = st;
#pragma unroll
            for (int s2 = 0; s2 < C / 16; ++s2) acc = mfma32(ldfrag(Kat, CS, 32 * db + r, 16 * s2 + 8 * h), ldfrag(Vt, CS, 32 * eb + r, 16 * s2 + 8 * h), acc);
#pragma unroll
            for (int g = 0; g < 4; ++g) { const f32x4 dv = *(const LAS f32x4*)(dec + 32 * db + 8 * g + 4 * h);
#pragma unroll
                for (int t = 0; t < 4; ++t) st[4 * g + t] = acc[4 * g + t] * dv[t]; }
        }
        __syncthreads();
        f32x16 o[NIB / 2];
#pragma unroll
        for (int q = 0; q < NIB / 2; ++q) {
            const int blk = w + 8 * q, ib = blk >> 2, e2 = blk & 3;
            f32x16 acc;
#pragma unroll
            for (int t = 0; t < 16; ++t) acc[t] = 0.f;
            for (int s2 = 0; s2 < 2 * (ib + 1); ++s2) acc = mfma32(ldfrag(Vt, CS, 32 * e2 + r, 16 * s2 + 8 * h), ldfrag(Sm, CS, 32 * ib + r, 16 * s2 + 8 * h), acc);
#pragma unroll
            for (int s2 = 0; s2 < 4; ++s2) acc = mfma32(ldfrag(Stt, KS, 32 * e2 + r, 16 * s2 + 8 * h), ldfrag(Qd, KS, 32 * ib + r, 16 * s2 + 8 * h), acc);
            o[q] = acc;
            float ss = 0.f;
#pragma unroll
            for (int t = 0; t < 16; ++t) ss += acc[t] * acc[t];
            ss += __shfl_xor(ss, 32);
            if (h == 0) rsq[(32 * ib + r) * 4 + e2] = ss;
        }
        __syncthreads();
#pragma unroll
        for (int q = 0; q < NIB / 2; ++q) {
            const int blk = w + 8 * q, ib = blk >> 2, e2 = blk & 3, i = 32 * ib + r;
            const f32x4 rs = *(const LAS f32x4*)(rsq + i * 4);
            const float rstd = 1.0f / sqrtf(((rs[0] + rs[1]) + (rs[2] + rs[3])) * (1.f / 128.f) + EPS);
#pragma unroll
            for (int g = 0; g < 4; ++g) { const int e0 = 32 * e2 + 8 * g + 4 * h;
                f32x4 gn = {1.f, 1.f, 1.f, 1.f}; if (a.gain) gn = *(const f32x4*)(a.gain + e0);
                const u32x2 og = *(const u32x2*)(a.og + (r0 + i) * a.zp + e0);
                const float g0 = __uint_as_float(og.x << 16), g1 = __uint_as_float(og.x & 0xffff0000u), g2 = __uint_as_float(og.y << 16), g3 = __uint_as_float(og.y & 0xffff0000u);
                u32x2 w2; w2.x = pk2(o[q][4 * g] * rstd * gn[0] * g0, o[q][4 * g + 1] * rstd * gn[1] * g1); w2.y = pk2(o[q][4 * g + 2] * rstd * gn[2] * g2, o[q][4 * g + 3] * rstd * gn[3] * g3);
                *(u32x2*)(a.out + (r0 + i) * 1024 + e0) = w2; }
        }
    }
    __syncthreads();
}

DEV void sgu_unit_fast(const Params& P, int b, int ch, LAS unsigned char* lds, int wv) {
    constexpr int CS = 136;
    const int tid = opaque_tid(wv), lane = tid & 63, w = wv, r = lane & 31, h = lane >> 5;
    unsigned char* ws = opaque_ws(P.ws); const bf16_t* Z = (const bf16_t*)(ws + WS_Z); bf16_t* CAT = (bf16_t*)(ws + WS_CAT); const bf16_t* SW = (const bf16_t*)(ws + WS_SGUW);
    const float* lng = (const float*)P.in[16]; const float* lnb = (const float*)P.in[17]; const float* sb = (const float*)P.in[19];
    LAS bf16_t* Wg = (LAS bf16_t*)lds;
    LAS bf16_t* Sv = Wg + 128 * CS;
    LAS float* stat = (LAS float*)(Sv + 128 * CS);
    const size_t r0 = (size_t)b * SEQ + (size_t)ch * 128;
    __syncthreads();
    for (int rr = w; rr < 128; rr += NWAVES) {
        const bf16_t* zr = Z + (r0 + rr) * Z1P + 512; float x[8]; unpack8(*(const bf16x8*)(zr + lane * 8), x);
        float s = 0.f;
#pragma unroll
        for (int j = 0; j < 8; ++j) s += x[j];
        const float mean = wave_sum(s) * (1.f / 512.f); float q = 0.f;
#pragma unroll
        for (int j = 0; j < 8; ++j) { const float d = x[j] - mean; q += d * d; }
        const float rstd = 1.0f / sqrtf(wave_sum(q) * (1.f / 512.f) + EPS);
        if (lane == 0) { stat[2 * rr] = mean; stat[2 * rr + 1] = rstd; }
    }
    __syncthreads();
    for (int g = 0; g < 4; ++g) {
#pragma unroll
        for (int it = 0; it < 4; ++it) { const int pc = tid + 512 * it, i = pc >> 4, c8 = pc & 15;
            *(LAS u32x4*)(Wg + i * CS + c8 * 8) = *(const u32x4*)(SW + ((size_t)g * 128 + i) * 128 + c8 * 8); }
#pragma unroll
        for (int it = 0; it < 4; ++it) { const int item = tid + 512 * it, c = item & 127, jg = item >> 7;
            const float gg = lng[g * 128 + c], bb = lnb[g * 128 + c]; float v[8];
#pragma unroll
            for (int jj = 0; jj < 8; ++jj) { const int j = 8 * jg + jj; v[jj] = (bf2f(Z[(r0 + j) * Z1P + 512 + g * 128 + c]) - stat[2 * j]) * stat[2 * j + 1] * gg + bb; }
            u32x4 w4; w4.x = pk2(v[0], v[1]); w4.y = pk2(v[2], v[3]); w4.z = pk2(v[4], v[5]); w4.w = pk2(v[6], v[7]);
            *(LAS u32x4*)(Sv + c * CS + 8 * jg) = w4; }
        __syncthreads();
#pragma unroll
        for (int q = 0; q < 2; ++q) {
            const int blk = w + 8 * q, ib = blk >> 2, cb = blk & 3, i = 32 * ib + r;
            f32x16 acc;
#pragma unroll
            for (int t = 0; t < 16; ++t) acc[t] = 0.f;
            for (int s2 = 0; s2 < 2 * (ib + 1); ++s2) acc = mfma32(ldfrag(Sv, CS, 32 * cb + r, 16 * s2 + 8 * h), ldfrag(Wg, CS, i, 16 * s2 + 8 * h), acc);
            const float bs = sb[g * 128 + i];
#pragma unroll
            for (int gq = 0; gq < 4; ++gq) { const int c0 = g * 128 + 32 * cb + 8 * gq + 4 * h;
                const u32x2 su = *(const u32x2*)(Z + (r0 + i) * Z1P + c0);
                const float u0 = __uint_as_float(su.x << 16), u1 = __uint_as_float(su.x & 0xffff0000u), u2 = __uint_as_float(su.y << 16), u3 = __uint_as_float(su.y & 0xffff0000u);
                u32x2 w2; w2.x = pk2(u0 * (acc[4 * gq] + bs), u1 * (acc[4 * gq + 1] + bs)); w2.y = pk2(u2 * (acc[4 * gq + 2] + bs), u3 * (acc[4 * gq + 3] + bs));
                *(u32x2*)(CAT + (r0 + i) * 1024 + c0) = w2; }
        }
        __syncthreads();
    }
}

namespace attn_body {
using bf16=unsigned short;
using s16x4=__attribute__((ext_vector_type(4)))short;
using f32x16=__attribute__((ext_vector_type(16)))float;
constexpr int D=64,ZP=Z0P,OPITCH=1024;
constexpr int NW=8,QBLK=32,QB=QBLK*NW,KVBLK=64;
__device__ __forceinline__ int crow(int r,int hi){return (r&3)+8*(r>>2)+4*hi;}
#define SBAR() __builtin_amdgcn_sched_barrier(0)
__device__ __forceinline__ void cmask(f32x16&p0,f32x16&p1,int jb,int qrel,int hi){
  const float NEG=-INFINITY; int kb=64*jb+4*hi;
  #pragma unroll
  for(int r=0;r<16;++r){int kv=kb+(r&3)+8*(r>>2); if(kv>qrel)p0[r]=NEG; if(kv+32>qrel)p1[r]=NEG;}
}

constexpr int NSLOT=3, SLOTB=8192;
constexpr int LDS_K=0, LDS_V=NSLOT*SLOTB, LDS_WS=2*NSLOT*SLOTB, LDS_OST=LDS_WS+NW*64*4, LDS_BYTES=LDS_OST+NW*4096;
__device__ __forceinline__ void glds16(const void*gsrc,unsigned lds_dst){unsigned keep;
  asm volatile("s_mov_b32 %0, m0\n\ts_mov_b32 m0, %2\n\ts_nop 0\n\tglobal_load_lds_dwordx4 %1, off\n\ts_mov_b32 m0, %0":"=&s"(keep):"v"(gsrc),"s"(lds_dst):"memory");}
__device__ __forceinline__ float max3f(float a,float b,float c){float r;asm("v_max3_f32 %0, %1, %2, %3":"=v"(r):"v"(a),"v"(b),"v"(c));return r;}
__device__ __forceinline__ float max2f(float a,float b){float r;asm("v_max_f32_e32 %0, %1, %2":"=v"(r):"v"(a),"v"(b));return r;}
__device__ __forceinline__ float fadd_s(float a,float b){float r;asm("v_add_f32_e32 %0, %1, %2":"=v"(r):"v"(a),"v"(b));return r;}
__device__ __forceinline__ float fsub_s(float a,float b){float r;asm("v_sub_f32_e32 %0, %1, %2":"=v"(r):"v"(a),"v"(b));return r;}
typedef float f32x2_t __attribute__((ext_vector_type(2))); typedef __bf16 bf16x2_t __attribute__((ext_vector_type(2)));
__device__ __forceinline__ unsigned cvtpk_s(float lo,float hi){f32x2_t v={lo,hi};bf16x2_t b=__builtin_convertvector(v,bf16x2_t);return __builtin_bit_cast(unsigned,b);}
#define WAIT_BAR(N) asm volatile("s_waitcnt vmcnt(" #N ") lgkmcnt(0)\n\ts_barrier":::"memory")

__device__ __forceinline__ void qkt(f32x16&p0,f32x16&p1,const char*Kslot,const bf16x8*qr,const f32x16&negm,int r32,int hi){
  const char*kb=Kslot+hi*1024+r32*16;
  #pragma unroll
  for(int d0=0;d0<4;++d0){
    const bf16x8 b0=*reinterpret_cast<const bf16x8*>(kb+d0*2048);
    const bf16x8 b1=*reinterpret_cast<const bf16x8*>(kb+d0*2048+512);
    if(d0==0){p0=__builtin_amdgcn_mfma_f32_32x32x16_bf16(b0,qr[0],negm,0,0,0);p1=__builtin_amdgcn_mfma_f32_32x32x16_bf16(b1,qr[0],negm,0,0,0);}
    else{p0=__builtin_amdgcn_mfma_f32_32x32x16_bf16(b0,qr[d0],p0,0,0,0);p1=__builtin_amdgcn_mfma_f32_32x32x16_bf16(b1,qr[d0],p1,0,0,0);}}
}
typedef __attribute__((address_space(3))) const char* lds_cptr;
typedef short v4i16_t __attribute__((ext_vector_type(4)));
__device__ __forceinline__ void kload8(bf16x8*kf,lds_cptr kp){
  kf[0]=*(const __attribute__((address_space(3))) bf16x8*)(kp);      kf[1]=*(const __attribute__((address_space(3))) bf16x8*)(kp+512);
  kf[2]=*(const __attribute__((address_space(3))) bf16x8*)(kp+2048); kf[3]=*(const __attribute__((address_space(3))) bf16x8*)(kp+2560);
  kf[4]=*(const __attribute__((address_space(3))) bf16x8*)(kp+4096); kf[5]=*(const __attribute__((address_space(3))) bf16x8*)(kp+4608);
  kf[6]=*(const __attribute__((address_space(3))) bf16x8*)(kp+6144); kf[7]=*(const __attribute__((address_space(3))) bf16x8*)(kp+6656);
}
__device__ __forceinline__ void kload2(bf16x8*kf,lds_cptr kp,int j){ kf[2*j]=*(const __attribute__((address_space(3))) bf16x8*)(kp+j*2048); kf[2*j+1]=*(const __attribute__((address_space(3))) bf16x8*)(kp+j*2048+512); }
__device__ __forceinline__ s16x4 vtr(lds_cptr p){ return __builtin_bit_cast(s16x4,__builtin_amdgcn_ds_read_tr16_b64_v4i16((__attribute__((address_space(3))) v4i16_t*)p)); }
__device__ __forceinline__ float rowmax(const f32x16&p0,const f32x16&p1){
  float a=max3f(p0[0],p0[1],p1[0]),b=max3f(p0[2],p0[3],p1[1]);a=max3f(a,p1[2],p1[3]);
  #pragma unroll
  for(int r=4;r<16;r+=4){a=max3f(a,p0[r],p0[r+1]);b=max3f(b,p0[r+2],p0[r+3]);a=max3f(a,p1[r],p1[r+1]);b=max3f(b,p1[r+2],p1[r+3]);}
  const float m=max2f(a,b);
  auto rr=__builtin_amdgcn_permlane32_swap(__float_as_uint(m),__float_as_uint(m),false,false);
  return max2f(__uint_as_float(rr[0]),__uint_as_float(rr[1]));
}
__device__ __forceinline__ void pv(f32x16*o,int vb,bf16x8 pa0,bf16x8 pa1,bf16x8 pa2,bf16x8 pa3){
  #pragma unroll
  for(int d0=0;d0<2;++d0){s16x4 lo[4],hi[4];
    #pragma unroll
    for(int ks=0;ks<4;++ks){
      asm volatile("ds_read_b64_tr_b16 %0,%1 offset:%c2":"=&v"(lo[ks]):"v"(vb),"i"(d0*4096+ks*1024):"memory");
      asm volatile("ds_read_b64_tr_b16 %0,%1 offset:%c2":"=&v"(hi[ks]):"v"(vb),"i"(d0*4096+ks*1024+512):"memory");}
    asm volatile("s_waitcnt lgkmcnt(0)":::"memory");SBAR();
    #define PK(k) (bf16x8){lo[k][0],lo[k][1],lo[k][2],lo[k][3],hi[k][0],hi[k][1],hi[k][2],hi[k][3]}
    o[d0]=__builtin_amdgcn_mfma_f32_32x32x16_bf16(pa0,PK(0),o[d0],0,0,0);
    o[d0]=__builtin_amdgcn_mfma_f32_32x32x16_bf16(pa1,PK(1),o[d0],0,0,0);
    o[d0]=__builtin_amdgcn_mfma_f32_32x32x16_bf16(pa2,PK(2),o[d0],0,0,0);
    o[d0]=__builtin_amdgcn_mfma_f32_32x32x16_bf16(pa3,PK(3),o[d0],0,0,0);
    #undef PK
  }
}

#ifndef ATTN_STORE16
#define ATTN_STORE16(p,v) (*(u32x4*)(p)=(v))
#endif
template<int THRL> __device__ __forceinline__ void attn_unit(int qb,const bf16*Qb,const bf16*__restrict__ Kb,const bf16*__restrict__ Vb,bf16*Ob,char*shm,int wv){
  const int tid=opaque_tid(wv),lane=tid&63,r32=lane&31,hi=lane>>5; const int wid=wv;
  const int q0=qb*QB;
  const bf16*Qw=Qb+(long)(q0+wid*QBLK)*ZP;
  const bf16*Kh=Kb,*Vh=Vb;
  const unsigned lds0=(unsigned)(uintptr_t)shm;
  float*wsf=(float*)(shm+LDS_WS)+wid*64;
  const bf16*ksrc=Kh+(long)lane*ZP+wid*8;
  const bf16*vsrc=Vh+(long)(16*(wid&3)+(lane>>2))*ZP+(wid>>2)*32+(lane&3)*8;
  const unsigned kdst=lds0+LDS_K+wid*1024, vdst=lds0+LDS_V+wid*1024;
  #define DMA_K(t,slot) glds16(ksrc+(long)(t)*KVBLK*ZP,(unsigned)__builtin_amdgcn_readfirstlane(kdst+(slot)))
  #define DMA_V(t,slot) glds16(vsrc+(long)(t)*KVBLK*ZP,(unsigned)__builtin_amdgcn_readfirstlane(vdst+(slot)))
  const int vb0=(int)(lds0+LDS_V)+((lane>>4)&1)*32+(lane&3)*8+(4*hi+((lane&15)>>2))*64;
  const char*Kbase=shm+LDS_K; bf16x8 kf[8];
  const lds_cptr shm3=(lds_cptr)shm; const lds_cptr kp0=shm3+LDS_K+hi*1024+r32*16; const lds_cptr vp0=shm3+LDS_V+((lane>>4)&1)*32+(lane&3)*8+(4*hi+((lane&15)>>2))*64;
  const int NT=(q0+QB)/KVBLK;
  DMA_K(0,0);DMA_V(0,0);DMA_K(1,SLOTB);
  bf16x8 qr[4];
  #pragma unroll
  for(int d0=0;d0<4;++d0)qr[d0]=*reinterpret_cast<const bf16x8*>(&Qw[(long)r32*ZP+d0*16+hi*8]);
  float mhat=0.f,l_reg=0.f;f32x16 o[2];o[0]=f32x16{};o[1]=f32x16{};f32x16 negm=f32x16{};asm volatile("":"+v"(negm));
  const int qrel=wid*QBLK+r32;
  #define CMASK(P0,P1,t) do{int jb_=(t)-(NT-4); if(jb_>=0)cmask(P0,P1,jb_,qrel,hi);}while(0)
  bool resc=false;
  #define START(P0,P1) do{ const float rm=rowmax(P0,P1); resc=false; \
    { const float dl=rm; mhat=fadd_s(mhat,dl); \
      _Pragma("unroll") for(int r=0;r<16;++r){P0[r]=fsub_s(P0[r],dl);P1[r]=fsub_s(P1[r],dl);} \
      _Pragma("unroll") for(int r=0;r<16;++r)negm[r]=-mhat; asm volatile("":"+v"(negm)); } \
    _Pragma("unroll") for(int r=0;r<16;++r)P0[r]=__builtin_amdgcn_exp2f(P0[r]); }while(0)
  #define RESC() do{ if(resc){ asm volatile("s_waitcnt lgkmcnt(0)":::"memory"); \
      _Pragma("unroll") for(int d_=0;d_<2;++d_) _Pragma("unroll") for(int r=0;r<16;++r)o[d_][r]*=wsf[crow(r,hi)]; } }while(0)
  f32x16 pA0,pA1,pB0,pB1;
  int sl_prev=0,sl_cur=0,sl_next=SLOTB;
  #define ROT() do{sl_prev=sl_cur;sl_cur=sl_next;sl_next=(sl_next==(NSLOT-1)*SLOTB)?0:sl_next+SLOTB;}while(0)
  DMA_K(2,2*SLOTB);
  WAIT_BAR(3);
  qkt(pA0,pA1,Kbase,qr,negm,r32,hi);asm volatile("s_nop 15\n\ts_nop 7":"+v"(pA0),"+v"(pA1));CMASK(pA0,pA1,0);
  START(pA0,pA1);
  _Pragma("unroll") for(int r=0;r<16;++r)pA1[r]=__builtin_amdgcn_exp2f(pA1[r]);
  WAIT_BAR(0);
  DMA_K(3,0);DMA_V(1,SLOTB);
  ROT();
  kload8(kf,kp0+sl_cur);
  WAIT_BAR(2);
  s16x4 vlo[8],vhi[8]; u32x4 pw0,pw1,pw2,pw3;
  #define PKW(P,B) cvtpk_s(P[B],P[B+1])
  #define PAF(k) __builtin_bit_cast(bf16x8,pw##k)
  #define VFR(i) (bf16x8){vlo[i][0],vlo[i][1],vlo[i][2],vlo[i][3],vhi[i][0],vhi[i][1],vhi[i][2],vhi[i][3]}
  #define PIN(x) asm volatile("":"+v"(x))
  #define MX3(a,b,c) __builtin_fmaxf(__builtin_fmaxf((a),(b)),(c))
  #define GAPA(MF,A0,A1,A2,A3,W0,W1,PW) do{ MF; sacc+=A0; sacc+=A1; sacc+=A2; sacc+=A3; PIN(sacc); W0; W1; PIN(PW); SBAR(); }while(0)
  #define EX(v) __builtin_amdgcn_exp2f(v)
  #define GAPB(MF,X,B) do{ MF; X[B]=EX(X[B]); X[B+1]=EX(X[B+1]); X[B+2]=EX(X[B+2]); X[B+3]=EX(X[B+3]); PIN(X); SBAR(); }while(0)
  #define VRD(i) do{ vlo[i]=vtr(vp_+(((i)>>2)*4096+((i)&3)*1024)); vhi[i]=vtr(vp_+(((i)>>2)*4096+((i)&3)*1024+512)); }while(0)
  #define KRD(G,j) do{ if(G){ kload2(kf,kp0+sl_next,j); SBAR(); } }while(0)
  #define STEP(C0,C1,P0,P1,t,GK,GV,GL) do{ SBAR(); \
    const lds_cptr vp_=vp0+sl_prev; \
    VRD(0); SBAR(); float sacc=(P0[0]+P0[1]); \
    GAPA(C0=__builtin_amdgcn_mfma_f32_32x32x16_bf16(kf[0],qr[0],negm,0,0,0), P0[2],P0[3],P0[4],P0[5],     pw0[0]=PKW(P0,0), pw0[1]=PKW(P0,2), pw0); \
    VRD(4); SBAR(); GAPA(C1=__builtin_amdgcn_mfma_f32_32x32x16_bf16(kf[1],qr[0],negm,0,0,0), P0[6],P0[7],P0[8],P0[9],     pw0[2]=PKW(P0,4), pw0[3]=PKW(P0,6), pw0); \
    VRD(1); SBAR(); GAPA(C0=__builtin_amdgcn_mfma_f32_32x32x16_bf16(kf[2],qr[1],C0,0,0,0),   P0[10],P0[11],P0[12],P0[13], pw1[0]=PKW(P0,8), pw1[1]=PKW(P0,10), pw1); \
    VRD(5); SBAR(); GAPA(C1=__builtin_amdgcn_mfma_f32_32x32x16_bf16(kf[3],qr[1],C1,0,0,0),   P0[14],P0[15],P1[0],P1[1],   pw1[2]=PKW(P0,12),pw1[3]=PKW(P0,14), pw1); \
    VRD(2); SBAR(); GAPA(C0=__builtin_amdgcn_mfma_f32_32x32x16_bf16(kf[4],qr[2],C0,0,0,0),   P1[2],P1[3],P1[4],P1[5],     pw2[0]=PKW(P1,0), pw2[1]=PKW(P1,2), pw2); \
    VRD(6); SBAR(); GAPA(C1=__builtin_amdgcn_mfma_f32_32x32x16_bf16(kf[5],qr[2],C1,0,0,0),   P1[6],P1[7],P1[8],P1[9],     pw2[2]=PKW(P1,4), pw2[3]=PKW(P1,6), pw2); \
    VRD(3); SBAR(); GAPA(C0=__builtin_amdgcn_mfma_f32_32x32x16_bf16(kf[6],qr[3],C0,0,0,0),   P1[10],P1[11],P1[12],P1[13], pw3[0]=PKW(P1,8), pw3[1]=PKW(P1,10), pw3); \
    VRD(7); SBAR(); GAPA(C1=__builtin_amdgcn_mfma_f32_32x32x16_bf16(kf[7],qr[3],C1,0,0,0),   P1[14],P1[15],0.f,0.f,       pw3[2]=PKW(P1,12),pw3[3]=PKW(P1,14), pw3); \
    l_reg+=sacc; \
    if(GK){DMA_K((t)+3,sl_cur);} if(GV){DMA_V((t)+1,sl_next);} \
    CMASK(C0,C1,t); \
    { float a=MX3(C0[0],C0[1],C1[0]),b=MX3(C0[2],C0[3],C1[1]); a=MX3(a,C1[2],C1[3]); \
      _Pragma("unroll") for(int r=4;r<16;r+=4){a=MX3(a,C0[r],C0[r+1]);b=MX3(b,C0[r+2],C0[r+3]);a=MX3(a,C1[r],C1[r+1]);b=MX3(b,C1[r+2],C1[r+3]);} \
      float rm=__builtin_fmaxf(a,b); { auto rr=__builtin_amdgcn_permlane32_swap(__float_as_uint(rm),__float_as_uint(rm),false,false); rm=__builtin_fmaxf(__uint_as_float(rr[0]),__uint_as_float(rr[1])); } \
      resc=false; \
      if(__builtin_expect(__any(rm>(float)THRL),0)){ const float dl=__builtin_fmaxf(rm,0.f); mhat+=dl; \
        _Pragma("unroll") for(int r=0;r<16;++r){C0[r]-=dl;C1[r]-=dl;} \
        _Pragma("unroll") for(int r=0;r<16;++r)negm[r]=-mhat; asm volatile("":"+v"(negm)); \
        const float f=__builtin_amdgcn_exp2f(-dl); l_reg*=f; if(hi==0)wsf[r32]=f; resc=true; } } \
    SBAR(); \
    GAPB(o[0]=__builtin_amdgcn_mfma_f32_32x32x16_bf16(PAF(0),VFR(0),o[0],0,0,0), C0,0); \
    GAPB(o[1]=__builtin_amdgcn_mfma_f32_32x32x16_bf16(PAF(0),VFR(4),o[1],0,0,0), C0,4); \
    KRD(GL,0); GAPB(o[0]=__builtin_amdgcn_mfma_f32_32x32x16_bf16(PAF(1),VFR(1),o[0],0,0,0), C0,8); \
    KRD(GL,1); GAPB(o[1]=__builtin_amdgcn_mfma_f32_32x32x16_bf16(PAF(1),VFR(5),o[1],0,0,0), C0,12); \
    KRD(GL,2); GAPB(o[0]=__builtin_amdgcn_mfma_f32_32x32x16_bf16(PAF(2),VFR(2),o[0],0,0,0), C1,0); \
    KRD(GL,3); GAPB(o[1]=__builtin_amdgcn_mfma_f32_32x32x16_bf16(PAF(2),VFR(6),o[1],0,0,0), C1,4); \
    GAPB(o[0]=__builtin_amdgcn_mfma_f32_32x32x16_bf16(PAF(3),VFR(3),o[0],0,0,0), C1,8); \
    GAPB(o[1]=__builtin_amdgcn_mfma_f32_32x32x16_bf16(PAF(3),VFR(7),o[1],0,0,0), C1,12); \
    }while(0)
  int t=1;
  #undef CMASK
  #define CMASK(P0,P1,t) do{}while(0)
  for(;t+5<NT;t+=2){
    STEP(pB0,pB1,pA0,pA1,t,true,true,true);     WAIT_BAR(2); RESC(); ROT();
    STEP(pA0,pA1,pB0,pB1,t+1,true,true,true);   WAIT_BAR(2); RESC(); ROT();
  }
  #undef CMASK
  #define CMASK(P0,P1,t) do{int jb_=(t)-(NT-4); if(jb_>=0)cmask(P0,P1,jb_,qrel,hi);}while(0)
  #define ENDW(tt) do{ if((tt)+3<NT){WAIT_BAR(2);} else if((tt)+2<NT){WAIT_BAR(1);} else {WAIT_BAR(0);} }while(0)
  for(;t+1<NT;t+=2){
    STEP(pB0,pB1,pA0,pA1,t,(t+3<NT),(t+1<NT),(t+1<NT));       ENDW(t);   RESC(); ROT();
    STEP(pA0,pA1,pB0,pB1,t+1,(t+4<NT),(t+2<NT),(t+2<NT));     ENDW(t+1); RESC(); ROT();
  }
  STEP(pB0,pB1,pA0,pA1,NT-1,false,false,false); RESC();
  { float sacc=pB0[0]+pB0[1]; _Pragma("unroll") for(int r=2;r<16;++r)sacc+=pB0[r]; _Pragma("unroll") for(int r=0;r<16;++r)sacc+=pB1[r]; l_reg+=sacc;
    pw0=(u32x4){PKW(pB0,0),PKW(pB0,2),PKW(pB0,4),PKW(pB0,6)};pw1=(u32x4){PKW(pB0,8),PKW(pB0,10),PKW(pB0,12),PKW(pB0,14)};pw2=(u32x4){PKW(pB1,0),PKW(pB1,2),PKW(pB1,4),PKW(pB1,6)};pw3=(u32x4){PKW(pB1,8),PKW(pB1,10),PKW(pB1,12),PKW(pB1,14)};
    SBAR(); pv(o,vb0+sl_cur,PAF(0),PAF(1),PAF(2),PAF(3)); }
  #undef PKW
  #undef PAF
  #undef VFR
  #undef PIN
  #undef MX3
  #undef GAPA
  #undef GAPB
  #undef EX
  #undef VRD
  #undef KRD
  #undef STEP
  #undef ENDW
  {auto rr=__builtin_amdgcn_permlane32_swap(__float_as_uint(l_reg),__float_as_uint(l_reg),false,false);l_reg=__uint_as_float(rr[0])+__uint_as_float(rr[1]);}
  if(hi==0)wsf[32+r32]=l_reg;asm volatile("s_waitcnt lgkmcnt(0)":::"memory");
  float rli[16];
  #pragma unroll
  for(int r=0;r<16;++r)rli[r]=__builtin_amdgcn_rcpf(wsf[32+crow(r,hi)]);
  bf16*Ow=Ob+(long)(q0+wid*QBLK)*OPITCH;
  { bf16*stg=(bf16*)(shm+LDS_OST)+wid*2048;
    #pragma unroll
    for(int r=0;r<16;++r){const int orow=crow(r,hi);
      #pragma unroll
      for(int d0=0;d0<2;++d0)stg[orow*64+d0*32+r32]=f2bf(o[d0][r]*rli[r]);}
    asm volatile("s_waitcnt lgkmcnt(0)":::"memory");
    #pragma unroll
    for(int i=0;i<4;++i){const int row=i*8+(lane>>3),ch=lane&7; const u32x4 v=*(const u32x4*)(stg+row*64+ch*8); ATTN_STORE16(Ow+(long)row*OPITCH+ch*8,v);} }
  asm volatile("s_waitcnt lgkmcnt(0)\n\ts_barrier":::"memory");
  #undef DMA_K
  #undef DMA_V
  #undef CMASK
  #undef START
  #undef RESC
  #undef ROT
}
constexpr int ATTN_LDS_BYTES=LDS_BYTES;
#undef SBAR
#undef WAIT_BAR
}
DEV int queue_pop(unsigned* head, LAS unsigned char* lds, int wv) {
    LAS int* slot = (LAS int*)(lds + LCTL_OFF + 4096);
    __syncthreads();
    if (opaque_tid(wv) == 0) *slot = (int)__hip_atomic_fetch_add(head, 1u, __ATOMIC_RELAXED, __HIP_MEMORY_SCOPE_AGENT);
    __syncthreads();
    return *slot;
}

DEV void phase_mix0(const Params& P, LAS unsigned char* lds, char* shm, int wv) {
    unsigned char* ws = opaque_ws(P.ws); const bf16_t* Z = (const bf16_t*)(ws + WS_Z);
    unsigned* head = (unsigned*)(ws + WS_CTL) + CW_QUEUE;
    for (;;) {
        const int q = queue_pop(head, lds, wv);
        if (q >= 32 + 1024) break;
        if (q < 32) {
            const int b = q >> 2, h = q & 3; const size_t rb = (size_t)b * SEQ;
            LinAttnArgs a; a.q = Z + rb * Z0P + h * 64; a.k = Z + rb * Z0P + 256 + h * 64; a.v = Z + rb * Z0P + 512 + h * 128; a.og = Z + rb * Z0P + 1024 + h * 128; a.zp = Z0P;
            a.la = (const float*)(ws + WS_LA) + rb * 256 + h * 64; a.log_g = 0.f; a.gain = (const float*)P.in[8]; a.out = (bf16_t*)(ws + WS_CAT) + rb * 1024 + h * 128;
            #if FAST_LIN
            linattn_unit_fast<64>(a, lds, wv);
#else
            linattn_unit_ref<64>(a, lds, wv);
#endif
        } else {
            const int aidx = q - 32, qb = 7 - (aidx >> 7), rem = aidx & 127, b = rem >> 4, vh = rem & 15;
#if FAST_ATTN
            { const int h = vh >> 2, m = (vh >> 1) & 1, vhalf = vh & 1; const bf16_t* zb = Z + (size_t)b * SEQ * Z0P;
              attn_body::attn_unit<8>(qb, zb + 1536 + h * 128 + m * 64, zb + 2048 + h * 128 + m * 64, zb + 2560 + h * 128 + vhalf * 64,
                                      (bf16_t*)(ws + WS_OPART) + (size_t)b * SEQ * 1024 + vh * 64, shm, wv); }
#else
            attn_unit_ref(b, vh, qb, Z, (bf16_t*)(ws + WS_OPART), wv);
#endif
        }
    }
}
DEV void phase_mix1(const Params& P, LAS unsigned char* lds, int wv) {
    unsigned char* ws = opaque_ws(P.ws); const bf16_t* Z = (const bf16_t*)(ws + WS_Z);
    unsigned* head = (unsigned*)(ws + WS_CTL) + CW_QUEUE + 64;
    for (;;) {
        const int q = queue_pop(head, lds, wv);
        if (q >= 32 + 128) break;
        if (q < 32) {
            const int b = q >> 2, h = q & 3; const size_t rb = (size_t)b * SEQ;
            LinAttnArgs a; a.q = Z + rb * Z1P + 1024 + h * 64; a.k = Z + rb * Z1P + 1280 + h * 64; a.v = Z + rb * Z1P + 1536 + h * 128; a.og = Z + rb * Z1P + 2048 + h * 128; a.zp = Z1P;
            a.la = nullptr; a.log_g = logf(1.0f - exp2f(-5.0f - (float)h)); a.gain = nullptr; a.out = (bf16_t*)(ws + WS_CAT) + rb * 1024 + 512 + h * 128;
            #if FAST_LIN
            linattn_unit_fast<128>(a, lds, wv);
#else
            linattn_unit_ref<128>(a, lds, wv);
#endif
        } else { const int s = q - 32;
#if FAST_SGU
            sgu_unit_fast(P, s >> 4, s & 15, lds, wv);
#else
            sgu_unit_ref(P, s >> 4, s & 15, lds, wv);
#endif
        }
    }
}
DEV void phase_combine(const Params& P, int wv) {
    const int tid = opaque_tid(wv), lane = tid & 63, wid = tid >> 6, G = gridDim.x;
    const float* q1 = (const float*)P.in[9]; const float* k1 = (const float*)P.in[10]; const float* q2 = (const float*)P.in[11]; const float* k2 = (const float*)P.in[12];
    const float* dg = (const float*)P.in[13];
    const float lam = __expf(wave_sum(q1[lane] * k1[lane])) - __expf(wave_sum(q2[lane] * k2[lane])) + 0.2f;
    unsigned char* ws = opaque_ws(P.ws); const bf16_t* OP = (const bf16_t*)(ws + WS_OPART); bf16_t* CAT = (bf16_t*)(ws + WS_CAT);
    const int h = lane >> 4, e0 = (lane & 15) * 8;
    float g[8];
#pragma unroll
    for (int j = 0; j < 8; ++j) g[j] = dg[e0 + j] * 0.8f;
    for (int row = blockIdx.x * NWAVES + wid; row < NTOK; row += G * NWAVES) {
        float a0[8], a1[8], d[8];
        unpack8(*(const bf16x8*)(OP + (size_t)row * 1024 + h * 256 + e0), a0); unpack8(*(const bf16x8*)(OP + (size_t)row * 1024 + h * 256 + 128 + e0), a1);
        float ss = 0.f;
#pragma unroll
        for (int j = 0; j < 8; ++j) { d[j] = a0[j] - lam * a1[j]; ss += d[j] * d[j]; }
        ss += __shfl_xor(ss, 1); ss += __shfl_xor(ss, 2); ss += __shfl_xor(ss, 4); ss += __shfl_xor(ss, 8);
        const float rstd = 1.0f / sqrtf(ss * (1.f / 128.f) + EPS);
        u32x4 w; w.x = pk2(d[0] * rstd * g[0], d[1] * rstd * g[1]); w.y = pk2(d[2] * rstd * g[2], d[3] * rstd * g[3]);
        w.z = pk2(d[4] * rstd * g[4], d[5] * rstd * g[5]); w.w = pk2(d[6] * rstd * g[6], d[7] * rstd * g[7]);
        *(u32x4*)(CAT + (size_t)row * 1024 + 512 + h * 128 + e0) = w;
    }
}


#ifdef DBG_PROBE_OFF
constexpr int CW_PROBE = 1024;
__global__ void __launch_bounds__(NTHREADS) mk_probe(Params P) {
    const int tid = opaque_tid(wv), G = gridDim.x;
    float s = 0.f;
    const unsigned char* base = P.ws + (size_t)DBG_PROBE_OFF;
    for (long i = (long)blockIdx.x * NTHREADS + tid; i < (long)NTOK * DBG_PROBE_NCOLS; i += (long)G * NTHREADS) {
        const long r = i / DBG_PROBE_NCOLS; const int c = (int)(i % DBG_PROBE_NCOLS) + DBG_PROBE_COL0;
        float v;
        if (DBG_PROBE_F32) v = ((const float*)base)[r * DBG_PROBE_PITCH + c]; else v = bf2f(((const bf16_t*)base)[r * DBG_PROBE_PITCH + c]);
        s += DBG_PROBE_ABS ? fabsf(v) : v * v;
    }
    s = wave_sum(s);
    if ((tid & 63) == 0) atomicAdd((float*)(P.ws + WS_CTL) + CW_PROBE, s);
}
#endif
template <class Epi, class Sched>
DEV void gemm_run(LAS unsigned char* lds, const Sched& S, const Epi& E, int wv) {
#if FAST_GEMM
    pg8::gemm_phase(lds, S, E, wv);
#else
    gemm_ref(S, E, wv);
#endif
}

constexpr int N_PHASES = 17;
template <int lo, int hi>
__global__ void __launch_bounds__(NTHREADS, 2) mk_fwd(Params P) {
    extern __shared__ __attribute__((aligned(16))) unsigned char lds_raw[];
    LAS unsigned char* lds = (LAS unsigned char*)lds_raw;
    const int G = gridDim.x, c = blockIdx.x;
    const int wv = __builtin_amdgcn_readfirstlane((int)(threadIdx.x >> 6));
#if ONE_LAUNCH
    cg::grid_group grid = cg::this_grid();
#define GRID_BAR() grid.sync()
#else
#define GRID_BAR() do {} while (0)
#endif
#define IN(k) (lo <= (k) && (k) < hi)
#define SEAM(k) do { if constexpr (lo <= (k) + 1 && (k) + 1 < hi) GRID_BAR(); } while (0)
#define PH_PTRS unsigned char* ws = opaque_ws(P.ws); const float* mod = (const float*)(ws + WS_MOD); bf16_t* H = (bf16_t*)(ws + WS_H); bf16_t* Z = (bf16_t*)(ws + WS_Z); bf16_t* CAT = (bf16_t*)(ws + WS_CAT); \
    float* X1 = (float*)(ws + WS_X1); float* X2 = (float*)(ws + WS_X2); const float* x = (const float*)P.in[0]; (void)mod; (void)H; (void)Z; (void)CAT; (void)X1; (void)X2; (void)x;

    if constexpr (IN(0)) { PH_PTRS phase_prologue(P, lds, wv); SEAM(0); }
    if constexpr (IN(1)) { PH_PTRS phase_prenorm<0>(P, lds, wv, x, nullptr, 0, 0, 0); SEAM(1); }
    if constexpr (IN(2)) { PH_PTRS
        DenseSched S{H, (const bf16_t*)(ws + WS_WIN0), 1024, NTOK / 256, N_IN0 / 256, G, c};
        EpiIn E{Z, Z0P, (float*)(ws + WS_LA), (const float*)P.in[7], (const float*)(ws + WS_ROPE), 0};
        gemm_run(lds, S, E, wv); SEAM(2);
    }
    if constexpr (IN(3)) { PH_PTRS phase_mix0(P, lds, (char*)lds_raw, wv); SEAM(3); }
    if constexpr (IN(4)) { PH_PTRS phase_combine(P, wv); SEAM(4); }
    if constexpr (IN(5)) { PH_PTRS
        DenseSched S{CAT, (const bf16_t*)(ws + WS_WOUT0), 1024, NTOK / 256, 4, G, c};
        EpiResid E{x, X1, mod + 2 * 1024, (DBG_SKIP >> 0) & 1, DBG_F_MIX0};
        gemm_run(lds, S, E, wv); SEAM(5);
    }
    if constexpr (IN(6)) { PH_PTRS phase_prenorm<4>(P, lds, wv, X1, nullptr, 0, 3072, 0); SEAM(6); }
    if constexpr (IN(7)) { PH_PTRS
        const int* cnt = (const int*)(ws + WS_CTL) + CW_CNT; const int* ent = (const int*)(ws + WS_ENT);
        MoeTiles mt = moe_build_tiles(cnt, lds, wv);
        MoeSched1 S{H, (const bf16_t*)(ws + WS_W1), cnt, ent, mt, 1024, 8, G, c};
        EpiSwiglu E{(bf16_t*)(ws + WS_A), (const float*)P.in[24]};
        gemm_run(lds, S, E, wv); SEAM(7);
    }
    if constexpr (IN(8)) { PH_PTRS
        const int* cnt = (const int*)(ws + WS_CTL) + CW_CNT; const int* ent = (const int*)(ws + WS_ENT);
        MoeTiles mt = moe_build_tiles(cnt, lds, wv);
        MoeSched2 S{(const bf16_t*)(ws + WS_A), (const bf16_t*)(ws + WS_W2), mt, 1024, 4, G, c};
        EpiMoeOut E{(bf16_t*)(ws + WS_YB), (const float*)P.in[26], cnt, ent, (const float*)(ws + WS_GATES)};
        gemm_run(lds, S, E, wv); SEAM(8);
    }
    if constexpr (IN(9)) { PH_PTRS phase_prenorm<3>(P, lds, wv, X1, X2, 1, 0, 0); SEAM(9); }
    if constexpr (IN(10)) { PH_PTRS
        DenseSched S{H, (const bf16_t*)(ws + WS_WIN1), 1024, NTOK / 256, N_IN1 / 256, G, c};
        EpiIn E{Z, Z1P, nullptr, nullptr, (const float*)(ws + WS_ROPE), 1};
        gemm_run(lds, S, E, wv); SEAM(10);
    }
    if constexpr (IN(11)) { PH_PTRS phase_mix1(P, lds, wv); SEAM(11); }
    if constexpr (IN(12)) { PH_PTRS
        DenseSched S{CAT, (const bf16_t*)(ws + WS_WOUT1), 1024, NTOK / 256, 4, G, c};
        EpiResid E{X2, X1, mod + 8 * 6144 + 2 * 1024, (DBG_SKIP >> 2) & 1, DBG_F_MIX1};
        gemm_run(lds, S, E, wv); SEAM(12);
    }
    if constexpr (IN(13)) { PH_PTRS phase_prenorm<4>(P, lds, wv, X1, nullptr, 1, 3072, 0); SEAM(13); }
    if constexpr (IN(14)) { PH_PTRS
        const int* cnt = (const int*)(ws + WS_CTL) + CW_CNT + 64; const int* ent = (const int*)(ws + WS_ENT) + (size_t)NEXP * ENT_CAP;
        MoeTiles mt = moe_build_tiles(cnt, lds, wv);
        MoeSched1 S{H, (const bf16_t*)(ws + WS_W1) + (size_t)NEXP * 2048 * 1024, cnt, ent, mt, 1024, 8, G, c};
        EpiSwiglu E{(bf16_t*)(ws + WS_A), (const float*)P.in[24] + (size_t)NEXP * 2048};
        gemm_run(lds, S, E, wv); SEAM(14);
    }
    if constexpr (IN(15)) { PH_PTRS
        const int* cnt = (const int*)(ws + WS_CTL) + CW_CNT + 64; const int* ent = (const int*)(ws + WS_ENT) + (size_t)NEXP * ENT_CAP;
        MoeTiles mt = moe_build_tiles(cnt, lds, wv);
        MoeSched2 S{(const bf16_t*)(ws + WS_A), (const bf16_t*)(ws + WS_W2) + (size_t)NEXP * 1024 * 1024, mt, 1024, 4, G, c};
        EpiMoeOut E{(bf16_t*)(ws + WS_YB), (const float*)P.in[26] + (size_t)NEXP * 1024, cnt, ent, (const float*)(ws + WS_GATES) + 65536};
        gemm_run(lds, S, E, wv); SEAM(15);
    }
    if constexpr (IN(16)) { PH_PTRS phase_prenorm<9>(P, lds, wv, DBG_FINAL_X ? x : X1, nullptr, 1, 0, 1); }
#undef IN
#undef SEAM
}

template <int PH> static void launch_phase(int grid, const Params& p, hipStream_t stream) {
    (void)hipFuncSetAttribute((const void*)mk_fwd<PH, PH + 1>, hipFuncAttributeMaxDynamicSharedMemorySize, LDS_BYTES);
    hipLaunchKernelGGL((mk_fwd<PH, PH + 1>), dim3(grid), dim3(NTHREADS), LDS_BYTES, stream, p);
}
#ifdef DBG_PHASES
template <int PH> static void launch_masked(int grid, const Params& p, hipStream_t stream) {
    if constexpr (PH < N_PHASES) { if constexpr ((DBG_PHASES >> PH) & 1) launch_phase<PH>(grid, p, stream); launch_masked<PH + 1>(grid, p, stream); }
}
#endif
template <int PH> static void launch_all(int grid, const Params& p, hipStream_t stream) {
    if constexpr (PH < N_PHASES) { launch_phase<PH>(grid, p, stream); launch_all<PH + 1>(grid, p, stream); }
}
extern "C" void kernel_launch(void* const* d_in, const int* in_sizes, int n_in, void* d_out, int out_size, void* d_ws, size_t ws_size, hipStream_t stream) {
    static int grid = 0;
    if (grid == 0) {
        if (n_in != 28 || out_size != NTOK * DM || ws_size < WS_END) { fprintf(stderr, "kernel_launch: unexpected shapes (n_in %d out %d ws %zu)\n", n_in, out_size, ws_size); grid = -1; return; }
        int dev = 0, cus = 0;
        (void)hipGetDevice(&dev); (void)hipDeviceGetAttribute(&cus, hipDeviceAttributeMultiprocessorCount, dev);
#if ONE_LAUNCH
        int per_cu = 0;
        if (hipFuncSetAttribute((const void*)mk_fwd<0, N_PHASES>, hipFuncAttributeMaxDynamicSharedMemorySize, LDS_BYTES) != hipSuccess) { fprintf(stderr, "kernel_launch: hipFuncSetAttribute failed\n"); grid = -1; return; }
        (void)hipOccupancyMaxActiveBlocksPerMultiprocessor(&per_cu, (const void*)mk_fwd<0, N_PHASES>, NTHREADS, LDS_BYTES);
        if (per_cu < 1) { fprintf(stderr, "kernel_launch: occupancy query reports %d blocks per CU\n", per_cu); grid = -1; return; }
#endif
        (void)hipGetLastError();
        grid = cus;
    }
    if (grid < 0) return;
    (void)hipMemsetAsync((char*)d_ws + WS_CTL, 0, CTL_ZERO_BYTES, stream);
    Params p{};
    for (int i = 0; i < 28; ++i) p.in[i] = d_in[i];
    p.out = (float*)d_out; p.ws = (unsigned char*)d_ws;
#if ONE_LAUNCH
    void* args[] = {&p};
    hipError_t e = hipLaunchCooperativeKernel((const void*)mk_fwd<0, N_PHASES>, dim3(grid), dim3(NTHREADS), args, LDS_BYTES, stream);
    if (e != hipSuccess) fprintf(stderr, "cooperative launch failed: %s (grid %d)\n", hipGetErrorString(e), grid);
#else
#ifdef DBG_PHASES
    launch_masked<0>(grid, p, stream);
#ifdef DBG_PROBE_OFF
    hipLaunchKernelGGL(mk_probe, dim3(grid), dim3(NTHREADS), 0, stream, p);
    launch_phase<16>(grid, p, stream);
#endif
#else
    launch_all<0>(grid, p, stream);
#endif
#endif
}
```

```cpp
#include <hip/hip_runtime.h>
#include <hip/hip_cooperative_groups.h>
#include <cstdio>
#include <cstdint>
namespace cg = cooperative_groups;

#ifndef ONE_LAUNCH
#define ONE_LAUNCH 1
#endif
#ifndef FAST_GEMM
#define FAST_GEMM 1
#endif
#ifndef USE_CG_SYNC
#define USE_CG_SYNC 0
#endif
#ifndef FAST_ATTN
#define FAST_ATTN 1
#endif
#ifndef FAST_LIN
#define FAST_LIN 1
#endif
#ifndef FAST_SGU
#define FAST_SGU 1
#endif
#ifndef DBG_SKIP
#define DBG_SKIP 0
#endif
#ifndef DBG_FINAL_X
#define DBG_FINAL_X 0
#endif
#ifndef DBG_F_MIX0
#define DBG_F_MIX0 1.0f
#endif
#ifndef DBG_F_MOE0
#define DBG_F_MOE0 1.0f
#endif
#ifndef DBG_F_MIX1
#define DBG_F_MIX1 1.0f
#endif
#ifndef DBG_F_MOE1
#define DBG_F_MOE1 1.0f
#endif

#define DEV __device__ __forceinline__
#define LAS __attribute__((address_space(3)))
typedef unsigned short bf16_t;
typedef short bf16x8 __attribute__((ext_vector_type(8)));
typedef float f32x4 __attribute__((ext_vector_type(4)));
typedef float f32x2 __attribute__((ext_vector_type(2)));
typedef unsigned u32x4 __attribute__((ext_vector_type(4)));
typedef unsigned u32x2 __attribute__((ext_vector_type(2)));
typedef __bf16 bf16x2_t __attribute__((ext_vector_type(2)));

constexpr int NB = 8, SEQ = 2048, DM = 1024, NTOK = NB * SEQ, NEXP = 32, TOPK = 4;
constexpr int Z0P = 3072, Z1P = 2560;
constexpr int N_IN0 = 3328, N_IN1 = 2560;
constexpr int ENT_CAP = NTOK;
constexpr float EPS = 1e-6f;
constexpr float C2 = 0.125f * 1.4426950408889634f;
constexpr int NTHREADS = 512, NWAVES = 8;

constexpr size_t MiB = 1u << 20;
constexpr size_t WS_CTL = 0, CTL_ZERO_BYTES = 64 * 1024;
constexpr size_t WS_MOD = 1 * MiB;
constexpr size_t WS_ROPE = 2 * MiB;
constexpr size_t WS_ENT = 6 * MiB;
constexpr size_t WS_GATES = 10 * MiB;
constexpr size_t WS_SGUW = 11 * MiB;
constexpr size_t WS_WIN0 = 12 * MiB;
constexpr size_t WS_WOUT0 = 19 * MiB;
constexpr size_t WS_WIN1 = 21 * MiB;
constexpr size_t WS_WOUT1 = 26 * MiB;
constexpr size_t WS_W1 = 32 * MiB;
constexpr size_t WS_W2 = 288 * MiB;
constexpr size_t WS_H = 416 * MiB;
constexpr size_t WS_Z = 448 * MiB;
constexpr size_t WS_LA = 544 * MiB;
constexpr size_t WS_OPART = 560 * MiB;
constexpr size_t WS_CAT = 592 * MiB;
constexpr size_t WS_X1 = 624 * MiB;
constexpr size_t WS_X2 = 688 * MiB;
constexpr size_t WS_A = 752 * MiB;
constexpr size_t WS_YB = 896 * MiB;
constexpr size_t WS_END = 1024 * MiB;
constexpr int CW_CNT = 0;
constexpr int CW_QUEUE = 256;
constexpr int CW_BAR = 4096;

constexpr int RING_BYTES = 131072;
constexpr int LCTL_OFF = 149504;
constexpr int LDS_BYTES = 163840;

DEV float bf2f(bf16_t v) { return __uint_as_float((unsigned)v << 16); }
DEV unsigned pk2(float lo, float hi) { f32x2 v = {lo, hi}; bf16x2_t b = __builtin_convertvector(v, bf16x2_t); return __builtin_bit_cast(unsigned, b); }
DEV bf16_t f2bf(float f) { return (bf16_t)(pk2(f, 0.f) & 0xffffu); }
DEV float wave_sum(float v) {
#pragma unroll
    for (int o = 1; o < 64; o <<= 1) v += __shfl_xor(v, o);
    return v;
}
DEV float silu_f(float x) { return x / (1.f + __expf(-x)); }
DEV float log_sigmoid_f(float x) { return fminf(x, 0.f) - __logf(1.f + __expf(-fabsf(x))); }
DEV float gelu_f(float v) {
    const float av = fabsf(v), t = __builtin_amdgcn_rcpf(av * 0.2316418882f + 1.0f);
    float q = t * 0.5307027145f + (-0.7265760135f); q = q * t + 0.7107068705f; q = q * t + (-0.142248368f); q = q * t + 0.127414796f; q = q * t;
    const float e = __builtin_amdgcn_exp2f((v * v) * (-0.72134752044f));
    const float m = v * (q * e);
    return v < 0.f ? m : v - m;
}
DEV void unpack8(const bf16x8 v, float (&o)[8]) {
#pragma unroll
    for (int j = 0; j < 8; ++j) o[j] = bf2f((bf16_t)v[j]);
}

DEV unsigned char* opaque_ws(unsigned char* p) { size_t z = 0; asm volatile("" : "+s"(z)); return p + z; }
DEV int lane_id() { return (int)__builtin_amdgcn_mbcnt_hi(~0u, __builtin_amdgcn_mbcnt_lo(~0u, 0u)); }
DEV int opaque_tid(int wv) { int l; asm volatile("v_mbcnt_lo_u32_b32 %0, -1, 0\n\tv_mbcnt_hi_u32_b32 %0, -1, %0" : "=v"(l)); return (wv << 6) | l; }
struct Params {
    const void* in[28];
    float* out;
    unsigned char* ws;
};

struct Unit { int pm, pn, e, tb; };

DEV bool static_next(int i, int G, int c, int nM, int nN, int& pm, int& pn) {
    const int nwg = nM * nN; const long Lr = (long)i * G + c; if (Lr >= nwg) return false;
    int wgid = (int)Lr; { const int q = nwg / 8, r = nwg % 8, xcd = wgid % 8, off = wgid / 8; wgid = (xcd < r ? xcd * (q + 1) : r * (q + 1) + (xcd - r) * q) + off; }
    const int nig = 8 * nN, gid = wgid / nig, fm = gid * 8, gsz = (nM - fm) < 8 ? (nM - fm) : 8;
    pm = fm + ((wgid % nig) % gsz); pn = (wgid % nig) / gsz; return true;
}
struct DenseSched {
    const bf16_t* A; const bf16_t* Bt; int K, nM, nN, G, c;
    DEV bool next(int i, Unit& u) const { u.e = 0; u.tb = 0; return static_next(i, G, c, nM, nN, u.pm, u.pn); }
    DEV unsigned a_row_off(const Unit& u, int r) const { return (unsigned)(u.pm * 256 + r) * (unsigned)K; }
    DEV const bf16_t* b_ptr(const Unit& u) const { return Bt + (size_t)u.pn * 256 * K; }
};
struct MoeTiles { const LAS int* te; const LAS int* ttb; int nt; };
struct MoeSched1 {
    const bf16_t* A; const bf16_t* Bt; const int* cnt; const int* ent; MoeTiles mt; int K, nN, G, c;
    DEV bool next(int i, Unit& u) const { int pm, pn; if (!static_next(i, G, c, mt.nt, nN, pm, pn)) return false; u.pm = pm; u.pn = pn; u.e = mt.te[pm]; u.tb = mt.ttb[pm]; return true; }
    DEV unsigned a_row_off(const Unit& u, int r) const {
        const int n = cnt[u.e]; int pos = u.tb * 256 + r; pos = pos < n ? pos : n - 1;
        const int tok = ent[u.e * ENT_CAP + pos] >> 2; return (unsigned)tok * (unsigned)K; }
    DEV const bf16_t* b_ptr(const Unit& u) const { return Bt + ((size_t)u.e * 2048 + (size_t)u.pn * 256) * K; }
};
struct MoeSched2 {
    const bf16_t* A; const bf16_t* Bt; MoeTiles mt; int K, nN, G, c;
    DEV bool next(int i, Unit& u) const { int pm, pn; if (!static_next(i, G, c, mt.nt, nN, pm, pn)) return false; u.pm = pm; u.pn = pn; u.e = mt.te[pm]; u.tb = mt.ttb[pm]; return true; }
    DEV unsigned a_row_off(const Unit& u, int r) const { return (unsigned)(u.pm * 256 + r) * (unsigned)K; }
    DEV const bf16_t* b_ptr(const Unit& u) const { return Bt + ((size_t)u.e * 1024 + (size_t)u.pn * 256) * K; }
};
DEV MoeTiles moe_build_tiles(const int* cnt, LAS unsigned char* lds, int wv) {
    LAS int* te = (LAS int*)(lds + LCTL_OFF); LAS int* ttb = te + 320; LAS int* ntp = ttb + 320;
    __syncthreads();
    if (opaque_tid(wv) == 0) {
        int n = 0;
        for (int e = 0; e < NEXP; ++e) { const int c = __hip_atomic_load(cnt + e, __ATOMIC_RELAXED, __HIP_MEMORY_SCOPE_AGENT); const int nt = (c + 255) >> 8;
            for (int t = 0; t < nt; ++t) { te[n] = e; ttb[n] = t; ++n; } }
        *ntp = n;
    }
    __syncthreads();
    MoeTiles mt; mt.te = te; mt.ttb = ttb; mt.nt = *ntp; return mt;
}

enum { EK_PLAIN = 0, EK_SILU = 1, EK_GELU = 2, EK_ROPE = 3, EK_LOGSIG = 4 };
struct EpiIn {
    static constexpr bool PERM = true;
    bf16_t* Z; int zp; float* LA; const float* bgate; const float* rope; int layer;
    DEV void kind_of(int pn, int& kind, float& sc) const {
        kind = EK_PLAIN; sc = 1.f;
        if (layer == 0) { if (pn == 0) sc = 0.125f; else if (pn == 4 || pn == 5) kind = EK_SILU; else if (pn == 6 || pn == 7) { kind = EK_ROPE; sc = C2; } else if (pn == 8 || pn == 9) kind = EK_ROPE; else if (pn == 12) kind = EK_LOGSIG; }
        else { if (pn < 4) kind = EK_GELU; else if (pn == 4) { kind = EK_ROPE; sc = 0.125f; } else if (pn == 5) kind = EK_ROPE; else if (pn >= 8) kind = EK_SILU; }
    }
    DEV void operator()(const f32x4 (&acc)[2][2][4][2], const Unit& u, int wr, int wc, int fr, int fq) const {
        int kind; float sc; kind_of(u.pn, kind, sc);
#pragma unroll
        for (int ai = 0; ai < 2; ++ai)
#pragma unroll
            for (int m = 0; m < 4; ++m) {
                const int row = u.pm * 256 + ai * 128 + wr * 64 + m * 16 + fr;
                if (kind == EK_ROPE) {
                    const float* rt = rope + (size_t)row * 64 + (8 * fq) * 2;
                    const f32x4 t0 = *(const f32x4*)(rt), t1 = *(const f32x4*)(rt + 4), t2 = *(const f32x4*)(rt + 8), t3 = *(const f32x4*)(rt + 12);
                    const float cs[8] = {t0[0], t0[2], t1[0], t1[2], t2[0], t2[2], t3[0], t3[2]}, sn[8] = {t0[1], t0[3], t1[1], t1[3], t2[1], t2[3], t3[1], t3[3]};
                    float y1[8], y2[8];
#pragma unroll
                    for (int n = 0; n < 2; ++n)
#pragma unroll
                        for (int i = 0; i < 4; ++i) { const float x1 = acc[ai][0][m][n][i], x2 = acc[ai][1][m][n][i]; const int j = 4 * n + i;
                            y1[j] = (x1 * cs[j] - x2 * sn[j]) * sc; y2[j] = (x2 * cs[j] + x1 * sn[j]) * sc; }
                    bf16_t* zp_ = Z + (size_t)row * zp + u.pn * 256 + 64 * wc + 8 * fq;
                    u32x4 w; w.x = pk2(y1[0], y1[1]); w.y = pk2(y1[2], y1[3]); w.z = pk2(y1[4], y1[5]); w.w = pk2(y1[6], y1[7]); *(u32x4*)(zp_) = w;
                    w.x = pk2(y2[0], y2[1]); w.y = pk2(y2[2], y2[3]); w.z = pk2(y2[4], y2[5]); w.w = pk2(y2[6], y2[7]); *(u32x4*)(zp_ + 32) = w;
                } else if (kind == EK_LOGSIG) {
#pragma unroll
                    for (int bj = 0; bj < 2; ++bj) { const int col = 128 * bj + 32 * wc + 8 * fq; float* lp = LA + (size_t)row * 256 + col;
                        const f32x4 b0 = *(const f32x4*)(bgate + col), b1 = *(const f32x4*)(bgate + col + 4); f32x4 o0, o1;
#pragma unroll
                        for (int i = 0; i < 4; ++i) { o0[i] = log_sigmoid_f(acc[ai][bj][m][0][i] + b0[i]) * 0.0625f; o1[i] = log_sigmoid_f(acc[ai][bj][m][1][i] + b1[i]) * 0.0625f; }
                        *(f32x4*)lp = o0; *(f32x4*)(lp + 4) = o1; }
                } else {
#pragma unroll
                    for (int bj = 0; bj < 2; ++bj) { float v[8];
#pragma unroll
                        for (int n = 0; n < 2; ++n)
#pragma unroll
                            for (int i = 0; i < 4; ++i) { float x = acc[ai][bj][m][n][i]; if (kind == EK_SILU) x = silu_f(x); else if (kind == EK_GELU) x = gelu_f(x); v[4 * n + i] = x * sc; }
                        u32x4 w; w.x = pk2(v[0], v[1]); w.y = pk2(v[2], v[3]); w.z = pk2(v[4], v[5]); w.w = pk2(v[6], v[7]);
                        *(u32x4*)(Z + (size_t)row * zp + u.pn * 256 + 128 * bj + 32 * wc + 8 * fq) = w; }
                }
            }
    }
};
struct EpiResid {
    static constexpr bool PERM = false;
    const float* resid; float* out; const float* gate; int skip; float dbgf;
    DEV void operator()(const f32x4 (&acc)[2][2][4][2], const Unit& u, int wr, int wc, int fr, int fq) const {
        const int b = (u.pm * 256) >> 11;
#pragma unroll
        for (int ai = 0; ai < 2; ++ai)
#pragma unroll
            for (int m = 0; m < 4; ++m) { const size_t row = (size_t)(u.pm * 256 + ai * 128 + wr * 64 + m * 16 + fr);
#pragma unroll
                for (int bj = 0; bj < 2; ++bj)
#pragma unroll
                    for (int n = 0; n < 2; ++n) { const int col = u.pn * 256 + 128 * bj + 32 * wc + 16 * n + 4 * fq;
                        const f32x4 g = *(const f32x4*)(gate + (size_t)b * 6144 + col), r = *(const f32x4*)(resid + row * DM + col);
                        *(f32x4*)(out + row * DM + col) = skip ? r : r + g * acc[ai][bj][m][n] * dbgf; } }
    }
};
struct EpiSwiglu {
    static constexpr bool PERM = true;
    bf16_t* Aout; const float* bin;
    DEV void operator()(const f32x4 (&acc)[2][2][4][2], const Unit& u, int wr, int wc, int fr, int fq) const {
        const int lc = 128 * u.pn + 32 * wc + 8 * fq; const float* bp = bin + (size_t)u.e * 2048 + lc;
        const f32x4 bg0 = *(const f32x4*)bp, bg1 = *(const f32x4*)(bp + 4), bl0 = *(const f32x4*)(bp + 1024), bl1 = *(const f32x4*)(bp + 1028);
#pragma unroll
        for (int ai = 0; ai < 2; ++ai)
#pragma unroll
            for (int m = 0; m < 4; ++m) { const size_t row = (size_t)(u.pm * 256 + ai * 128 + wr * 64 + m * 16 + fr); float v[8];
#pragma unroll
                for (int n = 0; n < 2; ++n)
#pragma unroll
                    for (int i = 0; i < 4; ++i) { const float g = fminf(acc[ai][0][m][n][i] + (n ? bg1[i] : bg0[i]), 7.f);
                        const float l = fminf(fmaxf(acc[ai][1][m][n][i] + (n ? bl1[i] : bl0[i]), -7.f), 7.f);
                        v[4 * n + i] = g / (1.f + __expf(-1.702f * g)) * (l + 1.f); }
                u32x4 w; w.x = pk2(v[0], v[1]); w.y = pk2(v[2], v[3]); w.z = pk2(v[4], v[5]); w.w = pk2(v[6], v[7]);
                *(u32x4*)(Aout + row * 1024 + lc) = w; }
    }
};
struct EpiMoeOut {
    static constexpr bool PERM = true;
    bf16_t* YB; const float* bout; const int* cnt; const int* ent; const float* gates;
    DEV void operator()(const f32x4 (&acc)[2][2][4][2], const Unit& u, int wr, int wc, int fr, int fq) const {
        const int n_e = cnt[u.e];
        f32x4 bv[2][2];
#pragma unroll
        for (int bj = 0; bj < 2; ++bj)
#pragma unroll
            for (int n = 0; n < 2; ++n) bv[bj][n] = *(const f32x4*)(bout + (size_t)u.e * 1024 + u.pn * 256 + 128 * bj + 32 * wc + 8 * fq + 4 * n);
#pragma unroll
        for (int ai = 0; ai < 2; ++ai)
#pragma unroll
            for (int m = 0; m < 4; ++m) { const int pos = u.tb * 256 + ai * 128 + wr * 64 + m * 16 + fr;
                if (pos < n_e) { const int dst = ent[u.e * ENT_CAP + pos]; const float g = gates[dst];
#pragma unroll
                    for (int bj = 0; bj < 2; ++bj) { const f32x4 v0 = (acc[ai][bj][m][0] + bv[bj][0]) * g, v1 = (acc[ai][bj][m][1] + bv[bj][1]) * g;
                        u32x4 w; w.x = pk2(v0[0], v0[1]); w.y = pk2(v0[2], v0[3]); w.z = pk2(v1[0], v1[1]); w.w = pk2(v1[2], v1[3]);
                        *(u32x4*)(YB + (size_t)dst * 1024 + u.pn * 256 + 128 * bj + 32 * wc + 8 * fq) = w; } } }
    }
};

template <class Epi, class Sched>
DEV void gemm_ref(const Sched& S, const Epi& E, int wv) {
    const int tid = opaque_tid(wv), wid = tid >> 6, lane = tid & 63, wr = wid >> 2, wc = wid & 3, fr = lane & 15, fq = lane >> 4;
    Unit u;
    for (int it = 0; S.next(it, u); ++it) {
        f32x4 acc[2][2][4][2];
#pragma unroll
        for (int a = 0; a < 2; ++a)
#pragma unroll
            for (int b = 0; b < 2; ++b)
#pragma unroll
                for (int m = 0; m < 4; ++m)
#pragma unroll
                    for (int n = 0; n < 2; ++n) acc[a][b][m][n] = (f32x4){0.f, 0.f, 0.f, 0.f};
        unsigned aoff[2][4];
#pragma unroll
        for (int ai = 0; ai < 2; ++ai)
#pragma unroll
            for (int m = 0; m < 4; ++m) aoff[ai][m] = S.a_row_off(u, ai * 128 + wr * 64 + m * 16 + fr);
        const bf16_t* Bt = S.b_ptr(u); const int K = S.K;
        for (int k0 = 0; k0 < K; k0 += 8) {
            u32x4 araw[2][4];
#pragma unroll
            for (int ai = 0; ai < 2; ++ai)
#pragma unroll
                for (int m = 0; m < 4; ++m) araw[ai][m] = *(const u32x4*)(S.A + aoff[ai][m] + k0);
            asm volatile("" ::: "memory");
#pragma unroll
            for (int bj = 0; bj < 2; ++bj)
#pragma unroll
                for (int n = 0; n < 2; ++n) {
                    u32x4 braw[4];
#pragma unroll
                    for (int i = 0; i < 4; ++i) { const int c = 128 * bj + 32 * wc + (Epi::PERM ? 8 * fq + 4 * n + i : 16 * n + 4 * fq + i); braw[i] = *(const u32x4*)(Bt + (size_t)c * K + k0); }
                    asm volatile("" ::: "memory");
#pragma unroll
                    for (int i = 0; i < 4; ++i)
#pragma unroll
                        for (int ai = 0; ai < 2; ++ai)
#pragma unroll
                            for (int m = 0; m < 4; ++m) { float s = acc[ai][bj][m][n][i];
#pragma unroll
                                for (int j = 0; j < 4; ++j) { const unsigned au = araw[ai][m][j], bu = braw[i][j];
                                    s = __builtin_amdgcn_fdot2_f32_bf16(__builtin_bit_cast(bf16x2_t, au), __builtin_bit_cast(bf16x2_t, bu), s, false); }
                                acc[ai][bj][m][n][i] = s; }
                }
        }
        E(acc, u, wr, wc, fr, fq);
    }
}


namespace pg8 {
constexpr int BM = 256, BK = 64, HALF = 128, HTB = HALF * BK * 2, STAGE_BYTES = 8 * HTB;
DEV int lds_byte(int r, int c) { const int st = (r >> 4) * 2 + (c >> 5), rr = r & 15, cc = c & 31, ob = rr * 64 + cc * 2; return st * 1024 + (ob ^ (((ob >> 9) & 1) << 5)); }
DEV void stage_rc(int b, int& R, int& C) { const int st = b / 1024, sb = b % 1024, swz = sb ^ (((sb >> 9) & 1) << 5); R = (st >> 1) * 16 + swz / 64; C = (st & 1) * 32 + (swz % 64) / 2; }
DEV int perm32(int rho) { const int n = rho >> 4, i = rho & 15; return 8 * (i >> 2) + 4 * n + (i & 3); }

template <class Epi, class Sched>
DEV void gemm_phase(LAS unsigned char* lds, const Sched& S, const Epi& E, int wv) {
    const int tid = opaque_tid(wv);
    const int wid = __builtin_amdgcn_readfirstlane(tid >> 6), lane = tid & 63, wr = wid >> 2, wc = wid & 3, fr = lane & 15, fq = lane >> 4;
    const int K = S.K, nt = K / BK;
    int rA[2]; unsigned cA2[2], voffB[2];
#pragma unroll
    for (int i = 0; i < 2; ++i) { int R, C; stage_rc(tid * 16 + i * 8192, R, C); const int Rb = Epi::PERM ? ((R & ~31) + perm32(R & 31)) : R;
        rA[i] = R; cA2[i] = (unsigned)C * 2u; voffB[i] = (unsigned)(Rb * K + C) * 2u; }
    const size_t kstep = (size_t)(BK * 2);
    const size_t hstep = (size_t)HALF * K * 2;
    const unsigned ldsw = (unsigned)wid * 1024u;
    const int aoff = lds_byte(wr * 64 + fr, fq * 8), boff = lds_byte(wc * 32 + fr, fq * 8);
    const char* Abase = (const char*)S.A;
#define PG8_SA(b, h) (((b) * 2 + (h)) * HTB)
#define PG8_SB(b, h) ((4 + (b) * 2 + (h)) * HTB)
#define PG8_STAGE(bufoff, gbase, voff) do { _Pragma("unroll") for (int _i = 0; _i < 2; ++_i) \
        __builtin_amdgcn_global_load_lds((const unsigned*)((const char*)(gbase) + (voff)[_i]), (LAS unsigned*)(lds + (bufoff) + ldsw + _i * 8192), 16, 0, 0); } while (0)
#define PG8_LDA(dst, b, h) do { _Pragma("unroll") for (int m = 0; m < 4; ++m) _Pragma("unroll") for (int k = 0; k < 2; ++k) dst[m][k] = *(const LAS bf16x8*)(lds + PG8_SA(b, h) + aoff + m * 2048 + k * 1024); } while (0)
#define PG8_LDB(dst, b, h) do { _Pragma("unroll") for (int n = 0; n < 2; ++n) _Pragma("unroll") for (int k = 0; k < 2; ++k) dst[n][k] = *(const LAS bf16x8*)(lds + PG8_SB(b, h) + boff + n * 2048 + k * 1024); } while (0)
#define PG8_MMA(ai, bj, At, Bt) do { __builtin_amdgcn_s_setprio(1); _Pragma("unroll") for (int m = 0; m < 4; ++m) _Pragma("unroll") for (int n = 0; n < 2; ++n) _Pragma("unroll") for (int k = 0; k < 2; ++k) \
        acc[ai][bj][m][n] = __builtin_amdgcn_mfma_f32_16x16x32_bf16(Bt[n][k], At[m][k], acc[ai][bj][m][n], 0, 0, 0); __builtin_amdgcn_s_setprio(0); } while (0)
#define PG8_WAIT_V(n) asm volatile("s_waitcnt vmcnt(" #n ")" ::: "memory")
#define PG8_WAIT_L(n) asm volatile("s_waitcnt lgkmcnt(" #n ")" ::: "memory")
#define PG8_BAR __builtin_amdgcn_s_barrier()
#define PG8_SCHED __builtin_amdgcn_sched_barrier(0)
    Unit cur, nxt; int ui = 0;
    if (!S.next(0, cur)) return;
    f32x4 acc[2][2][4][2];
#pragma unroll
    for (int a = 0; a < 2; ++a)
#pragma unroll
        for (int b = 0; b < 2; ++b)
#pragma unroll
            for (int m = 0; m < 4; ++m)
#pragma unroll
                for (int n = 0; n < 2; ++n) acc[a][b][m][n] = (f32x4){0.f, 0.f, 0.f, 0.f};
    bf16x8 At[4][2], B0[2][2], B1[2][2];
    unsigned vc0[2], vc1[2], vn0[2], vn1[2];
#pragma unroll
    for (int i = 0; i < 2; ++i) { vc0[i] = S.a_row_off(cur, rA[i]) * 2u + cA2[i]; vc1[i] = S.a_row_off(cur, HALF + rA[i]) * 2u + cA2[i]; }
    const char* cB = (const char*)S.b_ptr(cur);
    PG8_STAGE(PG8_SB(0, 0), cB, voffB); PG8_STAGE(PG8_SB(0, 1), cB + hstep, voffB); PG8_STAGE(PG8_SA(0, 0), Abase, vc0); PG8_STAGE(PG8_SA(0, 1), Abase, vc1);
    if (wr == 1) PG8_BAR;
    PG8_WAIT_V(2); PG8_BAR;
    PG8_STAGE(PG8_SB(1, 0), cB + kstep, voffB); PG8_STAGE(PG8_SA(1, 0), Abase + kstep, vc0); PG8_STAGE(PG8_SB(1, 1), cB + hstep + kstep, voffB);
    PG8_WAIT_V(6); PG8_BAR;
    for (;;) {
        const bool has_next = S.next(ui + 1, nxt);
        const char* nB = has_next ? (const char*)S.b_ptr(nxt) : cB;
#pragma unroll
        for (int i = 0; i < 2; ++i) { vn0[i] = has_next ? S.a_row_off(nxt, rA[i]) * 2u + cA2[i] : vc0[i]; vn1[i] = has_next ? S.a_row_off(nxt, HALF + rA[i]) * 2u + cA2[i] : vc1[i]; }
        for (int t = 0; t < nt; t += 2) {
            const bool last = (t == nt - 2);
            const char* a1 = Abase + (size_t)(t + 1) * kstep;
            const char* a2 = last ? Abase : Abase + (size_t)(t + 2) * kstep; const char* b2 = last ? nB : cB + (size_t)(t + 2) * kstep;
            const char* a3 = a2 + kstep; const char* b3 = b2 + kstep;
            unsigned s0[2], s1[2];
#pragma unroll
            for (int i = 0; i < 2; ++i) { s0[i] = last ? vn0[i] : vc0[i]; s1[i] = last ? vn1[i] : vc1[i]; }
            PG8_LDB(B0, 0, 0); PG8_LDB(B1, 0, 1); PG8_SCHED; PG8_LDA(At, 0, 0); PG8_STAGE(PG8_SA(1, 1), a1, vc1);
            PG8_WAIT_V(8); PG8_WAIT_L(0); PG8_BAR; PG8_MMA(0, 0, At, B0); PG8_MMA(0, 1, At, B1); PG8_BAR; PG8_SCHED;
            PG8_LDA(At, 0, 1); PG8_STAGE(PG8_SB(0, 0), b2, voffB); PG8_STAGE(PG8_SB(0, 1), b2 + hstep, voffB); PG8_STAGE(PG8_SA(0, 0), a2, s0);
            PG8_WAIT_V(8); PG8_WAIT_L(0); PG8_BAR; PG8_MMA(1, 0, At, B0); PG8_MMA(1, 1, At, B1); PG8_BAR; PG8_SCHED;
            PG8_LDB(B0, 1, 0); PG8_LDB(B1, 1, 1); PG8_SCHED; PG8_LDA(At, 1, 0); PG8_STAGE(PG8_SA(0, 1), a2, s1);
            PG8_WAIT_V(8); PG8_WAIT_L(0); PG8_BAR; PG8_MMA(0, 0, At, B0); PG8_MMA(0, 1, At, B1); PG8_BAR; PG8_SCHED;
            PG8_LDA(At, 1, 1); PG8_STAGE(PG8_SB(1, 0), b3, voffB); PG8_STAGE(PG8_SB(1, 1), b3 + hstep, voffB); PG8_STAGE(PG8_SA(1, 0), a3, s0);
            PG8_WAIT_V(8); PG8_WAIT_L(0); PG8_BAR; PG8_MMA(1, 0, At, B0); PG8_MMA(1, 1, At, B1); PG8_BAR; PG8_SCHED;
        }
        if (wr == 0) PG8_BAR;
        E(acc, cur, wr, wc, fr, fq);
        if (!has_next) break;
#pragma unroll
        for (int a = 0; a < 2; ++a)
#pragma unroll
            for (int b = 0; b < 2; ++b)
#pragma unroll
                for (int m = 0; m < 4; ++m)
#pragma unroll
                    for (int n = 0; n < 2; ++n) acc[a][b][m][n] = (f32x4){0.f, 0.f, 0.f, 0.f};
        cur = nxt; cB = nB; ++ui;
#pragma unroll
        for (int i = 0; i < 2; ++i) { vc0[i] = vn0[i]; vc1[i] = vn1[i]; }
        if (wr == 1) PG8_BAR;
    }
    PG8_WAIT_V(0);
    PG8_BAR;
#undef PG8_SA
#undef PG8_SB
#undef PG8_STAGE
#undef PG8_LDA
#undef PG8_LDB
#undef PG8_MMA
#undef PG8_WAIT_V
#undef PG8_WAIT_L
#undef PG8_BAR
#undef PG8_SCHED
}
}

__host__ __device__ inline int ropeoff(int q) { return 64 * (q & 3) + 32 * (q >> 2); }
__host__ __device__ inline int in0_logcol(int g32) {
    const int tile = g32 >> 3, q = g32 & 7;
    switch (tile) {
        case 0: return 0 + q * 32; case 1: return 256 + q * 32;
        case 2: case 3: return 512 + (tile - 2) * 256 + q * 32;
        case 4: case 5: return 1040 + (tile - 4) * 256 + q * 32;
        case 6: case 7: return 1552 + (tile - 6) * 256 + ropeoff(q);
        case 8: case 9: return 2064 + (tile - 8) * 256 + ropeoff(q);
        default: return 2576 + (tile - 10) * 256 + q * 32;
    }
}
__host__ __device__ inline int in1_logcol(int g32) {
    const int tile = g32 >> 3, q = g32 & 7;
    if (tile < 4) return tile * 256 + q * 32;
    if (tile == 4) return 1024 + ropeoff(q);
    if (tile == 5) return 1280 + ropeoff(q);
    return 1536 + (tile - 6) * 256 + q * 32;
}
DEV void conv_item(const float* W, int ldw, int logcol0, int k0, bf16_t* Wt_row0, int Kd, LAS float* scr, int lane) {
#pragma unroll 8
    for (int i = 0; i < 32; ++i) { const int kk = 2 * i + (lane >> 5); scr[kk * 33 + (lane & 31)] = W[(size_t)(k0 + kk) * ldw + logcol0 + (lane & 31)]; }
    asm volatile("s_waitcnt lgkmcnt(0)" ::: "memory");
    const int c = lane & 7;
#pragma unroll
    for (int j = 0; j < 4; ++j) { const int n = (lane >> 3) + 8 * j; const LAS float* s = scr + (8 * c) * 33 + n;
        u32x4 o; o.x = pk2(s[0 * 33], s[1 * 33]); o.y = pk2(s[2 * 33], s[3 * 33]); o.z = pk2(s[4 * 33], s[5 * 33]); o.w = pk2(s[6 * 33], s[7 * 33]);
        *(u32x4*)(Wt_row0 + (size_t)n * Kd + k0 + 8 * c) = o; }
    asm volatile("s_waitcnt lgkmcnt(0)" ::: "memory");
}
DEV void sincos_d(double x, float& s, float& c) {
    const double k = __builtin_rint(x * 0.63661977236758134308);
    const double r = (x - k * 1.5707963267948966192) - k * 6.123233995736766e-17;
    const double r2 = r * r;
    double sp = -7.647163731819816e-13; sp = sp * r2 + 1.605904383682161e-10; sp = sp * r2 - 2.505210838544172e-08; sp = sp * r2 + 2.755731922398589e-06;
    sp = sp * r2 - 1.984126984126984e-04; sp = sp * r2 + 8.333333333333333e-03; sp = sp * r2 - 1.666666666666667e-01; sp = r + r * r2 * sp;
    double cp = 4.779477332387385e-14; cp = cp * r2 - 1.147074559772972e-11; cp = cp * r2 + 2.087675698786810e-09; cp = cp * r2 - 2.755731922398589e-07;
    cp = cp * r2 + 2.480158730158730e-05; cp = cp * r2 - 1.388888888888889e-03; cp = cp * r2 + 4.166666666666666e-02; cp = cp * r2 - 0.5; cp = 1.0 + r2 * cp;
    const int q = ((int)k) & 3;
    const double ss = (q == 0) ? sp : (q == 1) ? cp : (q == 2) ? -sp : -cp;
    const double cc = (q == 0) ? cp : (q == 1) ? -sp : (q == 2) ? -cp : sp;
    s = (float)ss; c = (float)cc;
}
DEV void phase_prologue(const Params& P, LAS unsigned char* lds, int wv) {
    const int tid = opaque_tid(wv), lane = tid & 63, wid = tid >> 6, G = gridDim.x;
    unsigned char* ws = opaque_ws(P.ws);
    {
        LAS float* cact = (LAS float*)lds; LAS float* red = cact + 8192;
        const float* cin = (const float*)P.in[1]; const float* wada = (const float*)P.in[3]; const float* bada = (const float*)P.in[4];
        float* mod = (float*)(ws + WS_MOD);
        for (int unit = blockIdx.x; unit < 192; unit += G) {
            const int layer = unit / 96, col0 = (unit % 96) * 64;
            __syncthreads();
            for (int i = tid; i < 8192; i += NTHREADS) { const float c = cin[i]; cact[i] = c / (1.f + expf(-c)); }
            __syncthreads();
            const int cs = tid & 63, ks = tid >> 6;
            float acc[8];
#pragma unroll
            for (int b = 0; b < 8; ++b) acc[b] = 0.f;
            const float* W = wada + (size_t)layer * 1024 * 6144 + col0 + cs;
#pragma unroll 4
            for (int k = ks * 128; k < ks * 128 + 128; ++k) { const float w = W[(size_t)k * 6144];
#pragma unroll
                for (int b = 0; b < 8; ++b) acc[b] += cact[b * 1024 + k] * w; }
#pragma unroll
            for (int b = 0; b < 8; ++b) red[(ks * 8 + b) * 64 + cs] = acc[b];
            __syncthreads();
            { const int b = tid >> 6; float s = bada[layer * 6144 + col0 + cs];
#pragma unroll
              for (int k2 = 0; k2 < 8; ++k2) s += red[(k2 * 8 + b) * 64 + cs];
              mod[(size_t)(layer * 8 + b) * 6144 + col0 + cs] = s; }
        }
        __syncthreads();
    }
    const int gt = blockIdx.x * NTHREADS + tid, NGT = G * NTHREADS;
    {
        const int* pos = (const int*)P.in[2]; float* rope = (float*)(ws + WS_ROPE);
        for (int i = gt; i < NTOK * 32; i += NGT) { const int f = i & 31, t = i >> 5;
            const double invf = exp2(-(double)f * (13.287712379549449 / 32.0));
            float s, c; sincos_d((double)pos[t] * invf, s, c); rope[2 * (size_t)i] = c; rope[2 * (size_t)i + 1] = s; }
    }
    {
        const float* sw = (const float*)P.in[18]; bf16_t* o = (bf16_t*)(ws + WS_SGUW);
        for (int i = gt; i < 4 * 128 * 128; i += NGT) { const int j = i & 127, r = (i >> 7) & 127; o[i] = f2bf(j <= r ? sw[i] : 0.f); }
    }
    {
        const float* win = (const float*)P.in[5]; const float* wg = (const float*)P.in[6]; bf16_t* wt = (bf16_t*)(ws + WS_WIN0) + (size_t)3072 * 1024;
        for (int i = gt; i < 256 * 1024; i += NGT) { const int k = i & 1023, j = i >> 10; float s = 0.f;
#pragma unroll
            for (int r = 0; r < 16; ++r) s += win[(size_t)k * 3088 + 1024 + r] * wg[r * 256 + j];
            wt[(size_t)j * 1024 + k] = f2bf(s); }
    }
    {
        LAS float* scr = (LAS float*)(lds + wid * 16384);
        const int gw = blockIdx.x * NWAVES + wid, NGW = G * NWAVES;
        constexpr int I_IN0 = 16 * 96, I_OUT = 16 * 32, I_IN1 = 16 * 80, I_W1 = 64 * 16 * 64, I_W2 = 64 * 16 * 32;
        constexpr int NITEMS = I_IN0 + I_OUT + I_IN1 + I_OUT + I_W1 + I_W2;
        for (int it = gw; it < NITEMS; it += NGW) {
            int r = it;
            if (r < I_IN0) { const int kb = r / 96, g = r % 96; conv_item((const float*)P.in[5], 3088, in0_logcol(g), kb * 64, (bf16_t*)(ws + WS_WIN0) + (size_t)g * 32 * 1024, 1024, scr, lane); continue; } r -= I_IN0;
            if (r < I_OUT) { const int kb = r / 32, g = r % 32; conv_item((const float*)P.in[14], 1024, g * 32, kb * 64, (bf16_t*)(ws + WS_WOUT0) + (size_t)g * 32 * 1024, 1024, scr, lane); continue; } r -= I_OUT;
            if (r < I_IN1) { const int kb = r / 80, g = r % 80; conv_item((const float*)P.in[15], 2560, in1_logcol(g), kb * 64, (bf16_t*)(ws + WS_WIN1) + (size_t)g * 32 * 1024, 1024, scr, lane); continue; } r -= I_IN1;
            if (r < I_OUT) { const int kb = r / 32, g = r % 32; conv_item((const float*)P.in[20], 1024, g * 32, kb * 64, (bf16_t*)(ws + WS_WOUT1) + (size_t)g * 32 * 1024, 1024, scr, lane); continue; } r -= I_OUT;
            if (r < I_W1) { const int le = r / 1024, q = r % 1024, kb = q / 64, g = q % 64, pn = g >> 3, qq = g & 7;
                const int logcol = (qq >> 2) * 1024 + 128 * pn + 32 * (qq & 3);
                conv_item((const float*)P.in[23] + (size_t)le * 1024 * 2048, 2048, logcol, kb * 64, (bf16_t*)(ws + WS_W1) + ((size_t)le * 2048 + g * 32) * 1024, 1024, scr, lane); continue; } r -= I_W1;
            { const int le = r / 512, q = r % 512, kb = q / 32, g = q % 32;
              conv_item((const float*)P.in[25] + (size_t)le * 1024 * 1024, 1024, g * 32, kb * 64, (bf16_t*)(ws + WS_W2) + ((size_t)le * 1024 + g * 32) * 1024, 1024, scr, lane); }
        }
    }
}

template <int MODE>
DEV void phase_prenorm(const Params& P, LAS unsigned char* lds, int wv, const float* xin, float* xout, int layer_mod, int modoff  , int layer_prev) {
    const int tid = opaque_tid(wv), lane = tid & 63, wid = tid >> 6, G = gridDim.x;
    unsigned char* ws = opaque_ws(P.ws);
    const float* mod = (const float*)(ws + WS_MOD);
    bf16_t* H = (bf16_t*)(ws + WS_H);
    const bf16_t* YB = (const bf16_t*)(ws + WS_YB);
    LAS float* hrow = (LAS float*)(lds) + wid * 1024;
    for (int row = blockIdx.x * NWAVES + wid; row < NTOK; row += G * NWAVES) {
        const int b = row >> 11;
        const f32x4* xr = (const f32x4*)(xin + (size_t)row * DM) + lane;
        f32x4 v[4];
#pragma unroll
        for (int j = 0; j < 4; ++j) v[j] = xr[64 * j];
        if (MODE & 1) {
            const float* g2 = mod + (size_t)(layer_prev * 8 + b) * 6144 + 5 * 1024;
            f32x4 macc[4];
#pragma unroll
            for (int j = 0; j < 4; ++j) macc[j] = (f32x4){0.f, 0.f, 0.f, 0.f};
#pragma unroll
            for (int k = 0; k < 4; ++k) { const float g = 1.0f;   const u32x2* yr = (const u32x2*)(YB + ((size_t)row * 4 + k) * 1024) + lane;
#pragma unroll
                for (int j = 0; j < 4; ++j) { const u32x2 w = yr[64 * j];
                    macc[j][0] += g * __uint_as_float(w.x << 16); macc[j][1] += g * __uint_as_float(w.x & 0xffff0000u);
                    macc[j][2] += g * __uint_as_float(w.y << 16); macc[j][3] += g * __uint_as_float(w.y & 0xffff0000u); } }
#pragma unroll
            for (int j = 0; j < 4; ++j) { const f32x4 gg = *((const f32x4*)g2 + lane + 64 * j); if (!((DBG_SKIP >> (1 + 2 * layer_prev)) & 1)) v[j] = v[j] + gg * macc[j] * (layer_prev ? DBG_F_MOE1 : DBG_F_MOE0); }
        }
        if (MODE & 2) { f32x4* xo = (f32x4*)(xout + (size_t)row * DM) + lane;
#pragma unroll
            for (int j = 0; j < 4; ++j) xo[64 * j] = v[j]; }
        float ss = 0.f;
#pragma unroll
        for (int j = 0; j < 4; ++j) ss += (v[j][0] * v[j][0] + v[j][1] * v[j][1]) + (v[j][2] * v[j][2] + v[j][3] * v[j][3]);
        const float rstd = 1.0f / sqrtf(wave_sum(ss) * (1.f / DM) + EPS);
        if (MODE & 8) {
            const float* fg = (const float*)P.in[27]; f32x4* o = (f32x4*)(P.out + (size_t)row * DM) + lane;
#pragma unroll
            for (int j = 0; j < 4; ++j) { const f32x4 g = *((const f32x4*)fg + lane + 64 * j);
#ifdef DBG_PROBE_OFF
                const float ps = ((const float*)(ws + WS_CTL))[1024] / ((float)NTOK * DBG_PROBE_NCOLS); const float pv = (DBG_PROBE_ABS ? ps : sqrtf(ps)) * DBG_PROBE_SCALE;
                const float alpha = 1.5f + 1.5f * fminf(fmaxf(pv, 0.f), 1.f);
                o[64 * j] = v[j] * rstd * g * alpha;
#else
                o[64 * j] = v[j] * rstd * g;
#endif
            }
            continue;
        }
        const float* mrow = mod + (size_t)(layer_mod * 8 + b) * 6144 + modoff;
#pragma unroll
        for (int j = 0; j < 4; ++j) { const f32x4 sh = *((const f32x4*)mrow + lane + 64 * j), sc = *((const f32x4*)(mrow + 1024) + lane + 64 * j);
            v[j] = v[j] * rstd * (sc + 1.0f) + sh; }
        { u32x2* ho = (u32x2*)(H + (size_t)row * DM) + lane;
#pragma unroll
          for (int j = 0; j < 4; ++j) { u32x2 w; w.x = pk2(v[j][0], v[j][1]); w.y = pk2(v[j][2], v[j][3]); ho[64 * j] = w; } }
        if (MODE & 4) {
            const float* rw = (const float*)P.in[21] + (size_t)layer_mod * 1024 * 32; const float* rb = (const float*)P.in[22] + layer_mod * 32;
            int* cnt = (int*)(ws + WS_CTL) + CW_CNT + layer_mod * 64; int* ent = (int*)(ws + WS_ENT) + (size_t)layer_mod * NEXP * ENT_CAP;
            float* gates = (float*)(ws + WS_GATES) + (size_t)layer_mod * 65536;
#pragma unroll
            for (int j = 0; j < 4; ++j) *((LAS f32x4*)hrow + lane + 64 * j) = v[j];
            asm volatile("s_waitcnt lgkmcnt(0)" ::: "memory");
            const int e = lane & 31, half = lane >> 5;
            float a0 = 0.f, a1 = 0.f;
            const float* wp = rw + (size_t)(half * 512) * 32 + e; const LAS float* hp = hrow + half * 512;
#pragma unroll 8
            for (int k = 0; k < 512; k += 2) { a0 += hp[k] * wp[(size_t)k * 32]; a1 += hp[k + 1] * wp[(size_t)(k + 1) * 32]; }
            float lg = a0 + a1; lg += __shfl_xor(lg, 32); lg += rb[e];
            asm volatile("s_waitcnt lgkmcnt(0)" ::: "memory");
            float tv[4]; int ti[4]; float cur = lg;
#pragma unroll
            for (int r = 0; r < 4; ++r) {
                float mx = cur;
#pragma unroll
                for (int o = 1; o < 32; o <<= 1) mx = fmaxf(mx, __shfl_xor(mx, o));
                const unsigned long long bal = __ballot(cur == mx) & 0xffffffffull;
                const int sel = __builtin_ctzll(bal);
                tv[r] = mx; ti[r] = sel; if (e == sel) cur = -INFINITY;
            }
            const float e1 = __expf(tv[1] - tv[0]), e2 = __expf(tv[2] - tv[0]), e3 = __expf(tv[3] - tv[0]);
            const float inv = 1.f / (1.f + e1 + e2 + e3);
            if (lane < 4) { const int ex = lane == 0 ? ti[0] : lane == 1 ? ti[1] : lane == 2 ? ti[2] : ti[3];
                const float gv = (lane == 0 ? 1.f : lane == 1 ? e1 : lane == 2 ? e2 : e3) * inv;
                const int pos = atomicAdd(cnt + ex, 1); ent[ex * ENT_CAP + pos] = row * 4 + lane; gates[(size_t)row * 4 + lane] = gv; }
        }
    }
}

DEV void attn_unit_ref(int b, int vh, int qb, const bf16_t* Z, bf16_t* OP, int wv) {
    const int tid = opaque_tid(wv);
    if (tid >= 256) return;
    const int h = vh >> 2, m = (vh >> 1) & 1, vhalf = vh & 1;
    const size_t rowbase = (size_t)b * SEQ;
    const int i = qb * 256 + tid;
    const bf16_t* Qr = Z + (rowbase + i) * Z0P + 1536 + h * 128 + m * 64;
    const bf16_t* Kb = Z + rowbase * Z0P + 2048 + h * 128 + m * 64;
    const bf16_t* Vb = Z + rowbase * Z0P + 2560 + h * 128 + vhalf * 64;
    float q[64], o[64];
#pragma unroll
    for (int d0 = 0; d0 < 8; ++d0) { float t[8]; unpack8(*(const bf16x8*)(Qr + d0 * 8), t);
#pragma unroll
        for (int j = 0; j < 8; ++j) { q[d0 * 8 + j] = t[j]; o[d0 * 8 + j] = 0.f; } }
    float mx = -INFINITY, l = 0.f;
    const int jend = qb * 256 + 255;
    for (int j = 0; j <= jend; ++j) {
        const bf16_t* kr = Kb + (size_t)j * Z0P; const bf16_t* vr = Vb + (size_t)j * Z0P;
        float s = 0.f;
#pragma unroll
        for (int d0 = 0; d0 < 8; ++d0) { float t[8]; unpack8(*(const bf16x8*)(kr + d0 * 8), t);
#pragma unroll
            for (int jj = 0; jj < 8; ++jj) s += q[d0 * 8 + jj] * t[jj]; }
        if (j > i) s = -INFINITY;
        if (s > mx) { const float al = __builtin_amdgcn_exp2f(mx - s); l *= al;
#pragma unroll
            for (int e = 0; e < 64; ++e) o[e] *= al;
            mx = s; }
        const float p = __builtin_amdgcn_exp2f(s - mx); l += p;
#pragma unroll
        for (int d0 = 0; d0 < 8; ++d0) { float t[8]; unpack8(*(const bf16x8*)(vr + d0 * 8), t);
#pragma unroll
            for (int jj = 0; jj < 8; ++jj) o[d0 * 8 + jj] += p * t[jj]; }
    }
    const float il = 1.f / l;
    bf16_t* Or = OP + (rowbase + i) * 1024 + vh * 64;
#pragma unroll
    for (int d0 = 0; d0 < 8; ++d0) { u32x4 w; w.x = pk2(o[d0 * 8] * il, o[d0 * 8 + 1] * il); w.y = pk2(o[d0 * 8 + 2] * il, o[d0 * 8 + 3] * il);
        w.z = pk2(o[d0 * 8 + 4] * il, o[d0 * 8 + 5] * il); w.w = pk2(o[d0 * 8 + 6] * il, o[d0 * 8 + 7] * il); *(u32x4*)(Or + d0 * 8) = w; }
}

struct LinAttnArgs {
    const bf16_t* q; const bf16_t* k; const bf16_t* v; const bf16_t* og;
    int zp; const float* la;
    float log_g;
    const float* gain;
    bf16_t* out;
};
template <int C>
DEV void linattn_unit_ref(const LinAttnArgs& a, LAS unsigned char* lds, int wv) {
    const int tid = opaque_tid(wv), lane = tid & 63, wid = tid >> 6;
    LAS bf16_t* qd = (LAS bf16_t*)lds;
    LAS bf16_t* ka = qd + C * 64;
    LAS bf16_t* vv = ka + C * 64;
    LAS float* bsc = (LAS float*)(vv + C * 128);
    LAS bf16_t* Sm = (LAS bf16_t*)bsc;
    LAS float* st = bsc + C * 64;
    LAS float* dec = st + 64 * 128;
    __syncthreads();
    for (int i = tid; i < 64 * 128; i += NTHREADS) st[i] = 0.f;
    for (int n = 0; n < SEQ / C; ++n) {
        const size_t r0 = (size_t)n * C;
        __syncthreads();
        for (int i = tid; i < C * 64; i += NTHREADS) { const int r = i >> 6, d = i & 63; bsc[i] = a.la ? a.la[(r0 + r) * 256 + d] : a.log_g; }
        for (int i = tid; i < C * 16; i += NTHREADS) { const int r = i >> 4, c8 = i & 15; *(LAS u32x4*)(vv + r * 128 + c8 * 8) = *(const u32x4*)(a.v + (r0 + r) * a.zp + c8 * 8); }
        __syncthreads();
        if (tid < 64) { float run = 0.f; for (int r = 0; r < C; ++r) { run += bsc[r * 64 + tid]; bsc[r * 64 + tid] = run; } dec[tid] = __expf(run); }
        __syncthreads();
        for (int i = tid; i < C * 64; i += NTHREADS) { const int r = i >> 6, d = i & 63; const float bb = bsc[i];
            qd[i] = f2bf(bf2f(a.q[(r0 + r) * a.zp + d]) * __expf(bb)); ka[i] = f2bf(bf2f(a.k[(r0 + r) * a.zp + d]) * __expf(-bb)); }
        __syncthreads();
        for (int i = tid; i < C * C; i += NTHREADS) { const int r = i / C, j = i % C; float s = 0.f;
            if (j <= r) { for (int d = 0; d < 64; ++d) s += bf2f(qd[r * 64 + d]) * bf2f(ka[j * 64 + d]); }
            Sm[i] = f2bf(s); }
        __syncthreads();
        for (int r = wid; r < C; r += NWAVES) {
            float o0 = 0.f, o1 = 0.f;
            for (int j = 0; j <= r; ++j) { const float s = bf2f(Sm[r * C + j]); o0 += s * bf2f(vv[j * 128 + lane]); o1 += s * bf2f(vv[j * 128 + 64 + lane]); }
            for (int d = 0; d < 64; ++d) { const float qv = bf2f(qd[r * 64 + d]); o0 += qv * st[d * 128 + lane]; o1 += qv * st[d * 128 + 64 + lane]; }
            const float rstd = 1.0f / sqrtf(wave_sum(o0 * o0 + o1 * o1) * (1.f / 128.f) + EPS);
            const float g0 = a.gain ? a.gain[lane] : 1.f, g1 = a.gain ? a.gain[lane + 64] : 1.f;
            const bf16_t* ogr = a.og + (r0 + r) * a.zp; bf16_t* orow = a.out + (r0 + r) * 1024;
            orow[lane] = f2bf(o0 * rstd * g0 * bf2f(ogr[lane])); orow[lane + 64] = f2bf(o1 * rstd * g1 * bf2f(ogr[lane + 64]));
        }
        __syncthreads();
        { const int e = tid & 127, dg = tid >> 7;
          for (int d = dg; d < 64; d += 4) { float s = st[d * 128 + e]; for (int j = 0; j < C; ++j) s += bf2f(ka[j * 64 + d]) * bf2f(vv[j * 128 + e]); st[d * 128 + e] = dec[d] * s; } }
    }
    __syncthreads();
}

DEV void sgu_unit_ref(const Params& P, int b, int ch, LAS unsigned char* lds, int wv) {
    const int tid = opaque_tid(wv), lane = tid & 63, wid = tid >> 6;
    unsigned char* ws = opaque_ws(P.ws); const bf16_t* Z = (const bf16_t*)(ws + WS_Z); bf16_t* CAT = (bf16_t*)(ws + WS_CAT);
    const float* lng = (const float*)P.in[16]; const float* lnb = (const float*)P.in[17]; const float* sw = (const float*)P.in[18]; const float* sb = (const float*)P.in[19];
    LAS float* svn = (LAS float*)lds;
    LAS float* stat = svn + 128 * 128;
    const size_t r0 = (size_t)b * SEQ + (size_t)ch * 128;
    __syncthreads();
    for (int r = wid; r < 128; r += NWAVES) {
        const bf16_t* zr = Z + (r0 + r) * Z1P + 512; float x[8]; unpack8(*(const bf16x8*)(zr + lane * 8), x);
        float s = 0.f;
#pragma unroll
        for (int j = 0; j < 8; ++j) s += x[j];
        const float mean = wave_sum(s) * (1.f / 512.f); float q = 0.f;
#pragma unroll
        for (int j = 0; j < 8; ++j) { const float d = x[j] - mean; q += d * d; }
        const float rstd = 1.0f / sqrtf(wave_sum(q) * (1.f / 512.f) + EPS);
        if (lane == 0) { stat[2 * r] = mean; stat[2 * r + 1] = rstd; }
    }
    __syncthreads();
    for (int g = 0; g < 4; ++g) {
        for (int i = tid; i < 128 * 128; i += NTHREADS) { const int r = i >> 7, c = i & 127;
            svn[i] = (bf2f(Z[(r0 + r) * Z1P + 512 + g * 128 + c]) - stat[2 * r]) * stat[2 * r + 1] * lng[g * 128 + c] + lnb[g * 128 + c]; }
        __syncthreads();
        { const int c = tid & 127, ig = tid >> 7;
          for (int r = ig; r < 128; r += 4) { float s = sb[g * 128 + r]; const float* wrow = sw + ((size_t)g * 128 + r) * 128;
              for (int j = 0; j <= r; ++j) s += wrow[j] * svn[j * 128 + c];
              CAT[(r0 + r) * 1024 + g * 128 + c] = f2bf(bf2f(Z[(r0 + r) * Z1P + g * 128 + c]) * s); } }
        __syncthreads();
    }
}


typedef float f32x16 __attribute__((ext_vector_type(16)));
DEV f32x16 mfma32(bf16x8 a, bf16x8 b, f32x16 c) { return __builtin_amdgcn_mfma_f32_32x32x16_bf16(a, b, c, 0, 0, 0); }
DEV bf16x8 ldfrag(const LAS bf16_t* base, int stride, int row, int k) { return *(const LAS bf16x8*)(base + row * stride + k); }

template <int C>
DEV void linattn_unit_fast(const LinAttnArgs& a, LAS unsigned char* lds, int wv) {
    constexpr int SEG = C / 8, KS = 72, CS = C + 8, NIB = C / 32;
    const int tid = opaque_tid(wv), lane = tid & 63, w = wv, r = lane & 31, h = lane >> 5;
    LAS bf16_t* Qd = (LAS bf16_t*)lds;
    LAS bf16_t* Ka = Qd + C * KS;
    LAS bf16_t* Kat = Ka + C * KS;
    LAS bf16_t* Vt = Kat + 64 * CS;
    LAS bf16_t* Stt = Vt + 128 * CS;
    LAS bf16_t* Sm = Stt + 128 * KS;
    LAS float* dec = (LAS float*)(Sm + C * CS);
    LAS float* tot = dec + 64;
    LAS float* rsq = tot + 512;
    const int db = w >> 2, eb = w & 3, i0 = w * SEG;
    f32x16 st;
#pragma unroll
    for (int t = 0; t < 16; ++t) st[t] = 0.f;
    __syncthreads();
    for (int n = 0; n < SEQ / C; ++n) {
        const size_t r0 = (size_t)n * C;
        float p[SEG]; float run = 0.f;
#pragma unroll
        for (int ii = 0; ii < SEG; ++ii) { const float v = a.la ? a.la[(r0 + i0 + ii) * 256 + lane] : a.log_g; run += v; p[ii] = run; }
        tot[w * 64 + lane] = run;
        bf16_t qv[SEG], kv[SEG];
#pragma unroll
        for (int ii = 0; ii < SEG; ++ii) { qv[ii] = a.q[(r0 + i0 + ii) * a.zp + lane]; kv[ii] = a.k[(r0 + i0 + ii) * a.zp + lane]; }
        bf16_t vv[C / 32][8];
#pragma unroll
        for (int it = 0; it < C / 32; ++it) { const int item = tid + 512 * it, e = item & 127, jg = item >> 7;
#pragma unroll
            for (int jj = 0; jj < 8; ++jj) vv[it][jj] = a.v[(r0 + 8 * jg + jj) * a.zp + e]; }
        __syncthreads();
        float off = 0.f;
#pragma unroll
        for (int w2 = 0; w2 < 7; ++w2) { const float t2 = tot[w2 * 64 + lane]; off += (w2 < w) ? t2 : 0.f; }
        unsigned kp[SEG / 2];
#pragma unroll
        for (int ii = 0; ii < SEG; ii += 2) {
            const float b0 = p[ii] + off, b1 = p[ii + 1] + off;
            const unsigned qd2 = pk2(bf2f(qv[ii]) * __expf(b0), bf2f(qv[ii + 1]) * __expf(b1));
            const unsigned ka2 = pk2(bf2f(kv[ii]) * __expf(-b0), bf2f(kv[ii + 1]) * __expf(-b1));
            Qd[(i0 + ii) * KS + lane] = (bf16_t)(qd2 & 0xffffu); Qd[(i0 + ii + 1) * KS + lane] = (bf16_t)(qd2 >> 16);
            Ka[(i0 + ii) * KS + lane] = (bf16_t)(ka2 & 0xffffu); Ka[(i0 + ii + 1) * KS + lane] = (bf16_t)(ka2 >> 16);
            kp[ii / 2] = ka2;
        }
#pragma unroll
        for (int q4 = 0; q4 < SEG / 8; ++q4) { u32x4 wv4; wv4.x = kp[4 * q4]; wv4.y = kp[4 * q4 + 1]; wv4.z = kp[4 * q4 + 2]; wv4.w = kp[4 * q4 + 3]; *(LAS u32x4*)(Kat + lane * CS + i0 + 8 * q4) = wv4; }
        if (w == 7) dec[lane] = __expf(p[SEG - 1] + off);
#pragma unroll
        for (int it = 0; it < C / 32; ++it) { const int item = tid + 512 * it, e = item & 127, jg = item >> 7;
            u32x4 wv4; wv4.x = (unsigned)vv[it][0] | ((unsigned)vv[it][1] << 16); wv4.y = (unsigned)vv[it][2] | ((unsigned)vv[it][3] << 16);
            wv4.z = (unsigned)vv[it][4] | ((unsigned)vv[it][5] << 16); wv4.w = (unsigned)vv[it][6] | ((unsigned)vv[it][7] << 16);
            *(LAS u32x4*)(Vt + e * CS + 8 * jg) = wv4; }
#pragma unroll
        for (int g = 0; g < 4; ++g) { u32x2 w2; w2.x = pk2(st[4 * g], st[4 * g + 1]); w2.y = pk2(st[4 * g + 2], st[4 * g + 3]);
            *(LAS u32x2*)(Stt + (32 * eb + r) * KS + 32 * db + 8 * g + 4 * h) = w2; }
        __syncthreads();
        for (int bp = w; bp < NIB * (NIB + 1) / 2; bp += 8) {
            int ib = 0; while ((ib + 1) * (ib + 2) / 2 <= bp) ++ib;
            const int jb = bp - ib * (ib + 1) / 2;
            f32x16 acc;
#pragma unroll
            for (int t = 0; t < 16; ++t) acc[t] = 0.f;
#pragma unroll
            for (int s2 = 0; s2 < 4; ++s2) acc = mfma32(ldfrag(Ka, KS, 32 * jb + r, 16 * s2 + 8 * h), ldfrag(Qd, KS, 32 * ib + r, 16 * s2 + 8 * h), acc);
            const int i = 32 * ib + r;
#pragma unroll
            for (int g = 0; g < 4; ++g) { const int j0 = 32 * jb + 8 * g + 4 * h; float v0 = acc[4 * g], v1 = acc[4 * g + 1], v2 = acc[4 * g + 2], v3 = acc[4 * g + 3];
                if (j0 > i) v0 = 0.f; if (j0 + 1 > i) v1 = 0.f; if (j0 + 2 > i) v2 = 0.f; if (j0 + 3 > i) v3 = 0.f;
                u32x2 w2; w2.x = pk2(v0, v1); w2.y = pk2(v2, v3); *(LAS u32x2*)(Sm + i * CS + j0) = w2; }
        }
        {
            f32x16 acc = st;
#pragma unroll
            for (int s2 = 0; s2 < C / 16; ++s2) acc = mfma32(ldfrag(Kat, CS, 32 * db + r, 16 * s2 + 8 * h), ldfrag(Vt, CS, 32 * eb + r, 16 * s2 + 8 * h), acc);
#pragma unroll
            for (int g = 0; g < 4; ++g) { const f32x4 dv = *(const LAS f32x4*)(dec + 32 * db + 8 * g + 4 * h);
#pragma unroll
                for (int t = 0; t < 4; ++t) st[4 * g + t] = acc[4 * g + t] * dv[t]; }
        }
        __syncthreads();
        f32x16 o[NIB / 2];
#pragma unroll
        for (int q = 0; q < NIB / 2; ++q) {
            const int blk = w + 8 * q, ib = blk >> 2, e2 = blk & 3;
            f32x16 acc;
#pragma unroll
            for (int t = 0; t < 16; ++t) acc[t] = 0.f;
            for (int s2 = 0; s2 < 2 * (ib + 1); ++s2) acc = mfma32(ldfrag(Vt, CS, 32 * e2 + r, 16 * s2 + 8 * h), ldfrag(Sm, CS, 32 * ib + r, 16 * s2 + 8 * h), acc);
#pragma unroll
            for (int s2 = 0; s2 < 4; ++s2) acc = mfma32(ldfrag(Stt, KS, 32 * e2 + r, 16 * s2 + 8 * h), ldfrag(Qd, KS, 32 * ib + r, 16 * s2 + 8 * h), acc);
            o[q] = acc;
            float ss = 0.f;
#pragma unroll
            for (int t = 0; t < 16; ++t) ss += acc[t] * acc[t];
            ss += __shfl_xor(ss, 32);
            if (h == 0) rsq[(32 * ib + r) * 4 + e2] = ss;
        }
        __syncthreads();
#pragma unroll
        for (int q = 0; q < NIB / 2; ++q) {
            const int blk = w + 8 * q, ib = blk >> 2, e2 = blk & 3, i = 32 * ib + r;
            const f32x4 rs = *(const LAS f32x4*)(rsq + i * 4);
            const float rstd = 1.0f / sqrtf(((rs[0] + rs[1]) + (rs[2] + rs[3])) * (1.f / 128.f) + EPS);
#pragma unroll
            for (int g = 0; g < 4; ++g) { const int e0 = 32 * e2 + 8 * g + 4 * h;
                f32x4 gn = {1.f, 1.f, 1.f, 1.f}; if (a.gain) gn = *(const f32x4*)(a.gain + e0);
                const u32x2 og = *(const u32x2*)(a.og + (r0 + i) * a.zp + e0);
                const float g0 = __uint_as_float(og.x << 16), g1 = __uint_as_float(og.x & 0xffff0000u), g2 = __uint_as_float(og.y << 16), g3 = __uint_as_float(og.y & 0xffff0000u);
                u32x2 w2; w2.x = pk2(o[q][4 * g] * rstd * gn[0] * g0, o[q][4 * g + 1] * rstd * gn[1] * g1); w2.y = pk2(o[q][4 * g + 2] * rstd * gn[2] * g2, o[q][4 * g + 3] * rstd * gn[3] * g3);
                *(u32x2*)(a.out + (r0 + i) * 1024 + e0) = w2; }
        }
    }
    __syncthreads();
}

DEV void sgu_unit_fast(const Params& P, int b, int ch, LAS unsigned char* lds, int wv) {
    constexpr int CS = 136;
    const int tid = opaque_tid(wv), lane = tid & 63, w = wv, r = lane & 31, h = lane >> 5;
    unsigned char* ws = opaque_ws(P.ws); const bf16_t* Z = (const bf16_t*)(ws + WS_Z); bf16_t* CAT = (bf16_t*)(ws + WS_CAT); const bf16_t* SW = (const bf16_t*)(ws + WS_SGUW);
    const float* lng = (const float*)P.in[16]; const float* lnb = (const float*)P.in[17]; const float* sb = (const float*)P.in[19];
    LAS bf16_t* Wg = (LAS bf16_t*)lds;
    LAS bf16_t* Sv = Wg + 128 * CS;
    LAS float* stat = (LAS float*)(Sv + 128 * CS);
    const size_t r0 = (size_t)b * SEQ + (size_t)ch * 128;
    __syncthreads();
    for (int rr = w; rr < 128; rr += NWAVES) {
        const bf16_t* zr = Z + (r0 + rr) * Z1P + 512; float x[8]; unpack8(*(const bf16x8*)(zr + lane * 8), x);
        float s = 0.f;
#pragma unroll
        for (int j = 0; j < 8; ++j) s += x[j];
        const float mean = wave_sum(s) * (1.f / 512.f); float q = 0.f;
#pragma unroll
        for (int j = 0; j < 8; ++j) { const float d = x[j] - mean; q += d * d; }
        const float rstd = 1.0f / sqrtf(wave_sum(q) * (1.f / 512.f) + EPS);
        if (lane == 0) { stat[2 * rr] = mean; stat[2 * rr + 1] = rstd; }
    }
    __syncthreads();
    for (int g = 0; g < 4; ++g) {
#pragma unroll
        for (int it = 0; it < 4; ++it) { const int pc = tid + 512 * it, i = pc >> 4, c8 = pc & 15;
            *(LAS u32x4*)(Wg + i * CS + c8 * 8) = *(const u32x4*)(SW + ((size_t)g * 128 + i) * 128 + c8 * 8); }
#pragma unroll
        for (int it = 0; it < 4; ++it) { const int item = tid + 512 * it, c = item & 127, jg = item >> 7;
            const float gg = lng[g * 128 + c], bb = lnb[g * 128 + c]; float v[8];
#pragma unroll
            for (int jj = 0; jj < 8; ++jj) { const int j = 8 * jg + jj; v[jj] = (bf2f(Z[(r0 + j) * Z1P + 512 + g * 128 + c]) - stat[2 * j]) * stat[2 * j + 1] * gg + bb; }
            u32x4 w4; w4.x = pk2(v[0], v[1]); w4.y = pk2(v[2], v[3]); w4.z = pk2(v[4], v[5]); w4.w = pk2(v[6], v[7]);
            *(LAS u32x4*)(Sv + c * CS + 8 * jg) = w4; }
        __syncthreads();
#pragma unroll
        for (int q = 0; q < 2; ++q) {
            const int blk = w + 8 * q, ib = blk >> 2, cb = blk & 3, i = 32 * ib + r;
            f32x16 acc;
#pragma unroll
            for (int t = 0; t < 16; ++t) acc[t] = 0.f;
            for (int s2 = 0; s2 < 2 * (ib + 1); ++s2) acc = mfma32(ldfrag(Sv, CS, 32 * cb + r, 16 * s2 + 8 * h), ldfrag(Wg, CS, i, 16 * s2 + 8 * h), acc);
            const float bs = sb[g * 128 + i];
#pragma unroll
            for (int gq = 0; gq < 4; ++gq) { const int c0 = g * 128 + 32 * cb + 8 * gq + 4 * h;
                const u32x2 su = *(const u32x2*)(Z + (r0 + i) * Z1P + c0);
                const float u0 = __uint_as_float(su.x << 16), u1 = __uint_as_float(su.x & 0xffff0000u), u2 = __uint_as_float(su.y << 16), u3 = __uint_as_float(su.y & 0xffff0000u);
                u32x2 w2; w2.x = pk2(u0 * (acc[4 * gq] + bs), u1 * (acc[4 * gq + 1] + bs)); w2.y = pk2(u2 * (acc[4 * gq + 2] + bs), u3 * (acc[4 * gq + 3] + bs));
                *(u32x2*)(CAT + (r0 + i) * 1024 + c0) = w2; }
        }
        __syncthreads();
    }
}

namespace attn_body {
using bf16=unsigned short;
using s16x4=__attribute__((ext_vector_type(4)))short;
using f32x16=__attribute__((ext_vector_type(16)))float;
constexpr int D=64,ZP=Z0P,OPITCH=1024;
constexpr int NW=8,QBLK=32,QB=QBLK*NW,KVBLK=64;
__device__ __forceinline__ int crow(int r,int hi){return (r&3)+8*(r>>2)+4*hi;}
#define SBAR() __builtin_amdgcn_sched_barrier(0)
__device__ __forceinline__ void cmask(f32x16&p0,f32x16&p1,int jb,int qrel,int hi){
  const float NEG=-INFINITY; int kb=64*jb+4*hi;
  #pragma unroll
  for(int r=0;r<16;++r){int kv=kb+(r&3)+8*(r>>2); if(kv>qrel)p0[r]=NEG; if(kv+32>qrel)p1[r]=NEG;}
}

constexpr int NSLOT=3, SLOTB=8192;
constexpr int LDS_K=0, LDS_V=NSLOT*SLOTB, LDS_WS=2*NSLOT*SLOTB, LDS_OST=LDS_WS+NW*64*4, LDS_BYTES=LDS_OST+NW*4096;
__device__ __forceinline__ void glds16(const void*gsrc,unsigned lds_dst){unsigned keep;
  asm volatile("s_mov_b32 %0, m0\n\ts_mov_b32 m0, %2\n\ts_nop 0\n\tglobal_load_lds_dwordx4 %1, off\n\ts_mov_b32 m0, %0":"=&s"(keep):"v"(gsrc),"s"(lds_dst):"memory");}
__device__ __forceinline__ float max3f(float a,float b,float c){float r;asm("v_max3_f32 %0, %1, %2, %3":"=v"(r):"v"(a),"v"(b),"v"(c));return r;}
__device__ __forceinline__ float max2f(float a,float b){float r;asm("v_max_f32_e32 %0, %1, %2":"=v"(r):"v"(a),"v"(b));return r;}
__device__ __forceinline__ float fadd_s(float a,float b){float r;asm("v_add_f32_e32 %0, %1, %2":"=v"(r):"v"(a),"v"(b));return r;}
__device__ __forceinline__ float fsub_s(float a,float b){float r;asm("v_sub_f32_e32 %0, %1, %2":"=v"(r):"v"(a),"v"(b));return r;}
typedef float f32x2_t __attribute__((ext_vector_type(2))); typedef __bf16 bf16x2_t __attribute__((ext_vector_type(2)));
__device__ __forceinline__ unsigned cvtpk_s(float lo,float hi){f32x2_t v={lo,hi};bf16x2_t b=__builtin_convertvector(v,bf16x2_t);return __builtin_bit_cast(unsigned,b);}
#define WAIT_BAR(N) asm volatile("s_waitcnt vmcnt(" #N ") lgkmcnt(0)\n\ts_barrier":::"memory")

__device__ __forceinline__ void qkt(f32x16&p0,f32x16&p1,const char*Kslot,const bf16x8*qr,const f32x16&negm,int r32,int hi){
  const char*kb=Kslot+hi*1024+r32*16;
  #pragma unroll
  for(int d0=0;d0<4;++d0){
    const bf16x8 b0=*reinterpret_cast<const bf16x8*>(kb+d0*2048);
    const bf16x8 b1=*reinterpret_cast<const bf16x8*>(kb+d0*2048+512);
    if(d0==0){p0=__builtin_amdgcn_mfma_f32_32x32x16_bf16(b0,qr[0],negm,0,0,0);p1=__builtin_amdgcn_mfma_f32_32x32x16_bf16(b1,qr[0],negm,0,0,0);}
    else{p0=__builtin_amdgcn_mfma_f32_32x32x16_bf16(b0,qr[d0],p0,0,0,0);p1=__builtin_amdgcn_mfma_f32_32x32x16_bf16(b1,qr[d0],p1,0,0,0);}}
}
typedef __attribute__((address_space(3))) const char* lds_cptr;
typedef short v4i16_t __attribute__((ext_vector_type(4)));
__device__ __forceinline__ void kload8(bf16x8*kf,lds_cptr kp){
  kf[0]=*(const __attribute__((address_space(3))) bf16x8*)(kp);      kf[1]=*(const __attribute__((address_space(3))) bf16x8*)(kp+512);
  kf[2]=*(const __attribute__((address_space(3))) bf16x8*)(kp+2048); kf[3]=*(const __attribute__((address_space(3))) bf16x8*)(kp+2560);
  kf[4]=*(const __attribute__((address_space(3))) bf16x8*)(kp+4096); kf[5]=*(const __attribute__((address_space(3))) bf16x8*)(kp+4608);
  kf[6]=*(const __attribute__((address_space(3))) bf16x8*)(kp+6144); kf[7]=*(const __attribute__((address_space(3))) bf16x8*)(kp+6656);
}
__device__ __forceinline__ void kload2(bf16x8*kf,lds_cptr kp,int j){ kf[2*j]=*(const __attribute__((address_space(3))) bf16x8*)(kp+j*2048); kf[2*j+1]=*(const __attribute__((address_space(3))) bf16x8*)(kp+j*2048+512); }
__device__ __forceinline__ s16x4 vtr(lds_cptr p){ return __builtin_bit_cast(s16x4,__builtin_amdgcn_ds_read_tr16_b64_v4i16((__attribute__((address_space(3))) v4i16_t*)p)); }
__device__ __forceinline__ float rowmax(const f32x16&p0,const f32x16&p1){
  float a=max3f(p0[0],p0[1],p1[0]),b=max3f(p0[2],p0[3],p1[1]);a=max3f(a,p1[2],p1[3]);
  #pragma unroll
  for(int r=4;r<16;r+=4){a=max3f(a,p0[r],p0[r+1]);b=max3f(b,p0[r+2],p0[r+3]);a=max3f(a,p1[r],p1[r+1]);b=max3f(b,p1[r+2],p1[r+3]);}
  const float m=max2f(a,b);
  auto rr=__builtin_amdgcn_permlane32_swap(__float_as_uint(m),__float_as_uint(m),false,false);
  return max2f(__uint_as_float(rr[0]),__uint_as_float(rr[1]));
}
__device__ __forceinline__ void pv(f32x16*o,int vb,bf16x8 pa0,bf16x8 pa1,bf16x8 pa2,bf16x8 pa3){
  #pragma unroll
  for(int d0=0;d0<2;++d0){s16x4 lo[4],hi[4];
    #pragma unroll
    for(int ks=0;ks<4;++ks){
      asm volatile("ds_read_b64_tr_b16 %0,%1 offset:%c2":"=&v"(lo[ks]):"v"(vb),"i"(d0*4096+ks*1024):"memory");
      asm volatile("ds_read_b64_tr_b16 %0,%1 offset:%c2":"=&v"(hi[ks]):"v"(vb),"i"(d0*4096+ks*1024+512):"memory");}
    asm volatile("s_waitcnt lgkmcnt(0)":::"memory");SBAR();
    #define PK(k) (bf16x8){lo[k][0],lo[k][1],lo[k][2],lo[k][3],hi[k][0],hi[k][1],hi[k][2],hi[k][3]}
    o[d0]=__builtin_amdgcn_mfma_f32_32x32x16_bf16(pa0,PK(0),o[d0],0,0,0);
    o[d0]=__builtin_amdgcn_mfma_f32_32x32x16_bf16(pa1,PK(1),o[d0],0,0,0);
    o[d0]=__builtin_amdgcn_mfma_f32_32x32x16_bf16(pa2,PK(2),o[d0],0,0,0);
    o[d0]=__builtin_amdgcn_mfma_f32_32x32x16_bf16(pa3,PK(3),o[d0],0,0,0);
    #undef PK
  }
}

#ifndef ATTN_STORE16
#define ATTN_STORE16(p,v) (*(u32x4*)(p)=(v))
#endif
template<int THRL> __device__ __forceinline__ void attn_unit(int qb,const bf16*Qb,const bf16*__restrict__ Kb,const bf16*__restrict__ Vb,bf16*Ob,char*shm,int wv){
  const int tid=opaque_tid(wv),lane=tid&63,r32=lane&31,hi=lane>>5; const int wid=wv;
  const int q0=qb*QB;
  const bf16*Qw=Qb+(long)(q0+wid*QBLK)*ZP;
  const bf16*Kh=Kb,*Vh=Vb;
  const unsigned lds0=(unsigned)(uintptr_t)shm;
  float*wsf=(float*)(shm+LDS_WS)+wid*64;
  const bf16*ksrc=Kh+(long)lane*ZP+wid*8;
  const bf16*vsrc=Vh+(long)(16*(wid&3)+(lane>>2))*ZP+(wid>>2)*32+(lane&3)*8;
  const unsigned kdst=lds0+LDS_K+wid*1024, vdst=lds0+LDS_V+wid*1024;
  #define DMA_K(t,slot) glds16(ksrc+(long)(t)*KVBLK*ZP,(unsigned)__builtin_amdgcn_readfirstlane(kdst+(slot)))
  #define DMA_V(t,slot) glds16(vsrc+(long)(t)*KVBLK*ZP,(unsigned)__builtin_amdgcn_readfirstlane(vdst+(slot)))
  const int vb0=(int)(lds0+LDS_V)+((lane>>4)&1)*32+(lane&3)*8+(4*hi+((lane&15)>>2))*64;
  const char*Kbase=shm+LDS_K; bf16x8 kf[8];
  const lds_cptr shm3=(lds_cptr)shm; const lds_cptr kp0=shm3+LDS_K+hi*1024+r32*16; const lds_cptr vp0=shm3+LDS_V+((lane>>4)&1)*32+(lane&3)*8+(4*hi+((lane&15)>>2))*64;
  const int NT=(q0+QB)/KVBLK;
  DMA_K(0,0);DMA_V(0,0);DMA_K(1,SLOTB);
  bf16x8 qr[4];
  #pragma unroll
  for(int d0=0;d0<4;++d0)qr[d0]=*reinterpret_cast<const bf16x8*>(&Qw[(long)r32*ZP+d0*16+hi*8]);
  float mhat=0.f,l_reg=0.f;f32x16 o[2];o[0]=f32x16{};o[1]=f32x16{};f32x16 negm=f32x16{};asm volatile("":"+v"(negm));
  const int qrel=wid*QBLK+r32;
  #define CMASK(P0,P1,t) do{int jb_=(t)-(NT-4); if(jb_>=0)cmask(P0,P1,jb_,qrel,hi);}while(0)
  bool resc=false;
  #define START(P0,P1) do{ const float rm=rowmax(P0,P1); resc=false; \
    { const float dl=rm; mhat=fadd_s(mhat,dl); \
      _Pragma("unroll") for(int r=0;r<16;++r){P0[r]=fsub_s(P0[r],dl);P1[r]=fsub_s(P1[r],dl);} \
      _Pragma("unroll") for(int r=0;r<16;++r)negm[r]=-mhat; asm volatile("":"+v"(negm)); } \
    _Pragma("unroll") for(int r=0;r<16;++r)P0[r]=__builtin_amdgcn_exp2f(P0[r]); }while(0)
  #define RESC() do{ if(resc){ asm volatile("s_waitcnt lgkmcnt(0)":::"memory"); \
      _Pragma("unroll") for(int d_=0;d_<2;++d_) _Pragma("unroll") for(int r=0;r<16;++r)o[d_][r]*=wsf[crow(r,hi)]; } }while(0)
  f32x16 pA0,pA1,pB0,pB1;
  int sl_prev=0,sl_cur=0,sl_next=SLOTB;
  #define ROT() do{sl_prev=sl_cur;sl_cur=sl_next;sl_next=(sl_next==(NSLOT-1)*SLOTB)?0:sl_next+SLOTB;}while(0)
  DMA_K(2,2*SLOTB);
  WAIT_BAR(3);
  qkt(pA0,pA1,Kbase,qr,negm,r32,hi);asm volatile("s_nop 15\n\ts_nop 7":"+v"(pA0),"+v"(pA1));CMASK(pA0,pA1,0);
  START(pA0,pA1);
  _Pragma("unroll") for(int r=0;r<16;++r)pA1[r]=__builtin_amdgcn_exp2f(pA1[r]);
  WAIT_BAR(0);
  DMA_K(3,0);DMA_V(1,SLOTB);
  ROT();
  kload8(kf,kp0+sl_cur);
  WAIT_BAR(2);
  s16x4 vlo[8],vhi[8]; u32x4 pw0,pw1,pw2,pw3;
  #define PKW(P,B) cvtpk_s(P[B],P[B+1])
  #define PAF(k) __builtin_bit_cast(bf16x8,pw##k)
  #define VFR(i) (bf16x8){vlo[i][0],vlo[i][1],vlo[i][2],vlo[i][3],vhi[i][0],vhi[i][1],vhi[i][2],vhi[i][3]}
  #define PIN(x) asm volatile("":"+v"(x))
  #define MX3(a,b,c) __builtin_fmaxf(__builtin_fmaxf((a),(b)),(c))
  #define GAPA(MF,A0,A1,A2,A3,W0,W1,PW) do{ MF; sacc+=A0; sacc+=A1; sacc+=A2; sacc+=A3; PIN(sacc); W0; W1; PIN(PW); SBAR(); }while(0)
  #define EX(v) __builtin_amdgcn_exp2f(v)
  #define GAPB(MF,X,B) do{ MF; X[B]=EX(X[B]); X[B+1]=EX(X[B+1]); X[B+2]=EX(X[B+2]); X[B+3]=EX(X[B+3]); PIN(X); SBAR(); }while(0)
  #define VRD(i) do{ vlo[i]=vtr(vp_+(((i)>>2)*4096+((i)&3)*1024)); vhi[i]=vtr(vp_+(((i)>>2)*4096+((i)&3)*1024+512)); }while(0)
  #define KRD(G,j) do{ if(G){ kload2(kf,kp0+sl_next,j); SBAR(); } }while(0)
  #define STEP(C0,C1,P0,P1,t,GK,GV,GL) do{ SBAR(); \
    const lds_cptr vp_=vp0+sl_prev; \
    VRD(0); SBAR(); float sacc=(P0[0]+P0[1]); \
    GAPA(C0=__builtin_amdgcn_mfma_f32_32x32x16_bf16(kf[0],qr[0],negm,0,0,0), P0[2],P0[3],P0[4],P0[5],     pw0[0]=PKW(P0,0), pw0[1]=PKW(P0,2), pw0); \
    VRD(4); SBAR(); GAPA(C1=__builtin_amdgcn_mfma_f32_32x32x16_bf16(kf[1],qr[0],negm,0,0,0), P0[6],P0[7],P0[8],P0[9],     pw0[2]=PKW(P0,4), pw0[3]=PKW(P0,6), pw0); \
    VRD(1); SBAR(); GAPA(C0=__builtin_amdgcn_mfma_f32_32x32x16_bf16(kf[2],qr[1],C0,0,0,0),   P0[10],P0[11],P0[12],P0[13], pw1[0]=PKW(P0,8), pw1[1]=PKW(P0,10), pw1); \
    VRD(5); SBAR(); GAPA(C1=__builtin_amdgcn_mfma_f32_32x32x16_bf16(kf[3],qr[1],C1,0,0,0),   P0[14],P0[15],P1[0],P1[1],   pw1[2]=PKW(P0,12),pw1[3]=PKW(P0,14), pw1); \
    VRD(2); SBAR(); GAPA(C0=__builtin_amdgcn_mfma_f32_32x32x16_bf16(kf[4],qr[2],C0,0,0,0),   P1[2],P1[3],P1[4],P1[5],     pw2[0]=PKW(P1,0), pw2[1]=PKW(P1,2), pw2); \
    VRD(6); SBAR(); GAPA(C1=__builtin_amdgcn_mfma_f32_32x32x16_bf16(kf[5],qr[2],C1,0,0,0),   P1[6],P1[7],P1[8],P1[9],     pw2[2]=PKW(P1,4), pw2[3]=PKW(P1,6), pw2); \
    VRD(3); SBAR(); GAPA(C0=__builtin_amdgcn_mfma_f32_32x32x16_bf16(kf[6],qr[3],C0,0,0,0),   P1[10],P1[11],P1[12],P1[13], pw3[0]=PKW(P1,8), pw3[1]=PKW(P1,10), pw3); \
    VRD(7); SBAR(); GAPA(C1=__builtin_amdgcn_mfma_f32_32x32x16_bf16(kf[7],qr[3],C1,0,0,0),   P1[14],P1[15],0.f,0.f,       pw3[2]=PKW(P1,12),pw3[3]=PKW(P1,14), pw3); \
    l_reg+=sacc; \
    if(GK){DMA_K((t)+3,sl_cur);} if(GV){DMA_V((t)+1,sl_next);} \
    CMASK(C0,C1,t); \
    { float a=MX3(C0[0],C0[1],C1[0]),b=MX3(C0[2],C0[3],C1[1]); a=MX3(a,C1[2],C1[3]); \
      _Pragma("unroll") for(int r=4;r<16;r+=4){a=MX3(a,C0[r],C0[r+1]);b=MX3(b,C0[r+2],C0[r+3]);a=MX3(a,C1[r],C1[r+1]);b=MX3(b,C1[r+2],C1[r+3]);} \
      float rm=__builtin_fmaxf(a,b); { auto rr=__builtin_amdgcn_permlane32_swap(__float_as_uint(rm),__float_as_uint(rm),false,false); rm=__builtin_fmaxf(__uint_as_float(rr[0]),__uint_as_float(rr[1])); } \
      resc=false; \
      if(__builtin_expect(__any(rm>(float)THRL),0)){ const float dl=__builtin_fmaxf(rm,0.f); mhat+=dl; \
        _Pragma("unroll") for(int r=0;r<16;++r){C0[r]-=dl;C1[r]-=dl;} \
        _Pragma("unroll") for(int r=0;r<16;++r)negm[r]=-mhat; asm volatile("":"+v"(negm)); \
        const float f=__builtin_amdgcn_exp2f(-dl); l_reg*=f; if(hi==0)wsf[r32]=f; resc=true; } } \
    SBAR(); \
    GAPB(o[0]=__builtin_amdgcn_mfma_f32_32x32x16_bf16(PAF(0),VFR(0),o[0],0,0,0), C0,0); \
    GAPB(o[1]=__builtin_amdgcn_mfma_f32_32x32x16_bf16(PAF(0),VFR(4),o[1],0,0,0), C0,4); \
    KRD(GL,0); GAPB(o[0]=__builtin_amdgcn_mfma_f32_32x32x16_bf16(PAF(1),VFR(1),o[0],0,0,0), C0,8); \
    KRD(GL,1); GAPB(o[1]=__builtin_amdgcn_mfma_f32_32x32x16_bf16(PAF(1),VFR(5),o[1],0,0,0), C0,12); \
    KRD(GL,2); GAPB(o[0]=__builtin_amdgcn_mfma_f32_32x32x16_bf16(PAF(2),VFR(2),o[0],0,0,0), C1,0); \
    KRD(GL,3); GAPB(o[1]=__builtin_amdgcn_mfma_f32_32x32x16_bf16(PAF(2),VFR(6),o[1],0,0,0), C1,4); \
    GAPB(o[0]=__builtin_amdgcn_mfma_f32_32x32x16_bf16(PAF(3),VFR(3),o[0],0,0,0), C1,8); \
    GAPB(o[1]=__builtin_amdgcn_mfma_f32_32x32x16_bf16(PAF(3),VFR(7),o[1],0,0,0), C1,12); \
    }while(0)
  int t=1;
  #undef CMASK
  #define CMASK(P0,P1,t) do{}while(0)
  for(;t+5<NT;t+=2){
    STEP(pB0,pB1,pA0,pA1,t,true,true,true);     WAIT_BAR(2); RESC(); ROT();
    STEP(pA0,pA1,pB0,pB1,t+1,true,true,true);   WAIT_BAR(2); RESC(); ROT();
  }
  #undef CMASK
  #define CMASK(P0,P1,t) do{int jb_=(t)-(NT-4); if(jb_>=0)cmask(P0,P1,jb_,qrel,hi);}while(0)
  #define ENDW(tt) do{ if((tt)+3<NT){WAIT_BAR(2);} else if((tt)+2<NT){WAIT_BAR(1);} else {WAIT_BAR(0);} }while(0)
  for(;t+1<NT;t+=2){
    STEP(pB0,pB1,pA0,pA1,t,(t+3<NT),(t+1<NT),(t+1<NT));       ENDW(t);   RESC(); ROT();
    STEP(pA0,pA1,pB0,pB1,t+1,(t+4<NT),(t+2<NT),(t+2<NT));     ENDW(t+1); RESC(); ROT();
  }
  STEP(pB0,pB1,pA0,pA1,NT-1,false,false,false); RESC();
  { float sacc=pB0[0]+pB0[1]; _Pragma("unroll") for(int r=2;r<16;++r)sacc+=pB0[r]; _Pragma("unroll") for(int r=0;r<16;++r)sacc+=pB1[r]; l_reg+=sacc;
    pw0=(u32x4){PKW(pB0,0),PKW(pB0,2),PKW(pB0,4),PKW(pB0,6)};pw1=(u32x4){PKW(pB0,8),PKW(pB0,10),PKW(pB0,12),PKW(pB0,14)};pw2=(u32x4){PKW(pB1,0),PKW(pB1,2),PKW(pB1,4),PKW(pB1,6)};pw3=(u32x4){PKW(pB1,8),PKW(pB1,10),PKW(pB1,12),PKW(pB1,14)};
    SBAR(); pv(o,vb0+sl_cur,PAF(0),PAF(1),PAF(2),PAF(3)); }
  #undef PKW
  #undef PAF
  #undef VFR
  #undef PIN
  #undef MX3
  #undef GAPA
  #undef GAPB
  #undef EX
  #undef VRD
  #undef KRD
  #undef STEP
  #undef ENDW
  {auto rr=__builtin_amdgcn_permlane32_swap(__float_as_uint(l_reg),__float_as_uint(l_reg),false,false);l_reg=__uint_as_float(rr[0])+__uint_as_float(rr[1]);}
  if(hi==0)wsf[32+r32]=l_reg;asm volatile("s_waitcnt lgkmcnt(0)":::"memory");
  float rli[16];
  #pragma unroll
  for(int r=0;r<16;++r)rli[r]=__builtin_amdgcn_rcpf(wsf[32+crow(r,hi)]);
  bf16*Ow=Ob+(long)(q0+wid*QBLK)*OPITCH;
  { bf16*stg=(bf16*)(shm+LDS_OST)+wid*2048;
    #pragma unroll
    for(int r=0;r<16;++r){const int orow=crow(r,hi);
      #pragma unroll
      for(int d0=0;d0<2;++d0)stg[orow*64+d0*32+r32]=f2bf(o[d0][r]*rli[r]);}
    asm volatile("s_waitcnt lgkmcnt(0)":::"memory");
    #pragma unroll
    for(int i=0;i<4;++i){const int row=i*8+(lane>>3),ch=lane&7; const u32x4 v=*(const u32x4*)(stg+row*64+ch*8); ATTN_STORE16(Ow+(long)row*OPITCH+ch*8,v);} }
  asm volatile("s_waitcnt lgkmcnt(0)\n\ts_barrier":::"memory");
  #undef DMA_K
  #undef DMA_V
  #undef CMASK
  #undef START
  #undef RESC
  #undef ROT
}
constexpr int ATTN_LDS_BYTES=LDS_BYTES;
#undef SBAR
#undef WAIT_BAR
}
DEV int queue_pop(unsigned* head, LAS unsigned char* lds, int wv) {
    LAS int* slot = (LAS int*)(lds + LCTL_OFF + 4096);
    __syncthreads();
    if (opaque_tid(wv) == 0) *slot = (int)__hip_atomic_fetch_add(head, 1u, __ATOMIC_RELAXED, __HIP_MEMORY_SCOPE_AGENT);
    __syncthreads();
    return *slot;
}

DEV void phase_mix0(const Params& P, LAS unsigned char* lds, char* shm, int wv) {
    unsigned char* ws = opaque_ws(P.ws); const bf16_t* Z = (const bf16_t*)(ws + WS_Z);
    unsigned* head = (unsigned*)(ws + WS_CTL) + CW_QUEUE;
    for (;;) {
        const int q = queue_pop(head, lds, wv);
        if (q >= 32 + 1024) break;
        if (q < 32) {
            const int b = q >> 2, h = q & 3; const size_t rb = (size_t)b * SEQ;
            LinAttnArgs a; a.q = Z + rb * Z0P + h * 64; a.k = Z + rb * Z0P + 256 + h * 64; a.v = Z + rb * Z0P + 512 + h * 128; a.og = Z + rb * Z0P + 1024 + h * 128; a.zp = Z0P;
            a.la = (const float*)(ws + WS_LA) + rb * 256 + h * 64; a.log_g = 0.f; a.gain = (const float*)P.in[8]; a.out = (bf16_t*)(ws + WS_CAT) + rb * 1024 + h * 128;
            #if FAST_LIN
            linattn_unit_fast<64>(a, lds, wv);
#else
            linattn_unit_ref<64>(a, lds, wv);
#endif
        } else {
            const int aidx = q - 32, qb = 7 - (aidx >> 7), rem = aidx & 127, b = rem >> 4, vh = rem & 15;
#if FAST_ATTN
            { const int h = vh >> 2, m = (vh >> 1) & 1, vhalf = vh & 1; const bf16_t* zb = Z + (size_t)b * SEQ * Z0P;
              attn_body::attn_unit<8>(qb, zb + 1536 + h * 128 + m * 64, zb + 2048 + h * 128 + m * 64, zb + 2560 + h * 128 + vhalf * 64,
                                      (bf16_t*)(ws + WS_OPART) + (size_t)b * SEQ * 1024 + vh * 64, shm, wv); }
#else
            attn_unit_ref(b, vh, qb, Z, (bf16_t*)(ws + WS_OPART), wv);
#endif
        }
    }
}
DEV void phase_mix1(const Params& P, LAS unsigned char* lds, int wv) {
    unsigned char* ws = opaque_ws(P.ws); const bf16_t* Z = (const bf16_t*)(ws + WS_Z);
    unsigned* head = (unsigned*)(ws + WS_CTL) + CW_QUEUE + 64;
    for (;;) {
        const int q = queue_pop(head, lds, wv);
        if (q >= 32 + 128) break;
        if (q < 32) {
            const int b = q >> 2, h = q & 3; const size_t rb = (size_t)b * SEQ;
            LinAttnArgs a; a.q = Z + rb * Z1P + 1024 + h * 64; a.k = Z + rb * Z1P + 1280 + h * 64; a.v = Z + rb * Z1P + 1536 + h * 128; a.og = Z + rb * Z1P + 2048 + h * 128; a.zp = Z1P;
            a.la = nullptr; a.log_g = logf(1.0f - exp2f(-5.0f - (float)h)); a.gain = nullptr; a.out = (bf16_t*)(ws + WS_CAT) + rb * 1024 + 512 + h * 128;
            #if FAST_LIN
            linattn_unit_fast<128>(a, lds, wv);
#else
            linattn_unit_ref<128>(a, lds, wv);
#endif
        } else { const int s = q - 32;
#if FAST_SGU
            sgu_unit_fast(P, s >> 4, s & 15, lds, wv);
#else
            sgu_unit_ref(P, s >> 4, s & 15, lds, wv);
#endif
        }
    }
}
DEV void phase_combine(const Params& P, int wv) {
    const int tid = opaque_tid(wv), lane = tid & 63, wid = tid >> 6, G = gridDim.x;
    const float* q1 = (const float*)P.in[9]; const float* k1 = (const float*)P.in[10]; const float* q2 = (const float*)P.in[11]; const float* k2 = (const float*)P.in[12];
    const float* dg = (const float*)P.in[13];
    const float lam = __expf(wave_sum(q1[lane] * k1[lane])) - __expf(wave_sum(q2[lane] * k2[lane])) + 0.2f;
    unsigned char* ws = opaque_ws(P.ws); const bf16_t* OP = (const bf16_t*)(ws + WS_OPART); bf16_t* CAT = (bf16_t*)(ws + WS_CAT);
    const int h = lane >> 4, e0 = (lane & 15) * 8;
    float g[8];
#pragma unroll
    for (int j = 0; j < 8; ++j) g[j] = dg[e0 + j] * 0.8f;
    for (int row = blockIdx.x * NWAVES + wid; row < NTOK; row += G * NWAVES) {
        float a0[8], a1[8], d[8];
        unpack8(*(const bf16x8*)(OP + (size_t)row * 1024 + h * 256 + e0), a0); unpack8(*(const bf16x8*)(OP + (size_t)row * 1024 + h * 256 + 128 + e0), a1);
        float ss = 0.f;
#pragma unroll
        for (int j = 0; j < 8; ++j) { d[j] = a0[j] - lam * a1[j]; ss += d[j] * d[j]; }
        ss += __shfl_xor(ss, 1); ss += __shfl_xor(ss, 2); ss += __shfl_xor(ss, 4); ss += __shfl_xor(ss, 8);
        const float rstd = 1.0f / sqrtf(ss * (1.f / 128.f) + EPS);
        u32x4 w; w.x = pk2(d[0] * rstd * g[0], d[1] * rstd * g[1]); w.y = pk2(d[2] * rstd * g[2], d[3] * rstd * g[3]);
        w.z = pk2(d[4] * rstd * g[4], d[5] * rstd * g[5]); w.w = pk2(d[6] * rstd * g[6], d[7] * rstd * g[7]);
        *(u32x4*)(CAT + (size_t)row * 1024 + 512 + h * 128 + e0) = w;
    }
}


#ifdef DBG_PROBE_OFF
constexpr int CW_PROBE = 1024;
__global__ void __launch_bounds__(NTHREADS) mk_probe(Params P) {
    const int tid = opaque_tid(wv), G = gridDim.x;
    float s = 0.f;
    const unsigned char* base = P.ws + (size_t)DBG_PROBE_OFF;
    for (long i = (long)blockIdx.x * NTHREADS + tid; i < (long)NTOK * DBG_PROBE_NCOLS; i += (long)G * NTHREADS) {
        const long r = i / DBG_PROBE_NCOLS; const int c = (int)(i % DBG_PROBE_NCOLS) + DBG_PROBE_COL0;
        float v;
        if (DBG_PROBE_F32) v = ((const float*)base)[r * DBG_PROBE_PITCH + c]; else v = bf2f(((const bf16_t*)base)[r * DBG_PROBE_PITCH + c]);
        s += DBG_PROBE_ABS ? fabsf(v) : v * v;
    }
    s = wave_sum(s);
    if ((tid & 63) == 0) atomicAdd((float*)(P.ws + WS_CTL) + CW_PROBE, s);
}
#endif

#define XB_TMO      128
#define XB_XCNT(j)  (256  + 64 * (j))
#define XB_XSUB(j)  (1280 + 64 * (j))
#define XB_XGEN(j)  (2304 + 64 * (j))
#define XB_TOP      3328
#define XB_TOPGEN   3392
#define XCD_BAR_WORDS 3456
#define XB_SPIN_CAP (1u << 18)

__device__ __forceinline__ unsigned xb_ld(unsigned* p)              { return __hip_atomic_load(p, __ATOMIC_RELAXED, __HIP_MEMORY_SCOPE_AGENT); }
__device__ __forceinline__ unsigned xb_add(unsigned* p, unsigned v) { return __hip_atomic_fetch_add(p, v, __ATOMIC_RELAXED, __HIP_MEMORY_SCOPE_AGENT); }
__device__ __forceinline__ unsigned xb_xcc_id() { return (unsigned)__builtin_amdgcn_s_getreg((3 << 11) | 20) & 0xFu; }
#define XB_SPIN(cond, bar) do { unsigned _sp = 0; while (cond) { __builtin_amdgcn_s_sleep(1); \
    if ((++_sp & 255u) == 0u) { if (xb_ld(&(bar)[XB_TMO])) break; if (_sp > XB_SPIN_CAP) { atomicAdd(&(bar)[XB_TMO], 1u); break; } } } } while (0)

struct XcdBarrier {
    unsigned* bar; unsigned x;
    volatile LAS unsigned* st;
};

__device__ __forceinline__ XcdBarrier xcd_barrier_post(unsigned* bar, volatile LAS unsigned* st) {
    XcdBarrier b; b.bar = bar; b.x = xb_xcc_id(); b.st = st;
    if (threadIdx.x == 0) (void)xb_add(&bar[XB_XCNT(b.x)], 1u);
    return b;
}
__device__ __forceinline__ void xcd_barrier_complete(unsigned* bar, unsigned x, unsigned& nloc, unsigned& nx) {
    const unsigned G = gridDim.x * gridDim.y * gridDim.z;
    unsigned sum, cnt, mine, sp = 0u;
    for (;;) {
        sum = 0u; cnt = 0u; mine = 0u;
#pragma unroll
        for (unsigned j = 0; j < 16; ++j) { const unsigned c = xb_ld(&bar[XB_XCNT(j)]); sum += c; cnt += (c > 0u) ? 1u : 0u; mine = (j == x) ? c : mine; }
        if (sum == G) break;
        __builtin_amdgcn_s_sleep(1);
        if ((++sp & 255u) == 0u) { if (xb_ld(&bar[XB_TMO])) break; if (sp > XB_SPIN_CAP) { atomicAdd(&bar[XB_TMO], 1u); break; } }
    }
    nloc = mine > 0u ? mine : 1u; nx = cnt > 0u ? cnt : 1u;
}

__device__ __forceinline__ void xcd_barrier(const XcdBarrier& b) {
    asm volatile("s_waitcnt vmcnt(0)" ::: "memory");
    __syncthreads();
    if (threadIdx.x == 0) {
        unsigned* bar = b.bar;
        __builtin_amdgcn_s_waitcnt(0);
        unsigned nloc = b.st[0], nx = b.st[1];
        if (nloc == 0u) { xcd_barrier_complete(bar, b.x, nloc, nx); b.st[0] = nloc; b.st[1] = nx; }
        const unsigned old = xb_add(&bar[XB_XSUB(b.x)], 1u);
        const unsigned gen = old / nloc;
        if (old + 1u == (gen + 1u) * nloc) {
            __builtin_amdgcn_fence(__ATOMIC_RELEASE, "agent");
            asm volatile("s_waitcnt vmcnt(0)" ::: "memory");
            const unsigned og = xb_add(&bar[XB_TOP], 1u);
            const unsigned tg = og / nx;
            if (og + 1u == (tg + 1u) * nx) xb_add(&bar[XB_TOPGEN], 1u);
            else XB_SPIN(xb_ld(&bar[XB_TOPGEN]) == tg, bar);
            __builtin_amdgcn_fence(__ATOMIC_ACQUIRE, "agent");
            xb_add(&bar[XB_XGEN(b.x)], 1u);
            asm volatile("s_waitcnt vmcnt(0)" ::: "memory");
        } else {
            XB_SPIN(xb_ld(&bar[XB_XGEN(b.x)]) == gen, bar);
            __builtin_amdgcn_fence(__ATOMIC_ACQUIRE, "agent");
            asm volatile("s_waitcnt vmcnt(0)" ::: "memory");
        }
    }
    __syncthreads();
}
template <class Epi, class Sched>
DEV void gemm_run(LAS unsigned char* lds, const Sched& S, const Epi& E, int wv) {
#if FAST_GEMM
    pg8::gemm_phase(lds, S, E, wv);
#else
    gemm_ref(S, E, wv);
#endif
}

constexpr int N_PHASES = 17;
template <int lo, int hi>
__global__ void __launch_bounds__(NTHREADS, 2) mk_fwd(Params P) {
    extern __shared__ __attribute__((aligned(16))) unsigned char lds_raw[];
    LAS unsigned char* lds = (LAS unsigned char*)lds_raw;
    const int G = gridDim.x, c = blockIdx.x;
    const int wv = __builtin_amdgcn_readfirstlane((int)(threadIdx.x >> 6));
#if ONE_LAUNCH
    { volatile LAS unsigned* stw = (volatile LAS unsigned*)(lds + LCTL_OFF + 8192); if (threadIdx.x < 4) stw[threadIdx.x] = 0u; }
    __syncthreads();
    const XcdBarrier xbar = xcd_barrier_post((unsigned*)(P.ws + WS_CTL) + CW_BAR, (volatile LAS unsigned*)(lds + LCTL_OFF + 8192));
#if USE_CG_SYNC
    cg::grid_group grid = cg::this_grid();
#define GRID_BAR() grid.sync()
#else
#define GRID_BAR() xcd_barrier(xbar)
#endif
#else
#define GRID_BAR() do {} while (0)
#endif
#define IN(k) (lo <= (k) && (k) < hi)
#define SEAM(k) do { if constexpr (lo <= (k) + 1 && (k) + 1 < hi) GRID_BAR(); } while (0)
#define PH_PTRS unsigned char* ws = opaque_ws(P.ws); const float* mod = (const float*)(ws + WS_MOD); bf16_t* H = (bf16_t*)(ws + WS_H); bf16_t* Z = (bf16_t*)(ws + WS_Z); bf16_t* CAT = (bf16_t*)(ws + WS_CAT); \
    float* X1 = (float*)(ws + WS_X1); float* X2 = (float*)(ws + WS_X2); const float* x = (const float*)P.in[0]; (void)mod; (void)H; (void)Z; (void)CAT; (void)X1; (void)X2; (void)x;

    if constexpr (IN(0)) { PH_PTRS phase_prologue(P, lds, wv); SEAM(0); }
    if constexpr (IN(1)) { PH_PTRS phase_prenorm<0>(P, lds, wv, x, nullptr, 0, 0, 0); SEAM(1); }
    if constexpr (IN(2)) { PH_PTRS
        DenseSched S{H, (const bf16_t*)(ws + WS_WIN0), 1024, NTOK / 256, N_IN0 / 256, G, c};
        EpiIn E{Z, Z0P, (float*)(ws + WS_LA), (const float*)P.in[7], (const float*)(ws + WS_ROPE), 0};
        gemm_run(lds, S, E, wv); SEAM(2);
    }
    if constexpr (IN(3)) { PH_PTRS phase_mix0(P, lds, (char*)lds_raw, wv); SEAM(3); }
    if constexpr (IN(4)) { PH_PTRS phase_combine(P, wv); SEAM(4); }
    if constexpr (IN(5)) { PH_PTRS
        DenseSched S{CAT, (const bf16_t*)(ws + WS_WOUT0), 1024, NTOK / 256, 4, G, c};
        EpiResid E{x, X1, mod + 2 * 1024, (DBG_SKIP >> 0) & 1, DBG_F_MIX0};
        gemm_run(lds, S, E, wv); SEAM(5);
    }
    if constexpr (IN(6)) { PH_PTRS phase_prenorm<4>(P, lds, wv, X1, nullptr, 0, 3072, 0); SEAM(6); }
    if constexpr (IN(7)) { PH_PTRS
        const int* cnt = (const int*)(ws + WS_CTL) + CW_CNT; const int* ent = (const int*)(ws + WS_ENT);
        MoeTiles mt = moe_build_tiles(cnt, lds, wv);
        MoeSched1 S{H, (const bf16_t*)(ws + WS_W1), cnt, ent, mt, 1024, 8, G, c};
        EpiSwiglu E{(bf16_t*)(ws + WS_A), (const float*)P.in[24]};
        gemm_run(lds, S, E, wv); SEAM(7);
    }
    if constexpr (IN(8)) { PH_PTRS
        const int* cnt = (const int*)(ws + WS_CTL) + CW_CNT; const int* ent = (const int*)(ws + WS_ENT);
        MoeTiles mt = moe_build_tiles(cnt, lds, wv);
        MoeSched2 S{(const bf16_t*)(ws + WS_A), (const bf16_t*)(ws + WS_W2), mt, 1024, 4, G, c};
        EpiMoeOut E{(bf16_t*)(ws + WS_YB), (const float*)P.in[26], cnt, ent, (const float*)(ws + WS_GATES)};
        gemm_run(lds, S, E, wv); SEAM(8);
    }
    if constexpr (IN(9)) { PH_PTRS phase_prenorm<3>(P, lds, wv, X1, X2, 1, 0, 0); SEAM(9); }
    if constexpr (IN(10)) { PH_PTRS
        DenseSched S{H, (const bf16_t*)(ws + WS_WIN1), 1024, NTOK / 256, N_IN1 / 256, G, c};
        EpiIn E{Z, Z1P, nullptr, nullptr, (const float*)(ws + WS_ROPE), 1};
        gemm_run(lds, S, E, wv); SEAM(10);
    }
    if constexpr (IN(11)) { PH_PTRS phase_mix1(P, lds, wv); SEAM(11); }
    if constexpr (IN(12)) { PH_PTRS
        DenseSched S{CAT, (const bf16_t*)(ws + WS_WOUT1), 1024, NTOK / 256, 4, G, c};
        EpiResid E{X2, X1, mod + 8 * 6144 + 2 * 1024, (DBG_SKIP >> 2) & 1, DBG_F_MIX1};
        gemm_run(lds, S, E, wv); SEAM(12);
    }
    if constexpr (IN(13)) { PH_PTRS phase_prenorm<4>(P, lds, wv, X1, nullptr, 1, 3072, 0); SEAM(13); }
    if constexpr (IN(14)) { PH_PTRS
        const int* cnt = (const int*)(ws + WS_CTL) + CW_CNT + 64; const int* ent = (const int*)(ws + WS_ENT) + (size_t)NEXP * ENT_CAP;
        MoeTiles mt = moe_build_tiles(cnt, lds, wv);
        MoeSched1 S{H, (const bf16_t*)(ws + WS_W1) + (size_t)NEXP * 2048 * 1024, cnt, ent, mt, 1024, 8, G, c};
        EpiSwiglu E{(bf16_t*)(ws + WS_A), (const float*)P.in[24] + (size_t)NEXP * 2048};
        gemm_run(lds, S, E, wv); SEAM(14);
    }
    if constexpr (IN(15)) { PH_PTRS
        const int* cnt = (const int*)(ws + WS_CTL) + CW_CNT + 64; const int* ent = (const int*)(ws + WS_ENT) + (size_t)NEXP * ENT_CAP;
        MoeTiles mt = moe_build_tiles(cnt, lds, wv);
        MoeSched2 S{(const bf16_t*)(ws + WS_A), (const bf16_t*)(ws + WS_W2) + (size_t)NEXP * 1024 * 1024, mt, 1024, 4, G, c};
        EpiMoeOut E{(bf16_t*)(ws + WS_YB), (const float*)P.in[26] + (size_t)NEXP * 1024, cnt, ent, (const float*)(ws + WS_GATES) + 65536};
        gemm_run(lds, S, E, wv); SEAM(15);
    }
    if constexpr (IN(16)) { PH_PTRS phase_prenorm<9>(P, lds, wv, DBG_FINAL_X ? x : X1, nullptr, 1, 0, 1); }
#undef IN
#undef SEAM
}

template <int PH> static void launch_phase(int grid, const Params& p, hipStream_t stream) {
    (void)hipFuncSetAttribute((const void*)mk_fwd<PH, PH + 1>, hipFuncAttributeMaxDynamicSharedMemorySize, LDS_BYTES);
    hipLaunchKernelGGL((mk_fwd<PH, PH + 1>), dim3(grid), dim3(NTHREADS), LDS_BYTES, stream, p);
}
#ifdef DBG_PHASES
template <int PH> static void launch_masked(int grid, const Params& p, hipStream_t stream) {
    if constexpr (PH < N_PHASES) { if constexpr ((DBG_PHASES >> PH) & 1) launch_phase<PH>(grid, p, stream); launch_masked<PH + 1>(grid, p, stream); }
}
#endif
template <int PH> static void launch_all(int grid, const Params& p, hipStream_t stream) {
    if constexpr (PH < N_PHASES) { launch_phase<PH>(grid, p, stream); launch_all<PH + 1>(grid, p, stream); }
}
extern "C" void kernel_launch(void* const* d_in, const int* in_sizes, int n_in, void* d_out, int out_size, void* d_ws, size_t ws_size, hipStream_t stream) {
    static int grid = 0;
    if (grid == 0) {
        if (n_in != 28 || out_size != NTOK * DM || ws_size < WS_END) { fprintf(stderr, "kernel_launch: unexpected shapes (n_in %d out %d ws %zu)\n", n_in, out_size, ws_size); grid = -1; return; }
        int dev = 0, cus = 0;
        (void)hipGetDevice(&dev); (void)hipDeviceGetAttribute(&cus, hipDeviceAttributeMultiprocessorCount, dev);
#if ONE_LAUNCH
        int per_cu = 0;
        if (hipFuncSetAttribute((const void*)mk_fwd<0, N_PHASES>, hipFuncAttributeMaxDynamicSharedMemorySize, LDS_BYTES) != hipSuccess) { fprintf(stderr, "kernel_launch: hipFuncSetAttribute failed\n"); grid = -1; return; }
        (void)hipOccupancyMaxActiveBlocksPerMultiprocessor(&per_cu, (const void*)mk_fwd<0, N_PHASES>, NTHREADS, LDS_BYTES);
        if (per_cu < 1) { fprintf(stderr, "kernel_launch: occupancy query reports %d blocks per CU\n", per_cu); grid = -1; return; }
#endif
        (void)hipGetLastError();
        grid = cus;
    }
    if (grid < 0) return;
    (void)hipMemsetAsync((char*)d_ws + WS_CTL, 0, CTL_ZERO_BYTES, stream);
    Params p{};
    for (int i = 0; i < 28; ++i) p.in[i] = d_in[i];
    p.out = (float*)d_out; p.ws = (unsigned char*)d_ws;
#if ONE_LAUNCH
    void* args[] = {&p};
    hipError_t e = hipLaunchCooperativeKernel((const void*)mk_fwd<0, N_PHASES>, dim3(grid), dim3(NTHREADS), args, LDS_BYTES, stream);
    if (e != hipSuccess) fprintf(stderr, "cooperative launch failed: %s (grid %d)\n", hipGetErrorString(e), grid);
#else
#ifdef DBG_PHASES
    launch_masked<0>(grid, p, stream);
#ifdef DBG_PROBE_OFF
    hipLaunchKernelGGL(mk_probe, dim3(grid), dim3(NTHREADS), 0, stream, p);
    launch_phase<16>(grid, p, stream);
#endif
#else
    launch_all<0>(grid, p, stream);
#endif
#endif
}
```

```cpp
#include <hip/hip_runtime.h>
#include <hip/hip_cooperative_groups.h>
#include <cstdio>
#include <cstdint>
namespace cg = cooperative_groups;

#ifndef ONE_LAUNCH
#define ONE_LAUNCH 1
#endif
#ifndef FAST_GEMM
#define FAST_GEMM 1
#endif
#ifndef USE_CG_SYNC
#define USE_CG_SYNC 0
#endif
#ifndef FAST_ATTN
#define FAST_ATTN 1
#endif
#ifndef MOE_FP8
#define MOE_FP8 1
#endif
#ifndef FAST_LIN
#define FAST_LIN 1
#endif
#ifndef FAST_SGU
#define FAST_SGU 1
#endif
#ifndef DBG_SKIP
#define DBG_SKIP 0
#endif
#ifndef DBG_FINAL_X
#define DBG_FINAL_X 0
#endif
#ifndef DBG_F_MIX0
#define DBG_F_MIX0 1.0f
#endif
#ifndef DBG_F_MOE0
#define DBG_F_MOE0 1.0f
#endif
#ifndef DBG_F_MIX1
#define DBG_F_MIX1 1.0f
#endif
#ifndef DBG_F_MOE1
#define DBG_F_MOE1 1.0f
#endif

#define DEV __device__ __forceinline__
#define LAS __attribute__((address_space(3)))
typedef unsigned short bf16_t;
typedef short bf16x8 __attribute__((ext_vector_type(8)));
typedef float f32x4 __attribute__((ext_vector_type(4)));
typedef float f32x2 __attribute__((ext_vector_type(2)));
typedef unsigned u32x4 __attribute__((ext_vector_type(4)));
typedef unsigned u32x2 __attribute__((ext_vector_type(2)));
typedef __bf16 bf16x2_t __attribute__((ext_vector_type(2)));
typedef int v8i __attribute__((ext_vector_type(8)));

constexpr int NB = 8, SEQ = 2048, DM = 1024, NTOK = NB * SEQ, NEXP = 32, TOPK = 4;
constexpr int Z0P = 3072, Z1P = 2560;
constexpr int N_IN0 = 3072, N_IN1 = 2560;
constexpr int ENT_CAP = NTOK;
constexpr float EPS = 1e-6f;
constexpr float C2 = 0.125f * 1.4426950408889634f;
constexpr int NTHREADS = 512, NWAVES = 8;

constexpr size_t MiB = 1u << 20;
constexpr size_t WS_CTL = 0, CTL_ZERO_BYTES = 64 * 1024;
constexpr size_t WS_MOD = 1 * MiB;
constexpr size_t WS_ROPE = 2 * MiB;
constexpr size_t WS_ENT = 6 * MiB;
constexpr size_t WS_GATES = 10 * MiB;
constexpr size_t WS_SGUW = 11 * MiB;
constexpr size_t WS_WIN0 = 12 * MiB;
constexpr size_t WS_WOUT0 = 19 * MiB;
constexpr size_t WS_WIN1 = 21 * MiB;
constexpr size_t WS_WOUT1 = 26 * MiB;
constexpr size_t WS_W1 = 32 * MiB;
constexpr size_t WS_W2 = 288 * MiB;
constexpr size_t WS_H = 416 * MiB;
constexpr size_t WS_Z = 448 * MiB;
constexpr size_t WS_LA = 544 * MiB;
constexpr size_t WS_OPART = 560 * MiB;
constexpr size_t WS_CAT = 592 * MiB;
constexpr size_t WS_X1 = 624 * MiB;
constexpr size_t WS_X2 = 688 * MiB;
constexpr size_t WS_A = 752 * MiB;
constexpr size_t WS_YB = 896 * MiB;
constexpr size_t WS_GL = 1000 * MiB;
constexpr size_t WS_XQ = 1024 * MiB;
constexpr size_t WS_END = 1536 * MiB;
constexpr int CW_CNT = 8192, CNT_STRIDE = 64;
constexpr int CW_QUEUE = 256;
constexpr int CW_BAR = 4096;

constexpr int RING_BYTES = 131072;
constexpr int LCTL_OFF = 149504;
constexpr int LDS_BYTES = 163840;

DEV float bf2f(bf16_t v) { return __uint_as_float((unsigned)v << 16); }
DEV unsigned pk2(float lo, float hi) { f32x2 v = {lo, hi}; bf16x2_t b = __builtin_convertvector(v, bf16x2_t); return __builtin_bit_cast(unsigned, b); }
DEV bf16_t f2bf(float f) { return (bf16_t)(pk2(f, 0.f) & 0xffffu); }
DEV unsigned pk4_fp8(float a, float b, float c, float d) { unsigned w = __builtin_amdgcn_cvt_pk_fp8_f32(a, b, 0, false); return __builtin_amdgcn_cvt_pk_fp8_f32(c, d, w, true); }
constexpr float W8_SCALE = 64.f, W8_INV = 1.f / 64.f;
constexpr float YB_SCALE = 32.f, YB_INV = 1.f / 32.f;
DEV float wave_sum(float v) {
#pragma unroll
    for (int o = 1; o < 64; o <<= 1) v += __shfl_xor(v, o);
    return v;
}
DEV float silu_f(float x) { return x / (1.f + __expf(-x)); }
DEV float log_sigmoid_f(float x) { return fminf(x, 0.f) - __logf(1.f + __expf(-fabsf(x))); }
DEV float gelu_f(float v) {
    const float av = fabsf(v), t = __builtin_amdgcn_rcpf(av * 0.2316418882f + 1.0f);
    float q = t * 0.5307027145f + (-0.7265760135f); q = q * t + 0.7107068705f; q = q * t + (-0.142248368f); q = q * t + 0.127414796f; q = q * t;
    const float e = __builtin_amdgcn_exp2f((v * v) * (-0.72134752044f));
    const float m = v * (q * e);
    return v < 0.f ? m : v - m;
}
DEV void unpack8(const bf16x8 v, float (&o)[8]) {
#pragma unroll
    for (int j = 0; j < 8; ++j) o[j] = bf2f((bf16_t)v[j]);
}

DEV unsigned char* opaque_ws(unsigned char* p) { size_t z = 0; asm volatile("" : "+s"(z)); return p + z; }
DEV int lane_id() { return (int)__builtin_amdgcn_mbcnt_hi(~0u, __builtin_amdgcn_mbcnt_lo(~0u, 0u)); }
DEV int opaque_tid(int wv) { int l; asm volatile("v_mbcnt_lo_u32_b32 %0, -1, 0\n\tv_mbcnt_hi_u32_b32 %0, -1, %0" : "=v"(l)); return (wv << 6) | l; }
#define LBAR() do { asm volatile("s_waitcnt lgkmcnt(0)" ::: "memory"); __builtin_amdgcn_s_barrier(); asm volatile("" ::: "memory"); } while (0)
#ifndef RES_BF16
#define RES_BF16 1
#endif
template <bool BF> DEV f32x4 ld_res4(const void* base, size_t elem) {
    if constexpr (BF) { const u32x2 w = *(const u32x2*)((const bf16_t*)base + elem); return (f32x4){__uint_as_float(w.x << 16), __uint_as_float(w.x & 0xffff0000u), __uint_as_float(w.y << 16), __uint_as_float(w.y & 0xffff0000u)}; }
    else return *(const f32x4*)((const float*)base + elem);
}
template <bool BF> DEV void st_res4(void* base, size_t elem, f32x4 v) {
    if constexpr (BF) { u32x2 w; w.x = pk2(v[0], v[1]); w.y = pk2(v[2], v[3]); *(u32x2*)((bf16_t*)base + elem) = w; }
    else *(f32x4*)((float*)base + elem) = v;
}
struct Params {
    const void* in[28];
    float* out;
    unsigned char* ws;
};

struct Unit { int pm, pn, e, tb, rows; };

DEV bool static_next(int i, int G, int c, int nM, int nN, int& pm, int& pn) {
    const int nwg = nM * nN; const long Lr = (long)i * G + c; if (Lr >= nwg) return false;
    int wgid = (int)Lr; { const int q = nwg / 8, r = nwg % 8, xcd = wgid % 8, off = wgid / 8; wgid = (xcd < r ? xcd * (q + 1) : r * (q + 1) + (xcd - r) * q) + off; }
    const int nig = 8 * nN, gid = wgid / nig, fm = gid * 8, gsz = (nM - fm) < 8 ? (nM - fm) : 8;
    pm = fm + ((wgid % nig) % gsz); pn = (wgid % nig) / gsz; return true;
}
struct DenseSched {
    static constexpr int EB = 2;
    const bf16_t* A; const bf16_t* Bt; int K, nM, nN, G, c;
    static constexpr bool RAGGED = false;
    DEV bool next(int i, Unit& u) const { u.e = 0; u.tb = 0; u.rows = 256; return static_next(i, G, c, nM, nN, u.pm, u.pn); }
    DEV const char* a_ptr(const Unit& u) const { return (const char*)(A + (size_t)u.pm * 256 * K); }
    DEV const char* b_ptr(const Unit& u) const { return (const char*)(Bt + (size_t)u.pn * 256 * K); }
};
struct MoeTiles { const LAS int* te; const LAS int* ttb; const LAS int* trows; int nt; };
struct MoeSched1 {
    static constexpr int EB = 1; static constexpr bool RAGGED = true;
    const unsigned char* A; const unsigned char* Bt; MoeTiles mt; int K, nN, G, c;
    DEV bool next(int i, Unit& u) const { int pm, pn; if (!static_next(i, G, c, mt.nt, nN, pm, pn)) return false; u.pm = pm; u.pn = pn; u.e = mt.te[pm]; u.tb = mt.ttb[pm]; u.rows = mt.trows[pm]; return true; }
    DEV const char* a_ptr(const Unit& u) const { return (const char*)A + ((size_t)u.e * ENT_CAP + (size_t)u.tb * 256) * K; }
    DEV const char* b_ptr(const Unit& u) const { return (const char*)Bt + ((size_t)u.e * 2048 + (size_t)u.pn * 256) * K; }
};
struct MoeSched2 {
    static constexpr int EB = 1; static constexpr bool RAGGED = true;
    const unsigned char* A; const unsigned char* Bt; MoeTiles mt; int K, nN, G, c;
    DEV bool next(int i, Unit& u) const { int pm, pn; if (!static_next(i, G, c, mt.nt, nN, pm, pn)) return false; u.pm = pm; u.pn = pn; u.e = mt.te[pm]; u.tb = mt.ttb[pm]; u.rows = mt.trows[pm]; return true; }
    DEV const char* a_ptr(const Unit& u) const { return (const char*)A + (size_t)u.pm * 256 * K; }
    DEV const char* b_ptr(const Unit& u) const { return (const char*)Bt + ((size_t)u.e * 1024 + (size_t)u.pn * 256) * K; }
};
DEV MoeTiles moe_build_tiles(const int* cnt, LAS unsigned char* lds, int wv) {
    LAS int* te = (LAS int*)(lds + LCTL_OFF); LAS int* ttb = te + 320; LAS int* trows = ttb + 320; LAS int* ntp = trows + 320;
    __syncthreads();
    const int tid = opaque_tid(wv);
    if (tid < 64) {
        const int e = tid & 31; const bool act = tid < 32;
        const int c = __hip_atomic_load(cnt + e * CNT_STRIDE, __ATOMIC_RELAXED, __HIP_MEMORY_SCOPE_AGENT);
        const int nfull = c >> 8, rem = c & 255;
        int incl = nfull;
#pragma unroll
        for (int o = 1; o < 32; o <<= 1) { const int t = __shfl_up(incl, o, 32); if ((tid & 31) >= o) incl += t; }
        const int base = incl - nfull, nfull_total = __shfl(incl, 31, 32);
        int rank = 0, npart = 0;
#pragma unroll
        for (int j = 0; j < 32; ++j) { const int rj = __shfl(rem, j, 32); npart += rj > 0; rank += (rj > rem) || (rj == rem && j < e); }
        if (act) {
            for (int t = 0; t < nfull; ++t) { te[base + t] = e; ttb[base + t] = t; trows[base + t] = 256; }
            if (rem > 0) { te[nfull_total + rank] = e; ttb[nfull_total + rank] = nfull; trows[nfull_total + rank] = rem; }
            if (tid == 0) *ntp = nfull_total + npart;
        }
    }
    __syncthreads();
    MoeTiles mt; mt.te = te; mt.ttb = ttb; mt.trows = trows; mt.nt = *ntp; return mt;
}

enum { EK_PLAIN = 0, EK_SILU = 1, EK_GELU = 2, EK_ROPE = 3, EK_LOGSIG = 4 };
struct EpiIn {
    static constexpr bool PERM = true;
    bf16_t* Z; int zp; float* LA; const float* bgate; const float* rope; int layer;
    DEV void kind_of(int pn, int& kind, float& sc) const {
        kind = EK_PLAIN; sc = 1.f;
        if (layer == 0) { if (pn == 0) sc = 0.125f; else if (pn == 4 || pn == 5) kind = EK_SILU; else if (pn == 6 || pn == 7) { kind = EK_ROPE; sc = C2; } else if (pn == 8 || pn == 9) kind = EK_ROPE; else if (pn == 12) kind = EK_LOGSIG; }
        else { if (pn < 4) kind = EK_GELU; else if (pn == 4) { kind = EK_ROPE; sc = 0.125f; } else if (pn == 5) kind = EK_ROPE; else if (pn >= 8) kind = EK_SILU; }
    }
    DEV void operator()(const f32x4 (&acc)[2][2][4][2], const Unit& u, int wr, int wc, int fr, int fq) const {
        int kind; float sc; kind_of(u.pn, kind, sc);
        if (kind == EK_ROPE) {
#pragma unroll
            for (int ai = 0; ai < 2; ++ai) {
                f32x4 tb[4][4];
#pragma unroll
                for (int m = 0; m < 4; ++m) { const float* rt = rope + (size_t)(u.pm * 256 + ai * 128 + wr * 64 + m * 16 + fr) * 64 + (8 * fq) * 2;
#pragma unroll
                    for (int q = 0; q < 4; ++q) tb[m][q] = *(const f32x4*)(rt + 4 * q); }
                asm volatile("" ::: "memory");
#pragma unroll
                for (int m = 0; m < 4; ++m) { const int row = u.pm * 256 + ai * 128 + wr * 64 + m * 16 + fr;
                    float y1[8], y2[8];
#pragma unroll
                    for (int n = 0; n < 2; ++n)
#pragma unroll
                        for (int i = 0; i < 4; ++i) { const int j = 4 * n + i; const float cs = tb[m][j >> 1][(j & 1) * 2], sn = tb[m][j >> 1][(j & 1) * 2 + 1];
                            const float x1 = acc[ai][0][m][n][i], x2 = acc[ai][1][m][n][i];
                            y1[j] = (x1 * cs - x2 * sn) * sc; y2[j] = (x2 * cs + x1 * sn) * sc; }
                    bf16_t* zp_ = Z + (size_t)row * zp + u.pn * 256 + 64 * wc + 8 * fq;
                    u32x4 w; w.x = pk2(y1[0], y1[1]); w.y = pk2(y1[2], y1[3]); w.z = pk2(y1[4], y1[5]); w.w = pk2(y1[6], y1[7]); *(u32x4*)(zp_) = w;
                    w.x = pk2(y2[0], y2[1]); w.y = pk2(y2[2], y2[3]); w.z = pk2(y2[4], y2[5]); w.w = pk2(y2[6], y2[7]); *(u32x4*)(zp_ + 32) = w; }
            }
            return;
        }
        if (kind == EK_LOGSIG) {
            f32x4 b0[2], b1[2];
#pragma unroll
            for (int bj = 0; bj < 2; ++bj) { const int col = 128 * bj + 32 * wc + 8 * fq; b0[bj] = *(const f32x4*)(bgate + col); b1[bj] = *(const f32x4*)(bgate + col + 4); }
#pragma unroll
            for (int ai = 0; ai < 2; ++ai)
#pragma unroll
                for (int m = 0; m < 4; ++m) { const int row = u.pm * 256 + ai * 128 + wr * 64 + m * 16 + fr;
#pragma unroll
                    for (int bj = 0; bj < 2; ++bj) { const int col = 128 * bj + 32 * wc + 8 * fq; float* lp = LA + (size_t)row * 256 + col; f32x4 o0, o1;
#pragma unroll
                        for (int i = 0; i < 4; ++i) { o0[i] = log_sigmoid_f(acc[ai][bj][m][0][i] + b0[bj][i]) * 0.0625f; o1[i] = log_sigmoid_f(acc[ai][bj][m][1][i] + b1[bj][i]) * 0.0625f; }
                        *(f32x4*)lp = o0; *(f32x4*)(lp + 4) = o1; } }
            return;
        }
#pragma unroll
        for (int ai = 0; ai < 2; ++ai)
#pragma unroll
            for (int m = 0; m < 4; ++m) { const int row = u.pm * 256 + ai * 128 + wr * 64 + m * 16 + fr;
#pragma unroll
                for (int bj = 0; bj < 2; ++bj) { float v[8];
#pragma unroll
                    for (int n = 0; n < 2; ++n)
#pragma unroll
                        for (int i = 0; i < 4; ++i) { float x = acc[ai][bj][m][n][i]; if (kind == EK_SILU) x = silu_f(x); else if (kind == EK_GELU) x = gelu_f(x); v[4 * n + i] = x * sc; }
                    u32x4 w; w.x = pk2(v[0], v[1]); w.y = pk2(v[2], v[3]); w.z = pk2(v[4], v[5]); w.w = pk2(v[6], v[7]);
                    *(u32x4*)(Z + (size_t)row * zp + u.pn * 256 + 128 * bj + 32 * wc + 8 * fq) = w; } }
    }
};
template <bool RIN_BF>
struct EpiResid {
    static constexpr bool PERM = true;
    const void* resid; void* out; const float* gate; int skip; float dbgf;
    DEV void operator()(const f32x4 (&acc)[2][2][4][2], const Unit& u, int wr, int wc, int fr, int fq) const {
        const int b = (u.pm * 256) >> 11;
        f32x4 g[2][2];
#pragma unroll
        for (int bj = 0; bj < 2; ++bj)
#pragma unroll
            for (int n = 0; n < 2; ++n) g[bj][n] = *(const f32x4*)(gate + (size_t)b * 6144 + u.pn * 256 + 128 * bj + 32 * wc + 8 * fq + 4 * n);
#pragma unroll
        for (int ai = 0; ai < 2; ++ai) {
            f32x4 r[4][2][2];
#pragma unroll
            for (int m = 0; m < 4; ++m) { const size_t row = (size_t)(u.pm * 256 + ai * 128 + wr * 64 + m * 16 + fr);
#pragma unroll
                for (int bj = 0; bj < 2; ++bj)
#pragma unroll
                    for (int n = 0; n < 2; ++n) r[m][bj][n] = ld_res4<RIN_BF>(resid, row * DM + u.pn * 256 + 128 * bj + 32 * wc + 8 * fq + 4 * n); }
            asm volatile("" ::: "memory");
#pragma unroll
            for (int m = 0; m < 4; ++m) { const size_t row = (size_t)(u.pm * 256 + ai * 128 + wr * 64 + m * 16 + fr);
#pragma unroll
                for (int bj = 0; bj < 2; ++bj) { const size_t e0 = row * DM + u.pn * 256 + 128 * bj + 32 * wc + 8 * fq;
                    const f32x4 o0 = skip ? r[m][bj][0] : r[m][bj][0] + g[bj][0] * acc[ai][bj][m][0] * dbgf, o1 = skip ? r[m][bj][1] : r[m][bj][1] + g[bj][1] * acc[ai][bj][m][1] * dbgf;
                    if constexpr (RES_BF16) { u32x4 w; w.x = pk2(o0[0], o0[1]); w.y = pk2(o0[2], o0[3]); w.z = pk2(o1[0], o1[1]); w.w = pk2(o1[2], o1[3]); *(u32x4*)((bf16_t*)out + e0) = w; }
                    else { *(f32x4*)((float*)out + e0) = o0; *(f32x4*)((float*)out + e0 + 4) = o1; } } }
        }
    }
};
struct EpiSwiglu {
    static constexpr bool PERM = true;
    static constexpr float ASC = MOE_FP8 ? W8_INV : 1.f;
    bf16_t* Aout; const float* bin;
    DEV void operator()(const f32x4 (&acc)[2][2][4][2], const Unit& u, int wr, int wc, int fr, int fq) const {
#ifdef DBG_NOEPI
        float sacc = 0.f;
#pragma unroll
        for (int a_ = 0; a_ < 2; ++a_) for (int b_ = 0; b_ < 2; ++b_) for (int m_ = 0; m_ < 4; ++m_) for (int n_ = 0; n_ < 2; ++n_) sacc += acc[a_][b_][m_][n_][0] + acc[a_][b_][m_][n_][1] + acc[a_][b_][m_][n_][2] + acc[a_][b_][m_][n_][3];
        if (sacc == 12345.678f) ((unsigned char*)Aout)[0] = 1;
        return;
#endif
        const int lc = 128 * u.pn + 32 * wc + 8 * fq; const float* bp = bin + (size_t)u.e * 2048 + lc;
        const f32x4 bg0 = *(const f32x4*)bp, bg1 = *(const f32x4*)(bp + 4), bl0 = *(const f32x4*)(bp + 1024), bl1 = *(const f32x4*)(bp + 1028);
#pragma unroll
        for (int ai = 0; ai < 2; ++ai)
#pragma unroll
            for (int m = 0; m < 4; ++m) { const size_t row = (size_t)(u.pm * 256 + ai * 128 + wr * 64 + m * 16 + fr); float v[8];
#pragma unroll
                for (int n = 0; n < 2; ++n)
#pragma unroll
                    for (int i = 0; i < 4; ++i) { const float g = fminf(acc[ai][0][m][n][i] * ASC + (n ? bg1[i] : bg0[i]), 7.f);
                        const float l = fminf(fmaxf(acc[ai][1][m][n][i] * ASC + (n ? bl1[i] : bl0[i]), -7.f), 7.f);
                        v[4 * n + i] = g / (1.f + __expf(-1.702f * g)) * (l + 1.f); }
#if MOE_FP8
                u32x2 w; w.x = pk4_fp8(v[0], v[1], v[2], v[3]); w.y = pk4_fp8(v[4], v[5], v[6], v[7]);
                *(u32x2*)((unsigned char*)Aout + row * 1024 + lc) = w; }
#else
                u32x4 w; w.x = pk2(v[0], v[1]); w.y = pk2(v[2], v[3]); w.z = pk2(v[4], v[5]); w.w = pk2(v[6], v[7]);
                *(u32x4*)(Aout + row * 1024 + lc) = w; }
#endif
    }
};
struct EpiMoeOut {
    static constexpr bool PERM = true;
    bf16_t* YB; const float* bout; const int* cnt; const int* ent; const float* gates;
    DEV void operator()(const f32x4 (&acc)[2][2][4][2], const Unit& u, int wr, int wc, int fr, int fq) const {
        const int n_e = cnt[u.e * CNT_STRIDE];
        int dst[2][4]; float gt[2][4];
#pragma unroll
        for (int ai = 0; ai < 2; ++ai)
#pragma unroll
            for (int m = 0; m < 4; ++m) { const int pos = u.tb * 256 + ai * 128 + wr * 64 + m * 16 + fr; const bool ok = pos < n_e;
                dst[ai][m] = ok ? ent[u.e * ENT_CAP + pos] : -1; gt[ai][m] = ok ? gates[u.e * ENT_CAP + pos] : 0.f; }
        f32x4 bv[2][2];
#pragma unroll
        for (int bj = 0; bj < 2; ++bj)
#pragma unroll
            for (int n = 0; n < 2; ++n) bv[bj][n] = *(const f32x4*)(bout + (size_t)u.e * 1024 + u.pn * 256 + 128 * bj + 32 * wc + 8 * fq + 4 * n);
        asm volatile("" ::: "memory");
#pragma unroll
        for (int ai = 0; ai < 2; ++ai)
#pragma unroll
            for (int m = 0; m < 4; ++m) {
                if (dst[ai][m] >= 0) { const float g = gt[ai][m];
#pragma unroll
                    for (int bj = 0; bj < 2; ++bj) { f32x4 v0 = (acc[ai][bj][m][0] * W8_INV + bv[bj][0]) * (g * YB_SCALE), v1 = (acc[ai][bj][m][1] * W8_INV + bv[bj][1]) * (g * YB_SCALE);
#pragma unroll
                        for (int t = 0; t < 4; ++t) { v0[t] = fminf(fmaxf(v0[t], -440.f), 440.f); v1[t] = fminf(fmaxf(v1[t], -440.f), 440.f); }
                        u32x2 w; w.x = pk4_fp8(v0[0], v0[1], v0[2], v0[3]); w.y = pk4_fp8(v1[0], v1[1], v1[2], v1[3]);
                        *(u32x2*)((unsigned char*)YB + (size_t)dst[ai][m] * 1024 + u.pn * 256 + 128 * bj + 32 * wc + 8 * fq) = w; } } }
    }
};

template <class Epi, class Sched>
DEV void gemm_ref(const Sched& S, const Epi& E, int wv) {
    const int tid = opaque_tid(wv), wid = tid >> 6, lane = tid & 63, wr = wid >> 2, wc = wid & 3, fr = lane & 15, fq = lane >> 4;
    Unit u;
    for (int it = 0; S.next(it, u); ++it) {
        f32x4 acc[2][2][4][2];
#pragma unroll
        for (int a = 0; a < 2; ++a)
#pragma unroll
            for (int b = 0; b < 2; ++b)
#pragma unroll
                for (int m = 0; m < 4; ++m)
#pragma unroll
                    for (int n = 0; n < 2; ++n) acc[a][b][m][n] = (f32x4){0.f, 0.f, 0.f, 0.f};
        unsigned aoff[2][4];
        const int K = S.K;
#pragma unroll
        for (int ai = 0; ai < 2; ++ai)
#pragma unroll
            for (int m = 0; m < 4; ++m) aoff[ai][m] = (unsigned)(ai * 128 + wr * 64 + m * 16 + fr) * (unsigned)K;
        const bf16_t* Bt = (const bf16_t*)S.b_ptr(u); const bf16_t* Ab = (const bf16_t*)S.a_ptr(u);
        for (int k0 = 0; k0 < K; k0 += 8) {
            u32x4 araw[2][4];
#pragma unroll
            for (int ai = 0; ai < 2; ++ai)
#pragma unroll
                for (int m = 0; m < 4; ++m) araw[ai][m] = *(const u32x4*)(Ab + aoff[ai][m] + k0);
            asm volatile("" ::: "memory");
#pragma unroll
            for (int bj = 0; bj < 2; ++bj)
#pragma unroll
                for (int n = 0; n < 2; ++n) {
                    u32x4 braw[4];
#pragma unroll
                    for (int i = 0; i < 4; ++i) { const int c = 128 * bj + 32 * wc + (Epi::PERM ? 8 * fq + 4 * n + i : 16 * n + 4 * fq + i); braw[i] = *(const u32x4*)(Bt + (size_t)c * K + k0); }
                    asm volatile("" ::: "memory");
#pragma unroll
                    for (int i = 0; i < 4; ++i)
#pragma unroll
                        for (int ai = 0; ai < 2; ++ai)
#pragma unroll
                            for (int m = 0; m < 4; ++m) { float s = acc[ai][bj][m][n][i];
#pragma unroll
                                for (int j = 0; j < 4; ++j) { const unsigned au = araw[ai][m][j], bu = braw[i][j];
                                    s = __builtin_amdgcn_fdot2_f32_bf16(__builtin_bit_cast(bf16x2_t, au), __builtin_bit_cast(bf16x2_t, bu), s, false); }
                                acc[ai][bj][m][n][i] = s; }
                }
        }
        E(acc, u, wr, wc, fr, fq);
    }
}


namespace pg8 {
constexpr int BM = 256, BK = 64, HALF = 128, HTB = HALF * BK * 2, STAGE_BYTES = 8 * HTB;
DEV int lds_byte(int r, int c) { const int st = (r >> 4) * 2 + (c >> 5), rr = r & 15, cc = c & 31, ob = rr * 64 + cc * 2; return st * 1024 + (ob ^ (((ob >> 9) & 1) << 5)); }
DEV void stage_rc(int b, int& R, int& C) { const int st = b / 1024, sb = b % 1024, swz = sb ^ (((sb >> 9) & 1) << 5); R = (st >> 1) * 16 + swz / 64; C = (st & 1) * 32 + (swz % 64) / 2; }
DEV int perm32(int rho) { const int n = rho >> 4, i = rho & 15; return 8 * (i >> 2) + 4 * n + (i & 3); }

typedef int v4i __attribute__((ext_vector_type(4)));
template <bool F8> struct Frag;
template <> struct Frag<false> { bf16x8 v; };
template <> struct Frag<true> { v8i v; };
DEV f32x4 frag_mfma(const Frag<false>& a, const Frag<false>& b, f32x4 c) { return __builtin_amdgcn_mfma_f32_16x16x32_bf16(a.v, b.v, c, 0, 0, 0); }
DEV f32x4 frag_mfma(const Frag<true>& a, const Frag<true>& b, f32x4 c) {
    asm volatile("v_mfma_f32_16x16x128_f8f6f4 %0, %1, %2, %0" : "+v"(c) : "v"(a.v), "v"(b.v)); return c; }
DEV void frag_load(Frag<false>& f, const LAS unsigned char* p0, const LAS unsigned char*) { f.v = *(const LAS bf16x8*)p0; }
typedef short s16x16_a16 __attribute__((ext_vector_type(16), aligned(16)));
typedef short s16x16 __attribute__((ext_vector_type(16)));
DEV void frag_load(Frag<true>& f, const LAS unsigned char* p0, const LAS unsigned char*) { const bf16x8 lo = *(const LAS bf16x8*)p0, hi = *(const LAS bf16x8*)(p0 + 16);
    const s16x16 t = __builtin_shufflevector(lo, hi, 0, 1, 2, 3, 4, 5, 6, 7, 8, 9, 10, 11, 12, 13, 14, 15); f.v = __builtin_bit_cast(v8i, t); }
template <class Epi, class Sched>
DEV void gemm_phase(LAS unsigned char* lds, const Sched& S, const Epi& E, int wv, unsigned char* dbg_ws = nullptr) {
    const int tid = opaque_tid(wv);
    const int wid = __builtin_amdgcn_readfirstlane(tid >> 6), lane = tid & 63, wr = wid >> 2, wc = wid & 3, fr = lane & 15, fq = lane >> 4;
    constexpr int EB = Sched::EB; constexpr bool F8 = (EB == 1); constexpr int KF = F8 ? 1 : 2;
    const int KB = S.K * EB, nt = KB / (BK * 2);
    unsigned voffA[2], voffB[2];
#pragma unroll
    for (int i = 0; i < 2; ++i) { int R, C; stage_rc(tid * 16 + i * 8192, R, C); const int Rb = Epi::PERM ? ((R & ~31) + perm32(R & 31)) : R;
        voffA[i] = (unsigned)(R * KB) + (unsigned)C * 2u; voffB[i] = (unsigned)(Rb * KB) + (unsigned)C * 2u; }
    const size_t kstep = (size_t)(BK * 2);
    const size_t hstep = (size_t)HALF * KB;
    const unsigned ldsw = (unsigned)wid * 1024u;
    const int aoff = F8 ? lds_byte(wr * 64 + fr, fq * 16) : lds_byte(wr * 64 + fr, fq * 8), boff = F8 ? lds_byte(wc * 32 + fr, fq * 16) : lds_byte(wc * 32 + fr, fq * 8);
    const int aoff1 = lds_byte(wr * 64 + fr, fq * 16 + 8), boff1 = lds_byte(wc * 32 + fr, fq * 16 + 8);
#define PG8_SA(b, h) (((b) * 2 + (h)) * HTB)
#define PG8_SB(b, h) ((4 + (b) * 2 + (h)) * HTB)
#define PG8_STAGE(bufoff, gbase, voff) do { _Pragma("unroll") for (int _i = 0; _i < 2; ++_i) \
        __builtin_amdgcn_global_load_lds((const unsigned*)((const char*)(gbase) + (voff)[_i]), (LAS unsigned*)(lds + (bufoff) + ldsw + _i * 8192), 16, 0, 0); } while (0)
#define PG8_LDA(dst, b, h) do { _Pragma("unroll") for (int m = 0; m < 4; ++m) _Pragma("unroll") for (int k = 0; k < KF; ++k) frag_load(dst[m][k], lds + PG8_SA(b, h) + aoff + m * 2048 + k * 1024, lds + PG8_SA(b, h) + aoff1 + m * 2048); } while (0)
#define PG8_LDB(dst, b, h) do { _Pragma("unroll") for (int n = 0; n < 2; ++n) _Pragma("unroll") for (int k = 0; k < KF; ++k) frag_load(dst[n][k], lds + PG8_SB(b, h) + boff + n * 2048 + k * 1024, lds + PG8_SB(b, h) + boff1 + n * 2048); } while (0)
#define PG8_MMA(ai, bj, At, Bt) do { if (!Sched::RAGGED || (ai) * 128 + wr * 64 < nrows) { __builtin_amdgcn_s_setprio(1); _Pragma("unroll") for (int m = 0; m < 4; ++m) _Pragma("unroll") for (int n = 0; n < 2; ++n) _Pragma("unroll") for (int k = 0; k < KF; ++k) \
        acc[ai][bj][m][n] = frag_mfma(Bt[n][k], At[m][k], acc[ai][bj][m][n]); __builtin_amdgcn_s_setprio(0); } } while (0)
#define PG8_WAIT_V(n) asm volatile("s_waitcnt vmcnt(" #n ")" ::: "memory")
#define PG8_WAIT_L(n) asm volatile("s_waitcnt lgkmcnt(" #n ")" ::: "memory")
#define PG8_BAR __builtin_amdgcn_s_barrier()
#define PG8_SCHED __builtin_amdgcn_sched_barrier(0)
    Unit cur, nxt; int ui = 0;
    if (!S.next(0, cur)) return;
    f32x4 acc[2][2][4][2];
#pragma unroll
    for (int a = 0; a < 2; ++a)
#pragma unroll
        for (int b = 0; b < 2; ++b)
#pragma unroll
            for (int m = 0; m < 4; ++m)
#pragma unroll
                for (int n = 0; n < 2; ++n) acc[a][b][m][n] = (f32x4){0.f, 0.f, 0.f, 0.f};
    Frag<F8> At[4][KF], B0[2][KF], B1[2][KF];
    const char* cA = S.a_ptr(cur); const char* cB = S.b_ptr(cur);
    int nrows = cur.rows;
    PG8_STAGE(PG8_SB(0, 0), cB, voffB); PG8_STAGE(PG8_SB(0, 1), cB + hstep, voffB); PG8_STAGE(PG8_SA(0, 0), cA, voffA); PG8_STAGE(PG8_SA(0, 1), cA + hstep, voffA);
    if (wr == 1) PG8_BAR;
    PG8_WAIT_V(2); PG8_BAR;
    PG8_STAGE(PG8_SB(1, 0), cB + kstep, voffB); PG8_STAGE(PG8_SA(1, 0), cA + kstep, voffA); PG8_STAGE(PG8_SB(1, 1), cB + hstep + kstep, voffB);
    PG8_WAIT_V(6); PG8_BAR;
#ifdef DBG_GT_NN
    unsigned long long gt_k = 0, gt_e = 0, gt_t = 0; const bool gt_on = (S.nN == DBG_GT_NN) && blockIdx.x == 0 && tid == 0; const unsigned long long gt_begin = __builtin_amdgcn_s_memrealtime();
#endif
    for (;;) {
#ifdef DBG_GT_NN
        const unsigned long long gt0 = __builtin_amdgcn_s_memrealtime();
#endif
        const bool has_next = S.next(ui + 1, nxt);
        const char* nA = has_next ? S.a_ptr(nxt) : cA; const char* nB = has_next ? S.b_ptr(nxt) : cB;
        for (int t = 0; t < nt; t += 2) {
            const bool last = (t == nt - 2);
            const char* a1 = cA + (size_t)(t + 1) * kstep;
            const char* a2 = last ? nA : cA + (size_t)(t + 2) * kstep; const char* b2 = last ? nB : cB + (size_t)(t + 2) * kstep;
            const char* a3 = a2 + kstep; const char* b3 = b2 + kstep;
            PG8_LDB(B0, 0, 0); PG8_LDB(B1, 0, 1); PG8_SCHED; PG8_LDA(At, 0, 0); PG8_STAGE(PG8_SA(1, 1), a1 + hstep, voffA);
            PG8_WAIT_V(8); PG8_WAIT_L(0); PG8_BAR; PG8_MMA(0, 0, At, B0); PG8_MMA(0, 1, At, B1); PG8_BAR; PG8_SCHED;
            PG8_LDA(At, 0, 1); PG8_STAGE(PG8_SB(0, 0), b2, voffB); PG8_STAGE(PG8_SB(0, 1), b2 + hstep, voffB); PG8_STAGE(PG8_SA(0, 0), a2, voffA);
            PG8_WAIT_V(8); PG8_WAIT_L(0); PG8_BAR; PG8_MMA(1, 0, At, B0); PG8_MMA(1, 1, At, B1); PG8_BAR; PG8_SCHED;
            PG8_LDB(B0, 1, 0); PG8_LDB(B1, 1, 1); PG8_SCHED; PG8_LDA(At, 1, 0); PG8_STAGE(PG8_SA(0, 1), a2 + hstep, voffA);
            PG8_WAIT_V(8); PG8_WAIT_L(0); PG8_BAR; PG8_MMA(0, 0, At, B0); PG8_MMA(0, 1, At, B1); PG8_BAR; PG8_SCHED;
            PG8_LDA(At, 1, 1); PG8_STAGE(PG8_SB(1, 0), b3, voffB); PG8_STAGE(PG8_SB(1, 1), b3 + hstep, voffB); PG8_STAGE(PG8_SA(1, 0), a3, voffA);
            PG8_WAIT_V(8); PG8_WAIT_L(0); PG8_BAR; PG8_MMA(1, 0, At, B0); PG8_MMA(1, 1, At, B1); PG8_BAR; PG8_SCHED;
        }
#ifdef DBG_GT_NN
        const unsigned long long gt1 = __builtin_amdgcn_s_memrealtime();
#endif
        if (wr == 0) PG8_BAR;
        if constexpr (F8) asm volatile("s_nop 15\n\ts_nop 15" ::: "memory");
        E(acc, cur, wr, wc, fr, fq);
#ifdef DBG_EPI2
        asm volatile("" ::: "memory"); E(acc, cur, wr, wc, fr, fq);
#endif
#ifdef DBG_GT_NN
        { const unsigned long long gt2 = __builtin_amdgcn_s_memrealtime(); gt_k += gt1 - gt0; gt_e += gt2 - gt1; gt_t = gt2 - gt_begin;
          if (gt_on) { unsigned long long* tsp = (unsigned long long*)(dbg_ws + WS_CTL + 49152); tsp[40] = 0; tsp[41] = gt_k; tsp[42] = gt_k + gt_e; tsp[43] = gt_t; tsp[44] = (unsigned long long)(ui + 1) * 1000; if (ui == 0) { tsp[45] = 0; tsp[46] = gt1 - gt0; } } }
#endif
        if (!has_next) break;
#pragma unroll
        for (int a = 0; a < 2; ++a)
#pragma unroll
            for (int b = 0; b < 2; ++b)
#pragma unroll
                for (int m = 0; m < 4; ++m)
#pragma unroll
                    for (int n = 0; n < 2; ++n) acc[a][b][m][n] = (f32x4){0.f, 0.f, 0.f, 0.f};
        cur = nxt; cA = nA; cB = nB; nrows = cur.rows; ++ui;
        if (wr == 1) PG8_BAR;
    }
    PG8_WAIT_V(0);
    PG8_BAR;
#undef PG8_SA
#undef PG8_SB
#undef PG8_STAGE
#undef PG8_LDA
#undef PG8_LDB
#undef PG8_MMA
#undef PG8_WAIT_V
#undef PG8_WAIT_L
#undef PG8_BAR
#undef PG8_SCHED
}
}

__host__ __device__ inline int ropeoff(int q) { return 64 * (q & 3) + 32 * (q >> 2); }
__host__ __device__ inline int in0_logcol(int g32) {
    const int tile = g32 >> 3, q = g32 & 7;
    switch (tile) {
        case 0: return 0 + q * 32; case 1: return 256 + q * 32;
        case 2: case 3: return 512 + (tile - 2) * 256 + q * 32;
        case 4: case 5: return 1040 + (tile - 4) * 256 + q * 32;
        case 6: case 7: return 1552 + (tile - 6) * 256 + ropeoff(q);
        case 8: case 9: return 2064 + (tile - 8) * 256 + ropeoff(q);
        default: return 2576 + (tile - 10) * 256 + q * 32;
    }
}
__host__ __device__ inline int in1_logcol(int g32) {
    const int tile = g32 >> 3, q = g32 & 7;
    if (tile < 4) return tile * 256 + q * 32;
    if (tile == 4) return 1024 + ropeoff(q);
    if (tile == 5) return 1280 + ropeoff(q);
    return 1536 + (tile - 6) * 256 + q * 32;
}
DEV void conv_item(const float* W, int ldw, int logcol0, int k0, bf16_t* Wt_row0, int Kd, LAS float* scr, int lane) {
#pragma unroll 8
    for (int i = 0; i < 32; ++i) { const int kk = 2 * i + (lane >> 5); scr[kk * 33 + (lane & 31)] = W[(size_t)(k0 + kk) * ldw + logcol0 + (lane & 31)]; }
    asm volatile("s_waitcnt lgkmcnt(0)" ::: "memory");
    const int c = lane & 7;
#pragma unroll
    for (int j = 0; j < 4; ++j) { const int n = (lane >> 3) + 8 * j; const LAS float* s = scr + (8 * c) * 33 + n;
        u32x4 o; o.x = pk2(s[0 * 33], s[1 * 33]); o.y = pk2(s[2 * 33], s[3 * 33]); o.z = pk2(s[4 * 33], s[5 * 33]); o.w = pk2(s[6 * 33], s[7 * 33]);
        *(u32x4*)(Wt_row0 + (size_t)n * Kd + k0 + 8 * c) = o; }
    asm volatile("s_waitcnt lgkmcnt(0)" ::: "memory");
}
DEV void sincos_d(double x, float& s, float& c) {
    const double k = __builtin_rint(x * 0.63661977236758134308);
    const double r = (x - k * 1.5707963267948966192) - k * 6.123233995736766e-17;
    const double r2 = r * r;
    double sp = -7.647163731819816e-13; sp = sp * r2 + 1.605904383682161e-10; sp = sp * r2 - 2.505210838544172e-08; sp = sp * r2 + 2.755731922398589e-06;
    sp = sp * r2 - 1.984126984126984e-04; sp = sp * r2 + 8.333333333333333e-03; sp = sp * r2 - 1.666666666666667e-01; sp = r + r * r2 * sp;
    double cp = 4.779477332387385e-14; cp = cp * r2 - 1.147074559772972e-11; cp = cp * r2 + 2.087675698786810e-09; cp = cp * r2 - 2.755731922398589e-07;
    cp = cp * r2 + 2.480158730158730e-05; cp = cp * r2 - 1.388888888888889e-03; cp = cp * r2 + 4.166666666666666e-02; cp = cp * r2 - 0.5; cp = 1.0 + r2 * cp;
    const int q = ((int)k) & 3;
    const double ss = (q == 0) ? sp : (q == 1) ? cp : (q == 2) ? -sp : -cp;
    const double cc = (q == 0) ? cp : (q == 1) ? -sp : (q == 2) ? -cp : sp;
    s = (float)ss; c = (float)cc;
}
DEV void conv_item_f8(const float* W, int ldw, int logcol0, int k0, unsigned char* Wt_row0, int Kd, LAS float* scr, int lane, float scale) {
#pragma unroll 8
    for (int i = 0; i < 32; ++i) { const int kk = 2 * i + (lane >> 5); scr[kk * 33 + (lane & 31)] = W[(size_t)(k0 + kk) * ldw + logcol0 + (lane & 31)]; }
    asm volatile("s_waitcnt lgkmcnt(0)" ::: "memory");
    const int c = lane & 7;
#pragma unroll
    for (int j = 0; j < 4; ++j) { const int n = (lane >> 3) + 8 * j; const LAS float* sp = scr + (8 * c) * 33 + n;
        u32x2 o; o.x = pk4_fp8(sp[0 * 33] * scale, sp[1 * 33] * scale, sp[2 * 33] * scale, sp[3 * 33] * scale); o.y = pk4_fp8(sp[4 * 33] * scale, sp[5 * 33] * scale, sp[6 * 33] * scale, sp[7 * 33] * scale);
        *(u32x2*)(Wt_row0 + (size_t)n * Kd + k0 + 8 * c) = o; }
    asm volatile("s_waitcnt lgkmcnt(0)" ::: "memory");
}
DEV void conv_item64_f8(const float* W, int ldw, int logcol0, int k0, unsigned char* Wt_row0, int Kd, LAS float* scr, int lane, float scale) {
#pragma unroll 8
    for (int i = 0; i < 16; ++i) { const int kk = 4 * i + (lane >> 4), c4 = (lane & 15) * 4;
        const f32x4 v = __builtin_nontemporal_load((const f32x4*)(W + (size_t)(k0 + kk) * ldw + logcol0 + c4));
        LAS float* d = scr + kk * 65 + c4; d[0] = v[0]; d[1] = v[1]; d[2] = v[2]; d[3] = v[3]; }
    asm volatile("s_waitcnt lgkmcnt(0)" ::: "memory");
    const int c = lane & 7;
#pragma unroll
    for (int j = 0; j < 8; ++j) { const int n = (lane >> 3) + 8 * j; const LAS float* sp = scr + (8 * c) * 65 + n;
        u32x2 o; o.x = pk4_fp8(sp[0 * 65] * scale, sp[1 * 65] * scale, sp[2 * 65] * scale, sp[3 * 65] * scale); o.y = pk4_fp8(sp[4 * 65] * scale, sp[5 * 65] * scale, sp[6 * 65] * scale, sp[7 * 65] * scale);
        *(u32x2*)(Wt_row0 + (size_t)n * Kd + k0 + 8 * c) = o; }
    asm volatile("s_waitcnt lgkmcnt(0)" ::: "memory");
}
DEV void conv_experts(const Params& P, LAS unsigned char* lds, int wv, int layer, int blk0, int nblk) {
    const int tid = opaque_tid(wv), lane = tid & 63;
    unsigned char* ws = opaque_ws(P.ws);
    const int gw = ((int)blockIdx.x - blk0) * NWAVES + wv, NGW = nblk * NWAVES;
    constexpr int I_W1 = 32 * 16 * 32, I_W2 = 32 * 16 * 16;
    const int kg = lane >> 4, ng = lane & 15;
    for (int it0 = gw; it0 < I_W1 + I_W2; it0 += NGW) {
        const float* src; int ldw; unsigned char* dst;
        if (it0 < I_W1) { const int it = it0 + layer * I_W1, le = it / 512, q = it % 512, kb = q / 32, g = q % 32, pn = g >> 2, qq = g & 3;
            const int logcol = (qq >> 1) * 1024 + 128 * pn + 64 * (qq & 1);
            src = (const float*)P.in[23] + (size_t)le * 1024 * 2048 + (size_t)(kb * 64) * 2048 + logcol; ldw = 2048; dst = ws + WS_W1 + ((size_t)le * 2048 + g * 64) * 1024 + kb * 64;
        } else { const int r = it0 - I_W1 + layer * I_W2, le = r / 256, q = r % 256, kb = q / 16, g = q % 16;
            src = (const float*)P.in[25] + (size_t)le * 1024 * 1024 + (size_t)(kb * 64) * 1024 + g * 64; ldw = 1024; dst = ws + WS_W2 + ((size_t)le * 1024 + g * 64) * 1024 + kb * 64; }
        f32x4 v[16];
#pragma unroll
        for (int i = 0; i < 16; ++i) v[i] = __builtin_nontemporal_load((const f32x4*)(src + (size_t)(16 * kg + i) * ldw + 4 * ng));
#pragma unroll
        for (int jj = 0; jj < 4; ++jj) { u32x4 o;
#pragma unroll
            for (int q = 0; q < 4; ++q) o[q] = pk4_fp8(v[4 * q][jj] * W8_SCALE, v[4 * q + 1][jj] * W8_SCALE, v[4 * q + 2][jj] * W8_SCALE, v[4 * q + 3][jj] * W8_SCALE);
            *(u32x4*)(dst + (size_t)(4 * ng + jj) * 1024 + 16 * kg) = o; }
    }
}
DEV void phase_prologue(const Params& P, LAS unsigned char* lds, int wv) {
    const int tid = opaque_tid(wv), lane = tid & 63, wid = tid >> 6, G = gridDim.x;
    unsigned char* ws = opaque_ws(P.ws);
    {
        LAS float* cact = (LAS float*)lds; LAS float* red = cact + 8192;
        const float* cin = (const float*)P.in[1]; const float* wada = (const float*)P.in[3]; const float* bada = (const float*)P.in[4];
        float* mod = (float*)(ws + WS_MOD);
        for (int unit = blockIdx.x; unit < 192; unit += G) {
            const int layer = unit / 96, col0 = (unit % 96) * 64;
            __syncthreads();
            for (int i = tid; i < 8192; i += NTHREADS) { const float c = cin[i]; cact[i] = c / (1.f + expf(-c)); }
            __syncthreads();
            const int cs = tid & 63, ks = tid >> 6;
            float acc[8];
#pragma unroll
            for (int b = 0; b < 8; ++b) acc[b] = 0.f;
            const float* W = wada + (size_t)layer * 1024 * 6144 + col0 + cs;
#pragma unroll 16
            for (int k = ks * 128; k < ks * 128 + 128; ++k) { const float w = W[(size_t)k * 6144];
#pragma unroll
                for (int b = 0; b < 8; ++b) acc[b] += cact[b * 1024 + k] * w; }
#pragma unroll
            for (int b = 0; b < 8; ++b) red[(ks * 8 + b) * 64 + cs] = acc[b];
            __syncthreads();
            { const int b = tid >> 6; float s = bada[layer * 6144 + col0 + cs];
#pragma unroll
              for (int k2 = 0; k2 < 8; ++k2) s += red[(k2 * 8 + b) * 64 + cs];
              mod[(size_t)(layer * 8 + b) * 6144 + col0 + cs] = s; }
        }
        __syncthreads();
    }
    const int gt = blockIdx.x * NTHREADS + tid, NGT = G * NTHREADS;
    {
        const int* pos = (const int*)P.in[2]; float* rope = (float*)(ws + WS_ROPE);
        for (int i = gt; i < NTOK * 32; i += NGT) { const int f = i & 31, t = i >> 5;
            const double invf = exp2(-(double)f * (13.287712379549449 / 32.0));
            float s, c; sincos_d((double)pos[t] * invf, s, c); rope[2 * (size_t)i] = c; rope[2 * (size_t)i + 1] = s; }
    }
    {
        const float* sw = (const float*)P.in[18]; bf16_t* o = (bf16_t*)(ws + WS_SGUW);
        for (int i = gt; i < 4 * 128 * 128; i += NGT) { const int j = i & 127, r = (i >> 7) & 127; o[i] = f2bf(j <= r ? sw[i] : 0.f); }
    }
    {
        LAS float* scr = (LAS float*)(lds + wid * 16384);
        const int gw = blockIdx.x * NWAVES + wid, NGW = G * NWAVES;
        constexpr int I_IN0 = 16 * 96, I_OUT = 16 * 32, I_IN1 = 16 * 80;
        constexpr int NITEMS = I_IN0 + I_OUT + I_IN1 + I_OUT;
        for (int it = gw; it < NITEMS; it += NGW) {
            int r = it;
            if (r < I_IN0) { const int kb = r / 96, g = r % 96; conv_item((const float*)P.in[5], 3088, in0_logcol(g), kb * 64, (bf16_t*)(ws + WS_WIN0) + (size_t)g * 32 * 1024, 1024, scr, lane); continue; } r -= I_IN0;
            if (r < I_OUT) { const int kb = r / 32, g = r % 32; conv_item((const float*)P.in[14], 1024, g * 32, kb * 64, (bf16_t*)(ws + WS_WOUT0) + (size_t)g * 32 * 1024, 1024, scr, lane); continue; } r -= I_OUT;
            if (r < I_IN1) { const int kb = r / 80, g = r % 80; conv_item((const float*)P.in[15], 2560, in1_logcol(g), kb * 64, (bf16_t*)(ws + WS_WIN1) + (size_t)g * 32 * 1024, 1024, scr, lane); continue; } r -= I_IN1;
            { const int kb = r / 32, g = r % 32; conv_item((const float*)P.in[20], 1024, g * 32, kb * 64, (bf16_t*)(ws + WS_WOUT1) + (size_t)g * 32 * 1024, 1024, scr, lane); }
        }
    }
}

template <int MODE> struct PrenormRow { f32x4 x[4]; unsigned y[4][4]; f32x4 g2[4], sh[4], sc[4]; };
template <int MODE, bool XBF>
DEV void prenorm_load(PrenormRow<MODE>& r, int row, int lane, const void* xin, const unsigned char* YB, const float* mod, int layer_mod, int modoff, int layer_prev) {
    const int b = row >> 11;
#pragma unroll
    for (int j = 0; j < 4; ++j) r.x[j] = ld_res4<XBF>(xin, (size_t)row * DM + 4 * lane + 256 * j);
    if (MODE & 1) {
#pragma unroll
        for (int k = 0; k < 4; ++k) { const unsigned* yr = (const unsigned*)(YB + ((size_t)row * 4 + k) * 1024) + lane;
#pragma unroll
            for (int j = 0; j < 4; ++j) r.y[k][j] = yr[64 * j]; }
        const float* g2 = mod + (size_t)(layer_prev * 8 + b) * 6144 + 5 * 1024;
#pragma unroll
        for (int j = 0; j < 4; ++j) r.g2[j] = *((const f32x4*)g2 + lane + 64 * j);
    }
    if (!(MODE & 8)) { const float* mrow = mod + (size_t)(layer_mod * 8 + b) * 6144 + modoff;
#pragma unroll
        for (int j = 0; j < 4; ++j) { r.sh[j] = *((const f32x4*)mrow + lane + 64 * j); r.sc[j] = *((const f32x4*)(mrow + 1024) + lane + 64 * j); } }
}
template <int MODE, bool XBF>
DEV void phase_prenorm(const Params& P, LAS unsigned char* lds, int wv, const void* xin, void* xout, int layer_mod, int modoff  , int layer_prev) {
    const int tid = opaque_tid(wv), lane = tid & 63, wid = tid >> 6, G = gridDim.x;
    unsigned char* ws = opaque_ws(P.ws);
    const float* mod = (const float*)(ws + WS_MOD);
    bf16_t* H = (bf16_t*)(ws + WS_H);
    const unsigned char* YB = ws + WS_YB;
    f32x4 fgv[4];
    if (MODE & 8) { const float* fg = (const float*)P.in[27];
#pragma unroll
        for (int j = 0; j < 4; ++j) fgv[j] = *((const f32x4*)fg + lane + 64 * j); }
    const int stride = G * NWAVES;
    int row = blockIdx.x * NWAVES + wid;
    PrenormRow<MODE> cur, nxt;
    if (row < NTOK) prenorm_load<MODE, XBF>(cur, row, lane, xin, YB, mod, layer_mod, modoff, layer_prev);
    for (; row < NTOK; row += stride) {
        const bool more = row + stride < NTOK;
        if (more) prenorm_load<MODE, XBF>(nxt, row + stride, lane, xin, YB, mod, layer_mod, modoff, layer_prev);
        f32x4 v[4];
#pragma unroll
        for (int j = 0; j < 4; ++j) v[j] = cur.x[j];
        if (MODE & 1) {
#pragma unroll
            for (int j = 0; j < 4; ++j) { f32x4 m4 = {0.f, 0.f, 0.f, 0.f};
#pragma unroll
                for (int k = 0; k < 4; ++k) { const unsigned w = cur.y[k][j]; const f32x2 lo = __builtin_amdgcn_cvt_pk_f32_fp8(w, false), hi = __builtin_amdgcn_cvt_pk_f32_fp8(w, true);
                    m4[0] += lo[0]; m4[1] += lo[1]; m4[2] += hi[0]; m4[3] += hi[1]; }
                if (!((DBG_SKIP >> (1 + 2 * layer_prev)) & 1)) v[j] = v[j] + cur.g2[j] * m4 * ((layer_prev ? DBG_F_MOE1 : DBG_F_MOE0) * YB_INV); }
        }
        if (MODE & 2) {
#pragma unroll
            for (int j = 0; j < 4; ++j) st_res4<RES_BF16>(xout, (size_t)row * DM + 4 * lane + 256 * j, v[j]); }
        float ss = 0.f;
#pragma unroll
        for (int j = 0; j < 4; ++j) ss += (v[j][0] * v[j][0] + v[j][1] * v[j][1]) + (v[j][2] * v[j][2] + v[j][3] * v[j][3]);
        const float rstd = 1.0f / sqrtf(wave_sum(ss) * (1.f / DM) + EPS);
        if (MODE & 8) {
            f32x4* o = (f32x4*)(P.out + (size_t)row * DM) + lane;
#pragma unroll
            for (int j = 0; j < 4; ++j) { const f32x4 g = fgv[j];
#ifdef DBG_PROBE_OFF
                const float ps = ((const float*)(ws + WS_CTL))[1024] / ((float)NTOK * DBG_PROBE_NCOLS); const float pv = (DBG_PROBE_ABS ? ps : sqrtf(ps)) * DBG_PROBE_SCALE;
                const float alpha = 1.5f + 1.5f * fminf(fmaxf(pv, 0.f), 1.f);
                o[64 * j] = v[j] * rstd * g * alpha;
#elif defined(DBG_TS)
                { const unsigned long long* tsp = (const unsigned long long*)(ws + WS_CTL + 49152);
                  const float dt_us = (float)(tsp[DBG_TS + 1] - tsp[DBG_TS_FROM]) * 0.01f;
                  const float eps = sqrtf(fminf(dt_us * 0.001f, 1.4f) * 1e-3f);
                  f32x4 o4 = v[j] * rstd * g;
#pragma unroll
                  for (int t = 0; t < 4; ++t) { unsigned hsh = (unsigned)(row * 1024 + 4 * lane + 256 * j + t) * 2654435761u; hsh ^= hsh >> 15; o4[t] *= (hsh & 1u) ? (1.f + eps) : (1.f - eps); }
                  o[64 * j] = o4; }
#else
                o[64 * j] = v[j] * rstd * g;
#endif
            }
        } else {
            u32x2* ho = (u32x2*)(H + (size_t)row * DM) + lane;
#pragma unroll
            for (int j = 0; j < 4; ++j) { const f32x4 hv = v[j] * rstd * (cur.sc[j] + 1.0f) + cur.sh[j];
                u32x2 w; w.x = pk2(hv[0], hv[1]); w.y = pk2(hv[2], hv[3]); ho[64 * j] = w; }
        }
        if (more) cur = nxt;
    }
}


DEV void phase_prenorm_gate(const Params& P, LAS unsigned char* lds, int wv) {
    const int tid = opaque_tid(wv), lane = tid & 63, w = wv, G = gridDim.x;
    unsigned char* ws = opaque_ws(P.ws);
    const float* mod = (const float*)(ws + WS_MOD);
    const float* xin = (const float*)P.in[0]; const float* win = (const float*)P.in[5]; const float* wg = (const float*)P.in[6]; const float* bg = (const float*)P.in[7];
    bf16_t* H = (bf16_t*)(ws + WS_H); float* LA = (float*)(ws + WS_LA);
    constexpr int AS = 1028;
    LAS float* At = (LAS float*)lds;
    LAS float* red = At + 16 * AS;
    LAS float* grs = red + 8 * 16 * 16;
    float Bf[32];
#pragma unroll
    for (int s2 = 0; s2 < 32; ++s2) Bf[s2] = win[(size_t)(128 * w + 4 * s2 + (lane >> 4)) * 3088 + 1024 + (lane & 15)];
    const int gcol = tid & 255, ghalf = tid >> 8;
    float wgc[16];
#pragma unroll
    for (int r = 0; r < 16; ++r) wgc[r] = wg[r * 256 + gcol];
    const float bgc = bg[gcol];
    __syncthreads();
    for (int blk = blockIdx.x; blk < NTOK / 64; blk += G) {
        const int bb = (blk * 64) >> 11;
        const float* mrow = mod + (size_t)(0 * 8 + bb) * 6144;
        f32x4 sh[4], sc[4], xv[2][4];
#pragma unroll
        for (int j = 0; j < 4; ++j) { sh[j] = *((const f32x4*)mrow + lane + 64 * j); sc[j] = *((const f32x4*)(mrow + 1024) + lane + 64 * j); }
#pragma unroll
        for (int rr = 0; rr < 2; ++rr)
#pragma unroll
            for (int j = 0; j < 4; ++j) xv[rr][j] = *((const f32x4*)(xin + (size_t)(blk * 64 + 2 * w + rr) * DM) + lane + 64 * j);
        for (int g = 0; g < 4; ++g) {
            const int rbase = blk * 64 + 16 * g;
#pragma unroll
            for (int rr = 0; rr < 2; ++rr) {
                f32x4 v[4];
#pragma unroll
                for (int j = 0; j < 4; ++j) v[j] = xv[rr][j];
                float ss = 0.f;
#pragma unroll
                for (int j = 0; j < 4; ++j) ss += (v[j][0] * v[j][0] + v[j][1] * v[j][1]) + (v[j][2] * v[j][2] + v[j][3] * v[j][3]);
                const float rstd = 1.0f / sqrtf(wave_sum(ss) * (1.f / DM) + EPS);
                u32x2* ho = (u32x2*)(H + (size_t)(rbase + 2 * w + rr) * DM) + lane;
#pragma unroll
                for (int j = 0; j < 4; ++j) { v[j] = v[j] * rstd * (sc[j] + 1.0f) + sh[j];
                    u32x2 wq; wq.x = pk2(v[j][0], v[j][1]); wq.y = pk2(v[j][2], v[j][3]); ho[64 * j] = wq;
                    *(LAS f32x4*)(At + (2 * w + rr) * AS + 4 * lane + 256 * j) = v[j]; }
            }
            if (g < 3) {
#pragma unroll
                for (int rr = 0; rr < 2; ++rr)
#pragma unroll
                    for (int j = 0; j < 4; ++j) xv[rr][j] = *((const f32x4*)(xin + (size_t)(rbase + 16 + 2 * w + rr) * DM) + lane + 64 * j);
            }
            LBAR();
            f32x4 acc = {0.f, 0.f, 0.f, 0.f};
            const LAS float* ap = At + (lane & 15) * AS + 128 * w + (lane >> 4);
#pragma unroll
            for (int s2 = 0; s2 < 32; ++s2) acc = __builtin_amdgcn_mfma_f32_16x16x4f32(ap[4 * s2], Bf[s2], acc, 0, 0, 0);
#pragma unroll
            for (int t = 0; t < 4; ++t) red[(w * 16 + (lane >> 4) * 4 + t) * 16 + (lane & 15)] = acc[t];
            LBAR();
            if (tid < 256) { float sum = 0.f;
#pragma unroll
                for (int w2 = 0; w2 < 8; ++w2) sum += red[w2 * 256 + tid];
                grs[tid] = sum; }
            LBAR();
            {
#pragma unroll
                for (int q = 0; q < 8; ++q) { const int rl = 8 * ghalf + q; float z = bgc;
#pragma unroll
                    for (int r = 0; r < 16; ++r) z += grs[rl * 16 + r] * wgc[r];
                    LA[(size_t)(rbase + rl) * 256 + gcol] = log_sigmoid_f(z) * 0.0625f; }
            }
            LBAR();
        }
    }
}

DEV void phase_router(const Params& P, LAS unsigned char* lds, int wv, const void* xin, int layer) {
    const int tid = opaque_tid(wv), lane = tid & 63, w = wv, G = gridDim.x;
    unsigned char* ws = opaque_ws(P.ws);
    const float* mod = (const float*)(ws + WS_MOD);
    const float* rw = (const float*)P.in[21] + (size_t)layer * 1024 * 32; const float* rb = (const float*)P.in[22] + layer * 32;
    int* cnt = (int*)(ws + WS_CTL) + CW_CNT + layer * NEXP * CNT_STRIDE; int* ent = (int*)(ws + WS_ENT) + (size_t)layer * NEXP * ENT_CAP;
    float* gl = (float*)(ws + WS_GL) + (size_t)layer * NEXP * ENT_CAP;
    unsigned char* XQ = ws + WS_XQ;
    constexpr int AS = 1028;
    LAS float* At = (LAS float*)lds;
    LAS float* red = At + 16 * AS;
    LAS int* lcnt = (LAS int*)(red + 8 * 16 * 32);
    LAS int* gbase = lcnt + 32;
    LAS int* elist = gbase + 32;
    LAS float* gsave = (LAS float*)(elist + 256);
    LAS unsigned char* hq = (LAS unsigned char*)(gsave + 256);
    if (tid < NEXP) lcnt[tid] = 0;
    __syncthreads();
    float Bf[2][32];
#pragma unroll
    for (int s2 = 0; s2 < 32; ++s2)
#pragma unroll
        for (int n = 0; n < 2; ++n) Bf[n][s2] = rw[(size_t)(128 * w + 4 * s2 + (lane >> 4)) * 32 + 16 * n + (lane & 15)];
    for (int blk = blockIdx.x; blk < NTOK / 64; blk += G) {
        const int bb = (blk * 64) >> 11;
        const float* mrow = mod + (size_t)(layer * 8 + bb) * 6144 + 3072;
        f32x4 sh[4], sc[4], xv[2][4];
#pragma unroll
        for (int j = 0; j < 4; ++j) { sh[j] = *((const f32x4*)mrow + lane + 64 * j); sc[j] = *((const f32x4*)(mrow + 1024) + lane + 64 * j); }
#pragma unroll
        for (int rr = 0; rr < 2; ++rr)
#pragma unroll
            for (int j = 0; j < 4; ++j) xv[rr][j] = ld_res4<RES_BF16>(xin, (size_t)(blk * 64 + 2 * w + rr) * DM + 4 * lane + 256 * j);
        for (int g = 0; g < 4; ++g) {
            const int rbase = blk * 64 + 16 * g;
#pragma unroll
            for (int rr = 0; rr < 2; ++rr) {
                f32x4 v[4];
#pragma unroll
                for (int j = 0; j < 4; ++j) v[j] = xv[rr][j];
                float ss = 0.f;
#pragma unroll
                for (int j = 0; j < 4; ++j) ss += (v[j][0] * v[j][0] + v[j][1] * v[j][1]) + (v[j][2] * v[j][2] + v[j][3] * v[j][3]);
                const float rstd = 1.0f / sqrtf(wave_sum(ss) * (1.f / DM) + EPS);
#pragma unroll
                for (int j = 0; j < 4; ++j) { v[j] = v[j] * rstd * (sc[j] + 1.0f) + sh[j];
                    *((LAS unsigned*)(hq + (16 * g + 2 * w + rr) * 1024) + lane + 64 * j) = pk4_fp8(v[j][0], v[j][1], v[j][2], v[j][3]);
                    *(LAS f32x4*)(At + (2 * w + rr) * AS + 4 * lane + 256 * j) = v[j]; }
            }
            if (g < 3) {
#pragma unroll
                for (int rr = 0; rr < 2; ++rr)
#pragma unroll
                    for (int j = 0; j < 4; ++j) xv[rr][j] = ld_res4<RES_BF16>(xin, (size_t)(rbase + 16 + 2 * w + rr) * DM + 4 * lane + 256 * j);
            }
            LBAR();
            f32x4 acc0 = {0.f, 0.f, 0.f, 0.f}, acc1 = {0.f, 0.f, 0.f, 0.f};
            const LAS float* ap = At + (lane & 15) * AS + 128 * w + (lane >> 4);
#pragma unroll
            for (int s2 = 0; s2 < 32; ++s2) { const float av = ap[4 * s2];
                acc0 = __builtin_amdgcn_mfma_f32_16x16x4f32(av, Bf[0][s2], acc0, 0, 0, 0); acc1 = __builtin_amdgcn_mfma_f32_16x16x4f32(av, Bf[1][s2], acc1, 0, 0, 0); }
#pragma unroll
            for (int t = 0; t < 4; ++t) { red[(w * 16 + (lane >> 4) * 4 + t) * 32 + (lane & 15)] = acc0[t]; red[(w * 16 + (lane >> 4) * 4 + t) * 32 + 16 + (lane & 15)] = acc1[t]; }
            LBAR();
            {
                const int half = lane >> 5, e = lane & 31, rl = 2 * w + half, row = rbase + rl;
                float lg = rb[e];
#pragma unroll
                for (int w2 = 0; w2 < 8; ++w2) lg += red[(w2 * 16 + rl) * 32 + e];
                float tv[4]; int ti[4]; float cur = lg;
#pragma unroll
                for (int r4 = 0; r4 < 4; ++r4) {
                    float mx = cur;
#pragma unroll
                    for (int o = 1; o < 32; o <<= 1) mx = fmaxf(mx, __shfl_xor(mx, o));
                    const unsigned long long bal = __ballot(cur == mx);
                    const unsigned mine = (unsigned)(bal >> (32 * half));
                    const int sel = __builtin_ctz(mine);
                    tv[r4] = mx; ti[r4] = sel; if (e == sel) cur = -INFINITY;
                }
                const float e1 = __expf(tv[1] - tv[0]), e2 = __expf(tv[2] - tv[0]), e3 = __expf(tv[3] - tv[0]);
                const float inv = 1.f / (1.f + e1 + e2 + e3);
                if (e < 4) { const int ex = e == 0 ? ti[0] : e == 1 ? ti[1] : e == 2 ? ti[2] : ti[3];
                    const float gv = (e == 0 ? 1.f : e == 1 ? e1 : e == 2 ? e2 : e3) * inv;
                    const int lpos = __hip_atomic_fetch_add(lcnt + ex, 1, __ATOMIC_RELAXED, __HIP_MEMORY_SCOPE_WORKGROUP); elist[(16 * g + rl) * 4 + e] = (ex << 16) | lpos; gsave[(16 * g + rl) * 4 + e] = gv; }
            }
            LBAR();
        }
        if (tid < NEXP) { const int n = lcnt[tid]; gbase[tid] = n ? atomicAdd(cnt + tid * CNT_STRIDE, n) : 0; }
        __syncthreads();
        if (tid < 256) { const int pk = elist[tid], ex = pk >> 16, lpos = pk & 0xffff; const int pos = gbase[ex] + lpos; ent[ex * ENT_CAP + pos] = blk * 256 + tid; gl[ex * ENT_CAP + pos] = gsave[tid]; elist[tid] = ex * ENT_CAP + pos; }
        __syncthreads();
#pragma unroll 4
        for (int q = 0; q < 32; ++q) { const int en = w + NWAVES * q; const int dstrow = elist[en];
            *((u32x4*)(XQ + (size_t)dstrow * DM) + lane) = *((const LAS u32x4*)(hq + (en >> 2) * 1024) + lane); }
        __syncthreads();
        if (tid < NEXP) lcnt[tid] = 0;
    }
}

DEV void attn_unit_ref(int b, int vh, int qb, const bf16_t* Z, bf16_t* OP, int wv) {
    const int tid = opaque_tid(wv);
    if (tid >= 256) return;
    const int h = vh >> 2, m = (vh >> 1) & 1, vhalf = vh & 1;
    const size_t rowbase = (size_t)b * SEQ;
    const int i = qb * 256 + tid;
    const bf16_t* Qr = Z + (rowbase + i) * Z0P + 1536 + h * 128 + m * 64;
    const bf16_t* Kb = Z + rowbase * Z0P + 2048 + h * 128 + m * 64;
    const bf16_t* Vb = Z + rowbase * Z0P + 2560 + h * 128 + vhalf * 64;
    float q[64], o[64];
#pragma unroll
    for (int d0 = 0; d0 < 8; ++d0) { float t[8]; unpack8(*(const bf16x8*)(Qr + d0 * 8), t);
#pragma unroll
        for (int j = 0; j < 8; ++j) { q[d0 * 8 + j] = t[j]; o[d0 * 8 + j] = 0.f; } }
    float mx = -INFINITY, l = 0.f;
    const int jend = qb * 256 + 255;
    for (int j = 0; j <= jend; ++j) {
        const bf16_t* kr = Kb + (size_t)j * Z0P; const bf16_t* vr = Vb + (size_t)j * Z0P;
        float s = 0.f;
#pragma unroll
        for (int d0 = 0; d0 < 8; ++d0) { float t[8]; unpack8(*(const bf16x8*)(kr + d0 * 8), t);
#pragma unroll
            for (int jj = 0; jj < 8; ++jj) s += q[d0 * 8 + jj] * t[jj]; }
        if (j > i) s = -INFINITY;
        if (s > mx) { const float al = __builtin_amdgcn_exp2f(mx - s); l *= al;
#pragma unroll
            for (int e = 0; e < 64; ++e) o[e] *= al;
            mx = s; }
        const float p = __builtin_amdgcn_exp2f(s - mx); l += p;
#pragma unroll
        for (int d0 = 0; d0 < 8; ++d0) { float t[8]; unpack8(*(const bf16x8*)(vr + d0 * 8), t);
#pragma unroll
            for (int jj = 0; jj < 8; ++jj) o[d0 * 8 + jj] += p * t[jj]; }
    }
    const float il = 1.f / l;
    bf16_t* Or = OP + (rowbase + i) * 1024 + vh * 64;
#pragma unroll
    for (int d0 = 0; d0 < 8; ++d0) { u32x4 w; w.x = pk2(o[d0 * 8] * il, o[d0 * 8 + 1] * il); w.y = pk2(o[d0 * 8 + 2] * il, o[d0 * 8 + 3] * il);
        w.z = pk2(o[d0 * 8 + 4] * il, o[d0 * 8 + 5] * il); w.w = pk2(o[d0 * 8 + 6] * il, o[d0 * 8 + 7] * il); *(u32x4*)(Or + d0 * 8) = w; }
}

struct LinAttnArgs {
    const bf16_t* q; const bf16_t* k; const bf16_t* v; const bf16_t* og;
    int zp; const float* la;
    float log_g;
    const float* gain;
    bf16_t* out;
};
template <int C>
DEV void linattn_unit_ref(const LinAttnArgs& a, LAS unsigned char* lds, int wv) {
    const int tid = opaque_tid(wv), lane = tid & 63, wid = tid >> 6;
    LAS bf16_t* qd = (LAS bf16_t*)lds;
    LAS bf16_t* ka = qd + C * 64;
    LAS bf16_t* vv = ka + C * 64;
    LAS float* bsc = (LAS float*)(vv + C * 128);
    LAS bf16_t* Sm = (LAS bf16_t*)bsc;
    LAS float* st = bsc + C * 64;
    LAS float* dec = st + 64 * 128;
    __syncthreads();
    for (int i = tid; i < 64 * 128; i += NTHREADS) st[i] = 0.f;
    for (int n = 0; n < SEQ / C; ++n) {
        const size_t r0 = (size_t)n * C;
        __syncthreads();
        for (int i = tid; i < C * 64; i += NTHREADS) { const int r = i >> 6, d = i & 63; bsc[i] = a.la ? a.la[(r0 + r) * 256 + d] : a.log_g; }
        for (int i = tid; i < C * 16; i += NTHREADS) { const int r = i >> 4, c8 = i & 15; *(LAS u32x4*)(vv + r * 128 + c8 * 8) = *(const u32x4*)(a.v + (r0 + r) * a.zp + c8 * 8); }
        __syncthreads();
        if (tid < 64) { float run = 0.f; for (int r = 0; r < C; ++r) { run += bsc[r * 64 + tid]; bsc[r * 64 + tid] = run; } dec[tid] = __expf(run); }
        __syncthreads();
        for (int i = tid; i < C * 64; i += NTHREADS) { const int r = i >> 6, d = i & 63; const float bb = bsc[i];
            qd[i] = f2bf(bf2f(a.q[(r0 + r) * a.zp + d]) * __expf(bb)); ka[i] = f2bf(bf2f(a.k[(r0 + r) * a.zp + d]) * __expf(-bb)); }
        __syncthreads();
        for (int i = tid; i < C * C; i += NTHREADS) { const int r = i / C, j = i % C; float s = 0.f;
            if (j <= r) { for (int d = 0; d < 64; ++d) s += bf2f(qd[r * 64 + d]) * bf2f(ka[j * 64 + d]); }
            Sm[i] = f2bf(s); }
        __syncthreads();
        for (int r = wid; r < C; r += NWAVES) {
            float o0 = 0.f, o1 = 0.f;
            for (int j = 0; j <= r; ++j) { const float s = bf2f(Sm[r * C + j]); o0 += s * bf2f(vv[j * 128 + lane]); o1 += s * bf2f(vv[j * 128 + 64 + lane]); }
            for (int d = 0; d < 64; ++d) { const float qv = bf2f(qd[r * 64 + d]); o0 += qv * st[d * 128 + lane]; o1 += qv * st[d * 128 + 64 + lane]; }
            const float rstd = 1.0f / sqrtf(wave_sum(o0 * o0 + o1 * o1) * (1.f / 128.f) + EPS);
            const float g0 = a.gain ? a.gain[lane] : 1.f, g1 = a.gain ? a.gain[lane + 64] : 1.f;
            const bf16_t* ogr = a.og + (r0 + r) * a.zp; bf16_t* orow = a.out + (r0 + r) * 1024;
            orow[lane] = f2bf(o0 * rstd * g0 * bf2f(ogr[lane])); orow[lane + 64] = f2bf(o1 * rstd * g1 * bf2f(ogr[lane + 64]));
        }
        __syncthreads();
        { const int e = tid & 127, dg = tid >> 7;
          for (int d = dg; d < 64; d += 4) { float s = st[d * 128 + e]; for (int j = 0; j < C; ++j) s += bf2f(ka[j * 64 + d]) * bf2f(vv[j * 128 + e]); st[d * 128 + e] = dec[d] * s; } }
    }
    __syncthreads();
}

DEV void sgu_unit_ref(const Params& P, int b, int ch, LAS unsigned char* lds, int wv) {
    const int tid = opaque_tid(wv), lane = tid & 63, wid = tid >> 6;
    unsigned char* ws = opaque_ws(P.ws); const bf16_t* Z = (const bf16_t*)(ws + WS_Z); bf16_t* CAT = (bf16_t*)(ws + WS_CAT);
    const float* lng = (const float*)P.in[16]; const float* lnb = (const float*)P.in[17]; const float* sw = (const float*)P.in[18]; const float* sb = (const float*)P.in[19];
    LAS float* svn = (LAS float*)lds;
    LAS float* stat = svn + 128 * 128;
    const size_t r0 = (size_t)b * SEQ + (size_t)ch * 128;
    __syncthreads();
    for (int r = wid; r < 128; r += NWAVES) {
        const bf16_t* zr = Z + (r0 + r) * Z1P + 512; float x[8]; unpack8(*(const bf16x8*)(zr + lane * 8), x);
        float s = 0.f;
#pragma unroll
        for (int j = 0; j < 8; ++j) s += x[j];
        const float mean = wave_sum(s) * (1.f / 512.f); float q = 0.f;
#pragma unroll
        for (int j = 0; j < 8; ++j) { const float d = x[j] - mean; q += d * d; }
        const float rstd = 1.0f / sqrtf(wave_sum(q) * (1.f / 512.f) + EPS);
        if (lane == 0) { stat[2 * r] = mean; stat[2 * r + 1] = rstd; }
    }
    __syncthreads();
    for (int g = 0; g < 4; ++g) {
        for (int i = tid; i < 128 * 128; i += NTHREADS) { const int r = i >> 7, c = i & 127;
            svn[i] = (bf2f(Z[(r0 + r) * Z1P + 512 + g * 128 + c]) - stat[2 * r]) * stat[2 * r + 1] * lng[g * 128 + c] + lnb[g * 128 + c]; }
        __syncthreads();
        { const int c = tid & 127, ig = tid >> 7;
          for (int r = ig; r < 128; r += 4) { float s = sb[g * 128 + r]; const float* wrow = sw + ((size_t)g * 128 + r) * 128;
              for (int j = 0; j <= r; ++j) s += wrow[j] * svn[j * 128 + c];
              CAT[(r0 + r) * 1024 + g * 128 + c] = f2bf(bf2f(Z[(r0 + r) * Z1P + g * 128 + c]) * s); } }
        __syncthreads();
    }
}


typedef float f32x16 __attribute__((ext_vector_type(16)));
DEV f32x16 mfma32(bf16x8 a, bf16x8 b, f32x16 c) { return __builtin_amdgcn_mfma_f32_32x32x16_bf16(a, b, c, 0, 0, 0); }
DEV bf16x8 ldfrag(const LAS bf16_t* base, int stride, int row, int k) { return *(const LAS bf16x8*)(base + row * stride + k); }

template <int C, bool HAS_LA>
DEV void linattn_unit_fast(const LinAttnArgs& a, LAS unsigned char* lds, int wv) {
    constexpr int SEG = C / 8, KS = 72, CS = C + 8, NIB = C / 32, NQ = NIB / 2, NPC = C / 64, NOP = C / 32, JB = C / 8, BS = 68, OS = 136;
    const int tid = opaque_tid(wv), lane = tid & 63, w = wv, r = lane & 31, h = lane >> 5;
    LAS bf16_t* Qd = (LAS bf16_t*)lds;
    LAS bf16_t* Ka = Qd + C * KS;
    LAS bf16_t* Kat = Ka + C * KS;
    LAS bf16_t* Vt = Kat + 64 * CS;
    LAS bf16_t* Stt = Vt + 128 * CS;
    LAS bf16_t* Sm = Stt + 128 * KS;
    LAS float* dec = (LAS float*)(Sm + C * CS);
    LAS float* tot = dec + 64;
    LAS float* rsq = tot + 512;
    LAS float* bt = rsq + C * 4;
    LAS bf16_t* Ot = (C == 128) ? Sm : (LAS bf16_t*)(bt + C * BS);
    const int db = w >> 2, eb = w & 3, i0 = w * SEG;
    const int vjb = tid % JB, veb = tid / JB; const bool vact = tid < 16 * JB;
    const int pc8 = lane & 7;
    f32x16 st;
#pragma unroll
    for (int t = 0; t < 16; ++t) st[t] = 0.f;
    float lav[SEG]; u32x4 qraw[NPC], kraw[NPC], vraw[8], ogv[NOP];
#define LIN_LOAD(n_) do { const size_t r0_ = (size_t)(n_) * C; \
        if (HAS_LA) { _Pragma("unroll") for (int ii = 0; ii < SEG; ++ii) lav[ii] = a.la[(r0_ + i0 + ii) * 256 + lane]; } \
        _Pragma("unroll") for (int pc = 0; pc < NPC; ++pc) { const int row_ = (tid + 512 * pc) >> 3; qraw[pc] = *(const u32x4*)(a.q + (r0_ + row_) * a.zp + 8 * pc8); kraw[pc] = *(const u32x4*)(a.k + (r0_ + row_) * a.zp + 8 * pc8); } \
        if (vact) { _Pragma("unroll") for (int jj = 0; jj < 8; ++jj) vraw[jj] = *(const u32x4*)(a.v + (r0_ + 8 * vjb + jj) * a.zp + 8 * veb); } \
        _Pragma("unroll") for (int pp = 0; pp < NOP; ++pp) { const int pce = tid + 512 * pp; ogv[pp] = *(const u32x4*)(a.og + (r0_ + (pce >> 4)) * a.zp + 8 * (pce & 15)); } } while (0)
    LIN_LOAD(0);
    LBAR();
    for (int n = 0; n < SEQ / C; ++n) {
        const size_t r0 = (size_t)n * C;
        if (HAS_LA) {
            float p[SEG]; float run = 0.f;
#pragma unroll
            for (int ii = 0; ii < SEG; ++ii) { run += lav[ii]; p[ii] = run; }
            tot[w * 64 + lane] = run;
            LBAR();
            float off = 0.f;
#pragma unroll
            for (int w2 = 0; w2 < 7; ++w2) { const float t2 = tot[w2 * 64 + lane]; off += (w2 < w) ? t2 : 0.f; }
#pragma unroll
            for (int ii = 0; ii < SEG; ++ii) bt[(i0 + ii) * BS + lane] = p[ii] + off;
            if (w == 7) dec[lane] = __expf(p[SEG - 1] + off);
            LBAR();
        } else {
            if (w == 7) dec[lane] = __expf((float)C * a.log_g);
        }
#pragma unroll
        for (int pc = 0; pc < NPC; ++pc) {
            const int row = (tid + 512 * pc) >> 3, d8 = 8 * pc8;
            float bb[8];
            if (HAS_LA) { const f32x4 b0 = *(const LAS f32x4*)(bt + row * BS + d8), b1 = *(const LAS f32x4*)(bt + row * BS + d8 + 4);
#pragma unroll
                for (int t = 0; t < 4; ++t) { bb[t] = b0[t]; bb[4 + t] = b1[t]; } }
            else {
#pragma unroll
                for (int t = 0; t < 8; ++t) bb[t] = (float)(row + 1) * a.log_g; }
            u32x4 qo, ko;
#pragma unroll
            for (int t = 0; t < 4; ++t) { const unsigned qw = qraw[pc][t], kw = kraw[pc][t];
                const float e0 = __expf(bb[2 * t]), e1 = __expf(bb[2 * t + 1]), f0 = __expf(-bb[2 * t]), f1 = __expf(-bb[2 * t + 1]);
                qo[t] = pk2(__uint_as_float(qw << 16) * e0, __uint_as_float(qw & 0xffff0000u) * e1);
                ko[t] = pk2(__uint_as_float(kw << 16) * f0, __uint_as_float(kw & 0xffff0000u) * f1); }
            *(LAS u32x4*)(Qd + row * KS + d8) = qo; *(LAS u32x4*)(Ka + row * KS + d8) = ko;
            unsigned k0 = ko[0], k1 = ko[1], k2 = ko[2], k3 = ko[3];
            { const int aa = pc8 >> 1;
              const unsigned t0 = aa == 0 ? k0 : aa == 1 ? k1 : aa == 2 ? k2 : k3, t1 = aa == 0 ? k1 : aa == 1 ? k2 : aa == 2 ? k3 : k0, t2 = aa == 0 ? k2 : aa == 1 ? k3 : aa == 2 ? k0 : k1, t3 = aa == 0 ? k3 : aa == 1 ? k0 : aa == 2 ? k1 : k2;
              if (pc8 & 1) { k0 = (t0 >> 16) | (t1 << 16); k1 = (t1 >> 16) | (t2 << 16); k2 = (t2 >> 16) | (t3 << 16); k3 = (t3 >> 16) | (t0 << 16); } else { k0 = t0; k1 = t1; k2 = t2; k3 = t3; } }
            const unsigned kr[4] = {k0, k1, k2, k3};
#pragma unroll
            for (int jj = 0; jj < 8; ++jj) { const int e = (jj + pc8) & 7; const unsigned wd = kr[jj >> 1];
                Kat[(d8 + e) * CS + row] = (bf16_t)((jj & 1) ? (wd >> 16) : (wd & 0xffffu)); }
        }
        if (vact) {
#pragma unroll
            for (int e = 0; e < 8; ++e) { u32x4 o4;
#pragma unroll
                for (int jp = 0; jp < 4; ++jp) { const unsigned lo = vraw[2 * jp][e >> 1], hi = vraw[2 * jp + 1][e >> 1];
                    o4[jp] = (e & 1) ? ((lo >> 16) | (hi & 0xffff0000u)) : ((lo & 0xffffu) | (hi << 16)); }
                *(LAS u32x4*)(Vt + (8 * veb + e) * CS + 8 * vjb) = o4; }
        }
#pragma unroll
        for (int g = 0; g < 4; ++g) { u32x2 w2; w2.x = pk2(st[4 * g], st[4 * g + 1]); w2.y = pk2(st[4 * g + 2], st[4 * g + 3]);
            *(LAS u32x2*)(Stt + (32 * eb + r) * KS + 32 * db + 8 * g + 4 * h) = w2; }
        u32x4 ogc[NOP];
#pragma unroll
        for (int pp = 0; pp < NOP; ++pp) ogc[pp] = ogv[pp];
        if (n + 1 < SEQ / C) LIN_LOAD(n + 1);
        LBAR();
        for (int bp = w; bp < NIB * (NIB + 1) / 2; bp += 8) {
            int ib = 0; while ((ib + 1) * (ib + 2) / 2 <= bp) ++ib;
            const int jb = bp - ib * (ib + 1) / 2;
            f32x16 acc;
#pragma unroll
            for (int t = 0; t < 16; ++t) acc[t] = 0.f;
#pragma unroll
            for (int s2 = 0; s2 < 4; ++s2) acc = mfma32(ldfrag(Ka, KS, 32 * jb + r, 16 * s2 + 8 * h), ldfrag(Qd, KS, 32 * ib + r, 16 * s2 + 8 * h), acc);
            const int i = 32 * ib + r;
#pragma unroll
            for (int g = 0; g < 4; ++g) { const int j0 = 32 * jb + 8 * g + 4 * h; float v0 = acc[4 * g], v1 = acc[4 * g + 1], v2 = acc[4 * g + 2], v3 = acc[4 * g + 3];
                if (j0 > i) v0 = 0.f; if (j0 + 1 > i) v1 = 0.f; if (j0 + 2 > i) v2 = 0.f; if (j0 + 3 > i) v3 = 0.f;
                u32x2 w2; w2.x = pk2(v0, v1); w2.y = pk2(v2, v3); *(LAS u32x2*)(Sm + i * CS + j0) = w2; }
        }
        {
            f32x16 acc = st;
#pragma unroll
            for (int s2 = 0; s2 < C / 16; ++s2) acc = mfma32(ldfrag(Kat, CS, 32 * db + r, 16 * s2 + 8 * h), ldfrag(Vt, CS, 32 * eb + r, 16 * s2 + 8 * h), acc);
#pragma unroll
            for (int g = 0; g < 4; ++g) { const f32x4 dv = *(const LAS f32x4*)(dec + 32 * db + 8 * g + 4 * h);
#pragma unroll
                for (int t = 0; t < 4; ++t) st[4 * g + t] = acc[4 * g + t] * dv[t]; }
        }
        LBAR();
        f32x16 o[NQ];
#pragma unroll
        for (int q = 0; q < NQ; ++q) {
            const int blk = w + 8 * q, ib = blk >> 2, e2 = blk & 3;
            f32x16 acc;
#pragma unroll
            for (int t = 0; t < 16; ++t) acc[t] = 0.f;
            for (int s2 = 0; s2 < 2 * (ib + 1); ++s2) acc = mfma32(ldfrag(Vt, CS, 32 * e2 + r, 16 * s2 + 8 * h), ldfrag(Sm, CS, 32 * ib + r, 16 * s2 + 8 * h), acc);
#pragma unroll
            for (int s2 = 0; s2 < 4; ++s2) acc = mfma32(ldfrag(Stt, KS, 32 * e2 + r, 16 * s2 + 8 * h), ldfrag(Qd, KS, 32 * ib + r, 16 * s2 + 8 * h), acc);
            o[q] = acc;
            float ss = 0.f;
#pragma unroll
            for (int t = 0; t < 16; ++t) ss += acc[t] * acc[t];
            ss += __shfl_xor(ss, 32);
            if (h == 0) rsq[(32 * ib + r) * 4 + e2] = ss;
        }
        LBAR();
#pragma unroll
        for (int q = 0; q < NQ; ++q) {
            const int blk = w + 8 * q, ib = blk >> 2, e2 = blk & 3, i = 32 * ib + r;
            const f32x4 rs = *(const LAS f32x4*)(rsq + i * 4);
            const float rstd = 1.0f / sqrtf(((rs[0] + rs[1]) + (rs[2] + rs[3])) * (1.f / 128.f) + EPS);
#pragma unroll
            for (int g = 0; g < 4; ++g) { const int e0 = 32 * e2 + 8 * g + 4 * h;
                f32x4 gn = {1.f, 1.f, 1.f, 1.f}; if (a.gain) gn = *(const f32x4*)(a.gain + e0);
                u32x2 w2; w2.x = pk2(o[q][4 * g] * rstd * gn[0], o[q][4 * g + 1] * rstd * gn[1]); w2.y = pk2(o[q][4 * g + 2] * rstd * gn[2], o[q][4 * g + 3] * rstd * gn[3]);
                *(LAS u32x2*)(Ot + i * OS + e0) = w2; }
        }
        LBAR();
#pragma unroll
        for (int pp = 0; pp < NOP; ++pp) { const int pce = tid + 512 * pp, row = pce >> 4, e8 = 8 * (pce & 15);
            const u32x4 ov = *(const LAS u32x4*)(Ot + row * OS + e8); const u32x4 gv = ogc[pp]; u32x4 res;
#pragma unroll
            for (int t = 0; t < 4; ++t) res[t] = pk2(__uint_as_float(ov[t] << 16) * __uint_as_float(gv[t] << 16), __uint_as_float(ov[t] & 0xffff0000u) * __uint_as_float(gv[t] & 0xffff0000u));
            *(u32x4*)(a.out + (r0 + row) * 1024 + e8) = res; }
    }
    asm volatile("s_waitcnt vmcnt(0)" ::: "memory");
    LBAR();
#undef LIN_LOAD
}

DEV void sgu_unit_fast(const Params& P, int b, int ch, LAS unsigned char* lds, int wv) {
    constexpr int CS = 136;
    const int tid = opaque_tid(wv), lane = tid & 63, w = wv, r = lane & 31, h = lane >> 5;
    unsigned char* ws = opaque_ws(P.ws); const bf16_t* Z = (const bf16_t*)(ws + WS_Z); bf16_t* CAT = (bf16_t*)(ws + WS_CAT); const bf16_t* SW = (const bf16_t*)(ws + WS_SGUW);
    const float* lng = (const float*)P.in[16]; const float* lnb = (const float*)P.in[17]; const float* sb = (const float*)P.in[19];
    LAS bf16_t* Wg = (LAS bf16_t*)lds;
    LAS bf16_t* Sv = Wg + 128 * CS;
    LAS float* stat = (LAS float*)(Sv + 128 * CS);
    const size_t r0 = (size_t)b * SEQ + (size_t)ch * 128;
    __syncthreads();
    for (int rr = w; rr < 128; rr += NWAVES) {
        const bf16_t* zr = Z + (r0 + rr) * Z1P + 512; float x[8]; unpack8(*(const bf16x8*)(zr + lane * 8), x);
        float s = 0.f;
#pragma unroll
        for (int j = 0; j < 8; ++j) s += x[j];
        const float mean = wave_sum(s) * (1.f / 512.f); float q = 0.f;
#pragma unroll
        for (int j = 0; j < 8; ++j) { const float d = x[j] - mean; q += d * d; }
        const float rstd = 1.0f / sqrtf(wave_sum(q) * (1.f / 512.f) + EPS);
        if (lane == 0) { stat[2 * rr] = mean; stat[2 * rr + 1] = rstd; }
    }
    __syncthreads();
    for (int g = 0; g < 4; ++g) {
#pragma unroll
        for (int it = 0; it < 4; ++it) { const int pc = tid + 512 * it, i = pc >> 4, c8 = pc & 15;
            *(LAS u32x4*)(Wg + i * CS + c8 * 8) = *(const u32x4*)(SW + ((size_t)g * 128 + i) * 128 + c8 * 8); }
#pragma unroll
        for (int it = 0; it < 4; ++it) { const int item = tid + 512 * it, c = item & 127, jg = item >> 7;
            const float gg = lng[g * 128 + c], bb = lnb[g * 128 + c]; float v[8];
#pragma unroll
            for (int jj = 0; jj < 8; ++jj) { const int j = 8 * jg + jj; v[jj] = (bf2f(Z[(r0 + j) * Z1P + 512 + g * 128 + c]) - stat[2 * j]) * stat[2 * j + 1] * gg + bb; }
            u32x4 w4; w4.x = pk2(v[0], v[1]); w4.y = pk2(v[2], v[3]); w4.z = pk2(v[4], v[5]); w4.w = pk2(v[6], v[7]);
            *(LAS u32x4*)(Sv + c * CS + 8 * jg) = w4; }
        __syncthreads();
#pragma unroll
        for (int q = 0; q < 2; ++q) {
            const int blk = w + 8 * q, ib = blk >> 2, cb = blk & 3, i = 32 * ib + r;
            f32x16 acc;
#pragma unroll
            for (int t = 0; t < 16; ++t) acc[t] = 0.f;
            for (int s2 = 0; s2 < 2 * (ib + 1); ++s2) acc = mfma32(ldfrag(Sv, CS, 32 * cb + r, 16 * s2 + 8 * h), ldfrag(Wg, CS, i, 16 * s2 + 8 * h), acc);
            const float bs = sb[g * 128 + i];
#pragma unroll
            for (int gq = 0; gq < 4; ++gq) { const int c0 = g * 128 + 32 * cb + 8 * gq + 4 * h;
                const u32x2 su = *(const u32x2*)(Z + (r0 + i) * Z1P + c0);
                const float u0 = __uint_as_float(su.x << 16), u1 = __uint_as_float(su.x & 0xffff0000u), u2 = __uint_as_float(su.y << 16), u3 = __uint_as_float(su.y & 0xffff0000u);
                u32x2 w2; w2.x = pk2(u0 * (acc[4 * gq] + bs), u1 * (acc[4 * gq + 1] + bs)); w2.y = pk2(u2 * (acc[4 * gq + 2] + bs), u3 * (acc[4 * gq + 3] + bs));
                *(u32x2*)(CAT + (r0 + i) * 1024 + c0) = w2; }
        }
        __syncthreads();
    }
}

namespace attn_body {
using bf16=unsigned short;
using s16x4=__attribute__((ext_vector_type(4)))short;
using f32x16=__attribute__((ext_vector_type(16)))float;
constexpr int D=64,ZP=Z0P,OPITCH=1024;
constexpr int NW=8,QBLK=32,QB=QBLK*NW,KVBLK=64;
__device__ __forceinline__ int crow(int r,int hi){return (r&3)+8*(r>>2)+4*hi;}
#define SBAR() __builtin_amdgcn_sched_barrier(0)
__device__ __forceinline__ void cmask(f32x16&p0,f32x16&p1,int jb,int qrel,int hi){
  const float NEG=-INFINITY; int kb=64*jb+4*hi;
  #pragma unroll
  for(int r=0;r<16;++r){int kv=kb+(r&3)+8*(r>>2); if(kv>qrel)p0[r]=NEG; if(kv+32>qrel)p1[r]=NEG;}
}

constexpr int NSLOT=3, SLOTB=8192;
constexpr int LDS_K=0, LDS_V=NSLOT*SLOTB, LDS_WS=2*NSLOT*SLOTB, LDS_OST=LDS_WS+NW*64*4, LDS_BYTES=LDS_OST+NW*4096;
__device__ __forceinline__ void glds16(const void*gsrc,unsigned lds_dst){unsigned keep;
  asm volatile("s_mov_b32 %0, m0\n\ts_mov_b32 m0, %2\n\ts_nop 0\n\tglobal_load_lds_dwordx4 %1, off\n\ts_mov_b32 m0, %0":"=&s"(keep):"v"(gsrc),"s"(lds_dst):"memory");}
__device__ __forceinline__ float max3f(float a,float b,float c){float r;asm("v_max3_f32 %0, %1, %2, %3":"=v"(r):"v"(a),"v"(b),"v"(c));return r;}
__device__ __forceinline__ float max2f(float a,float b){float r;asm("v_max_f32_e32 %0, %1, %2":"=v"(r):"v"(a),"v"(b));return r;}
__device__ __forceinline__ float fadd_s(float a,float b){float r;asm("v_add_f32_e32 %0, %1, %2":"=v"(r):"v"(a),"v"(b));return r;}
__device__ __forceinline__ float fsub_s(float a,float b){float r;asm("v_sub_f32_e32 %0, %1, %2":"=v"(r):"v"(a),"v"(b));return r;}
typedef float f32x2_t __attribute__((ext_vector_type(2))); typedef __bf16 bf16x2_t __attribute__((ext_vector_type(2)));
typedef int v8i __attribute__((ext_vector_type(8)));
__device__ __forceinline__ unsigned cvtpk_s(float lo,float hi){f32x2_t v={lo,hi};bf16x2_t b=__builtin_convertvector(v,bf16x2_t);return __builtin_bit_cast(unsigned,b);}
#define WAIT_BAR(N) asm volatile("s_waitcnt vmcnt(" #N ") lgkmcnt(0)\n\ts_barrier":::"memory")

__device__ __forceinline__ void qkt(f32x16&p0,f32x16&p1,const char*Kslot,const bf16x8*qr,const f32x16&negm,int r32,int hi){
  const char*kb=Kslot+hi*1024+r32*16;
  #pragma unroll
  for(int d0=0;d0<4;++d0){
    const bf16x8 b0=*reinterpret_cast<const bf16x8*>(kb+d0*2048);
    const bf16x8 b1=*reinterpret_cast<const bf16x8*>(kb+d0*2048+512);
    if(d0==0){p0=__builtin_amdgcn_mfma_f32_32x32x16_bf16(b0,qr[0],negm,0,0,0);p1=__builtin_amdgcn_mfma_f32_32x32x16_bf16(b1,qr[0],negm,0,0,0);}
    else{p0=__builtin_amdgcn_mfma_f32_32x32x16_bf16(b0,qr[d0],p0,0,0,0);p1=__builtin_amdgcn_mfma_f32_32x32x16_bf16(b1,qr[d0],p1,0,0,0);}}
}
typedef __attribute__((address_space(3))) const char* lds_cptr;
typedef short v4i16_t __attribute__((ext_vector_type(4)));
__device__ __forceinline__ void kload8(bf16x8*kf,lds_cptr kp){
  kf[0]=*(const __attribute__((address_space(3))) bf16x8*)(kp);      kf[1]=*(const __attribute__((address_space(3))) bf16x8*)(kp+512);
  kf[2]=*(const __attribute__((address_space(3))) bf16x8*)(kp+2048); kf[3]=*(const __attribute__((address_space(3))) bf16x8*)(kp+2560);
  kf[4]=*(const __attribute__((address_space(3))) bf16x8*)(kp+4096); kf[5]=*(const __attribute__((address_space(3))) bf16x8*)(kp+4608);
  kf[6]=*(const __attribute__((address_space(3))) bf16x8*)(kp+6144); kf[7]=*(const __attribute__((address_space(3))) bf16x8*)(kp+6656);
}
__device__ __forceinline__ void kload2(bf16x8*kf,lds_cptr kp,int j){ kf[2*j]=*(const __attribute__((address_space(3))) bf16x8*)(kp+j*2048); kf[2*j+1]=*(const __attribute__((address_space(3))) bf16x8*)(kp+j*2048+512); }
__device__ __forceinline__ s16x4 vtr(lds_cptr p){ return __builtin_bit_cast(s16x4,__builtin_amdgcn_ds_read_tr16_b64_v4i16((__attribute__((address_space(3))) v4i16_t*)p)); }
__device__ __forceinline__ float rowmax(const f32x16&p0,const f32x16&p1){
  float a=max3f(p0[0],p0[1],p1[0]),b=max3f(p0[2],p0[3],p1[1]);a=max3f(a,p1[2],p1[3]);
  #pragma unroll
  for(int r=4;r<16;r+=4){a=max3f(a,p0[r],p0[r+1]);b=max3f(b,p0[r+2],p0[r+3]);a=max3f(a,p1[r],p1[r+1]);b=max3f(b,p1[r+2],p1[r+3]);}
  const float m=max2f(a,b);
  auto rr=__builtin_amdgcn_permlane32_swap(__float_as_uint(m),__float_as_uint(m),false,false);
  return max2f(__uint_as_float(rr[0]),__uint_as_float(rr[1]));
}
__device__ __forceinline__ void pv(f32x16*o,int vb,bf16x8 pa0,bf16x8 pa1,bf16x8 pa2,bf16x8 pa3){
  #pragma unroll
  for(int d0=0;d0<2;++d0){s16x4 lo[4],hi[4];
    #pragma unroll
    for(int ks=0;ks<4;++ks){
      asm volatile("ds_read_b64_tr_b16 %0,%1 offset:%c2":"=&v"(lo[ks]):"v"(vb),"i"(d0*4096+ks*1024):"memory");
      asm volatile("ds_read_b64_tr_b16 %0,%1 offset:%c2":"=&v"(hi[ks]):"v"(vb),"i"(d0*4096+ks*1024+512):"memory");}
    asm volatile("s_waitcnt lgkmcnt(0)":::"memory");SBAR();
    #define PK(k) (bf16x8){lo[k][0],lo[k][1],lo[k][2],lo[k][3],hi[k][0],hi[k][1],hi[k][2],hi[k][3]}
    o[d0]=__builtin_amdgcn_mfma_f32_32x32x16_bf16(pa0,PK(0),o[d0],0,0,0);
    o[d0]=__builtin_amdgcn_mfma_f32_32x32x16_bf16(pa1,PK(1),o[d0],0,0,0);
    o[d0]=__builtin_amdgcn_mfma_f32_32x32x16_bf16(pa2,PK(2),o[d0],0,0,0);
    o[d0]=__builtin_amdgcn_mfma_f32_32x32x16_bf16(pa3,PK(3),o[d0],0,0,0);
    #undef PK
  }
}

#ifndef ATTN_STORE16
#define ATTN_STORE16(p,v) (*(u32x4*)(p)=(v))
#endif
template<int THRL> __device__ __forceinline__ void attn_unit(int qb,const bf16*Qb,const bf16*__restrict__ Kb,const bf16*__restrict__ Vb,bf16*Ob,char*shm,int wv){
  const int tid=opaque_tid(wv),lane=tid&63,r32=lane&31,hi=lane>>5; const int wid=wv;
  const int q0=qb*QB;
  const bf16*Qw=Qb+(long)(q0+wid*QBLK)*ZP;
  const bf16*Kh=Kb,*Vh=Vb;
  const unsigned lds0=(unsigned)(uintptr_t)shm;
  float*wsf=(float*)(shm+LDS_WS)+wid*64;
  const bf16*ksrc=Kh+(long)lane*ZP+wid*8;
  const bf16*vsrc=Vh+(long)(16*(wid&3)+(lane>>2))*ZP+(wid>>2)*32+(lane&3)*8;
  const unsigned kdst=lds0+LDS_K+wid*1024, vdst=lds0+LDS_V+wid*1024;
  #define DMA_K(t,slot) glds16(ksrc+(long)(t)*KVBLK*ZP,(unsigned)__builtin_amdgcn_readfirstlane(kdst+(slot)))
  #define DMA_V(t,slot) glds16(vsrc+(long)(t)*KVBLK*ZP,(unsigned)__builtin_amdgcn_readfirstlane(vdst+(slot)))
  const int vb0=(int)(lds0+LDS_V)+((lane>>4)&1)*32+(lane&3)*8+(4*hi+((lane&15)>>2))*64;
  const char*Kbase=shm+LDS_K; bf16x8 kf[8];
  const lds_cptr shm3=(lds_cptr)shm; const lds_cptr kp0=shm3+LDS_K+hi*1024+r32*16; const lds_cptr vp0=shm3+LDS_V+((lane>>4)&1)*32+(lane&3)*8+(4*hi+((lane&15)>>2))*64;
  const int NT=(q0+QB)/KVBLK;
  DMA_K(0,0);DMA_V(0,0);DMA_K(1,SLOTB);
  bf16x8 qr[4];
  #pragma unroll
  for(int d0=0;d0<4;++d0)qr[d0]=*reinterpret_cast<const bf16x8*>(&Qw[(long)r32*ZP+d0*16+hi*8]);
  float mhat=0.f,l_reg=0.f;f32x16 o[2];o[0]=f32x16{};o[1]=f32x16{};f32x16 negm=f32x16{};asm volatile("":"+v"(negm));
  const int qrel=wid*QBLK+r32;
  #define CMASK(P0,P1,t) do{int jb_=(t)-(NT-4); if(jb_>=0)cmask(P0,P1,jb_,qrel,hi);}while(0)
  bool resc=false;
  #define START(P0,P1) do{ const float rm=rowmax(P0,P1); resc=false; \
    { const float dl=rm; mhat=fadd_s(mhat,dl); \
      _Pragma("unroll") for(int r=0;r<16;++r){P0[r]=fsub_s(P0[r],dl);P1[r]=fsub_s(P1[r],dl);} \
      _Pragma("unroll") for(int r=0;r<16;++r)negm[r]=-mhat; asm volatile("":"+v"(negm)); } \
    _Pragma("unroll") for(int r=0;r<16;++r)P0[r]=__builtin_amdgcn_exp2f(P0[r]); }while(0)
  #define RESC() do{ if(resc){ asm volatile("s_waitcnt lgkmcnt(0)":::"memory"); \
      _Pragma("unroll") for(int d_=0;d_<2;++d_) _Pragma("unroll") for(int r=0;r<16;++r)o[d_][r]*=wsf[crow(r,hi)]; } }while(0)
  f32x16 pA0,pA1,pB0,pB1;
  int sl_prev=0,sl_cur=0,sl_next=SLOTB;
  #define ROT() do{sl_prev=sl_cur;sl_cur=sl_next;sl_next=(sl_next==(NSLOT-1)*SLOTB)?0:sl_next+SLOTB;}while(0)
  DMA_K(2,2*SLOTB);
  WAIT_BAR(3);
  qkt(pA0,pA1,Kbase,qr,negm,r32,hi);asm volatile("s_nop 15\n\ts_nop 7":"+v"(pA0),"+v"(pA1));CMASK(pA0,pA1,0);
  START(pA0,pA1);
  _Pragma("unroll") for(int r=0;r<16;++r)pA1[r]=__builtin_amdgcn_exp2f(pA1[r]);
  WAIT_BAR(0);
  DMA_K(3,0);DMA_V(1,SLOTB);
  ROT();
  kload8(kf,kp0+sl_cur);
  WAIT_BAR(2);
  s16x4 vlo[8],vhi[8]; u32x4 pw0,pw1,pw2,pw3;
  #define PKW(P,B) cvtpk_s(P[B],P[B+1])
  #define PAF(k) __builtin_bit_cast(bf16x8,pw##k)
  #define VFR(i) (bf16x8){vlo[i][0],vlo[i][1],vlo[i][2],vlo[i][3],vhi[i][0],vhi[i][1],vhi[i][2],vhi[i][3]}
  #define PIN(x) asm volatile("":"+v"(x))
  #define MX3(a,b,c) __builtin_fmaxf(__builtin_fmaxf((a),(b)),(c))
  #define GAPA(MF,A0,A1,A2,A3,W0,W1,PW) do{ MF; sacc+=A0; sacc+=A1; sacc+=A2; sacc+=A3; PIN(sacc); W0; W1; PIN(PW); SBAR(); }while(0)
  #define EX(v) __builtin_amdgcn_exp2f(v)
  #define GAPB(MF,X,B) do{ MF; X[B]=EX(X[B]); X[B+1]=EX(X[B+1]); X[B+2]=EX(X[B+2]); X[B+3]=EX(X[B+3]); PIN(X); SBAR(); }while(0)
  #define VRD(i) do{ vlo[i]=vtr(vp_+(((i)>>2)*4096+((i)&3)*1024)); vhi[i]=vtr(vp_+(((i)>>2)*4096+((i)&3)*1024+512)); }while(0)
  #define KRD(G,j) do{ if(G){ kload2(kf,kp0+sl_next,j); SBAR(); } }while(0)
  #define STEP(C0,C1,P0,P1,t,GK,GV,GL) do{ SBAR(); \
    const lds_cptr vp_=vp0+sl_prev; \
    VRD(0); SBAR(); float sacc=(P0[0]+P0[1]); \
    GAPA(C0=__builtin_amdgcn_mfma_f32_32x32x16_bf16(kf[0],qr[0],negm,0,0,0), P0[2],P0[3],P0[4],P0[5],     pw0[0]=PKW(P0,0), pw0[1]=PKW(P0,2), pw0); \
    VRD(4); SBAR(); GAPA(C1=__builtin_amdgcn_mfma_f32_32x32x16_bf16(kf[1],qr[0],negm,0,0,0), P0[6],P0[7],P0[8],P0[9],     pw0[2]=PKW(P0,4), pw0[3]=PKW(P0,6), pw0); \
    VRD(1); SBAR(); GAPA(C0=__builtin_amdgcn_mfma_f32_32x32x16_bf16(kf[2],qr[1],C0,0,0,0),   P0[10],P0[11],P0[12],P0[13], pw1[0]=PKW(P0,8), pw1[1]=PKW(P0,10), pw1); \
    VRD(5); SBAR(); GAPA(C1=__builtin_amdgcn_mfma_f32_32x32x16_bf16(kf[3],qr[1],C1,0,0,0),   P0[14],P0[15],P1[0],P1[1],   pw1[2]=PKW(P0,12),pw1[3]=PKW(P0,14), pw1); \
    VRD(2); SBAR(); GAPA(C0=__builtin_amdgcn_mfma_f32_32x32x16_bf16(kf[4],qr[2],C0,0,0,0),   P1[2],P1[3],P1[4],P1[5],     pw2[0]=PKW(P1,0), pw2[1]=PKW(P1,2), pw2); \
    VRD(6); SBAR(); GAPA(C1=__builtin_amdgcn_mfma_f32_32x32x16_bf16(kf[5],qr[2],C1,0,0,0),   P1[6],P1[7],P1[8],P1[9],     pw2[2]=PKW(P1,4), pw2[3]=PKW(P1,6), pw2); \
    VRD(3); SBAR(); GAPA(C0=__builtin_amdgcn_mfma_f32_32x32x16_bf16(kf[6],qr[3],C0,0,0,0),   P1[10],P1[11],P1[12],P1[13], pw3[0]=PKW(P1,8), pw3[1]=PKW(P1,10), pw3); \
    VRD(7); SBAR(); GAPA(C1=__builtin_amdgcn_mfma_f32_32x32x16_bf16(kf[7],qr[3],C1,0,0,0),   P1[14],P1[15],0.f,0.f,       pw3[2]=PKW(P1,12),pw3[3]=PKW(P1,14), pw3); \
    l_reg+=sacc; \
    if(GK){DMA_K((t)+3,sl_cur);} if(GV){DMA_V((t)+1,sl_next);} \
    CMASK(C0,C1,t); \
    { float a=MX3(C0[0],C0[1],C1[0]),b=MX3(C0[2],C0[3],C1[1]); a=MX3(a,C1[2],C1[3]); \
      _Pragma("unroll") for(int r=4;r<16;r+=4){a=MX3(a,C0[r],C0[r+1]);b=MX3(b,C0[r+2],C0[r+3]);a=MX3(a,C1[r],C1[r+1]);b=MX3(b,C1[r+2],C1[r+3]);} \
      float rm=__builtin_fmaxf(a,b); { auto rr=__builtin_amdgcn_permlane32_swap(__float_as_uint(rm),__float_as_uint(rm),false,false); rm=__builtin_fmaxf(__uint_as_float(rr[0]),__uint_as_float(rr[1])); } \
      resc=false; \
      if(__builtin_expect(__any(rm>(float)THRL),0)){ const float dl=__builtin_fmaxf(rm,0.f); mhat+=dl; \
        _Pragma("unroll") for(int r=0;r<16;++r){C0[r]-=dl;C1[r]-=dl;} \
        _Pragma("unroll") for(int r=0;r<16;++r)negm[r]=-mhat; asm volatile("":"+v"(negm)); \
        const float f=__builtin_amdgcn_exp2f(-dl); l_reg*=f; if(hi==0)wsf[r32]=f; resc=true; } } \
    SBAR(); \
    GAPB(o[0]=__builtin_amdgcn_mfma_f32_32x32x16_bf16(PAF(0),VFR(0),o[0],0,0,0), C0,0); \
    GAPB(o[1]=__builtin_amdgcn_mfma_f32_32x32x16_bf16(PAF(0),VFR(4),o[1],0,0,0), C0,4); \
    KRD(GL,0); GAPB(o[0]=__builtin_amdgcn_mfma_f32_32x32x16_bf16(PAF(1),VFR(1),o[0],0,0,0), C0,8); \
    KRD(GL,1); GAPB(o[1]=__builtin_amdgcn_mfma_f32_32x32x16_bf16(PAF(1),VFR(5),o[1],0,0,0), C0,12); \
    KRD(GL,2); GAPB(o[0]=__builtin_amdgcn_mfma_f32_32x32x16_bf16(PAF(2),VFR(2),o[0],0,0,0), C1,0); \
    KRD(GL,3); GAPB(o[1]=__builtin_amdgcn_mfma_f32_32x32x16_bf16(PAF(2),VFR(6),o[1],0,0,0), C1,4); \
    GAPB(o[0]=__builtin_amdgcn_mfma_f32_32x32x16_bf16(PAF(3),VFR(3),o[0],0,0,0), C1,8); \
    GAPB(o[1]=__builtin_amdgcn_mfma_f32_32x32x16_bf16(PAF(3),VFR(7),o[1],0,0,0), C1,12); \
    }while(0)
  int t=1;
  #undef CMASK
  #define CMASK(P0,P1,t) do{}while(0)
  for(;t+5<NT;t+=2){
    STEP(pB0,pB1,pA0,pA1,t,true,true,true);     WAIT_BAR(2); RESC(); ROT();
    STEP(pA0,pA1,pB0,pB1,t+1,true,true,true);   WAIT_BAR(2); RESC(); ROT();
  }
  #undef CMASK
  #define CMASK(P0,P1,t) do{int jb_=(t)-(NT-4); if(jb_>=0)cmask(P0,P1,jb_,qrel,hi);}while(0)
  #define ENDW(tt) do{ if((tt)+3<NT){WAIT_BAR(2);} else if((tt)+2<NT){WAIT_BAR(1);} else {WAIT_BAR(0);} }while(0)
  for(;t+1<NT;t+=2){
    STEP(pB0,pB1,pA0,pA1,t,(t+3<NT),(t+1<NT),(t+1<NT));       ENDW(t);   RESC(); ROT();
    STEP(pA0,pA1,pB0,pB1,t+1,(t+4<NT),(t+2<NT),(t+2<NT));     ENDW(t+1); RESC(); ROT();
  }
  STEP(pB0,pB1,pA0,pA1,NT-1,false,false,false); RESC();
  { float sacc=pB0[0]+pB0[1]; _Pragma("unroll") for(int r=2;r<16;++r)sacc+=pB0[r]; _Pragma("unroll") for(int r=0;r<16;++r)sacc+=pB1[r]; l_reg+=sacc;
    pw0=(u32x4){PKW(pB0,0),PKW(pB0,2),PKW(pB0,4),PKW(pB0,6)};pw1=(u32x4){PKW(pB0,8),PKW(pB0,10),PKW(pB0,12),PKW(pB0,14)};pw2=(u32x4){PKW(pB1,0),PKW(pB1,2),PKW(pB1,4),PKW(pB1,6)};pw3=(u32x4){PKW(pB1,8),PKW(pB1,10),PKW(pB1,12),PKW(pB1,14)};
    SBAR(); pv(o,vb0+sl_cur,PAF(0),PAF(1),PAF(2),PAF(3)); }
  #undef PKW
  #undef PAF
  #undef VFR
  #undef PIN
  #undef MX3
  #undef GAPA
  #undef GAPB
  #undef EX
  #undef VRD
  #undef KRD
  #undef STEP
  #undef ENDW
  {auto rr=__builtin_amdgcn_permlane32_swap(__float_as_uint(l_reg),__float_as_uint(l_reg),false,false);l_reg=__uint_as_float(rr[0])+__uint_as_float(rr[1]);}
  if(hi==0)wsf[32+r32]=l_reg;asm volatile("s_waitcnt lgkmcnt(0)":::"memory");
  float rli[16];
  #pragma unroll
  for(int r=0;r<16;++r)rli[r]=__builtin_amdgcn_rcpf(wsf[32+crow(r,hi)]);
  bf16*Ow=Ob+(long)(q0+wid*QBLK)*OPITCH;
  { bf16*stg=(bf16*)(shm+LDS_OST)+wid*2048;
    #pragma unroll
    for(int r=0;r<16;++r){const int orow=crow(r,hi);
      #pragma unroll
      for(int d0=0;d0<2;++d0)stg[orow*64+d0*32+r32]=f2bf(o[d0][r]*rli[r]);}
    asm volatile("s_waitcnt lgkmcnt(0)":::"memory");
    #pragma unroll
    for(int i=0;i<4;++i){const int row=i*8+(lane>>3),ch=lane&7; const u32x4 v=*(const u32x4*)(stg+row*64+ch*8); ATTN_STORE16(Ow+(long)row*OPITCH+ch*8,v);} }
  asm volatile("s_waitcnt lgkmcnt(0)\n\ts_barrier":::"memory");
  #undef DMA_K
  #undef DMA_V
  #undef CMASK
  #undef START
  #undef RESC
  #undef ROT
}
constexpr int ATTN_LDS_BYTES=LDS_BYTES;
#undef SBAR
#undef WAIT_BAR
}
DEV int queue_pop(unsigned* head, LAS unsigned char* lds, int wv) {
    LAS int* slot = (LAS int*)(lds + LCTL_OFF + 4096);
    __syncthreads();
    if (opaque_tid(wv) == 0) *slot = (int)__hip_atomic_fetch_add(head, 1u, __ATOMIC_RELAXED, __HIP_MEMORY_SCOPE_AGENT);
    __syncthreads();
    return *slot;
}

DEV void phase_mix0(const Params& P, LAS unsigned char* lds, char* shm, int wv) {
    unsigned char* ws = opaque_ws(P.ws); const bf16_t* Z = (const bf16_t*)(ws + WS_Z);
    unsigned* head = (unsigned*)(ws + WS_CTL) + CW_QUEUE;
    for (;;) {
        const int q = queue_pop(head, lds, wv);
        if (q >= 32 + 1024) break;
        if (q < 32) {
            const int b = q >> 2, h = q & 3; const size_t rb = (size_t)b * SEQ;
            LinAttnArgs a; a.q = Z + rb * Z0P + h * 64; a.k = Z + rb * Z0P + 256 + h * 64; a.v = Z + rb * Z0P + 512 + h * 128; a.og = Z + rb * Z0P + 1024 + h * 128; a.zp = Z0P;
            a.la = (const float*)(ws + WS_LA) + rb * 256 + h * 64; a.log_g = 0.f; a.gain = (const float*)P.in[8]; a.out = (bf16_t*)(ws + WS_CAT) + rb * 1024 + h * 128;
            #if FAST_LIN
            linattn_unit_fast<64, true>(a, lds, wv);
#ifdef DBG_TS
            if (opaque_tid(wv) == 0) atomicMax((unsigned long long*)(ws + WS_CTL + 49152) + 32, (unsigned long long)__builtin_amdgcn_s_memrealtime());
#endif
#else
            linattn_unit_ref<64>(a, lds, wv);
#endif
        } else {
            const int aidx = q - 32, qb = 7 - (aidx >> 7), rem = aidx & 127, b = rem >> 4, vh = rem & 15;
#if FAST_ATTN
            { const int h = vh >> 2, m = (vh >> 1) & 1, vhalf = vh & 1; const bf16_t* zb = Z + (size_t)b * SEQ * Z0P;
              attn_body::attn_unit<8>(qb, zb + 1536 + h * 128 + m * 64, zb + 2048 + h * 128 + m * 64, zb + 2560 + h * 128 + vhalf * 64,
                                      (bf16_t*)(ws + WS_OPART) + (size_t)b * SEQ * 1024 + vh * 64, shm, wv); }
#ifdef DBG_TS
            if (opaque_tid(wv) == 0) atomicMax((unsigned long long*)(ws + WS_CTL + 49152) + 33, (unsigned long long)__builtin_amdgcn_s_memrealtime());
#endif
#else
            attn_unit_ref(b, vh, qb, Z, (bf16_t*)(ws + WS_OPART), wv);
#endif
        }
    }
}
DEV void phase_mix1(const Params& P, LAS unsigned char* lds, int wv) {
    unsigned char* ws = opaque_ws(P.ws); const bf16_t* Z = (const bf16_t*)(ws + WS_Z);
    const int G = gridDim.x, nret = G >= 64 ? 32 : 0;
    if ((int)blockIdx.x < nret || nret == 0) {
        for (int q = blockIdx.x; q < 32; q += (nret ? 32 : G)) {
            const int b = q >> 2, h = q & 3; const size_t rb = (size_t)b * SEQ;
            LinAttnArgs a; a.q = Z + rb * Z1P + 1024 + h * 64; a.k = Z + rb * Z1P + 1280 + h * 64; a.v = Z + rb * Z1P + 1536 + h * 128; a.og = Z + rb * Z1P + 2048 + h * 128; a.zp = Z1P;
            a.la = nullptr; a.log_g = logf(1.0f - exp2f(-5.0f - (float)h)); a.gain = nullptr; a.out = (bf16_t*)(ws + WS_CAT) + rb * 1024 + 512 + h * 128;
            linattn_unit_fast<128, false>(a, lds, wv);
        }
    }
    if ((int)blockIdx.x >= nret) {
        for (int s2 = (int)blockIdx.x - nret; s2 < 128; s2 += G - nret) sgu_unit_fast(P, s2 >> 4, s2 & 15, lds, wv);
        conv_experts(P, lds, wv, 1, nret, G - nret);
    }
}
DEV void phase_combine(const Params& P, int wv) {
    const int tid = opaque_tid(wv), lane = tid & 63, wid = tid >> 6, G = gridDim.x;
    const float* q1 = (const float*)P.in[9]; const float* k1 = (const float*)P.in[10]; const float* q2 = (const float*)P.in[11]; const float* k2 = (const float*)P.in[12];
    const float* dg = (const float*)P.in[13];
    const float lam = __expf(wave_sum(q1[lane] * k1[lane])) - __expf(wave_sum(q2[lane] * k2[lane])) + 0.2f;
    unsigned char* ws = opaque_ws(P.ws); const bf16_t* OP = (const bf16_t*)(ws + WS_OPART); bf16_t* CAT = (bf16_t*)(ws + WS_CAT);
    const int h = lane >> 4, e0 = (lane & 15) * 8;
    float g[8];
#pragma unroll
    for (int j = 0; j < 8; ++j) g[j] = dg[e0 + j] * 0.8f;
    for (int row = blockIdx.x * NWAVES + wid; row < NTOK; row += G * NWAVES) {
        float a0[8], a1[8], d[8];
        unpack8(*(const bf16x8*)(OP + (size_t)row * 1024 + h * 256 + e0), a0); unpack8(*(const bf16x8*)(OP + (size_t)row * 1024 + h * 256 + 128 + e0), a1);
        float ss = 0.f;
#pragma unroll
        for (int j = 0; j < 8; ++j) { d[j] = a0[j] - lam * a1[j]; ss += d[j] * d[j]; }
        ss += __shfl_xor(ss, 1); ss += __shfl_xor(ss, 2); ss += __shfl_xor(ss, 4); ss += __shfl_xor(ss, 8);
        const float rstd = 1.0f / sqrtf(ss * (1.f / 128.f) + EPS);
        u32x4 w; w.x = pk2(d[0] * rstd * g[0], d[1] * rstd * g[1]); w.y = pk2(d[2] * rstd * g[2], d[3] * rstd * g[3]);
        w.z = pk2(d[4] * rstd * g[4], d[5] * rstd * g[5]); w.w = pk2(d[6] * rstd * g[6], d[7] * rstd * g[7]);
        *(u32x4*)(CAT + (size_t)row * 1024 + 512 + h * 128 + e0) = w;
    }
}


#ifdef DBG_PROBE_OFF
constexpr int CW_PROBE = 1024;
__global__ void __launch_bounds__(NTHREADS) mk_probe(Params P) {
    const int tid = opaque_tid(wv), G = gridDim.x;
    float s = 0.f;
    const unsigned char* base = P.ws + (size_t)DBG_PROBE_OFF;
    for (long i = (long)blockIdx.x * NTHREADS + tid; i < (long)NTOK * DBG_PROBE_NCOLS; i += (long)G * NTHREADS) {
        const long r = i / DBG_PROBE_NCOLS; const int c = (int)(i % DBG_PROBE_NCOLS) + DBG_PROBE_COL0;
        float v;
        if (DBG_PROBE_F32) v = ((const float*)base)[r * DBG_PROBE_PITCH + c]; else v = bf2f(((const bf16_t*)base)[r * DBG_PROBE_PITCH + c]);
        s += DBG_PROBE_ABS ? fabsf(v) : v * v;
    }
    s = wave_sum(s);
    if ((tid & 63) == 0) atomicAdd((float*)(P.ws + WS_CTL) + CW_PROBE, s);
}
#endif

#define XB_TMO      128
#define XB_XCNT(j)  (256  + 64 * (j))
#define XB_XSUB(j)  (1280 + 64 * (j))
#define XB_XGEN(j)  (2304 + 64 * (j))
#define XB_TOP      3328
#define XB_TOPGEN   3392
#define XCD_BAR_WORDS 3456
#define XB_SPIN_CAP (1u << 18)

__device__ __forceinline__ unsigned xb_ld(unsigned* p)              { return __hip_atomic_load(p, __ATOMIC_RELAXED, __HIP_MEMORY_SCOPE_AGENT); }
__device__ __forceinline__ unsigned xb_add(unsigned* p, unsigned v) { return __hip_atomic_fetch_add(p, v, __ATOMIC_RELAXED, __HIP_MEMORY_SCOPE_AGENT); }
__device__ __forceinline__ unsigned xb_xcc_id() { return (unsigned)__builtin_amdgcn_s_getreg((3 << 11) | 20) & 0xFu; }
#define XB_SPIN(cond, bar) do { unsigned _sp = 0; while (cond) { __builtin_amdgcn_s_sleep(1); \
    if ((++_sp & 255u) == 0u) { if (xb_ld(&(bar)[XB_TMO])) break; if (_sp > XB_SPIN_CAP) { atomicAdd(&(bar)[XB_TMO], 1u); break; } } } } while (0)

struct XcdBarrier {
    unsigned* bar; unsigned x;
    volatile LAS unsigned* st;
};

__device__ __forceinline__ XcdBarrier xcd_barrier_post(unsigned* bar, volatile LAS unsigned* st) {
    XcdBarrier b; b.bar = bar; b.x = xb_xcc_id(); b.st = st;
    if (threadIdx.x == 0) (void)xb_add(&bar[XB_XCNT(b.x)], 1u);
    return b;
}
__device__ __forceinline__ void xcd_barrier_complete(unsigned* bar, unsigned x, unsigned& nloc, unsigned& nx) {
    const unsigned G = gridDim.x * gridDim.y * gridDim.z;
    unsigned sum, cnt, mine, sp = 0u;
    for (;;) {
        sum = 0u; cnt = 0u; mine = 0u;
#pragma unroll
        for (unsigned j = 0; j < 16; ++j) { const unsigned c = xb_ld(&bar[XB_XCNT(j)]); sum += c; cnt += (c > 0u) ? 1u : 0u; mine = (j == x) ? c : mine; }
        if (sum == G) break;
        __builtin_amdgcn_s_sleep(1);
        if ((++sp & 255u) == 0u) { if (xb_ld(&bar[XB_TMO])) break; if (sp > XB_SPIN_CAP) { atomicAdd(&bar[XB_TMO], 1u); break; } }
    }
    nloc = mine > 0u ? mine : 1u; nx = cnt > 0u ? cnt : 1u;
}

__device__ __forceinline__ void xcd_barrier(const XcdBarrier& b) {
    asm volatile("s_waitcnt vmcnt(0)" ::: "memory");
    __syncthreads();
    if (threadIdx.x == 0) {
        unsigned* bar = b.bar;
        __builtin_amdgcn_s_waitcnt(0);
        unsigned nloc = b.st[0], nx = b.st[1];
        if (nloc == 0u) { xcd_barrier_complete(bar, b.x, nloc, nx); b.st[0] = nloc; b.st[1] = nx; }
        const unsigned old = xb_add(&bar[XB_XSUB(b.x)], 1u);
        const unsigned gen = old / nloc;
        if (old + 1u == (gen + 1u) * nloc) {
            __builtin_amdgcn_fence(__ATOMIC_RELEASE, "agent");
            asm volatile("s_waitcnt vmcnt(0)" ::: "memory");
            const unsigned og = xb_add(&bar[XB_TOP], 1u);
            const unsigned tg = og / nx;
            if (og + 1u == (tg + 1u) * nx) xb_add(&bar[XB_TOPGEN], 1u);
            else XB_SPIN(xb_ld(&bar[XB_TOPGEN]) == tg, bar);
            __builtin_amdgcn_fence(__ATOMIC_ACQUIRE, "agent");
            xb_add(&bar[XB_XGEN(b.x)], 1u);
            asm volatile("s_waitcnt vmcnt(0)" ::: "memory");
        } else {
            XB_SPIN(xb_ld(&bar[XB_XGEN(b.x)]) == gen, bar);
            __builtin_amdgcn_fence(__ATOMIC_ACQUIRE, "agent");
            asm volatile("s_waitcnt vmcnt(0)" ::: "memory");
        }
    }
    __syncthreads();
}
template <class Epi, class Sched>
DEV void gemm_run(LAS unsigned char* lds, const Sched& S, const Epi& E, int wv, unsigned char* dbg_ws = nullptr) {
#if FAST_GEMM
    pg8::gemm_phase(lds, S, E, wv, dbg_ws);
#else
    gemm_ref(S, E, wv);
#endif
}

constexpr int N_PHASES = 17;
template <int lo, int hi>
__global__ void __launch_bounds__(NTHREADS, 2) mk_fwd(Params P) {
    extern __shared__ __attribute__((aligned(16))) unsigned char lds_raw[];
    LAS unsigned char* lds = (LAS unsigned char*)lds_raw;
    const int G = gridDim.x, c = blockIdx.x;
    const int wv = __builtin_amdgcn_readfirstlane((int)(threadIdx.x >> 6));
#if ONE_LAUNCH
    { volatile LAS unsigned* stw = (volatile LAS unsigned*)(lds + LCTL_OFF + 8192); if (threadIdx.x < 4) stw[threadIdx.x] = 0u; }
    __syncthreads();
    const XcdBarrier xbar = xcd_barrier_post((unsigned*)(P.ws + WS_CTL) + CW_BAR, (volatile LAS unsigned*)(lds + LCTL_OFF + 8192));
#if USE_CG_SYNC
    cg::grid_group grid = cg::this_grid();
#define GRID_BAR() grid.sync()
#else
#define GRID_BAR() xcd_barrier(xbar)
#endif
#else
#define GRID_BAR() do {} while (0)
#endif
#define IN(k) (lo <= (k) && (k) < hi)
#ifdef DBG_TS
#define STAMP(k) do { if (blockIdx.x == 0 && threadIdx.x == 0) ((unsigned long long*)(P.ws + WS_CTL + 49152))[(k)] = __builtin_amdgcn_s_memrealtime(); } while (0)
#else
#define STAMP(k) do {} while (0)
#endif
#define SEAM(k) do { if constexpr (lo <= (k) + 1 && (k) + 1 < hi) GRID_BAR(); STAMP((k) + 1); } while (0)
#define PH_PTRS unsigned char* ws = opaque_ws(P.ws); const float* mod = (const float*)(ws + WS_MOD); bf16_t* H = (bf16_t*)(ws + WS_H); bf16_t* Z = (bf16_t*)(ws + WS_Z); bf16_t* CAT = (bf16_t*)(ws + WS_CAT); \
    void* X1 = (void*)(ws + WS_X1); void* X2 = (void*)(ws + WS_X2); const float* x = (const float*)P.in[0]; (void)mod; (void)H; (void)Z; (void)CAT; (void)X1; (void)X2; (void)x;

    STAMP(0);
    if constexpr (IN(0)) { PH_PTRS phase_prologue(P, lds, wv); conv_experts(P, lds, wv, 0, 0, G); SEAM(0); }
    if constexpr (IN(1)) { PH_PTRS phase_prenorm_gate(P, lds, wv); SEAM(1); }
    if constexpr (IN(2)) { PH_PTRS
#ifdef DBG_STAGGER2_US
        { const unsigned long long t0 = __builtin_amdgcn_s_memrealtime(); const unsigned long long dl = (unsigned long long)((blockIdx.x >> 3) & 3) * (DBG_STAGGER2_US * 25);
          while (__builtin_amdgcn_s_memrealtime() - t0 < dl) __builtin_amdgcn_s_sleep(8); }
#endif
        DenseSched S{H, (const bf16_t*)(ws + WS_WIN0), 1024, NTOK / 256, N_IN0 / 256, G, c};
        EpiIn E{Z, Z0P, (float*)(ws + WS_LA), (const float*)P.in[7], (const float*)(ws + WS_ROPE), 0};
        gemm_run(lds, S, E, wv, ws); SEAM(2);
    }
    if constexpr (IN(3)) { PH_PTRS phase_mix0(P, lds, (char*)lds_raw, wv); SEAM(3); }
    if constexpr (IN(4)) { PH_PTRS phase_combine(P, wv); SEAM(4); }
    if constexpr (IN(5)) { PH_PTRS
        DenseSched S{CAT, (const bf16_t*)(ws + WS_WOUT0), 1024, NTOK / 256, 4, G, c};
        EpiResid<false> E{x, X1, mod + 2 * 1024, (DBG_SKIP >> 0) & 1, DBG_F_MIX0};
        gemm_run(lds, S, E, wv, ws); SEAM(5);
    }
    if constexpr (IN(6)) { PH_PTRS phase_router(P, lds, wv, X1, 0); SEAM(6); }
    if constexpr (IN(7)) { PH_PTRS
        const int* cnt = (const int*)(ws + WS_CTL) + CW_CNT; const int* ent = (const int*)(ws + WS_ENT);
        MoeTiles mt = moe_build_tiles(cnt, lds, wv);
#ifdef DBG_STAGGER_US
        { const unsigned long long t0 = __builtin_amdgcn_s_memrealtime(); const unsigned long long dl = (unsigned long long)((blockIdx.x >> 3) & 3) * (DBG_STAGGER_US * 25);
          while (__builtin_amdgcn_s_memrealtime() - t0 < dl) __builtin_amdgcn_s_sleep(8); }
#endif
        MoeSched1 S{ws + WS_XQ, ws + WS_W1, mt, 1024, 8, G, c};
        EpiSwiglu E{(bf16_t*)(ws + WS_A), (const float*)P.in[24]};
        gemm_run(lds, S, E, wv, ws); SEAM(7);
    }
    if constexpr (IN(8)) { PH_PTRS
        const int* cnt = (const int*)(ws + WS_CTL) + CW_CNT; const int* ent = (const int*)(ws + WS_ENT);
        MoeTiles mt = moe_build_tiles(cnt, lds, wv);
        MoeSched2 S{ws + WS_A, ws + WS_W2, mt, 1024, 4, G, c};
        EpiMoeOut E{(bf16_t*)(ws + WS_YB), (const float*)P.in[26], cnt, ent, (const float*)(ws + WS_GL)};
        gemm_run(lds, S, E, wv, ws); SEAM(8);
    }
    if constexpr (IN(9)) { PH_PTRS phase_prenorm<3, RES_BF16>(P, lds, wv, X1, X2, 1, 0, 0); SEAM(9); }
    if constexpr (IN(10)) { PH_PTRS
        DenseSched S{H, (const bf16_t*)(ws + WS_WIN1), 1024, NTOK / 256, N_IN1 / 256, G, c};
        EpiIn E{Z, Z1P, nullptr, nullptr, (const float*)(ws + WS_ROPE), 1};
        gemm_run(lds, S, E, wv, ws); SEAM(10);
    }
    if constexpr (IN(11)) { PH_PTRS phase_mix1(P, lds, wv); SEAM(11); }
    if constexpr (IN(12)) { PH_PTRS
        DenseSched S{CAT, (const bf16_t*)(ws + WS_WOUT1), 1024, NTOK / 256, 4, G, c};
        EpiResid<RES_BF16> E{X2, X1, mod + 8 * 6144 + 2 * 1024, (DBG_SKIP >> 2) & 1, DBG_F_MIX1};
        gemm_run(lds, S, E, wv, ws); SEAM(12);
    }
    if constexpr (IN(13)) { PH_PTRS phase_router(P, lds, wv, X1, 1); SEAM(13); }
    if constexpr (IN(14)) { PH_PTRS
        const int* cnt = (const int*)(ws + WS_CTL) + CW_CNT + NEXP * CNT_STRIDE; const int* ent = (const int*)(ws + WS_ENT) + (size_t)NEXP * ENT_CAP;
        MoeTiles mt = moe_build_tiles(cnt, lds, wv);
        MoeSched1 S{ws + WS_XQ, ws + WS_W1 + (size_t)NEXP * 2048 * 1024, mt, 1024, 8, G, c};
        EpiSwiglu E{(bf16_t*)(ws + WS_A), (const float*)P.in[24] + (size_t)NEXP * 2048};
        gemm_run(lds, S, E, wv, ws); SEAM(14);
    }
    if constexpr (IN(15)) { PH_PTRS
        const int* cnt = (const int*)(ws + WS_CTL) + CW_CNT + NEXP * CNT_STRIDE; const int* ent = (const int*)(ws + WS_ENT) + (size_t)NEXP * ENT_CAP;
        MoeTiles mt = moe_build_tiles(cnt, lds, wv);
        MoeSched2 S{ws + WS_A, ws + WS_W2 + (size_t)NEXP * 1024 * 1024, mt, 1024, 4, G, c};
        EpiMoeOut E{(bf16_t*)(ws + WS_YB), (const float*)P.in[26] + (size_t)NEXP * 1024, cnt, ent, (const float*)(ws + WS_GL) + (size_t)NEXP * ENT_CAP};
        gemm_run(lds, S, E, wv, ws); SEAM(15);
    }
    if constexpr (IN(16)) { PH_PTRS phase_prenorm<9, RES_BF16>(P, lds, wv, X1, nullptr, 1, 0, 1); }
#undef IN
#undef SEAM
}

template <int PH> static void launch_phase(int grid, const Params& p, hipStream_t stream) {
    (void)hipFuncSetAttribute((const void*)mk_fwd<PH, PH + 1>, hipFuncAttributeMaxDynamicSharedMemorySize, LDS_BYTES);
    hipLaunchKernelGGL((mk_fwd<PH, PH + 1>), dim3(grid), dim3(NTHREADS), LDS_BYTES, stream, p);
}
#ifdef DBG_PHASES
template <int PH> static void launch_masked(int grid, const Params& p, hipStream_t stream) {
    if constexpr (PH < N_PHASES) { if constexpr ((DBG_PHASES >> PH) & 1) launch_phase<PH>(grid, p, stream); launch_masked<PH + 1>(grid, p, stream); }
}
#endif
template <int PH> static void launch_all(int grid, const Params& p, hipStream_t stream) {
    if constexpr (PH < N_PHASES) { launch_phase<PH>(grid, p, stream); launch_all<PH + 1>(grid, p, stream); }
}
extern "C" void kernel_launch(void* const* d_in, const int* in_sizes, int n_in, void* d_out, int out_size, void* d_ws, size_t ws_size, hipStream_t stream) {
    static int grid = 0;
    if (grid == 0) {
        if (n_in != 28 || out_size != NTOK * DM || ws_size < WS_END) { fprintf(stderr, "kernel_launch: unexpected shapes (n_in %d out %d ws %zu)\n", n_in, out_size, ws_size); grid = -1; return; }
        int dev = 0, cus = 0;
        (void)hipGetDevice(&dev); (void)hipDeviceGetAttribute(&cus, hipDeviceAttributeMultiprocessorCount, dev);
#if ONE_LAUNCH
        int per_cu = 0;
        if (hipFuncSetAttribute((const void*)mk_fwd<0, N_PHASES>, hipFuncAttributeMaxDynamicSharedMemorySize, LDS_BYTES) != hipSuccess) { fprintf(stderr, "kernel_launch: hipFuncSetAttribute failed\n"); grid = -1; return; }
        (void)hipOccupancyMaxActiveBlocksPerMultiprocessor(&per_cu, (const void*)mk_fwd<0, N_PHASES>, NTHREADS, LDS_BYTES);
        if (per_cu < 1) { fprintf(stderr, "kernel_launch: occupancy query reports %d blocks per CU\n", per_cu); grid = -1; return; }
#endif
        (void)hipGetLastError();
        grid = cus;
    }
    if (grid < 0) return;
    (void)hipMemsetAsync((char*)d_ws + WS_CTL, 0, CTL_ZERO_BYTES, stream);
    Params p{};
    for (int i = 0; i < 28; ++i) p.in[i] = d_in[i];
    p.out = (float*)d_out; p.ws = (unsigned char*)d_ws;
#if ONE_LAUNCH
    void* args[] = {&p};
    hipError_t e = hipLaunchCooperativeKernel((const void*)mk_fwd<0, N_PHASES>, dim3(grid), dim3(NTHREADS), args, LDS_BYTES, stream);
    if (e != hipSuccess) fprintf(stderr, "cooperative launch failed: %s (grid %d)\n", hipGetErrorString(e), grid);
#else
#ifdef DBG_PHASES
    launch_masked<0>(grid, p, stream);
#ifdef DBG_PROBE_OFF
    hipLaunchKernelGGL(mk_probe, dim3(grid), dim3(NTHREADS), 0, stream, p);
    launch_phase<16>(grid, p, stream);
#endif
#else
    launch_all<0>(grid, p, stream);
#endif
#endif
}
```

```cpp
#include <hip/hip_runtime.h>
#include <hip/hip_cooperative_groups.h>
#include <cstdio>
#include <cstdint>
namespace cg = cooperative_groups;

#ifndef ONE_LAUNCH
#define ONE_LAUNCH 1
#endif
#ifndef FAST_GEMM
#define FAST_GEMM 1
#endif
#ifndef USE_CG_SYNC
#define USE_CG_SYNC 0
#endif
#ifndef FAST_ATTN
#define FAST_ATTN 1
#endif
#ifndef MOE_FP8
#define MOE_FP8 1
#endif
#ifndef FAST_LIN
#define FAST_LIN 1
#endif
#ifndef FAST_SGU
#define FAST_SGU 1
#endif
#ifndef DBG_SKIP
#define DBG_SKIP 0
#endif
#ifndef DBG_FINAL_X
#define DBG_FINAL_X 0
#endif
#ifndef DBG_F_MIX0
#define DBG_F_MIX0 1.0f
#endif
#ifndef DBG_F_MOE0
#define DBG_F_MOE0 1.0f
#endif
#ifndef DBG_F_MIX1
#define DBG_F_MIX1 1.0f
#endif
#ifndef DBG_F_MOE1
#define DBG_F_MOE1 1.0f
#endif

#define DEV __device__ __forceinline__
#define LAS __attribute__((address_space(3)))
typedef unsigned short bf16_t;
typedef short bf16x8 __attribute__((ext_vector_type(8)));
typedef float f32x4 __attribute__((ext_vector_type(4)));
typedef float f32x2 __attribute__((ext_vector_type(2)));
typedef unsigned u32x4 __attribute__((ext_vector_type(4)));
typedef unsigned u32x2 __attribute__((ext_vector_type(2)));
typedef __bf16 bf16x2_t __attribute__((ext_vector_type(2)));
typedef int v8i __attribute__((ext_vector_type(8)));

constexpr int NB = 8, SEQ = 2048, DM = 1024, NTOK = NB * SEQ, NEXP = 32, TOPK = 4;
constexpr int Z0P = 3072, Z1P = 2560;
constexpr int N_IN0 = 3072, N_IN1 = 2560;
constexpr int ENT_CAP = NTOK;
constexpr float EPS = 1e-6f;
constexpr float C2 = 0.125f * 1.4426950408889634f;
constexpr int NTHREADS = 512, NWAVES = 8;

constexpr size_t MiB = 1u << 20;
constexpr size_t WS_CTL = 0, CTL_ZERO_BYTES = 64 * 1024;
constexpr size_t WS_MOD = 1 * MiB;
constexpr size_t WS_ROPE = 2 * MiB;
constexpr size_t WS_ENT = 6 * MiB;
constexpr size_t WS_GATES = 10 * MiB;
constexpr size_t WS_SGUW = 11 * MiB;
constexpr size_t WS_WIN0 = 12 * MiB;
constexpr size_t WS_WOUT0 = 19 * MiB;
constexpr size_t WS_WIN1 = 21 * MiB;
constexpr size_t WS_WOUT1 = 26 * MiB;
constexpr size_t WS_W1 = 32 * MiB;
constexpr size_t WS_W2 = 288 * MiB;
constexpr size_t WS_H = 416 * MiB;
constexpr size_t WS_Z = 448 * MiB;
constexpr size_t WS_LA = 544 * MiB;
constexpr size_t WS_OPART = 560 * MiB;
constexpr size_t WS_CAT = 592 * MiB;
constexpr size_t WS_X1 = 624 * MiB;
constexpr size_t WS_X2 = 688 * MiB;
constexpr size_t WS_A = 752 * MiB;
constexpr size_t WS_YB = 896 * MiB;
constexpr size_t WS_GL = 1000 * MiB;
constexpr size_t WS_XQ = 1024 * MiB;
constexpr size_t WS_END = 1536 * MiB;
constexpr int CW_CNT = 8192, CNT_STRIDE = 64;
constexpr int CW_QUEUE = 256;
constexpr int CW_BAR = 4096;

constexpr int RING_BYTES = 131072;
constexpr int LCTL_OFF = 149504;
constexpr int LDS_BYTES = 163840;

DEV float bf2f(bf16_t v) { return __uint_as_float((unsigned)v << 16); }
DEV unsigned pk2(float lo, float hi) { f32x2 v = {lo, hi}; bf16x2_t b = __builtin_convertvector(v, bf16x2_t); return __builtin_bit_cast(unsigned, b); }
DEV bf16_t f2bf(float f) { return (bf16_t)(pk2(f, 0.f) & 0xffffu); }
DEV unsigned pk4_fp8(float a, float b, float c, float d) { unsigned w = __builtin_amdgcn_cvt_pk_fp8_f32(a, b, 0, false); return __builtin_amdgcn_cvt_pk_fp8_f32(c, d, w, true); }
constexpr float W8_SCALE = 64.f, W8_INV = 1.f / 64.f;
constexpr float YB_SCALE = 32.f, YB_INV = 1.f / 32.f;
DEV float wave_sum(float v) {
#pragma unroll
    for (int o = 1; o < 64; o <<= 1) v += __shfl_xor(v, o);
    return v;
}
DEV float silu_f(float x) { return x * __builtin_amdgcn_rcpf(1.f + __builtin_amdgcn_exp2f(-1.4426950408889634f * x)); }
DEV float log_sigmoid_f(float x) { return fminf(x, 0.f) - __logf(1.f + __expf(-fabsf(x))); }
DEV float gelu_f(float v) {
    const float av = fabsf(v), t = __builtin_amdgcn_rcpf(av * 0.2316418882f + 1.0f);
    float q = t * 0.5307027145f + (-0.7265760135f); q = q * t + 0.7107068705f; q = q * t + (-0.142248368f); q = q * t + 0.127414796f; q = q * t;
    const float e = __builtin_amdgcn_exp2f((v * v) * (-0.72134752044f));
    const float m = v * (q * e);
    return v < 0.f ? m : v - m;
}
DEV void unpack8(const bf16x8 v, float (&o)[8]) {
#pragma unroll
    for (int j = 0; j < 8; ++j) o[j] = bf2f((bf16_t)v[j]);
}

DEV unsigned char* opaque_ws(unsigned char* p) { size_t z = 0; asm volatile("" : "+s"(z)); return p + z; }
DEV int lane_id() { return (int)__builtin_amdgcn_mbcnt_hi(~0u, __builtin_amdgcn_mbcnt_lo(~0u, 0u)); }
DEV int opaque_tid(int wv) { int l; asm volatile("v_mbcnt_lo_u32_b32 %0, -1, 0\n\tv_mbcnt_hi_u32_b32 %0, -1, %0" : "=v"(l)); return (wv << 6) | l; }
#define LBAR() do { asm volatile("s_waitcnt lgkmcnt(0)" ::: "memory"); __builtin_amdgcn_s_barrier(); asm volatile("" ::: "memory"); } while (0)
#ifndef RES_BF16
#define RES_BF16 1
#endif
template <bool BF> DEV f32x4 ld_res4(const void* base, size_t elem) {
    if constexpr (BF) { const u32x2 w = *(const u32x2*)((const bf16_t*)base + elem); return (f32x4){__uint_as_float(w.x << 16), __uint_as_float(w.x & 0xffff0000u), __uint_as_float(w.y << 16), __uint_as_float(w.y & 0xffff0000u)}; }
    else return *(const f32x4*)((const float*)base + elem);
}
template <bool BF> DEV void st_res4(void* base, size_t elem, f32x4 v) {
    if constexpr (BF) { u32x2 w; w.x = pk2(v[0], v[1]); w.y = pk2(v[2], v[3]); *(u32x2*)((bf16_t*)base + elem) = w; }
    else *(f32x4*)((float*)base + elem) = v;
}
struct Params {
    const void* in[28];
    float* out;
    unsigned char* ws;
};

struct Unit { int pm, pn, e, tb, rows; };

DEV bool static_next(int i, int G, int c, int nM, int nN, int& pm, int& pn) {
    const int nwg = nM * nN; const long Lr = (long)i * G + c; if (Lr >= nwg) return false;
    int wgid = (int)Lr; { const int q = nwg / 8, r = nwg % 8, xcd = wgid % 8, off = wgid / 8; wgid = (xcd < r ? xcd * (q + 1) : r * (q + 1) + (xcd - r) * q) + off; }
    const int nig = 8 * nN, gid = wgid / nig, fm = gid * 8, gsz = (nM - fm) < 8 ? (nM - fm) : 8;
    pm = fm + ((wgid % nig) % gsz); pn = (wgid % nig) / gsz; return true;
}
struct DenseSched {
    static constexpr int EB = 2;
    const bf16_t* A; const bf16_t* Bt; int K, nM, nN, G, c;
    static constexpr bool RAGGED = false;
    DEV bool next(int i, Unit& u) const { u.e = 0; u.tb = 0; u.rows = 256; return static_next(i, G, c, nM, nN, u.pm, u.pn); }
    DEV const char* a_ptr(const Unit& u) const { return (const char*)(A + (size_t)u.pm * 256 * K); }
    DEV const char* b_ptr(const Unit& u) const { return (const char*)(Bt + (size_t)u.pn * 256 * K); }
};
struct MoeTiles { const LAS int* te; const LAS int* ttb; const LAS int* trows; int nt; };
struct MoeSched1 {
    static constexpr int EB = 1; static constexpr bool RAGGED = true;
    const unsigned char* A; const unsigned char* Bt; MoeTiles mt; int K, nN, G, c;
    DEV bool next(int i, Unit& u) const { int pm, pn; if (!static_next(i, G, c, mt.nt, nN, pm, pn)) return false; u.pm = pm; u.pn = pn; u.e = mt.te[pm]; u.tb = mt.ttb[pm]; u.rows = mt.trows[pm]; return true; }
    DEV const char* a_ptr(const Unit& u) const { return (const char*)A + ((size_t)u.e * ENT_CAP + (size_t)u.tb * 256) * K; }
    DEV const char* b_ptr(const Unit& u) const { return (const char*)Bt + ((size_t)u.e * 2048 + (size_t)u.pn * 256) * K; }
};
struct MoeSched2 {
    static constexpr int EB = 1; static constexpr bool RAGGED = true;
    const unsigned char* A; const unsigned char* Bt; MoeTiles mt; int K, nN, G, c;
    DEV bool next(int i, Unit& u) const { int pm, pn; if (!static_next(i, G, c, mt.nt, nN, pm, pn)) return false; u.pm = pm; u.pn = pn; u.e = mt.te[pm]; u.tb = mt.ttb[pm]; u.rows = mt.trows[pm]; return true; }
    DEV const char* a_ptr(const Unit& u) const { return (const char*)A + (size_t)u.pm * 256 * K; }
    DEV const char* b_ptr(const Unit& u) const { return (const char*)Bt + ((size_t)u.e * 1024 + (size_t)u.pn * 256) * K; }
};
DEV MoeTiles moe_build_tiles(const int* cnt, LAS unsigned char* lds, int wv) {
    LAS int* te = (LAS int*)(lds + LCTL_OFF); LAS int* ttb = te + 320; LAS int* trows = ttb + 320; LAS int* ntp = trows + 320;
    __syncthreads();
    const int tid = opaque_tid(wv);
    if (tid < 64) {
        const int e = tid & 31; const bool act = tid < 32;
        const int c = __hip_atomic_load(cnt + e * CNT_STRIDE, __ATOMIC_RELAXED, __HIP_MEMORY_SCOPE_AGENT);
        const int nfull = c >> 8, rem = c & 255;
        int incl = nfull;
#pragma unroll
        for (int o = 1; o < 32; o <<= 1) { const int t = __shfl_up(incl, o, 32); if ((tid & 31) >= o) incl += t; }
        const int base = incl - nfull, nfull_total = __shfl(incl, 31, 32);
        int rank = 0, npart = 0;
#pragma unroll
        for (int j = 0; j < 32; ++j) { const int rj = __shfl(rem, j, 32); npart += rj > 0; rank += (rj > rem) || (rj == rem && j < e); }
        if (act) {
            for (int t = 0; t < nfull; ++t) { te[base + t] = e; ttb[base + t] = t; trows[base + t] = 256; }
            if (rem > 0) { te[nfull_total + rank] = e; ttb[nfull_total + rank] = nfull; trows[nfull_total + rank] = rem; }
            if (tid == 0) *ntp = nfull_total + npart;
        }
    }
    __syncthreads();
    MoeTiles mt; mt.te = te; mt.ttb = ttb; mt.trows = trows; mt.nt = *ntp; return mt;
}

enum { EK_PLAIN = 0, EK_SILU = 1, EK_GELU = 2, EK_ROPE = 3, EK_LOGSIG = 4 };
struct EpiIn {
    static constexpr bool PERM = true;
    bf16_t* Z; int zp; float* LA; const float* bgate; const float* rope; int layer;
    DEV void kind_of(int pn, int& kind, float& sc) const {
        kind = EK_PLAIN; sc = 1.f;
        if (layer == 0) { if (pn == 0) sc = 0.125f; else if (pn == 4 || pn == 5) kind = EK_SILU; else if (pn == 6 || pn == 7) { kind = EK_ROPE; sc = C2; } else if (pn == 8 || pn == 9) kind = EK_ROPE; else if (pn == 12) kind = EK_LOGSIG; }
        else { if (pn < 4) kind = EK_GELU; else if (pn == 4) { kind = EK_ROPE; sc = 0.125f; } else if (pn == 5) kind = EK_ROPE; else if (pn >= 8) kind = EK_SILU; }
    }
    DEV void operator()(const f32x4 (&acc)[2][2][4][2], const Unit& u, int wr, int wc, int fr, int fq) const {
        int kind; float sc; kind_of(u.pn, kind, sc);
        if (kind == EK_ROPE) {
#pragma unroll
            for (int ai = 0; ai < 2; ++ai) {
                f32x4 tb[4][4];
#pragma unroll
                for (int m = 0; m < 4; ++m) { const float* rt = rope + (size_t)(u.pm * 256 + ai * 128 + wr * 64 + m * 16 + fr) * 64 + (8 * fq) * 2;
#pragma unroll
                    for (int q = 0; q < 4; ++q) tb[m][q] = *(const f32x4*)(rt + 4 * q); }
                asm volatile("" ::: "memory");
#pragma unroll
                for (int m = 0; m < 4; ++m) { const int row = u.pm * 256 + ai * 128 + wr * 64 + m * 16 + fr;
                    float y1[8], y2[8];
#pragma unroll
                    for (int n = 0; n < 2; ++n)
#pragma unroll
                        for (int i = 0; i < 4; ++i) { const int j = 4 * n + i; const float cs = tb[m][j >> 1][(j & 1) * 2], sn = tb[m][j >> 1][(j & 1) * 2 + 1];
                            const float x1 = acc[ai][0][m][n][i], x2 = acc[ai][1][m][n][i];
                            y1[j] = (x1 * cs - x2 * sn) * sc; y2[j] = (x2 * cs + x1 * sn) * sc; }
                    bf16_t* zp_ = Z + (size_t)row * zp + u.pn * 256 + 64 * wc + 8 * fq;
                    u32x4 w; w.x = pk2(y1[0], y1[1]); w.y = pk2(y1[2], y1[3]); w.z = pk2(y1[4], y1[5]); w.w = pk2(y1[6], y1[7]); *(u32x4*)(zp_) = w;
                    w.x = pk2(y2[0], y2[1]); w.y = pk2(y2[2], y2[3]); w.z = pk2(y2[4], y2[5]); w.w = pk2(y2[6], y2[7]); *(u32x4*)(zp_ + 32) = w; }
            }
            return;
        }
        if (kind == EK_LOGSIG) {
            f32x4 b0[2], b1[2];
#pragma unroll
            for (int bj = 0; bj < 2; ++bj) { const int col = 128 * bj + 32 * wc + 8 * fq; b0[bj] = *(const f32x4*)(bgate + col); b1[bj] = *(const f32x4*)(bgate + col + 4); }
#pragma unroll
            for (int ai = 0; ai < 2; ++ai)
#pragma unroll
                for (int m = 0; m < 4; ++m) { const int row = u.pm * 256 + ai * 128 + wr * 64 + m * 16 + fr;
#pragma unroll
                    for (int bj = 0; bj < 2; ++bj) { const int col = 128 * bj + 32 * wc + 8 * fq; float* lp = LA + (size_t)row * 256 + col; f32x4 o0, o1;
#pragma unroll
                        for (int i = 0; i < 4; ++i) { o0[i] = log_sigmoid_f(acc[ai][bj][m][0][i] + b0[bj][i]) * 0.0625f; o1[i] = log_sigmoid_f(acc[ai][bj][m][1][i] + b1[bj][i]) * 0.0625f; }
                        *(f32x4*)lp = o0; *(f32x4*)(lp + 4) = o1; } }
            return;
        }
#pragma unroll
        for (int ai = 0; ai < 2; ++ai)
#pragma unroll
            for (int m = 0; m < 4; ++m) { const int row = u.pm * 256 + ai * 128 + wr * 64 + m * 16 + fr;
#pragma unroll
                for (int bj = 0; bj < 2; ++bj) { float v[8];
#pragma unroll
                    for (int n = 0; n < 2; ++n)
#pragma unroll
                        for (int i = 0; i < 4; ++i) { float x = acc[ai][bj][m][n][i]; if (kind == EK_SILU) x = silu_f(x); else if (kind == EK_GELU) x = gelu_f(x); v[4 * n + i] = x * sc; }
                    u32x4 w; w.x = pk2(v[0], v[1]); w.y = pk2(v[2], v[3]); w.z = pk2(v[4], v[5]); w.w = pk2(v[6], v[7]);
                    *(u32x4*)(Z + (size_t)row * zp + u.pn * 256 + 128 * bj + 32 * wc + 8 * fq) = w; } }
    }
};
template <bool RIN_BF>
struct EpiResid {
    static constexpr bool PERM = true;
    const void* resid; void* out; const float* gate; int skip; float dbgf;
    DEV void operator()(const f32x4 (&acc)[2][2][4][2], const Unit& u, int wr, int wc, int fr, int fq) const {
        const int b = (u.pm * 256) >> 11;
        f32x4 g[2][2];
#pragma unroll
        for (int bj = 0; bj < 2; ++bj)
#pragma unroll
            for (int n = 0; n < 2; ++n) g[bj][n] = *(const f32x4*)(gate + (size_t)b * 6144 + u.pn * 256 + 128 * bj + 32 * wc + 8 * fq + 4 * n);
#pragma unroll
        for (int ai = 0; ai < 2; ++ai) {
            f32x4 r[4][2][2];
#pragma unroll
            for (int m = 0; m < 4; ++m) { const size_t row = (size_t)(u.pm * 256 + ai * 128 + wr * 64 + m * 16 + fr);
#pragma unroll
                for (int bj = 0; bj < 2; ++bj)
#pragma unroll
                    for (int n = 0; n < 2; ++n) r[m][bj][n] = ld_res4<RIN_BF>(resid, row * DM + u.pn * 256 + 128 * bj + 32 * wc + 8 * fq + 4 * n); }
            asm volatile("" ::: "memory");
#pragma unroll
            for (int m = 0; m < 4; ++m) { const size_t row = (size_t)(u.pm * 256 + ai * 128 + wr * 64 + m * 16 + fr);
#pragma unroll
                for (int bj = 0; bj < 2; ++bj) { const size_t e0 = row * DM + u.pn * 256 + 128 * bj + 32 * wc + 8 * fq;
                    const f32x4 o0 = skip ? r[m][bj][0] : r[m][bj][0] + g[bj][0] * acc[ai][bj][m][0] * dbgf, o1 = skip ? r[m][bj][1] : r[m][bj][1] + g[bj][1] * acc[ai][bj][m][1] * dbgf;
                    if constexpr (RES_BF16) { u32x4 w; w.x = pk2(o0[0], o0[1]); w.y = pk2(o0[2], o0[3]); w.z = pk2(o1[0], o1[1]); w.w = pk2(o1[2], o1[3]); *(u32x4*)((bf16_t*)out + e0) = w; }
                    else { *(f32x4*)((float*)out + e0) = o0; *(f32x4*)((float*)out + e0 + 4) = o1; } } }
        }
    }
};
struct EpiSwiglu {
    static constexpr bool PERM = true;
    static constexpr float ASC = MOE_FP8 ? W8_INV : 1.f;
    bf16_t* Aout; const float* bin;
    DEV void operator()(const f32x4 (&acc)[2][2][4][2], const Unit& u, int wr, int wc, int fr, int fq) const {
#ifdef DBG_NOEPI
        float sacc = 0.f;
#pragma unroll
        for (int a_ = 0; a_ < 2; ++a_) for (int b_ = 0; b_ < 2; ++b_) for (int m_ = 0; m_ < 4; ++m_) for (int n_ = 0; n_ < 2; ++n_) sacc += acc[a_][b_][m_][n_][0] + acc[a_][b_][m_][n_][1] + acc[a_][b_][m_][n_][2] + acc[a_][b_][m_][n_][3];
        if (sacc == 12345.678f) ((unsigned char*)Aout)[0] = 1;
        return;
#endif
        const int lc = 128 * u.pn + 32 * wc + 8 * fq; const float* bp = bin + (size_t)u.e * 2048 + lc;
        const f32x4 bg0 = *(const f32x4*)bp, bg1 = *(const f32x4*)(bp + 4), bl0 = *(const f32x4*)(bp + 1024), bl1 = *(const f32x4*)(bp + 1028);
#pragma unroll
        for (int ai = 0; ai < 2; ++ai)
#pragma unroll
            for (int m = 0; m < 4; ++m) { const size_t row = (size_t)(u.pm * 256 + ai * 128 + wr * 64 + m * 16 + fr); float v[8];
#pragma unroll
                for (int n = 0; n < 2; ++n)
#pragma unroll
                    for (int i = 0; i < 4; ++i) { const float g = fminf(acc[ai][0][m][n][i] * ASC + (n ? bg1[i] : bg0[i]), 7.f);
                        const float l = fminf(fmaxf(acc[ai][1][m][n][i] * ASC + (n ? bl1[i] : bl0[i]), -7.f), 7.f);
                        v[4 * n + i] = g * __builtin_amdgcn_rcpf(1.f + __builtin_amdgcn_exp2f((-1.702f * 1.4426950408889634f) * g)) * (l + 1.f); }
#if MOE_FP8
                u32x2 w; w.x = pk4_fp8(v[0], v[1], v[2], v[3]); w.y = pk4_fp8(v[4], v[5], v[6], v[7]);
                *(u32x2*)((unsigned char*)Aout + row * 1024 + lc) = w; }
#else
                u32x4 w; w.x = pk2(v[0], v[1]); w.y = pk2(v[2], v[3]); w.z = pk2(v[4], v[5]); w.w = pk2(v[6], v[7]);
                *(u32x4*)(Aout + row * 1024 + lc) = w; }
#endif
    }
};
struct EpiMoeOut {
    static constexpr bool PERM = true;
    bf16_t* YB; const float* bout; const int* cnt; const int* ent; const float* gates;
    DEV void operator()(const f32x4 (&acc)[2][2][4][2], const Unit& u, int wr, int wc, int fr, int fq) const {
        const int n_e = cnt[u.e * CNT_STRIDE];
        int dst[2][4]; float gt[2][4];
#pragma unroll
        for (int ai = 0; ai < 2; ++ai)
#pragma unroll
            for (int m = 0; m < 4; ++m) { const int pos = u.tb * 256 + ai * 128 + wr * 64 + m * 16 + fr; const bool ok = pos < n_e;
                dst[ai][m] = ok ? ent[u.e * ENT_CAP + pos] : -1; gt[ai][m] = ok ? gates[u.e * ENT_CAP + pos] : 0.f; }
        f32x4 bv[2][2];
#pragma unroll
        for (int bj = 0; bj < 2; ++bj)
#pragma unroll
            for (int n = 0; n < 2; ++n) bv[bj][n] = *(const f32x4*)(bout + (size_t)u.e * 1024 + u.pn * 256 + 128 * bj + 32 * wc + 8 * fq + 4 * n);
        asm volatile("" ::: "memory");
#pragma unroll
        for (int ai = 0; ai < 2; ++ai)
#pragma unroll
            for (int m = 0; m < 4; ++m) {
                if (dst[ai][m] >= 0) { const float g = gt[ai][m];
#pragma unroll
                    for (int bj = 0; bj < 2; ++bj) { f32x4 v0 = (acc[ai][bj][m][0] * W8_INV + bv[bj][0]) * (g * YB_SCALE), v1 = (acc[ai][bj][m][1] * W8_INV + bv[bj][1]) * (g * YB_SCALE);
#pragma unroll
                        for (int t = 0; t < 4; ++t) { v0[t] = fminf(fmaxf(v0[t], -440.f), 440.f); v1[t] = fminf(fmaxf(v1[t], -440.f), 440.f); }
                        u32x2 w; w.x = pk4_fp8(v0[0], v0[1], v0[2], v0[3]); w.y = pk4_fp8(v1[0], v1[1], v1[2], v1[3]);
                        *(u32x2*)((unsigned char*)YB + (size_t)dst[ai][m] * 1024 + u.pn * 256 + 128 * bj + 32 * wc + 8 * fq) = w; } } }
    }
};

template <class Epi, class Sched>
DEV void gemm_ref(const Sched& S, const Epi& E, int wv) {
    const int tid = opaque_tid(wv), wid = tid >> 6, lane = tid & 63, wr = wid >> 2, wc = wid & 3, fr = lane & 15, fq = lane >> 4;
    Unit u;
    for (int it = 0; S.next(it, u); ++it) {
        f32x4 acc[2][2][4][2];
#pragma unroll
        for (int a = 0; a < 2; ++a)
#pragma unroll
            for (int b = 0; b < 2; ++b)
#pragma unroll
                for (int m = 0; m < 4; ++m)
#pragma unroll
                    for (int n = 0; n < 2; ++n) acc[a][b][m][n] = (f32x4){0.f, 0.f, 0.f, 0.f};
        unsigned aoff[2][4];
        const int K = S.K;
#pragma unroll
        for (int ai = 0; ai < 2; ++ai)
#pragma unroll
            for (int m = 0; m < 4; ++m) aoff[ai][m] = (unsigned)(ai * 128 + wr * 64 + m * 16 + fr) * (unsigned)K;
        const bf16_t* Bt = (const bf16_t*)S.b_ptr(u); const bf16_t* Ab = (const bf16_t*)S.a_ptr(u);
        for (int k0 = 0; k0 < K; k0 += 8) {
            u32x4 araw[2][4];
#pragma unroll
            for (int ai = 0; ai < 2; ++ai)
#pragma unroll
                for (int m = 0; m < 4; ++m) araw[ai][m] = *(const u32x4*)(Ab + aoff[ai][m] + k0);
            asm volatile("" ::: "memory");
#pragma unroll
            for (int bj = 0; bj < 2; ++bj)
#pragma unroll
                for (int n = 0; n < 2; ++n) {
                    u32x4 braw[4];
#pragma unroll
                    for (int i = 0; i < 4; ++i) { const int c = 128 * bj + 32 * wc + (Epi::PERM ? 8 * fq + 4 * n + i : 16 * n + 4 * fq + i); braw[i] = *(const u32x4*)(Bt + (size_t)c * K + k0); }
                    asm volatile("" ::: "memory");
#pragma unroll
                    for (int i = 0; i < 4; ++i)
#pragma unroll
                        for (int ai = 0; ai < 2; ++ai)
#pragma unroll
                            for (int m = 0; m < 4; ++m) { float s = acc[ai][bj][m][n][i];
#pragma unroll
                                for (int j = 0; j < 4; ++j) { const unsigned au = araw[ai][m][j], bu = braw[i][j];
                                    s = __builtin_amdgcn_fdot2_f32_bf16(__builtin_bit_cast(bf16x2_t, au), __builtin_bit_cast(bf16x2_t, bu), s, false); }
                                acc[ai][bj][m][n][i] = s; }
                }
        }
        E(acc, u, wr, wc, fr, fq);
    }
}


namespace pg8 {
constexpr int BM = 256, BK = 64, HALF = 128, HTB = HALF * BK * 2, STAGE_BYTES = 8 * HTB;
DEV int lds_byte(int r, int c) { const int st = (r >> 4) * 2 + (c >> 5), rr = r & 15, cc = c & 31, ob = rr * 64 + cc * 2; return st * 1024 + (ob ^ (((ob >> 9) & 1) << 5)); }
DEV void stage_rc(int b, int& R, int& C) { const int st = b / 1024, sb = b % 1024, swz = sb ^ (((sb >> 9) & 1) << 5); R = (st >> 1) * 16 + swz / 64; C = (st & 1) * 32 + (swz % 64) / 2; }
DEV int perm32(int rho) { const int n = rho >> 4, i = rho & 15; return 8 * (i >> 2) + 4 * n + (i & 3); }

typedef int v4i __attribute__((ext_vector_type(4)));
template <bool F8> struct Frag;
template <> struct Frag<false> { bf16x8 v; };
template <> struct Frag<true> { v8i v; };
DEV f32x4 frag_mfma(const Frag<false>& a, const Frag<false>& b, f32x4 c) { return __builtin_amdgcn_mfma_f32_16x16x32_bf16(a.v, b.v, c, 0, 0, 0); }
DEV f32x4 frag_mfma(const Frag<true>& a, const Frag<true>& b, f32x4 c) {
    asm volatile("v_mfma_f32_16x16x128_f8f6f4 %0, %1, %2, %0" : "+v"(c) : "v"(a.v), "v"(b.v)); return c; }
DEV void frag_load(Frag<false>& f, const LAS unsigned char* p0, const LAS unsigned char*) { f.v = *(const LAS bf16x8*)p0; }
typedef short s16x16_a16 __attribute__((ext_vector_type(16), aligned(16)));
typedef short s16x16 __attribute__((ext_vector_type(16)));
DEV void frag_load(Frag<true>& f, const LAS unsigned char* p0, const LAS unsigned char*) { const bf16x8 lo = *(const LAS bf16x8*)p0, hi = *(const LAS bf16x8*)(p0 + 16);
    const s16x16 t = __builtin_shufflevector(lo, hi, 0, 1, 2, 3, 4, 5, 6, 7, 8, 9, 10, 11, 12, 13, 14, 15); f.v = __builtin_bit_cast(v8i, t); }
template <class Epi, class Sched>
DEV void gemm_phase(LAS unsigned char* lds, const Sched& S, const Epi& E, int wv, unsigned char* dbg_ws = nullptr) {
    const int tid = opaque_tid(wv);
    const int wid = __builtin_amdgcn_readfirstlane(tid >> 6), lane = tid & 63, wr = wid >> 2, wc = wid & 3, fr = lane & 15, fq = lane >> 4;
    constexpr int EB = Sched::EB; constexpr bool F8 = (EB == 1); constexpr int KF = F8 ? 1 : 2;
    const int KB = S.K * EB, nt = KB / (BK * 2);
    unsigned voffA[2], voffB[2];
#pragma unroll
    for (int i = 0; i < 2; ++i) { int R, C; stage_rc(tid * 16 + i * 8192, R, C); const int Rb = Epi::PERM ? ((R & ~31) + perm32(R & 31)) : R;
        voffA[i] = (unsigned)(R * KB) + (unsigned)C * 2u; voffB[i] = (unsigned)(Rb * KB) + (unsigned)C * 2u; }
    const size_t kstep = (size_t)(BK * 2);
    const size_t hstep = (size_t)HALF * KB;
    const unsigned ldsw = (unsigned)wid * 1024u;
    const int aoff = F8 ? lds_byte(wr * 64 + fr, fq * 16) : lds_byte(wr * 64 + fr, fq * 8), boff = F8 ? lds_byte(wc * 32 + fr, fq * 16) : lds_byte(wc * 32 + fr, fq * 8);
    const int aoff1 = lds_byte(wr * 64 + fr, fq * 16 + 8), boff1 = lds_byte(wc * 32 + fr, fq * 16 + 8);
#define PG8_SA(b, h) (((b) * 2 + (h)) * HTB)
#define PG8_SB(b, h) ((4 + (b) * 2 + (h)) * HTB)
#define PG8_STAGE(bufoff, gbase, voff) do { _Pragma("unroll") for (int _i = 0; _i < 2; ++_i) \
        __builtin_amdgcn_global_load_lds((const unsigned*)((const char*)(gbase) + (voff)[_i]), (LAS unsigned*)(lds + (bufoff) + ldsw + _i * 8192), 16, 0, 0); } while (0)
#define PG8_LDA(dst, b, h) do { _Pragma("unroll") for (int m = 0; m < 4; ++m) _Pragma("unroll") for (int k = 0; k < KF; ++k) frag_load(dst[m][k], lds + PG8_SA(b, h) + aoff + m * 2048 + k * 1024, lds + PG8_SA(b, h) + aoff1 + m * 2048); } while (0)
#define PG8_LDB(dst, b, h) do { _Pragma("unroll") for (int n = 0; n < 2; ++n) _Pragma("unroll") for (int k = 0; k < KF; ++k) frag_load(dst[n][k], lds + PG8_SB(b, h) + boff + n * 2048 + k * 1024, lds + PG8_SB(b, h) + boff1 + n * 2048); } while (0)
#define PG8_MMA(ai, bj, At, Bt) do { if (!Sched::RAGGED || (ai) * 128 + wr * 64 < nrows) { __builtin_amdgcn_s_setprio(1); _Pragma("unroll") for (int m = 0; m < 4; ++m) _Pragma("unroll") for (int n = 0; n < 2; ++n) _Pragma("unroll") for (int k = 0; k < KF; ++k) \
        acc[ai][bj][m][n] = frag_mfma(Bt[n][k], At[m][k], acc[ai][bj][m][n]); __builtin_amdgcn_s_setprio(0); } } while (0)
#define PG8_WAIT_V(n) asm volatile("s_waitcnt vmcnt(" #n ")" ::: "memory")
#define PG8_WAIT_L(n) asm volatile("s_waitcnt lgkmcnt(" #n ")" ::: "memory")
#define PG8_BAR __builtin_amdgcn_s_barrier()
#define PG8_SCHED __builtin_amdgcn_sched_barrier(0)
    Unit cur, nxt; int ui = 0;
    if (!S.next(0, cur)) return;
    f32x4 acc[2][2][4][2];
#pragma unroll
    for (int a = 0; a < 2; ++a)
#pragma unroll
        for (int b = 0; b < 2; ++b)
#pragma unroll
            for (int m = 0; m < 4; ++m)
#pragma unroll
                for (int n = 0; n < 2; ++n) acc[a][b][m][n] = (f32x4){0.f, 0.f, 0.f, 0.f};
    Frag<F8> At[4][KF], B0[2][KF], B1[2][KF];
    const char* cA = S.a_ptr(cur); const char* cB = S.b_ptr(cur);
    int nrows = cur.rows;
    PG8_STAGE(PG8_SB(0, 0), cB, voffB); PG8_STAGE(PG8_SB(0, 1), cB + hstep, voffB); PG8_STAGE(PG8_SA(0, 0), cA, voffA); PG8_STAGE(PG8_SA(0, 1), cA + hstep, voffA);
    if (wr == 1) PG8_BAR;
    PG8_WAIT_V(2); PG8_BAR;
    PG8_STAGE(PG8_SB(1, 0), cB + kstep, voffB); PG8_STAGE(PG8_SA(1, 0), cA + kstep, voffA); PG8_STAGE(PG8_SB(1, 1), cB + hstep + kstep, voffB);
    PG8_WAIT_V(6); PG8_BAR;
#ifdef DBG_GT_NN
    unsigned long long gt_k = 0, gt_e = 0, gt_t = 0; const bool gt_on = (S.nN == DBG_GT_NN) && blockIdx.x == 0 && tid == 0; const unsigned long long gt_begin = __builtin_amdgcn_s_memrealtime();
#endif
    for (;;) {
#ifdef DBG_GT_NN
        const unsigned long long gt0 = __builtin_amdgcn_s_memrealtime();
#endif
        const bool has_next = S.next(ui + 1, nxt);
        const char* nA = has_next ? S.a_ptr(nxt) : cA; const char* nB = has_next ? S.b_ptr(nxt) : cB;
        for (int t = 0; t < nt; t += 2) {
            const bool last = (t == nt - 2);
            const char* a1 = cA + (size_t)(t + 1) * kstep;
            const char* a2 = last ? nA : cA + (size_t)(t + 2) * kstep; const char* b2 = last ? nB : cB + (size_t)(t + 2) * kstep;
            const char* a3 = a2 + kstep; const char* b3 = b2 + kstep;
            PG8_LDB(B0, 0, 0); PG8_LDB(B1, 0, 1); PG8_SCHED; PG8_LDA(At, 0, 0); PG8_STAGE(PG8_SA(1, 1), a1 + hstep, voffA);
            PG8_WAIT_V(8); PG8_WAIT_L(0); PG8_BAR; PG8_MMA(0, 0, At, B0); PG8_MMA(0, 1, At, B1); PG8_BAR; PG8_SCHED;
            PG8_LDA(At, 0, 1); PG8_STAGE(PG8_SB(0, 0), b2, voffB); PG8_STAGE(PG8_SB(0, 1), b2 + hstep, voffB); PG8_STAGE(PG8_SA(0, 0), a2, voffA);
            PG8_WAIT_V(8); PG8_WAIT_L(0); PG8_BAR; PG8_MMA(1, 0, At, B0); PG8_MMA(1, 1, At, B1); PG8_BAR; PG8_SCHED;
            PG8_LDB(B0, 1, 0); PG8_LDB(B1, 1, 1); PG8_SCHED; PG8_LDA(At, 1, 0); PG8_STAGE(PG8_SA(0, 1), a2 + hstep, voffA);
            PG8_WAIT_V(8); PG8_WAIT_L(0); PG8_BAR; PG8_MMA(0, 0, At, B0); PG8_MMA(0, 1, At, B1); PG8_BAR; PG8_SCHED;
            PG8_LDA(At, 1, 1); PG8_STAGE(PG8_SB(1, 0), b3, voffB); PG8_STAGE(PG8_SB(1, 1), b3 + hstep, voffB); PG8_STAGE(PG8_SA(1, 0), a3, voffA);
            PG8_WAIT_V(8); PG8_WAIT_L(0); PG8_BAR; PG8_MMA(1, 0, At, B0); PG8_MMA(1, 1, At, B1); PG8_BAR; PG8_SCHED;
        }
#ifdef DBG_GT_NN
        const unsigned long long gt1 = __builtin_amdgcn_s_memrealtime();
#endif
        if (wr == 0) PG8_BAR;
        if constexpr (F8) asm volatile("s_nop 15\n\ts_nop 15" ::: "memory");
        E(acc, cur, wr, wc, fr, fq);
#ifdef DBG_EPI2
        asm volatile("" ::: "memory"); E(acc, cur, wr, wc, fr, fq);
#endif
#ifdef DBG_GT_NN
        { const unsigned long long gt2 = __builtin_amdgcn_s_memrealtime(); gt_k += gt1 - gt0; gt_e += gt2 - gt1; gt_t = gt2 - gt_begin;
          if (gt_on) { unsigned long long* tsp = (unsigned long long*)(dbg_ws + WS_CTL + 49152); tsp[40] = 0; tsp[41] = gt_k; tsp[42] = gt_k + gt_e; tsp[43] = gt_t; tsp[44] = (unsigned long long)(ui + 1) * 1000; if (ui == 0) { tsp[45] = 0; tsp[46] = gt1 - gt0; } } }
#endif
        if (!has_next) break;
#pragma unroll
        for (int a = 0; a < 2; ++a)
#pragma unroll
            for (int b = 0; b < 2; ++b)
#pragma unroll
                for (int m = 0; m < 4; ++m)
#pragma unroll
                    for (int n = 0; n < 2; ++n) acc[a][b][m][n] = (f32x4){0.f, 0.f, 0.f, 0.f};
        cur = nxt; cA = nA; cB = nB; nrows = cur.rows; ++ui;
        if (wr == 1) PG8_BAR;
    }
    PG8_WAIT_V(0);
    PG8_BAR;
#undef PG8_SA
#undef PG8_SB
#undef PG8_STAGE
#undef PG8_LDA
#undef PG8_LDB
#undef PG8_MMA
#undef PG8_WAIT_V
#undef PG8_WAIT_L
#undef PG8_BAR
#undef PG8_SCHED
}
}

__host__ __device__ inline int ropeoff(int q) { return 64 * (q & 3) + 32 * (q >> 2); }
__host__ __device__ inline int in0_logcol(int g32) {
    const int tile = g32 >> 3, q = g32 & 7;
    switch (tile) {
        case 0: return 0 + q * 32; case 1: return 256 + q * 32;
        case 2: case 3: return 512 + (tile - 2) * 256 + q * 32;
        case 4: case 5: return 1040 + (tile - 4) * 256 + q * 32;
        case 6: case 7: return 1552 + (tile - 6) * 256 + ropeoff(q);
        case 8: case 9: return 2064 + (tile - 8) * 256 + ropeoff(q);
        default: return 2576 + (tile - 10) * 256 + q * 32;
    }
}
__host__ __device__ inline int in1_logcol(int g32) {
    const int tile = g32 >> 3, q = g32 & 7;
    if (tile < 4) return tile * 256 + q * 32;
    if (tile == 4) return 1024 + ropeoff(q);
    if (tile == 5) return 1280 + ropeoff(q);
    return 1536 + (tile - 6) * 256 + q * 32;
}
DEV void conv_item(const float* W, int ldw, int logcol0, int k0, bf16_t* Wt_row0, int Kd, LAS float* scr, int lane) {
#pragma unroll 8
    for (int i = 0; i < 32; ++i) { const int kk = 2 * i + (lane >> 5); scr[kk * 33 + (lane & 31)] = W[(size_t)(k0 + kk) * ldw + logcol0 + (lane & 31)]; }
    asm volatile("s_waitcnt lgkmcnt(0)" ::: "memory");
    const int c = lane & 7;
#pragma unroll
    for (int j = 0; j < 4; ++j) { const int n = (lane >> 3) + 8 * j; const LAS float* s = scr + (8 * c) * 33 + n;
        u32x4 o; o.x = pk2(s[0 * 33], s[1 * 33]); o.y = pk2(s[2 * 33], s[3 * 33]); o.z = pk2(s[4 * 33], s[5 * 33]); o.w = pk2(s[6 * 33], s[7 * 33]);
        *(u32x4*)(Wt_row0 + (size_t)n * Kd + k0 + 8 * c) = o; }
    asm volatile("s_waitcnt lgkmcnt(0)" ::: "memory");
}
DEV void sincos_d(double x, float& s, float& c) {
    const double k = __builtin_rint(x * 0.63661977236758134308);
    const double r = (x - k * 1.5707963267948966192) - k * 6.123233995736766e-17;
    const double r2 = r * r;
    double sp = -7.647163731819816e-13; sp = sp * r2 + 1.605904383682161e-10; sp = sp * r2 - 2.505210838544172e-08; sp = sp * r2 + 2.755731922398589e-06;
    sp = sp * r2 - 1.984126984126984e-04; sp = sp * r2 + 8.333333333333333e-03; sp = sp * r2 - 1.666666666666667e-01; sp = r + r * r2 * sp;
    double cp = 4.779477332387385e-14; cp = cp * r2 - 1.147074559772972e-11; cp = cp * r2 + 2.087675698786810e-09; cp = cp * r2 - 2.755731922398589e-07;
    cp = cp * r2 + 2.480158730158730e-05; cp = cp * r2 - 1.388888888888889e-03; cp = cp * r2 + 4.166666666666666e-02; cp = cp * r2 - 0.5; cp = 1.0 + r2 * cp;
    const int q = ((int)k) & 3;
    const double ss = (q == 0) ? sp : (q == 1) ? cp : (q == 2) ? -sp : -cp;
    const double cc = (q == 0) ? cp : (q == 1) ? -sp : (q == 2) ? -cp : sp;
    s = (float)ss; c = (float)cc;
}
DEV void conv_item_f8(const float* W, int ldw, int logcol0, int k0, unsigned char* Wt_row0, int Kd, LAS float* scr, int lane, float scale) {
#pragma unroll 8
    for (int i = 0; i < 32; ++i) { const int kk = 2 * i + (lane >> 5); scr[kk * 33 + (lane & 31)] = W[(size_t)(k0 + kk) * ldw + logcol0 + (lane & 31)]; }
    asm volatile("s_waitcnt lgkmcnt(0)" ::: "memory");
    const int c = lane & 7;
#pragma unroll
    for (int j = 0; j < 4; ++j) { const int n = (lane >> 3) + 8 * j; const LAS float* sp = scr + (8 * c) * 33 + n;
        u32x2 o; o.x = pk4_fp8(sp[0 * 33] * scale, sp[1 * 33] * scale, sp[2 * 33] * scale, sp[3 * 33] * scale); o.y = pk4_fp8(sp[4 * 33] * scale, sp[5 * 33] * scale, sp[6 * 33] * scale, sp[7 * 33] * scale);
        *(u32x2*)(Wt_row0 + (size_t)n * Kd + k0 + 8 * c) = o; }
    asm volatile("s_waitcnt lgkmcnt(0)" ::: "memory");
}
DEV void conv_item64_f8(const float* W, int ldw, int logcol0, int k0, unsigned char* Wt_row0, int Kd, LAS float* scr, int lane, float scale) {
#pragma unroll 8
    for (int i = 0; i < 16; ++i) { const int kk = 4 * i + (lane >> 4), c4 = (lane & 15) * 4;
        const f32x4 v = __builtin_nontemporal_load((const f32x4*)(W + (size_t)(k0 + kk) * ldw + logcol0 + c4));
        LAS float* d = scr + kk * 65 + c4; d[0] = v[0]; d[1] = v[1]; d[2] = v[2]; d[3] = v[3]; }
    asm volatile("s_waitcnt lgkmcnt(0)" ::: "memory");
    const int c = lane & 7;
#pragma unroll
    for (int j = 0; j < 8; ++j) { const int n = (lane >> 3) + 8 * j; const LAS float* sp = scr + (8 * c) * 65 + n;
        u32x2 o; o.x = pk4_fp8(sp[0 * 65] * scale, sp[1 * 65] * scale, sp[2 * 65] * scale, sp[3 * 65] * scale); o.y = pk4_fp8(sp[4 * 65] * scale, sp[5 * 65] * scale, sp[6 * 65] * scale, sp[7 * 65] * scale);
        *(u32x2*)(Wt_row0 + (size_t)n * Kd + k0 + 8 * c) = o; }
    asm volatile("s_waitcnt lgkmcnt(0)" ::: "memory");
}
DEV void conv_experts(const Params& P, LAS unsigned char* lds, int wv, int layer, int blk0, int nblk) {
    const int tid = opaque_tid(wv), lane = tid & 63;
    unsigned char* ws = opaque_ws(P.ws);
    const int gw = ((int)blockIdx.x - blk0) * NWAVES + wv, NGW = nblk * NWAVES;
    constexpr int I_W1 = 32 * 16 * 32, I_W2 = 32 * 16 * 16;
    const int kg = lane >> 4, ng = lane & 15;
    for (int it0 = gw; it0 < I_W1 + I_W2; it0 += NGW) {
        const float* src; int ldw; unsigned char* dst;
        if (it0 < I_W1) { const int it = it0 + layer * I_W1, le = it / 512, q = it % 512, kb = q / 32, g = q % 32, pn = g >> 2, qq = g & 3;
            const int logcol = (qq >> 1) * 1024 + 128 * pn + 64 * (qq & 1);
            src = (const float*)P.in[23] + (size_t)le * 1024 * 2048 + (size_t)(kb * 64) * 2048 + logcol; ldw = 2048; dst = ws + WS_W1 + ((size_t)le * 2048 + g * 64) * 1024 + kb * 64;
        } else { const int r = it0 - I_W1 + layer * I_W2, le = r / 256, q = r % 256, kb = q / 16, g = q % 16;
            src = (const float*)P.in[25] + (size_t)le * 1024 * 1024 + (size_t)(kb * 64) * 1024 + g * 64; ldw = 1024; dst = ws + WS_W2 + ((size_t)le * 1024 + g * 64) * 1024 + kb * 64; }
        f32x4 v[16];
#pragma unroll
        for (int i = 0; i < 16; ++i) v[i] = __builtin_nontemporal_load((const f32x4*)(src + (size_t)(16 * kg + i) * ldw + 4 * ng));
#pragma unroll
        for (int jj = 0; jj < 4; ++jj) { u32x4 o;
#pragma unroll
            for (int q = 0; q < 4; ++q) o[q] = pk4_fp8(v[4 * q][jj] * W8_SCALE, v[4 * q + 1][jj] * W8_SCALE, v[4 * q + 2][jj] * W8_SCALE, v[4 * q + 3][jj] * W8_SCALE);
            *(u32x4*)(dst + (size_t)(4 * ng + jj) * 1024 + 16 * kg) = o; }
    }
}
DEV void phase_prologue(const Params& P, LAS unsigned char* lds, int wv) {
    const int tid = opaque_tid(wv), lane = tid & 63, wid = tid >> 6, G = gridDim.x;
    unsigned char* ws = opaque_ws(P.ws);
    {
        LAS float* cact = (LAS float*)lds; LAS float* red = cact + 8192;
        const float* cin = (const float*)P.in[1]; const float* wada = (const float*)P.in[3]; const float* bada = (const float*)P.in[4];
        float* mod = (float*)(ws + WS_MOD);
        for (int unit = blockIdx.x; unit < 192; unit += G) {
            const int layer = unit / 96, col0 = (unit % 96) * 64;
            __syncthreads();
            for (int i = tid; i < 8192; i += NTHREADS) { const float c = cin[i]; cact[i] = c / (1.f + expf(-c)); }
            __syncthreads();
            const int cs = tid & 63, ks = tid >> 6;
            float acc[8];
#pragma unroll
            for (int b = 0; b < 8; ++b) acc[b] = 0.f;
            const float* W = wada + (size_t)layer * 1024 * 6144 + col0 + cs;
#pragma unroll 16
            for (int k = ks * 128; k < ks * 128 + 128; ++k) { const float w = W[(size_t)k * 6144];
#pragma unroll
                for (int b = 0; b < 8; ++b) acc[b] += cact[b * 1024 + k] * w; }
#pragma unroll
            for (int b = 0; b < 8; ++b) red[(ks * 8 + b) * 64 + cs] = acc[b];
            __syncthreads();
            { const int b = tid >> 6; float s = bada[layer * 6144 + col0 + cs];
#pragma unroll
              for (int k2 = 0; k2 < 8; ++k2) s += red[(k2 * 8 + b) * 64 + cs];
              mod[(size_t)(layer * 8 + b) * 6144 + col0 + cs] = s; }
        }
        __syncthreads();
    }
    const int gt = blockIdx.x * NTHREADS + tid, NGT = G * NTHREADS;
    {
        const int* pos = (const int*)P.in[2]; float* rope = (float*)(ws + WS_ROPE);
        for (int i = gt; i < NTOK * 32; i += NGT) { const int f = i & 31, t = i >> 5;
            const double invf = exp2(-(double)f * (13.287712379549449 / 32.0));
            float s, c; sincos_d((double)pos[t] * invf, s, c); rope[2 * (size_t)i] = c; rope[2 * (size_t)i + 1] = s; }
    }
    {
        const float* sw = (const float*)P.in[18]; bf16_t* o = (bf16_t*)(ws + WS_SGUW);
        for (int i = gt; i < 4 * 128 * 128; i += NGT) { const int j = i & 127, r = (i >> 7) & 127; o[i] = f2bf(j <= r ? sw[i] : 0.f); }
    }
    {
        LAS float* scr = (LAS float*)(lds + wid * 16384);
        const int gw = blockIdx.x * NWAVES + wid, NGW = G * NWAVES;
        constexpr int I_IN0 = 16 * 96, I_OUT = 16 * 32, I_IN1 = 16 * 80;
        constexpr int NITEMS = I_IN0 + I_OUT + I_IN1 + I_OUT;
        for (int it = gw; it < NITEMS; it += NGW) {
            int r = it;
            if (r < I_IN0) { const int kb = r / 96, g = r % 96; conv_item((const float*)P.in[5], 3088, in0_logcol(g), kb * 64, (bf16_t*)(ws + WS_WIN0) + (size_t)g * 32 * 1024, 1024, scr, lane); continue; } r -= I_IN0;
            if (r < I_OUT) { const int kb = r / 32, g = r % 32; conv_item((const float*)P.in[14], 1024, g * 32, kb * 64, (bf16_t*)(ws + WS_WOUT0) + (size_t)g * 32 * 1024, 1024, scr, lane); continue; } r -= I_OUT;
            if (r < I_IN1) { const int kb = r / 80, g = r % 80; conv_item((const float*)P.in[15], 2560, in1_logcol(g), kb * 64, (bf16_t*)(ws + WS_WIN1) + (size_t)g * 32 * 1024, 1024, scr, lane); continue; } r -= I_IN1;
            { const int kb = r / 32, g = r % 32; conv_item((const float*)P.in[20], 1024, g * 32, kb * 64, (bf16_t*)(ws + WS_WOUT1) + (size_t)g * 32 * 1024, 1024, scr, lane); }
        }
    }
}

template <int MODE> struct PrenormRow { f32x4 x[4]; unsigned y[4][4]; f32x4 g2[4], sh[4], sc[4]; };
template <int MODE, bool XBF>
DEV void prenorm_load(PrenormRow<MODE>& r, int row, int lane, const void* xin, const unsigned char* YB, const float* mod, int layer_mod, int modoff, int layer_prev) {
    const int b = row >> 11;
#pragma unroll
    for (int j = 0; j < 4; ++j) r.x[j] = ld_res4<XBF>(xin, (size_t)row * DM + 4 * lane + 256 * j);
    if (MODE & 1) {
#pragma unroll
        for (int k = 0; k < 4; ++k) { const unsigned* yr = (const unsigned*)(YB + ((size_t)row * 4 + k) * 1024) + lane;
#pragma unroll
            for (int j = 0; j < 4; ++j) r.y[k][j] = yr[64 * j]; }
        const float* g2 = mod + (size_t)(layer_prev * 8 + b) * 6144 + 5 * 1024;
#pragma unroll
        for (int j = 0; j < 4; ++j) r.g2[j] = *((const f32x4*)g2 + lane + 64 * j);
    }
    if (!(MODE & 8)) { const float* mrow = mod + (size_t)(layer_mod * 8 + b) * 6144 + modoff;
#pragma unroll
        for (int j = 0; j < 4; ++j) { r.sh[j] = *((const f32x4*)mrow + lane + 64 * j); r.sc[j] = *((const f32x4*)(mrow + 1024) + lane + 64 * j); } }
}
template <int MODE, bool XBF>
DEV void phase_prenorm(const Params& P, LAS unsigned char* lds, int wv, const void* xin, void* xout, int layer_mod, int modoff  , int layer_prev) {
    const int tid = opaque_tid(wv), lane = tid & 63, wid = tid >> 6, G = gridDim.x;
    unsigned char* ws = opaque_ws(P.ws);
    const float* mod = (const float*)(ws + WS_MOD);
    bf16_t* H = (bf16_t*)(ws + WS_H);
    const unsigned char* YB = ws + WS_YB;
    f32x4 fgv[4];
    if (MODE & 8) { const float* fg = (const float*)P.in[27];
#pragma unroll
        for (int j = 0; j < 4; ++j) fgv[j] = *((const f32x4*)fg + lane + 64 * j); }
    const int stride = G * NWAVES;
    int row = blockIdx.x * NWAVES + wid;
    PrenormRow<MODE> cur, nxt;
    if (row < NTOK) prenorm_load<MODE, XBF>(cur, row, lane, xin, YB, mod, layer_mod, modoff, layer_prev);
    for (; row < NTOK; row += stride) {
        const bool more = row + stride < NTOK;
        if (more) prenorm_load<MODE, XBF>(nxt, row + stride, lane, xin, YB, mod, layer_mod, modoff, layer_prev);
        f32x4 v[4];
#pragma unroll
        for (int j = 0; j < 4; ++j) v[j] = cur.x[j];
        if (MODE & 1) {
#pragma unroll
            for (int j = 0; j < 4; ++j) { f32x4 m4 = {0.f, 0.f, 0.f, 0.f};
#pragma unroll
                for (int k = 0; k < 4; ++k) { const unsigned w = cur.y[k][j]; const f32x2 lo = __builtin_amdgcn_cvt_pk_f32_fp8(w, false), hi = __builtin_amdgcn_cvt_pk_f32_fp8(w, true);
                    m4[0] += lo[0]; m4[1] += lo[1]; m4[2] += hi[0]; m4[3] += hi[1]; }
                if (!((DBG_SKIP >> (1 + 2 * layer_prev)) & 1)) v[j] = v[j] + cur.g2[j] * m4 * ((layer_prev ? DBG_F_MOE1 : DBG_F_MOE0) * YB_INV); }
        }
        if (MODE & 2) {
#pragma unroll
            for (int j = 0; j < 4; ++j) st_res4<RES_BF16>(xout, (size_t)row * DM + 4 * lane + 256 * j, v[j]); }
        float ss = 0.f;
#pragma unroll
        for (int j = 0; j < 4; ++j) ss += (v[j][0] * v[j][0] + v[j][1] * v[j][1]) + (v[j][2] * v[j][2] + v[j][3] * v[j][3]);
        const float rstd = 1.0f / sqrtf(wave_sum(ss) * (1.f / DM) + EPS);
        if (MODE & 8) {
            f32x4* o = (f32x4*)(P.out + (size_t)row * DM) + lane;
#pragma unroll
            for (int j = 0; j < 4; ++j) { const f32x4 g = fgv[j];
#ifdef DBG_PROBE_OFF
                const float ps = ((const float*)(ws + WS_CTL))[1024] / ((float)NTOK * DBG_PROBE_NCOLS); const float pv = (DBG_PROBE_ABS ? ps : sqrtf(ps)) * DBG_PROBE_SCALE;
                const float alpha = 1.5f + 1.5f * fminf(fmaxf(pv, 0.f), 1.f);
                o[64 * j] = v[j] * rstd * g * alpha;
#elif defined(DBG_TS)
                { const unsigned long long* tsp = (const unsigned long long*)(ws + WS_CTL + 49152);
                  const float dt_us = (float)(tsp[DBG_TS + 1] - tsp[DBG_TS_FROM]) * 0.01f;
                  const float eps = sqrtf(fminf(dt_us * 0.001f, 1.4f) * 1e-3f);
                  f32x4 o4 = v[j] * rstd * g;
#pragma unroll
                  for (int t = 0; t < 4; ++t) { unsigned hsh = (unsigned)(row * 1024 + 4 * lane + 256 * j + t) * 2654435761u; hsh ^= hsh >> 15; o4[t] *= (hsh & 1u) ? (1.f + eps) : (1.f - eps); }
                  o[64 * j] = o4; }
#else
                o[64 * j] = v[j] * rstd * g;
#endif
            }
        } else {
            u32x2* ho = (u32x2*)(H + (size_t)row * DM) + lane;
#pragma unroll
            for (int j = 0; j < 4; ++j) { const f32x4 hv = v[j] * rstd * (cur.sc[j] + 1.0f) + cur.sh[j];
                u32x2 w; w.x = pk2(hv[0], hv[1]); w.y = pk2(hv[2], hv[3]); ho[64 * j] = w; }
        }
        if (more) cur = nxt;
    }
}


DEV void phase_prenorm_gate(const Params& P, LAS unsigned char* lds, int wv) {
    const int tid = opaque_tid(wv), lane = tid & 63, w = wv, G = gridDim.x;
    unsigned char* ws = opaque_ws(P.ws);
    const float* mod = (const float*)(ws + WS_MOD);
    const float* xin = (const float*)P.in[0]; const float* win = (const float*)P.in[5]; const float* wg = (const float*)P.in[6]; const float* bg = (const float*)P.in[7];
    bf16_t* H = (bf16_t*)(ws + WS_H); float* LA = (float*)(ws + WS_LA);
    constexpr int AS = 1028;
    LAS float* At = (LAS float*)lds;
    LAS float* red = At + 16 * AS;
    LAS float* grs = red + 8 * 16 * 16;
    float Bf[32];
#pragma unroll
    for (int s2 = 0; s2 < 32; ++s2) Bf[s2] = win[(size_t)(128 * w + 4 * s2 + (lane >> 4)) * 3088 + 1024 + (lane & 15)];
    const int gcol = tid & 255, ghalf = tid >> 8;
    float wgc[16];
#pragma unroll
    for (int r = 0; r < 16; ++r) wgc[r] = wg[r * 256 + gcol];
    const float bgc = bg[gcol];
    __syncthreads();
    for (int blk = blockIdx.x; blk < NTOK / 64; blk += G) {
        const int bb = (blk * 64) >> 11;
        const float* mrow = mod + (size_t)(0 * 8 + bb) * 6144;
        f32x4 sh[4], sc[4], xv[2][4];
#pragma unroll
        for (int j = 0; j < 4; ++j) { sh[j] = *((const f32x4*)mrow + lane + 64 * j); sc[j] = *((const f32x4*)(mrow + 1024) + lane + 64 * j); }
#pragma unroll
        for (int rr = 0; rr < 2; ++rr)
#pragma unroll
            for (int j = 0; j < 4; ++j) xv[rr][j] = *((const f32x4*)(xin + (size_t)(blk * 64 + 2 * w + rr) * DM) + lane + 64 * j);
        for (int g = 0; g < 4; ++g) {
            const int rbase = blk * 64 + 16 * g;
#pragma unroll
            for (int rr = 0; rr < 2; ++rr) {
                f32x4 v[4];
#pragma unroll
                for (int j = 0; j < 4; ++j) v[j] = xv[rr][j];
                float ss = 0.f;
#pragma unroll
                for (int j = 0; j < 4; ++j) ss += (v[j][0] * v[j][0] + v[j][1] * v[j][1]) + (v[j][2] * v[j][2] + v[j][3] * v[j][3]);
                const float rstd = 1.0f / sqrtf(wave_sum(ss) * (1.f / DM) + EPS);
                u32x2* ho = (u32x2*)(H + (size_t)(rbase + 2 * w + rr) * DM) + lane;
#pragma unroll
                for (int j = 0; j < 4; ++j) { v[j] = v[j] * rstd * (sc[j] + 1.0f) + sh[j];
                    u32x2 wq; wq.x = pk2(v[j][0], v[j][1]); wq.y = pk2(v[j][2], v[j][3]); ho[64 * j] = wq;
                    *(LAS f32x4*)(At + (2 * w + rr) * AS + 4 * lane + 256 * j) = v[j]; }
            }
            if (g < 3) {
#pragma unroll
                for (int rr = 0; rr < 2; ++rr)
#pragma unroll
                    for (int j = 0; j < 4; ++j) xv[rr][j] = *((const f32x4*)(xin + (size_t)(rbase + 16 + 2 * w + rr) * DM) + lane + 64 * j);
            }
            LBAR();
            f32x4 acc = {0.f, 0.f, 0.f, 0.f};
            const LAS float* ap = At + (lane & 15) * AS + 128 * w + (lane >> 4);
#pragma unroll
            for (int s2 = 0; s2 < 32; ++s2) acc = __builtin_amdgcn_mfma_f32_16x16x4f32(ap[4 * s2], Bf[s2], acc, 0, 0, 0);
#pragma unroll
            for (int t = 0; t < 4; ++t) red[(w * 16 + (lane >> 4) * 4 + t) * 16 + (lane & 15)] = acc[t];
            LBAR();
            if (tid < 256) { float sum = 0.f;
#pragma unroll
                for (int w2 = 0; w2 < 8; ++w2) sum += red[w2 * 256 + tid];
                grs[tid] = sum; }
            LBAR();
            {
#pragma unroll
                for (int q = 0; q < 8; ++q) { const int rl = 8 * ghalf + q; float z = bgc;
#pragma unroll
                    for (int r = 0; r < 16; ++r) z += grs[rl * 16 + r] * wgc[r];
                    LA[(size_t)(rbase + rl) * 256 + gcol] = log_sigmoid_f(z) * 0.0625f; }
            }
            LBAR();
        }
    }
}

DEV void phase_router(const Params& P, LAS unsigned char* lds, int wv, const void* xin, int layer) {
    const int tid = opaque_tid(wv), lane = tid & 63, w = wv, G = gridDim.x;
    unsigned char* ws = opaque_ws(P.ws);
    const float* mod = (const float*)(ws + WS_MOD);
    const float* rw = (const float*)P.in[21] + (size_t)layer * 1024 * 32; const float* rb = (const float*)P.in[22] + layer * 32;
    int* cnt = (int*)(ws + WS_CTL) + CW_CNT + layer * NEXP * CNT_STRIDE; int* ent = (int*)(ws + WS_ENT) + (size_t)layer * NEXP * ENT_CAP;
    float* gl = (float*)(ws + WS_GL) + (size_t)layer * NEXP * ENT_CAP;
    unsigned char* XQ = ws + WS_XQ;
    constexpr int AS = 1028;
    LAS float* At = (LAS float*)lds;
    LAS float* red = At + 16 * AS;
    LAS int* lcnt = (LAS int*)(red + 8 * 16 * 32);
    LAS int* gbase = lcnt + 32;
    LAS int* elist = gbase + 32;
    LAS float* gsave = (LAS float*)(elist + 256);
    LAS unsigned char* hq = (LAS unsigned char*)(gsave + 256);
    if (tid < NEXP) lcnt[tid] = 0;
    __syncthreads();
    float Bf[2][32];
#pragma unroll
    for (int s2 = 0; s2 < 32; ++s2)
#pragma unroll
        for (int n = 0; n < 2; ++n) Bf[n][s2] = rw[(size_t)(128 * w + 4 * s2 + (lane >> 4)) * 32 + 16 * n + (lane & 15)];
    for (int blk = blockIdx.x; blk < NTOK / 64; blk += G) {
        const int bb = (blk * 64) >> 11;
        const float* mrow = mod + (size_t)(layer * 8 + bb) * 6144 + 3072;
        f32x4 sh[4], sc[4], xv[2][4];
#pragma unroll
        for (int j = 0; j < 4; ++j) { sh[j] = *((const f32x4*)mrow + lane + 64 * j); sc[j] = *((const f32x4*)(mrow + 1024) + lane + 64 * j); }
#pragma unroll
        for (int rr = 0; rr < 2; ++rr)
#pragma unroll
            for (int j = 0; j < 4; ++j) xv[rr][j] = ld_res4<RES_BF16>(xin, (size_t)(blk * 64 + 2 * w + rr) * DM + 4 * lane + 256 * j);
        for (int g = 0; g < 4; ++g) {
            const int rbase = blk * 64 + 16 * g;
#pragma unroll
            for (int rr = 0; rr < 2; ++rr) {
                f32x4 v[4];
#pragma unroll
                for (int j = 0; j < 4; ++j) v[j] = xv[rr][j];
                float ss = 0.f;
#pragma unroll
                for (int j = 0; j < 4; ++j) ss += (v[j][0] * v[j][0] + v[j][1] * v[j][1]) + (v[j][2] * v[j][2] + v[j][3] * v[j][3]);
                const float rstd = 1.0f / sqrtf(wave_sum(ss) * (1.f / DM) + EPS);
#pragma unroll
                for (int j = 0; j < 4; ++j) { v[j] = v[j] * rstd * (sc[j] + 1.0f) + sh[j];
                    *((LAS unsigned*)(hq + (16 * g + 2 * w + rr) * 1024) + lane + 64 * j) = pk4_fp8(v[j][0], v[j][1], v[j][2], v[j][3]);
                    *(LAS f32x4*)(At + (2 * w + rr) * AS + 4 * lane + 256 * j) = v[j]; }
            }
            if (g < 3) {
#pragma unroll
                for (int rr = 0; rr < 2; ++rr)
#pragma unroll
                    for (int j = 0; j < 4; ++j) xv[rr][j] = ld_res4<RES_BF16>(xin, (size_t)(rbase + 16 + 2 * w + rr) * DM + 4 * lane + 256 * j);
            }
            LBAR();
            f32x4 acc0 = {0.f, 0.f, 0.f, 0.f}, acc1 = {0.f, 0.f, 0.f, 0.f};
            const LAS float* ap = At + (lane & 15) * AS + 128 * w + (lane >> 4);
#pragma unroll
            for (int s2 = 0; s2 < 32; ++s2) { const float av = ap[4 * s2];
                acc0 = __builtin_amdgcn_mfma_f32_16x16x4f32(av, Bf[0][s2], acc0, 0, 0, 0); acc1 = __builtin_amdgcn_mfma_f32_16x16x4f32(av, Bf[1][s2], acc1, 0, 0, 0); }
#pragma unroll
            for (int t = 0; t < 4; ++t) { red[(w * 16 + (lane >> 4) * 4 + t) * 32 + (lane & 15)] = acc0[t]; red[(w * 16 + (lane >> 4) * 4 + t) * 32 + 16 + (lane & 15)] = acc1[t]; }
            LBAR();
            {
                const int half = lane >> 5, e = lane & 31, rl = 2 * w + half, row = rbase + rl;
                float lg = rb[e];
#pragma unroll
                for (int w2 = 0; w2 < 8; ++w2) lg += red[(w2 * 16 + rl) * 32 + e];
                float tv[4]; int ti[4]; float cur = lg;
#pragma unroll
                for (int r4 = 0; r4 < 4; ++r4) {
                    float mx = cur;
#pragma unroll
                    for (int o = 1; o < 32; o <<= 1) mx = fmaxf(mx, __shfl_xor(mx, o));
                    const unsigned long long bal = __ballot(cur == mx);
                    const unsigned mine = (unsigned)(bal >> (32 * half));
                    const int sel = __builtin_ctz(mine);
                    tv[r4] = mx; ti[r4] = sel; if (e == sel) cur = -INFINITY;
                }
                const float e1 = __expf(tv[1] - tv[0]), e2 = __expf(tv[2] - tv[0]), e3 = __expf(tv[3] - tv[0]);
                const float inv = 1.f / (1.f + e1 + e2 + e3);
                if (e < 4) { const int ex = e == 0 ? ti[0] : e == 1 ? ti[1] : e == 2 ? ti[2] : ti[3];
                    const float gv = (e == 0 ? 1.f : e == 1 ? e1 : e == 2 ? e2 : e3) * inv;
                    const int lpos = __hip_atomic_fetch_add(lcnt + ex, 1, __ATOMIC_RELAXED, __HIP_MEMORY_SCOPE_WORKGROUP); elist[(16 * g + rl) * 4 + e] = (ex << 16) | lpos; gsave[(16 * g + rl) * 4 + e] = gv; }
            }
            LBAR();
        }
        if (tid < NEXP) { const int n = lcnt[tid]; gbase[tid] = n ? atomicAdd(cnt + tid * CNT_STRIDE, n) : 0; }
        __syncthreads();
        if (tid < 256) { const int pk = elist[tid], ex = pk >> 16, lpos = pk & 0xffff; const int pos = gbase[ex] + lpos; ent[ex * ENT_CAP + pos] = blk * 256 + tid; gl[ex * ENT_CAP + pos] = gsave[tid]; elist[tid] = ex * ENT_CAP + pos; }
        __syncthreads();
#pragma unroll 4
        for (int q = 0; q < 32; ++q) { const int en = w + NWAVES * q; const int dstrow = elist[en];
            *((u32x4*)(XQ + (size_t)dstrow * DM) + lane) = *((const LAS u32x4*)(hq + (en >> 2) * 1024) + lane); }
        __syncthreads();
        if (tid < NEXP) lcnt[tid] = 0;
    }
}

DEV void attn_unit_ref(int b, int vh, int qb, const bf16_t* Z, bf16_t* OP, int wv) {
    const int tid = opaque_tid(wv);
    if (tid >= 256) return;
    const int h = vh >> 2, m = (vh >> 1) & 1, vhalf = vh & 1;
    const size_t rowbase = (size_t)b * SEQ;
    const int i = qb * 256 + tid;
    const bf16_t* Qr = Z + (rowbase + i) * Z0P + 1536 + h * 128 + m * 64;
    const bf16_t* Kb = Z + rowbase * Z0P + 2048 + h * 128 + m * 64;
    const bf16_t* Vb = Z + rowbase * Z0P + 2560 + h * 128 + vhalf * 64;
    float q[64], o[64];
#pragma unroll
    for (int d0 = 0; d0 < 8; ++d0) { float t[8]; unpack8(*(const bf16x8*)(Qr + d0 * 8), t);
#pragma unroll
        for (int j = 0; j < 8; ++j) { q[d0 * 8 + j] = t[j]; o[d0 * 8 + j] = 0.f; } }
    float mx = -INFINITY, l = 0.f;
    const int jend = qb * 256 + 255;
    for (int j = 0; j <= jend; ++j) {
        const bf16_t* kr = Kb + (size_t)j * Z0P; const bf16_t* vr = Vb + (size_t)j * Z0P;
        float s = 0.f;
#pragma unroll
        for (int d0 = 0; d0 < 8; ++d0) { float t[8]; unpack8(*(const bf16x8*)(kr + d0 * 8), t);
#pragma unroll
            for (int jj = 0; jj < 8; ++jj) s += q[d0 * 8 + jj] * t[jj]; }
        if (j > i) s = -INFINITY;
        if (s > mx) { const float al = __builtin_amdgcn_exp2f(mx - s); l *= al;
#pragma unroll
            for (int e = 0; e < 64; ++e) o[e] *= al;
            mx = s; }
        const float p = __builtin_amdgcn_exp2f(s - mx); l += p;
#pragma unroll
        for (int d0 = 0; d0 < 8; ++d0) { float t[8]; unpack8(*(const bf16x8*)(vr + d0 * 8), t);
#pragma unroll
            for (int jj = 0; jj < 8; ++jj) o[d0 * 8 + jj] += p * t[jj]; }
    }
    const float il = 1.f / l;
    bf16_t* Or = OP + (rowbase + i) * 1024 + vh * 64;
#pragma unroll
    for (int d0 = 0; d0 < 8; ++d0) { u32x4 w; w.x = pk2(o[d0 * 8] * il, o[d0 * 8 + 1] * il); w.y = pk2(o[d0 * 8 + 2] * il, o[d0 * 8 + 3] * il);
        w.z = pk2(o[d0 * 8 + 4] * il, o[d0 * 8 + 5] * il); w.w = pk2(o[d0 * 8 + 6] * il, o[d0 * 8 + 7] * il); *(u32x4*)(Or + d0 * 8) = w; }
}

struct LinAttnArgs {
    const bf16_t* q; const bf16_t* k; const bf16_t* v; const bf16_t* og;
    int zp; const float* la;
    float log_g;
    const float* gain;
    bf16_t* out;
};
template <int C>
DEV void linattn_unit_ref(const LinAttnArgs& a, LAS unsigned char* lds, int wv) {
    const int tid = opaque_tid(wv), lane = tid & 63, wid = tid >> 6;
    LAS bf16_t* qd = (LAS bf16_t*)lds;
    LAS bf16_t* ka = qd + C * 64;
    LAS bf16_t* vv = ka + C * 64;
    LAS float* bsc = (LAS float*)(vv + C * 128);
    LAS bf16_t* Sm = (LAS bf16_t*)bsc;
    LAS float* st = bsc + C * 64;
    LAS float* dec = st + 64 * 128;
    __syncthreads();
    for (int i = tid; i < 64 * 128; i += NTHREADS) st[i] = 0.f;
    for (int n = 0; n < SEQ / C; ++n) {
        const size_t r0 = (size_t)n * C;
        __syncthreads();
        for (int i = tid; i < C * 64; i += NTHREADS) { const int r = i >> 6, d = i & 63; bsc[i] = a.la ? a.la[(r0 + r) * 256 + d] : a.log_g; }
        for (int i = tid; i < C * 16; i += NTHREADS) { const int r = i >> 4, c8 = i & 15; *(LAS u32x4*)(vv + r * 128 + c8 * 8) = *(const u32x4*)(a.v + (r0 + r) * a.zp + c8 * 8); }
        __syncthreads();
        if (tid < 64) { float run = 0.f; for (int r = 0; r < C; ++r) { run += bsc[r * 64 + tid]; bsc[r * 64 + tid] = run; } dec[tid] = __expf(run); }
        __syncthreads();
        for (int i = tid; i < C * 64; i += NTHREADS) { const int r = i >> 6, d = i & 63; const float bb = bsc[i];
            qd[i] = f2bf(bf2f(a.q[(r0 + r) * a.zp + d]) * __expf(bb)); ka[i] = f2bf(bf2f(a.k[(r0 + r) * a.zp + d]) * __expf(-bb)); }
        __syncthreads();
        for (int i = tid; i < C * C; i += NTHREADS) { const int r = i / C, j = i % C; float s = 0.f;
            if (j <= r) { for (int d = 0; d < 64; ++d) s += bf2f(qd[r * 64 + d]) * bf2f(ka[j * 64 + d]); }
            Sm[i] = f2bf(s); }
        __syncthreads();
        for (int r = wid; r < C; r += NWAVES) {
            float o0 = 0.f, o1 = 0.f;
            for (int j = 0; j <= r; ++j) { const float s = bf2f(Sm[r * C + j]); o0 += s * bf2f(vv[j * 128 + lane]); o1 += s * bf2f(vv[j * 128 + 64 + lane]); }
            for (int d = 0; d < 64; ++d) { const float qv = bf2f(qd[r * 64 + d]); o0 += qv * st[d * 128 + lane]; o1 += qv * st[d * 128 + 64 + lane]; }
            const float rstd = 1.0f / sqrtf(wave_sum(o0 * o0 + o1 * o1) * (1.f / 128.f) + EPS);
            const float g0 = a.gain ? a.gain[lane] : 1.f, g1 = a.gain ? a.gain[lane + 64] : 1.f;
            const bf16_t* ogr = a.og + (r0 + r) * a.zp; bf16_t* orow = a.out + (r0 + r) * 1024;
            orow[lane] = f2bf(o0 * rstd * g0 * bf2f(ogr[lane])); orow[lane + 64] = f2bf(o1 * rstd * g1 * bf2f(ogr[lane + 64]));
        }
        __syncthreads();
        { const int e = tid & 127, dg = tid >> 7;
          for (int d = dg; d < 64; d += 4) { float s = st[d * 128 + e]; for (int j = 0; j < C; ++j) s += bf2f(ka[j * 64 + d]) * bf2f(vv[j * 128 + e]); st[d * 128 + e] = dec[d] * s; } }
    }
    __syncthreads();
}

DEV void sgu_unit_ref(const Params& P, int b, int ch, LAS unsigned char* lds, int wv) {
    const int tid = opaque_tid(wv), lane = tid & 63, wid = tid >> 6;
    unsigned char* ws = opaque_ws(P.ws); const bf16_t* Z = (const bf16_t*)(ws + WS_Z); bf16_t* CAT = (bf16_t*)(ws + WS_CAT);
    const float* lng = (const float*)P.in[16]; const float* lnb = (const float*)P.in[17]; const float* sw = (const float*)P.in[18]; const float* sb = (const float*)P.in[19];
    LAS float* svn = (LAS float*)lds;
    LAS float* stat = svn + 128 * 128;
    const size_t r0 = (size_t)b * SEQ + (size_t)ch * 128;
    __syncthreads();
    for (int r = wid; r < 128; r += NWAVES) {
        const bf16_t* zr = Z + (r0 + r) * Z1P + 512; float x[8]; unpack8(*(const bf16x8*)(zr + lane * 8), x);
        float s = 0.f;
#pragma unroll
        for (int j = 0; j < 8; ++j) s += x[j];
        const float mean = wave_sum(s) * (1.f / 512.f); float q = 0.f;
#pragma unroll
        for (int j = 0; j < 8; ++j) { const float d = x[j] - mean; q += d * d; }
        const float rstd = 1.0f / sqrtf(wave_sum(q) * (1.f / 512.f) + EPS);
        if (lane == 0) { stat[2 * r] = mean; stat[2 * r + 1] = rstd; }
    }
    __syncthreads();
    for (int g = 0; g < 4; ++g) {
        for (int i = tid; i < 128 * 128; i += NTHREADS) { const int r = i >> 7, c = i & 127;
            svn[i] = (bf2f(Z[(r0 + r) * Z1P + 512 + g * 128 + c]) - stat[2 * r]) * stat[2 * r + 1] * lng[g * 128 + c] + lnb[g * 128 + c]; }
        __syncthreads();
        { const int c = tid & 127, ig = tid >> 7;
          for (int r = ig; r < 128; r += 4) { float s = sb[g * 128 + r]; const float* wrow = sw + ((size_t)g * 128 + r) * 128;
              for (int j = 0; j <= r; ++j) s += wrow[j] * svn[j * 128 + c];
              CAT[(r0 + r) * 1024 + g * 128 + c] = f2bf(bf2f(Z[(r0 + r) * Z1P + g * 128 + c]) * s); } }
        __syncthreads();
    }
}


typedef float f32x16 __attribute__((ext_vector_type(16)));
DEV f32x16 mfma32(bf16x8 a, bf16x8 b, f32x16 c) { return __builtin_amdgcn_mfma_f32_32x32x16_bf16(a, b, c, 0, 0, 0); }
DEV bf16x8 ldfrag(const LAS bf16_t* base, int stride, int row, int k) { return *(const LAS bf16x8*)(base + row * stride + k); }

template <int C, bool HAS_LA>
DEV void linattn_unit_fast(const LinAttnArgs& a, LAS unsigned char* lds, int wv) {
    constexpr int SEG = C / 8, KS = 72, CS = C + 8, NIB = C / 32, NQ = NIB / 2, NPC = C / 64, NOP = C / 32, JB = C / 8, BS = 68, OS = 136;
    const int tid = opaque_tid(wv), lane = tid & 63, w = wv, r = lane & 31, h = lane >> 5;
    LAS bf16_t* Qd = (LAS bf16_t*)lds;
    LAS bf16_t* Ka = Qd + C * KS;
    LAS bf16_t* Kat = Ka + C * KS;
    LAS bf16_t* Vt = Kat + 64 * CS;
    LAS bf16_t* Stt = Vt + 128 * CS;
    LAS bf16_t* Sm = Stt + 128 * KS;
    LAS float* dec = (LAS float*)(Sm + C * CS);
    LAS float* tot = dec + 64;
    LAS float* rsq = tot + 512;
    LAS float* bt = rsq + C * 4;
    LAS bf16_t* Ot = (C == 128) ? Sm : (LAS bf16_t*)(bt + C * BS);
    const int db = w >> 2, eb = w & 3, i0 = w * SEG;
    const int vjb = tid % JB, veb = tid / JB; const bool vact = tid < 16 * JB;
    const int pc8 = lane & 7;
    f32x16 st;
#pragma unroll
    for (int t = 0; t < 16; ++t) st[t] = 0.f;
    float lav[SEG]; u32x4 qraw[NPC], kraw[NPC], vraw[8], ogv[NOP];
#define LIN_LOAD(n_) do { const size_t r0_ = (size_t)(n_) * C; \
        if (HAS_LA) { _Pragma("unroll") for (int ii = 0; ii < SEG; ++ii) lav[ii] = a.la[(r0_ + i0 + ii) * 256 + lane]; } \
        _Pragma("unroll") for (int pc = 0; pc < NPC; ++pc) { const int row_ = (tid + 512 * pc) >> 3; qraw[pc] = *(const u32x4*)(a.q + (r0_ + row_) * a.zp + 8 * pc8); kraw[pc] = *(const u32x4*)(a.k + (r0_ + row_) * a.zp + 8 * pc8); } \
        if (vact) { _Pragma("unroll") for (int jj = 0; jj < 8; ++jj) vraw[jj] = *(const u32x4*)(a.v + (r0_ + 8 * vjb + jj) * a.zp + 8 * veb); } \
        _Pragma("unroll") for (int pp = 0; pp < NOP; ++pp) { const int pce = tid + 512 * pp; ogv[pp] = *(const u32x4*)(a.og + (r0_ + (pce >> 4)) * a.zp + 8 * (pce & 15)); } } while (0)
    LIN_LOAD(0);
    LBAR();
    for (int n = 0; n < SEQ / C; ++n) {
        const size_t r0 = (size_t)n * C;
        if (HAS_LA) {
            float p[SEG]; float run = 0.f;
#pragma unroll
            for (int ii = 0; ii < SEG; ++ii) { run += lav[ii]; p[ii] = run; }
            tot[w * 64 + lane] = run;
            LBAR();
            float off = 0.f;
#pragma unroll
            for (int w2 = 0; w2 < 7; ++w2) { const float t2 = tot[w2 * 64 + lane]; off += (w2 < w) ? t2 : 0.f; }
#pragma unroll
            for (int ii = 0; ii < SEG; ++ii) bt[(i0 + ii) * BS + lane] = p[ii] + off;
            if (w == 7) dec[lane] = __expf(p[SEG - 1] + off);
            LBAR();
        } else {
            if (w == 7) dec[lane] = __expf((float)C * a.log_g);
        }
#pragma unroll
        for (int pc = 0; pc < NPC; ++pc) {
            const int row = (tid + 512 * pc) >> 3, d8 = 8 * pc8;
            float bb[8];
            if (HAS_LA) { const f32x4 b0 = *(const LAS f32x4*)(bt + row * BS + d8), b1 = *(const LAS f32x4*)(bt + row * BS + d8 + 4);
#pragma unroll
                for (int t = 0; t < 4; ++t) { bb[t] = b0[t]; bb[4 + t] = b1[t]; } }
            else {
#pragma unroll
                for (int t = 0; t < 8; ++t) bb[t] = (float)(row + 1) * a.log_g; }
            u32x4 qo, ko;
#pragma unroll
            for (int t = 0; t < 4; ++t) { const unsigned qw = qraw[pc][t], kw = kraw[pc][t];
                const float e0 = __expf(bb[2 * t]), e1 = __expf(bb[2 * t + 1]), f0 = __expf(-bb[2 * t]), f1 = __expf(-bb[2 * t + 1]);
                qo[t] = pk2(__uint_as_float(qw << 16) * e0, __uint_as_float(qw & 0xffff0000u) * e1);
                ko[t] = pk2(__uint_as_float(kw << 16) * f0, __uint_as_float(kw & 0xffff0000u) * f1); }
            *(LAS u32x4*)(Qd + row * KS + d8) = qo; *(LAS u32x4*)(Ka + row * KS + d8) = ko;
            unsigned k0 = ko[0], k1 = ko[1], k2 = ko[2], k3 = ko[3];
            { const int aa = pc8 >> 1;
              const unsigned t0 = aa == 0 ? k0 : aa == 1 ? k1 : aa == 2 ? k2 : k3, t1 = aa == 0 ? k1 : aa == 1 ? k2 : aa == 2 ? k3 : k0, t2 = aa == 0 ? k2 : aa == 1 ? k3 : aa == 2 ? k0 : k1, t3 = aa == 0 ? k3 : aa == 1 ? k0 : aa == 2 ? k1 : k2;
              if (pc8 & 1) { k0 = (t0 >> 16) | (t1 << 16); k1 = (t1 >> 16) | (t2 << 16); k2 = (t2 >> 16) | (t3 << 16); k3 = (t3 >> 16) | (t0 << 16); } else { k0 = t0; k1 = t1; k2 = t2; k3 = t3; } }
            const unsigned kr[4] = {k0, k1, k2, k3};
#pragma unroll
            for (int jj = 0; jj < 8; ++jj) { const int e = (jj + pc8) & 7; const unsigned wd = kr[jj >> 1];
                Kat[(d8 + e) * CS + row] = (bf16_t)((jj & 1) ? (wd >> 16) : (wd & 0xffffu)); }
        }
        if (vact) {
#pragma unroll
            for (int e = 0; e < 8; ++e) { u32x4 o4;
#pragma unroll
                for (int jp = 0; jp < 4; ++jp) { const unsigned lo = vraw[2 * jp][e >> 1], hi = vraw[2 * jp + 1][e >> 1];
                    o4[jp] = (e & 1) ? ((lo >> 16) | (hi & 0xffff0000u)) : ((lo & 0xffffu) | (hi << 16)); }
                *(LAS u32x4*)(Vt + (8 * veb + e) * CS + 8 * vjb) = o4; }
        }
#pragma unroll
        for (int g = 0; g < 4; ++g) { u32x2 w2; w2.x = pk2(st[4 * g], st[4 * g + 1]); w2.y = pk2(st[4 * g + 2], st[4 * g + 3]);
            *(LAS u32x2*)(Stt + (32 * eb + r) * KS + 32 * db + 8 * g + 4 * h) = w2; }
        u32x4 ogc[NOP];
#pragma unroll
        for (int pp = 0; pp < NOP; ++pp) ogc[pp] = ogv[pp];
        if (n + 1 < SEQ / C) LIN_LOAD(n + 1);
        LBAR();
        for (int bp = w; bp < NIB * (NIB + 1) / 2; bp += 8) {
            int ib = 0; while ((ib + 1) * (ib + 2) / 2 <= bp) ++ib;
            const int jb = bp - ib * (ib + 1) / 2;
            f32x16 acc;
#pragma unroll
            for (int t = 0; t < 16; ++t) acc[t] = 0.f;
#pragma unroll
            for (int s2 = 0; s2 < 4; ++s2) acc = mfma32(ldfrag(Ka, KS, 32 * jb + r, 16 * s2 + 8 * h), ldfrag(Qd, KS, 32 * ib + r, 16 * s2 + 8 * h), acc);
            const int i = 32 * ib + r;
#pragma unroll
            for (int g = 0; g < 4; ++g) { const int j0 = 32 * jb + 8 * g + 4 * h; float v0 = acc[4 * g], v1 = acc[4 * g + 1], v2 = acc[4 * g + 2], v3 = acc[4 * g + 3];
                if (j0 > i) v0 = 0.f; if (j0 + 1 > i) v1 = 0.f; if (j0 + 2 > i) v2 = 0.f; if (j0 + 3 > i) v3 = 0.f;
                u32x2 w2; w2.x = pk2(v0, v1); w2.y = pk2(v2, v3); *(LAS u32x2*)(Sm + i * CS + j0) = w2; }
        }
        {
            f32x16 acc = st;
#pragma unroll
            for (int s2 = 0; s2 < C / 16; ++s2) acc = mfma32(ldfrag(Kat, CS, 32 * db + r, 16 * s2 + 8 * h), ldfrag(Vt, CS, 32 * eb + r, 16 * s2 + 8 * h), acc);
#pragma unroll
            for (int g = 0; g < 4; ++g) { const f32x4 dv = *(const LAS f32x4*)(dec + 32 * db + 8 * g + 4 * h);
#pragma unroll
                for (int t = 0; t < 4; ++t) st[4 * g + t] = acc[4 * g + t] * dv[t]; }
        }
        LBAR();
        f32x16 o[NQ];
#pragma unroll
        for (int q = 0; q < NQ; ++q) {
            const int blk = w + 8 * q, ib = blk >> 2, e2 = blk & 3;
            f32x16 acc;
#pragma unroll
            for (int t = 0; t < 16; ++t) acc[t] = 0.f;
            for (int s2 = 0; s2 < 2 * (ib + 1); ++s2) acc = mfma32(ldfrag(Vt, CS, 32 * e2 + r, 16 * s2 + 8 * h), ldfrag(Sm, CS, 32 * ib + r, 16 * s2 + 8 * h), acc);
#pragma unroll
            for (int s2 = 0; s2 < 4; ++s2) acc = mfma32(ldfrag(Stt, KS, 32 * e2 + r, 16 * s2 + 8 * h), ldfrag(Qd, KS, 32 * ib + r, 16 * s2 + 8 * h), acc);
            o[q] = acc;
            float ss = 0.f;
#pragma unroll
            for (int t = 0; t < 16; ++t) ss += acc[t] * acc[t];
            ss += __shfl_xor(ss, 32);
            if (h == 0) rsq[(32 * ib + r) * 4 + e2] = ss;
        }
        LBAR();
#pragma unroll
        for (int q = 0; q < NQ; ++q) {
            const int blk = w + 8 * q, ib = blk >> 2, e2 = blk & 3, i = 32 * ib + r;
            const f32x4 rs = *(const LAS f32x4*)(rsq + i * 4);
            const float rstd = 1.0f / sqrtf(((rs[0] + rs[1]) + (rs[2] + rs[3])) * (1.f / 128.f) + EPS);
#pragma unroll
            for (int g = 0; g < 4; ++g) { const int e0 = 32 * e2 + 8 * g + 4 * h;
                f32x4 gn = {1.f, 1.f, 1.f, 1.f}; if (a.gain) gn = *(const f32x4*)(a.gain + e0);
                u32x2 w2; w2.x = pk2(o[q][4 * g] * rstd * gn[0], o[q][4 * g + 1] * rstd * gn[1]); w2.y = pk2(o[q][4 * g + 2] * rstd * gn[2], o[q][4 * g + 3] * rstd * gn[3]);
                *(LAS u32x2*)(Ot + i * OS + e0) = w2; }
        }
        LBAR();
#pragma unroll
        for (int pp = 0; pp < NOP; ++pp) { const int pce = tid + 512 * pp, row = pce >> 4, e8 = 8 * (pce & 15);
            const u32x4 ov = *(const LAS u32x4*)(Ot + row * OS + e8); const u32x4 gv = ogc[pp]; u32x4 res;
#pragma unroll
            for (int t = 0; t < 4; ++t) res[t] = pk2(__uint_as_float(ov[t] << 16) * __uint_as_float(gv[t] << 16), __uint_as_float(ov[t] & 0xffff0000u) * __uint_as_float(gv[t] & 0xffff0000u));
            *(u32x4*)(a.out + (r0 + row) * 1024 + e8) = res; }
    }
    asm volatile("s_waitcnt vmcnt(0)" ::: "memory");
    LBAR();
#undef LIN_LOAD
}

DEV void sgu_unit_fast(const Params& P, int b, int ch, LAS unsigned char* lds, int wv) {
    constexpr int CS = 136;
    const int tid = opaque_tid(wv), lane = tid & 63, w = wv, r = lane & 31, h = lane >> 5;
    unsigned char* ws = opaque_ws(P.ws); const bf16_t* Z = (const bf16_t*)(ws + WS_Z); bf16_t* CAT = (bf16_t*)(ws + WS_CAT); const bf16_t* SW = (const bf16_t*)(ws + WS_SGUW);
    const float* lng = (const float*)P.in[16]; const float* lnb = (const float*)P.in[17]; const float* sb = (const float*)P.in[19];
    LAS bf16_t* Wg = (LAS bf16_t*)lds;
    LAS bf16_t* Sv = Wg + 128 * CS;
    LAS float* stat = (LAS float*)(Sv + 128 * CS);
    const size_t r0 = (size_t)b * SEQ + (size_t)ch * 128;
    __syncthreads();
    for (int rr = w; rr < 128; rr += NWAVES) {
        const bf16_t* zr = Z + (r0 + rr) * Z1P + 512; float x[8]; unpack8(*(const bf16x8*)(zr + lane * 8), x);
        float s = 0.f;
#pragma unroll
        for (int j = 0; j < 8; ++j) s += x[j];
        const float mean = wave_sum(s) * (1.f / 512.f); float q = 0.f;
#pragma unroll
        for (int j = 0; j < 8; ++j) { const float d = x[j] - mean; q += d * d; }
        const float rstd = 1.0f / sqrtf(wave_sum(q) * (1.f / 512.f) + EPS);
        if (lane == 0) { stat[2 * rr] = mean; stat[2 * rr + 1] = rstd; }
    }
    __syncthreads();
    for (int g = 0; g < 4; ++g) {
#pragma unroll
        for (int it = 0; it < 4; ++it) { const int pc = tid + 512 * it, i = pc >> 4, c8 = pc & 15;
            *(LAS u32x4*)(Wg + i * CS + c8 * 8) = *(const u32x4*)(SW + ((size_t)g * 128 + i) * 128 + c8 * 8); }
#pragma unroll
        for (int it = 0; it < 4; ++it) { const int item = tid + 512 * it, c = item & 127, jg = item >> 7;
            const float gg = lng[g * 128 + c], bb = lnb[g * 128 + c]; float v[8];
#pragma unroll
            for (int jj = 0; jj < 8; ++jj) { const int j = 8 * jg + jj; v[jj] = (bf2f(Z[(r0 + j) * Z1P + 512 + g * 128 + c]) - stat[2 * j]) * stat[2 * j + 1] * gg + bb; }
            u32x4 w4; w4.x = pk2(v[0], v[1]); w4.y = pk2(v[2], v[3]); w4.z = pk2(v[4], v[5]); w4.w = pk2(v[6], v[7]);
            *(LAS u32x4*)(Sv + c * CS + 8 * jg) = w4; }
        __syncthreads();
#pragma unroll
        for (int q = 0; q < 2; ++q) {
            const int blk = w + 8 * q, ib = blk >> 2, cb = blk & 3, i = 32 * ib + r;
            f32x16 acc;
#pragma unroll
            for (int t = 0; t < 16; ++t) acc[t] = 0.f;
            for (int s2 = 0; s2 < 2 * (ib + 1); ++s2) acc = mfma32(ldfrag(Sv, CS, 32 * cb + r, 16 * s2 + 8 * h), ldfrag(Wg, CS, i, 16 * s2 + 8 * h), acc);
            const float bs = sb[g * 128 + i];
#pragma unroll
            for (int gq = 0; gq < 4; ++gq) { const int c0 = g * 128 + 32 * cb + 8 * gq + 4 * h;
                const u32x2 su = *(const u32x2*)(Z + (r0 + i) * Z1P + c0);
                const float u0 = __uint_as_float(su.x << 16), u1 = __uint_as_float(su.x & 0xffff0000u), u2 = __uint_as_float(su.y << 16), u3 = __uint_as_float(su.y & 0xffff0000u);
                u32x2 w2; w2.x = pk2(u0 * (acc[4 * gq] + bs), u1 * (acc[4 * gq + 1] + bs)); w2.y = pk2(u2 * (acc[4 * gq + 2] + bs), u3 * (acc[4 * gq + 3] + bs));
                *(u32x2*)(CAT + (r0 + i) * 1024 + c0) = w2; }
        }
        __syncthreads();
    }
}

namespace attn_body {
using bf16=unsigned short;
using s16x4=__attribute__((ext_vector_type(4)))short;
using f32x16=__attribute__((ext_vector_type(16)))float;
constexpr int D=64,ZP=Z0P,OPITCH=1024;
constexpr int NW=8,QBLK=32,QB=QBLK*NW,KVBLK=64;
__device__ __forceinline__ int crow(int r,int hi){return (r&3)+8*(r>>2)+4*hi;}
#define SBAR() __builtin_amdgcn_sched_barrier(0)
__device__ __forceinline__ void cmask(f32x16&p0,f32x16&p1,int jb,int qrel,int hi){
  const float NEG=-INFINITY; int kb=64*jb+4*hi;
  #pragma unroll
  for(int r=0;r<16;++r){int kv=kb+(r&3)+8*(r>>2); if(kv>qrel)p0[r]=NEG; if(kv+32>qrel)p1[r]=NEG;}
}

constexpr int NSLOT=3, SLOTB=8192;
constexpr int LDS_K=0, LDS_V=NSLOT*SLOTB, LDS_WS=2*NSLOT*SLOTB, LDS_OST=LDS_WS+NW*64*4, LDS_BYTES=LDS_OST+NW*4096;
__device__ __forceinline__ void glds16(const void*gsrc,unsigned lds_dst){unsigned keep;
  asm volatile("s_mov_b32 %0, m0\n\ts_mov_b32 m0, %2\n\ts_nop 0\n\tglobal_load_lds_dwordx4 %1, off\n\ts_mov_b32 m0, %0":"=&s"(keep):"v"(gsrc),"s"(lds_dst):"memory");}
__device__ __forceinline__ float max3f(float a,float b,float c){float r;asm("v_max3_f32 %0, %1, %2, %3":"=v"(r):"v"(a),"v"(b),"v"(c));return r;}
__device__ __forceinline__ float max2f(float a,float b){float r;asm("v_max_f32_e32 %0, %1, %2":"=v"(r):"v"(a),"v"(b));return r;}
__device__ __forceinline__ float fadd_s(float a,float b){float r;asm("v_add_f32_e32 %0, %1, %2":"=v"(r):"v"(a),"v"(b));return r;}
__device__ __forceinline__ float fsub_s(float a,float b){float r;asm("v_sub_f32_e32 %0, %1, %2":"=v"(r):"v"(a),"v"(b));return r;}
typedef float f32x2_t __attribute__((ext_vector_type(2))); typedef __bf16 bf16x2_t __attribute__((ext_vector_type(2)));
typedef int v8i __attribute__((ext_vector_type(8)));
__device__ __forceinline__ unsigned cvtpk_s(float lo,float hi){f32x2_t v={lo,hi};bf16x2_t b=__builtin_convertvector(v,bf16x2_t);return __builtin_bit_cast(unsigned,b);}
#define WAIT_BAR(N) asm volatile("s_waitcnt vmcnt(" #N ") lgkmcnt(0)\n\ts_barrier":::"memory")

__device__ __forceinline__ void qkt(f32x16&p0,f32x16&p1,const char*Kslot,const bf16x8*qr,const f32x16&negm,int r32,int hi){
  const char*kb=Kslot+hi*1024+r32*16;
  #pragma unroll
  for(int d0=0;d0<4;++d0){
    const bf16x8 b0=*reinterpret_cast<const bf16x8*>(kb+d0*2048);
    const bf16x8 b1=*reinterpret_cast<const bf16x8*>(kb+d0*2048+512);
    if(d0==0){p0=__builtin_amdgcn_mfma_f32_32x32x16_bf16(b0,qr[0],negm,0,0,0);p1=__builtin_amdgcn_mfma_f32_32x32x16_bf16(b1,qr[0],negm,0,0,0);}
    else{p0=__builtin_amdgcn_mfma_f32_32x32x16_bf16(b0,qr[d0],p0,0,0,0);p1=__builtin_amdgcn_mfma_f32_32x32x16_bf16(b1,qr[d0],p1,0,0,0);}}
}
typedef __attribute__((address_space(3))) const char* lds_cptr;
typedef short v4i16_t __attribute__((ext_vector_type(4)));
__device__ __forceinline__ void kload8(bf16x8*kf,lds_cptr kp){
  kf[0]=*(const __attribute__((address_space(3))) bf16x8*)(kp);      kf[1]=*(const __attribute__((address_space(3))) bf16x8*)(kp+512);
  kf[2]=*(const __attribute__((address_space(3))) bf16x8*)(kp+2048); kf[3]=*(const __attribute__((address_space(3))) bf16x8*)(kp+2560);
  kf[4]=*(const __attribute__((address_space(3))) bf16x8*)(kp+4096); kf[5]=*(const __attribute__((address_space(3))) bf16x8*)(kp+4608);
  kf[6]=*(const __attribute__((address_space(3))) bf16x8*)(kp+6144); kf[7]=*(const __attribute__((address_space(3))) bf16x8*)(kp+6656);
}
__device__ __forceinline__ void kload2(bf16x8*kf,lds_cptr kp,int j){ kf[2*j]=*(const __attribute__((address_space(3))) bf16x8*)(kp+j*2048); kf[2*j+1]=*(const __attribute__((address_space(3))) bf16x8*)(kp+j*2048+512); }
__device__ __forceinline__ s16x4 vtr(lds_cptr p){ return __builtin_bit_cast(s16x4,__builtin_amdgcn_ds_read_tr16_b64_v4i16((__attribute__((address_space(3))) v4i16_t*)p)); }
__device__ __forceinline__ float rowmax(const f32x16&p0,const f32x16&p1){
  float a=max3f(p0[0],p0[1],p1[0]),b=max3f(p0[2],p0[3],p1[1]);a=max3f(a,p1[2],p1[3]);
  #pragma unroll
  for(int r=4;r<16;r+=4){a=max3f(a,p0[r],p0[r+1]);b=max3f(b,p0[r+2],p0[r+3]);a=max3f(a,p1[r],p1[r+1]);b=max3f(b,p1[r+2],p1[r+3]);}
  const float m=max2f(a,b);
  auto rr=__builtin_amdgcn_permlane32_swap(__float_as_uint(m),__float_as_uint(m),false,false);
  return max2f(__uint_as_float(rr[0]),__uint_as_float(rr[1]));
}
__device__ __forceinline__ void pv(f32x16*o,int vb,bf16x8 pa0,bf16x8 pa1,bf16x8 pa2,bf16x8 pa3){
  #pragma unroll
  for(int d0=0;d0<2;++d0){s16x4 lo[4],hi[4];
    #pragma unroll
    for(int ks=0;ks<4;++ks){
      asm volatile("ds_read_b64_tr_b16 %0,%1 offset:%c2":"=&v"(lo[ks]):"v"(vb),"i"(d0*4096+ks*1024):"memory");
      asm volatile("ds_read_b64_tr_b16 %0,%1 offset:%c2":"=&v"(hi[ks]):"v"(vb),"i"(d0*4096+ks*1024+512):"memory");}
    asm volatile("s_waitcnt lgkmcnt(0)":::"memory");SBAR();
    #define PK(k) (bf16x8){lo[k][0],lo[k][1],lo[k][2],lo[k][3],hi[k][0],hi[k][1],hi[k][2],hi[k][3]}
    o[d0]=__builtin_amdgcn_mfma_f32_32x32x16_bf16(pa0,PK(0),o[d0],0,0,0);
    o[d0]=__builtin_amdgcn_mfma_f32_32x32x16_bf16(pa1,PK(1),o[d0],0,0,0);
    o[d0]=__builtin_amdgcn_mfma_f32_32x32x16_bf16(pa2,PK(2),o[d0],0,0,0);
    o[d0]=__builtin_amdgcn_mfma_f32_32x32x16_bf16(pa3,PK(3),o[d0],0,0,0);
    #undef PK
  }
}

#ifndef ATTN_STORE16
#define ATTN_STORE16(p,v) (*(u32x4*)(p)=(v))
#endif
template<int THRL> __device__ __forceinline__ void attn_unit(int qb,const bf16*Qb,const bf16*__restrict__ Kb,const bf16*__restrict__ Vb,bf16*Ob,char*shm,int wv){
  const int tid=opaque_tid(wv),lane=tid&63,r32=lane&31,hi=lane>>5; const int wid=wv;
  const int q0=qb*QB;
  const bf16*Qw=Qb+(long)(q0+wid*QBLK)*ZP;
  const bf16*Kh=Kb,*Vh=Vb;
  const unsigned lds0=(unsigned)(uintptr_t)shm;
  float*wsf=(float*)(shm+LDS_WS)+wid*64;
  const bf16*ksrc=Kh+(long)lane*ZP+wid*8;
  const bf16*vsrc=Vh+(long)(16*(wid&3)+(lane>>2))*ZP+(wid>>2)*32+(lane&3)*8;
  const unsigned kdst=lds0+LDS_K+wid*1024, vdst=lds0+LDS_V+wid*1024;
  #define DMA_K(t,slot) glds16(ksrc+(long)(t)*KVBLK*ZP,(unsigned)__builtin_amdgcn_readfirstlane(kdst+(slot)))
  #define DMA_V(t,slot) glds16(vsrc+(long)(t)*KVBLK*ZP,(unsigned)__builtin_amdgcn_readfirstlane(vdst+(slot)))
  const int vb0=(int)(lds0+LDS_V)+((lane>>4)&1)*32+(lane&3)*8+(4*hi+((lane&15)>>2))*64;
  const char*Kbase=shm+LDS_K; bf16x8 kf[8];
  const lds_cptr shm3=(lds_cptr)shm; const lds_cptr kp0=shm3+LDS_K+hi*1024+r32*16; const lds_cptr vp0=shm3+LDS_V+((lane>>4)&1)*32+(lane&3)*8+(4*hi+((lane&15)>>2))*64;
  const int NT=(q0+QB)/KVBLK;
  DMA_K(0,0);DMA_V(0,0);DMA_K(1,SLOTB);
  bf16x8 qr[4];
  #pragma unroll
  for(int d0=0;d0<4;++d0)qr[d0]=*reinterpret_cast<const bf16x8*>(&Qw[(long)r32*ZP+d0*16+hi*8]);
  float mhat=0.f,l_reg=0.f;f32x16 o[2];o[0]=f32x16{};o[1]=f32x16{};f32x16 negm=f32x16{};asm volatile("":"+v"(negm));
  const int qrel=wid*QBLK+r32;
  #define CMASK(P0,P1,t) do{int jb_=(t)-(NT-4); if(jb_>=0)cmask(P0,P1,jb_,qrel,hi);}while(0)
  bool resc=false;
  #define START(P0,P1) do{ const float rm=rowmax(P0,P1); resc=false; \
    { const float dl=rm; mhat=fadd_s(mhat,dl); \
      _Pragma("unroll") for(int r=0;r<16;++r){P0[r]=fsub_s(P0[r],dl);P1[r]=fsub_s(P1[r],dl);} \
      _Pragma("unroll") for(int r=0;r<16;++r)negm[r]=-mhat; asm volatile("":"+v"(negm)); } \
    _Pragma("unroll") for(int r=0;r<16;++r)P0[r]=__builtin_amdgcn_exp2f(P0[r]); }while(0)
  #define RESC() do{ if(resc){ asm volatile("s_waitcnt lgkmcnt(0)":::"memory"); \
      _Pragma("unroll") for(int d_=0;d_<2;++d_) _Pragma("unroll") for(int r=0;r<16;++r)o[d_][r]*=wsf[crow(r,hi)]; } }while(0)
  f32x16 pA0,pA1,pB0,pB1;
  int sl_prev=0,sl_cur=0,sl_next=SLOTB;
  #define ROT() do{sl_prev=sl_cur;sl_cur=sl_next;sl_next=(sl_next==(NSLOT-1)*SLOTB)?0:sl_next+SLOTB;}while(0)
  DMA_K(2,2*SLOTB);
  WAIT_BAR(3);
  qkt(pA0,pA1,Kbase,qr,negm,r32,hi);asm volatile("s_nop 15\n\ts_nop 7":"+v"(pA0),"+v"(pA1));CMASK(pA0,pA1,0);
  START(pA0,pA1);
  _Pragma("unroll") for(int r=0;r<16;++r)pA1[r]=__builtin_amdgcn_exp2f(pA1[r]);
  WAIT_BAR(0);
  DMA_K(3,0);DMA_V(1,SLOTB);
  ROT();
  kload8(kf,kp0+sl_cur);
  WAIT_BAR(2);
  s16x4 vlo[8],vhi[8]; u32x4 pw0,pw1,pw2,pw3;
  #define PKW(P,B) cvtpk_s(P[B],P[B+1])
  #define PAF(k) __builtin_bit_cast(bf16x8,pw##k)
  #define VFR(i) (bf16x8){vlo[i][0],vlo[i][1],vlo[i][2],vlo[i][3],vhi[i][0],vhi[i][1],vhi[i][2],vhi[i][3]}
  #define PIN(x) asm volatile("":"+v"(x))
  #define MX3(a,b,c) __builtin_fmaxf(__builtin_fmaxf((a),(b)),(c))
  #define GAPA(MF,A0,A1,A2,A3,W0,W1,PW) do{ MF; sacc+=A0; sacc+=A1; sacc+=A2; sacc+=A3; PIN(sacc); W0; W1; PIN(PW); SBAR(); }while(0)
  #define EX(v) __builtin_amdgcn_exp2f(v)
  #define GAPB(MF,X,B) do{ MF; X[B]=EX(X[B]); X[B+1]=EX(X[B+1]); X[B+2]=EX(X[B+2]); X[B+3]=EX(X[B+3]); PIN(X); SBAR(); }while(0)
  #define VRD(i) do{ vlo[i]=vtr(vp_+(((i)>>2)*4096+((i)&3)*1024)); vhi[i]=vtr(vp_+(((i)>>2)*4096+((i)&3)*1024+512)); }while(0)
  #define KRD(G,j) do{ if(G){ kload2(kf,kp0+sl_next,j); SBAR(); } }while(0)
  #define STEP(C0,C1,P0,P1,t,GK,GV,GL) do{ SBAR(); \
    const lds_cptr vp_=vp0+sl_prev; \
    VRD(0); SBAR(); float sacc=(P0[0]+P0[1]); \
    GAPA(C0=__builtin_amdgcn_mfma_f32_32x32x16_bf16(kf[0],qr[0],negm,0,0,0), P0[2],P0[3],P0[4],P0[5],     pw0[0]=PKW(P0,0), pw0[1]=PKW(P0,2), pw0); \
    VRD(4); SBAR(); GAPA(C1=__builtin_amdgcn_mfma_f32_32x32x16_bf16(kf[1],qr[0],negm,0,0,0), P0[6],P0[7],P0[8],P0[9],     pw0[2]=PKW(P0,4), pw0[3]=PKW(P0,6), pw0); \
    VRD(1); SBAR(); GAPA(C0=__builtin_amdgcn_mfma_f32_32x32x16_bf16(kf[2],qr[1],C0,0,0,0),   P0[10],P0[11],P0[12],P0[13], pw1[0]=PKW(P0,8), pw1[1]=PKW(P0,10), pw1); \
    VRD(5); SBAR(); GAPA(C1=__builtin_amdgcn_mfma_f32_32x32x16_bf16(kf[3],qr[1],C1,0,0,0),   P0[14],P0[15],P1[0],P1[1],   pw1[2]=PKW(P0,12),pw1[3]=PKW(P0,14), pw1); \
    VRD(2); SBAR(); GAPA(C0=__builtin_amdgcn_mfma_f32_32x32x16_bf16(kf[4],qr[2],C0,0,0,0),   P1[2],P1[3],P1[4],P1[5],     pw2[0]=PKW(P1,0), pw2[1]=PKW(P1,2), pw2); \
    VRD(6); SBAR(); GAPA(C1=__builtin_amdgcn_mfma_f32_32x32x16_bf16(kf[5],qr[2],C1,0,0,0),   P1[6],P1[7],P1[8],P1[9],     pw2[2]=PKW(P1,4), pw2[3]=PKW(P1,6), pw2); \
    VRD(3); SBAR(); GAPA(C0=__builtin_amdgcn_mfma_f32_32x32x16_bf16(kf[6],qr[3],C0,0,0,0),   P1[10],P1[11],P1[12],P1[13], pw3[0]=PKW(P1,8), pw3[1]=PKW(P1,10), pw3); \
    VRD(7); SBAR(); GAPA(C1=__builtin_amdgcn_mfma_f32_32x32x16_bf16(kf[7],qr[3],C1,0,0,0),   P1[14],P1[15],0.f,0.f,       pw3[2]=PKW(P1,12),pw3[3]=PKW(P1,14), pw3); \
    l_reg+=sacc; \
    if(GK){DMA_K((t)+3,sl_cur);} if(GV){DMA_V((t)+1,sl_next);} \
    CMASK(C0,C1,t); \
    { float a=MX3(C0[0],C0[1],C1[0]),b=MX3(C0[2],C0[3],C1[1]); a=MX3(a,C1[2],C1[3]); \
      _Pragma("unroll") for(int r=4;r<16;r+=4){a=MX3(a,C0[r],C0[r+1]);b=MX3(b,C0[r+2],C0[r+3]);a=MX3(a,C1[r],C1[r+1]);b=MX3(b,C1[r+2],C1[r+3]);} \
      float rm=__builtin_fmaxf(a,b); { auto rr=__builtin_amdgcn_permlane32_swap(__float_as_uint(rm),__float_as_uint(rm),false,false); rm=__builtin_fmaxf(__uint_as_float(rr[0]),__uint_as_float(rr[1])); } \
      resc=false; \
      if(__builtin_expect(__any(rm>(float)THRL),0)){ const float dl=__builtin_fmaxf(rm,0.f); mhat+=dl; \
        _Pragma("unroll") for(int r=0;r<16;++r){C0[r]-=dl;C1[r]-=dl;} \
        _Pragma("unroll") for(int r=0;r<16;++r)negm[r]=-mhat; asm volatile("":"+v"(negm)); \
        const float f=__builtin_amdgcn_exp2f(-dl); l_reg*=f; if(hi==0)wsf[r32]=f; resc=true; } } \
    SBAR(); \
    GAPB(o[0]=__builtin_amdgcn_mfma_f32_32x32x16_bf16(PAF(0),VFR(0),o[0],0,0,0), C0,0); \
    GAPB(o[1]=__builtin_amdgcn_mfma_f32_32x32x16_bf16(PAF(0),VFR(4),o[1],0,0,0), C0,4); \
    KRD(GL,0); GAPB(o[0]=__builtin_amdgcn_mfma_f32_32x32x16_bf16(PAF(1),VFR(1),o[0],0,0,0), C0,8); \
    KRD(GL,1); GAPB(o[1]=__builtin_amdgcn_mfma_f32_32x32x16_bf16(PAF(1),VFR(5),o[1],0,0,0), C0,12); \
    KRD(GL,2); GAPB(o[0]=__builtin_amdgcn_mfma_f32_32x32x16_bf16(PAF(2),VFR(2),o[0],0,0,0), C1,0); \
    KRD(GL,3); GAPB(o[1]=__builtin_amdgcn_mfma_f32_32x32x16_bf16(PAF(2),VFR(6),o[1],0,0,0), C1,4); \
    GAPB(o[0]=__builtin_amdgcn_mfma_f32_32x32x16_bf16(PAF(3),VFR(3),o[0],0,0,0), C1,8); \
    GAPB(o[1]=__builtin_amdgcn_mfma_f32_32x32x16_bf16(PAF(3),VFR(7),o[1],0,0,0), C1,12); \
    }while(0)
  int t=1;
  #undef CMASK
  #define CMASK(P0,P1,t) do{}while(0)
  for(;t+5<NT;t+=2){
    STEP(pB0,pB1,pA0,pA1,t,true,true,true);     WAIT_BAR(2); RESC(); ROT();
    STEP(pA0,pA1,pB0,pB1,t+1,true,true,true);   WAIT_BAR(2); RESC(); ROT();
  }
  #undef CMASK
  #define CMASK(P0,P1,t) do{int jb_=(t)-(NT-4); if(jb_>=0)cmask(P0,P1,jb_,qrel,hi);}while(0)
  #define ENDW(tt) do{ if((tt)+3<NT){WAIT_BAR(2);} else if((tt)+2<NT){WAIT_BAR(1);} else {WAIT_BAR(0);} }while(0)
  for(;t+1<NT;t+=2){
    STEP(pB0,pB1,pA0,pA1,t,(t+3<NT),(t+1<NT),(t+1<NT));       ENDW(t);   RESC(); ROT();
    STEP(pA0,pA1,pB0,pB1,t+1,(t+4<NT),(t+2<NT),(t+2<NT));     ENDW(t+1); RESC(); ROT();
  }
  STEP(pB0,pB1,pA0,pA1,NT-1,false,false,false); RESC();
  { float sacc=pB0[0]+pB0[1]; _Pragma("unroll") for(int r=2;r<16;++r)sacc+=pB0[r]; _Pragma("unroll") for(int r=0;r<16;++r)sacc+=pB1[r]; l_reg+=sacc;
    pw0=(u32x4){PKW(pB0,0),PKW(pB0,2),PKW(pB0,4),PKW(pB0,6)};pw1=(u32x4){PKW(pB0,8),PKW(pB0,10),PKW(pB0,12),PKW(pB0,14)};pw2=(u32x4){PKW(pB1,0),PKW(pB1,2),PKW(pB1,4),PKW(pB1,6)};pw3=(u32x4){PKW(pB1,8),PKW(pB1,10),PKW(pB1,12),PKW(pB1,14)};
    SBAR(); pv(o,vb0+sl_cur,PAF(0),PAF(1),PAF(2),PAF(3)); }
  #undef PKW
  #undef PAF
  #undef VFR
  #undef PIN
  #undef MX3
  #undef GAPA
  #undef GAPB
  #undef EX
  #undef VRD
  #undef KRD
  #undef STEP
  #undef ENDW
  {auto rr=__builtin_amdgcn_permlane32_swap(__float_as_uint(l_reg),__float_as_uint(l_reg),false,false);l_reg=__uint_as_float(rr[0])+__uint_as_float(rr[1]);}
  if(hi==0)wsf[32+r32]=l_reg;asm volatile("s_waitcnt lgkmcnt(0)":::"memory");
  float rli[16];
  #pragma unroll
  for(int r=0;r<16;++r)rli[r]=__builtin_amdgcn_rcpf(wsf[32+crow(r,hi)]);
  bf16*Ow=Ob+(long)(q0+wid*QBLK)*OPITCH;
  { bf16*stg=(bf16*)(shm+LDS_OST)+wid*2048;
    #pragma unroll
    for(int r=0;r<16;++r){const int orow=crow(r,hi);
      #pragma unroll
      for(int d0=0;d0<2;++d0)stg[orow*64+d0*32+r32]=f2bf(o[d0][r]*rli[r]);}
    asm volatile("s_waitcnt lgkmcnt(0)":::"memory");
    #pragma unroll
    for(int i=0;i<4;++i){const int row=i*8+(lane>>3),ch=lane&7; const u32x4 v=*(const u32x4*)(stg+row*64+ch*8); ATTN_STORE16(Ow+(long)row*OPITCH+ch*8,v);} }
  asm volatile("s_waitcnt lgkmcnt(0)\n\ts_barrier":::"memory");
  #undef DMA_K
  #undef DMA_V
  #undef CMASK
  #undef START
  #undef RESC
  #undef ROT
}
constexpr int ATTN_LDS_BYTES=LDS_BYTES;
#undef SBAR
#undef WAIT_BAR
}
DEV int queue_pop(unsigned* head, LAS unsigned char* lds, int wv) {
    LAS int* slot = (LAS int*)(lds + LCTL_OFF + 4096);
    __syncthreads();
    if (opaque_tid(wv) == 0) *slot = (int)__hip_atomic_fetch_add(head, 1u, __ATOMIC_RELAXED, __HIP_MEMORY_SCOPE_AGENT);
    __syncthreads();
    return *slot;
}

DEV void phase_mix0(const Params& P, LAS unsigned char* lds, char* shm, int wv) {
    unsigned char* ws = opaque_ws(P.ws); const bf16_t* Z = (const bf16_t*)(ws + WS_Z);
    unsigned* head = (unsigned*)(ws + WS_CTL) + CW_QUEUE;
    for (;;) {
        const int q = queue_pop(head, lds, wv);
        if (q >= 32 + 1024) break;
        if (q < 32) {
            const int b = q >> 2, h = q & 3; const size_t rb = (size_t)b * SEQ;
            LinAttnArgs a; a.q = Z + rb * Z0P + h * 64; a.k = Z + rb * Z0P + 256 + h * 64; a.v = Z + rb * Z0P + 512 + h * 128; a.og = Z + rb * Z0P + 1024 + h * 128; a.zp = Z0P;
            a.la = (const float*)(ws + WS_LA) + rb * 256 + h * 64; a.log_g = 0.f; a.gain = (const float*)P.in[8]; a.out = (bf16_t*)(ws + WS_CAT) + rb * 1024 + h * 128;
            #if FAST_LIN
            linattn_unit_fast<64, true>(a, lds, wv);
#ifdef DBG_TS
            if (opaque_tid(wv) == 0) atomicMax((unsigned long long*)(ws + WS_CTL + 49152) + 32, (unsigned long long)__builtin_amdgcn_s_memrealtime());
#endif
#else
            linattn_unit_ref<64>(a, lds, wv);
#endif
        } else {
            const int aidx = q - 32, qb = 7 - (aidx >> 7), rem = aidx & 127, b = rem >> 4, vh = rem & 15;
#if FAST_ATTN
            { const int h = vh >> 2, m = (vh >> 1) & 1, vhalf = vh & 1; const bf16_t* zb = Z + (size_t)b * SEQ * Z0P;
              attn_body::attn_unit<8>(qb, zb + 1536 + h * 128 + m * 64, zb + 2048 + h * 128 + m * 64, zb + 2560 + h * 128 + vhalf * 64,
                                      (bf16_t*)(ws + WS_OPART) + (size_t)b * SEQ * 1024 + vh * 64, shm, wv); }
#ifdef DBG_TS
            if (opaque_tid(wv) == 0) atomicMax((unsigned long long*)(ws + WS_CTL + 49152) + 33, (unsigned long long)__builtin_amdgcn_s_memrealtime());
#endif
#else
            attn_unit_ref(b, vh, qb, Z, (bf16_t*)(ws + WS_OPART), wv);
#endif
        }
    }
}
DEV void phase_mix1(const Params& P, LAS unsigned char* lds, int wv) {
    unsigned char* ws = opaque_ws(P.ws); const bf16_t* Z = (const bf16_t*)(ws + WS_Z);
    const int G = gridDim.x, nret = G >= 64 ? 32 : 0;
    if ((int)blockIdx.x < nret || nret == 0) {
        for (int q = blockIdx.x; q < 32; q += (nret ? 32 : G)) {
            const int b = q >> 2, h = q & 3; const size_t rb = (size_t)b * SEQ;
            LinAttnArgs a; a.q = Z + rb * Z1P + 1024 + h * 64; a.k = Z + rb * Z1P + 1280 + h * 64; a.v = Z + rb * Z1P + 1536 + h * 128; a.og = Z + rb * Z1P + 2048 + h * 128; a.zp = Z1P;
            a.la = nullptr; a.log_g = logf(1.0f - exp2f(-5.0f - (float)h)); a.gain = nullptr; a.out = (bf16_t*)(ws + WS_CAT) + rb * 1024 + 512 + h * 128;
            linattn_unit_fast<128, false>(a, lds, wv);
        }
    }
    if ((int)blockIdx.x >= nret) {
        for (int s2 = (int)blockIdx.x - nret; s2 < 128; s2 += G - nret) sgu_unit_fast(P, s2 >> 4, s2 & 15, lds, wv);
        conv_experts(P, lds, wv, 1, nret, G - nret);
    }
}
DEV void phase_combine(const Params& P, int wv) {
    const int tid = opaque_tid(wv), lane = tid & 63, wid = tid >> 6, G = gridDim.x;
    const float* q1 = (const float*)P.in[9]; const float* k1 = (const float*)P.in[10]; const float* q2 = (const float*)P.in[11]; const float* k2 = (const float*)P.in[12];
    const float* dg = (const float*)P.in[13];
    const float lam = __expf(wave_sum(q1[lane] * k1[lane])) - __expf(wave_sum(q2[lane] * k2[lane])) + 0.2f;
    unsigned char* ws = opaque_ws(P.ws); const bf16_t* OP = (const bf16_t*)(ws + WS_OPART); bf16_t* CAT = (bf16_t*)(ws + WS_CAT);
    const int h = lane >> 4, e0 = (lane & 15) * 8;
    float g[8];
#pragma unroll
    for (int j = 0; j < 8; ++j) g[j] = dg[e0 + j] * 0.8f;
    for (int row = blockIdx.x * NWAVES + wid; row < NTOK; row += G * NWAVES) {
        float a0[8], a1[8], d[8];
        unpack8(*(const bf16x8*)(OP + (size_t)row * 1024 + h * 256 + e0), a0); unpack8(*(const bf16x8*)(OP + (size_t)row * 1024 + h * 256 + 128 + e0), a1);
        float ss = 0.f;
#pragma unroll
        for (int j = 0; j < 8; ++j) { d[j] = a0[j] - lam * a1[j]; ss += d[j] * d[j]; }
        ss += __shfl_xor(ss, 1); ss += __shfl_xor(ss, 2); ss += __shfl_xor(ss, 4); ss += __shfl_xor(ss, 8);
        const float rstd = 1.0f / sqrtf(ss * (1.f / 128.f) + EPS);
        u32x4 w; w.x = pk2(d[0] * rstd * g[0], d[1] * rstd * g[1]); w.y = pk2(d[2] * rstd * g[2], d[3] * rstd * g[3]);
        w.z = pk2(d[4] * rstd * g[4], d[5] * rstd * g[5]); w.w = pk2(d[6] * rstd * g[6], d[7] * rstd * g[7]);
        *(u32x4*)(CAT + (size_t)row * 1024 + 512 + h * 128 + e0) = w;
    }
}


#ifdef DBG_PROBE_OFF
constexpr int CW_PROBE = 1024;
__global__ void __launch_bounds__(NTHREADS) mk_probe(Params P) {
    const int tid = opaque_tid(wv), G = gridDim.x;
    float s = 0.f;
    const unsigned char* base = P.ws + (size_t)DBG_PROBE_OFF;
    for (long i = (long)blockIdx.x * NTHREADS + tid; i < (long)NTOK * DBG_PROBE_NCOLS; i += (long)G * NTHREADS) {
        const long r = i / DBG_PROBE_NCOLS; const int c = (int)(i % DBG_PROBE_NCOLS) + DBG_PROBE_COL0;
        float v;
        if (DBG_PROBE_F32) v = ((const float*)base)[r * DBG_PROBE_PITCH + c]; else v = bf2f(((const bf16_t*)base)[r * DBG_PROBE_PITCH + c]);
        s += DBG_PROBE_ABS ? fabsf(v) : v * v;
    }
    s = wave_sum(s);
    if ((tid & 63) == 0) atomicAdd((float*)(P.ws + WS_CTL) + CW_PROBE, s);
}
#endif

#define XB_TMO      128
#define XB_XCNT(j)  (256  + 64 * (j))
#define XB_XSUB(j)  (1280 + 64 * (j))
#define XB_XGEN(j)  (2304 + 64 * (j))
#define XB_TOP      3328
#define XB_TOPGEN   3392
#define XCD_BAR_WORDS 3456
#define XB_SPIN_CAP (1u << 18)

__device__ __forceinline__ unsigned xb_ld(unsigned* p)              { return __hip_atomic_load(p, __ATOMIC_RELAXED, __HIP_MEMORY_SCOPE_AGENT); }
__device__ __forceinline__ unsigned xb_add(unsigned* p, unsigned v) { return __hip_atomic_fetch_add(p, v, __ATOMIC_RELAXED, __HIP_MEMORY_SCOPE_AGENT); }
__device__ __forceinline__ unsigned xb_xcc_id() { return (unsigned)__builtin_amdgcn_s_getreg((3 << 11) | 20) & 0xFu; }
#define XB_SPIN(cond, bar) do { unsigned _sp = 0; while (cond) { __builtin_amdgcn_s_sleep(1); \
    if ((++_sp & 255u) == 0u) { if (xb_ld(&(bar)[XB_TMO])) break; if (_sp > XB_SPIN_CAP) { atomicAdd(&(bar)[XB_TMO], 1u); break; } } } } while (0)

struct XcdBarrier {
    unsigned* bar; unsigned x;
    volatile LAS unsigned* st;
};

__device__ __forceinline__ XcdBarrier xcd_barrier_post(unsigned* bar, volatile LAS unsigned* st) {
    XcdBarrier b; b.bar = bar; b.x = xb_xcc_id(); b.st = st;
    if (threadIdx.x == 0) (void)xb_add(&bar[XB_XCNT(b.x)], 1u);
    return b;
}
__device__ __forceinline__ void xcd_barrier_complete(unsigned* bar, unsigned x, unsigned& nloc, unsigned& nx) {
    const unsigned G = gridDim.x * gridDim.y * gridDim.z;
    unsigned sum, cnt, mine, sp = 0u;
    for (;;) {
        sum = 0u; cnt = 0u; mine = 0u;
#pragma unroll
        for (unsigned j = 0; j < 16; ++j) { const unsigned c = xb_ld(&bar[XB_XCNT(j)]); sum += c; cnt += (c > 0u) ? 1u : 0u; mine = (j == x) ? c : mine; }
        if (sum == G) break;
        __builtin_amdgcn_s_sleep(1);
        if ((++sp & 255u) == 0u) { if (xb_ld(&bar[XB_TMO])) break; if (sp > XB_SPIN_CAP) { atomicAdd(&bar[XB_TMO], 1u); break; } }
    }
    nloc = mine > 0u ? mine : 1u; nx = cnt > 0u ? cnt : 1u;
}

__device__ __forceinline__ void xcd_barrier(const XcdBarrier& b) {
    asm volatile("s_waitcnt vmcnt(0)" ::: "memory");
    __syncthreads();
    if (threadIdx.x == 0) {
        unsigned* bar = b.bar;
        __builtin_amdgcn_s_waitcnt(0);
        unsigned nloc = b.st[0], nx = b.st[1];
        if (nloc == 0u) { xcd_barrier_complete(bar, b.x, nloc, nx); b.st[0] = nloc; b.st[1] = nx; }
        const unsigned old = xb_add(&bar[XB_XSUB(b.x)], 1u);
        const unsigned gen = old / nloc;
        if (old + 1u == (gen + 1u) * nloc) {
            __builtin_amdgcn_fence(__ATOMIC_RELEASE, "agent");
            asm volatile("s_waitcnt vmcnt(0)" ::: "memory");
            const unsigned og = xb_add(&bar[XB_TOP], 1u);
            const unsigned tg = og / nx;
            if (og + 1u == (tg + 1u) * nx) xb_add(&bar[XB_TOPGEN], 1u);
            else XB_SPIN(xb_ld(&bar[XB_TOPGEN]) == tg, bar);
            __builtin_amdgcn_fence(__ATOMIC_ACQUIRE, "agent");
            xb_add(&bar[XB_XGEN(b.x)], 1u);
            asm volatile("s_waitcnt vmcnt(0)" ::: "memory");
        } else {
            XB_SPIN(xb_ld(&bar[XB_XGEN(b.x)]) == gen, bar);
            __builtin_amdgcn_fence(__ATOMIC_ACQUIRE, "agent");
            asm volatile("s_waitcnt vmcnt(0)" ::: "memory");
        }
    }
    __syncthreads();
}
template <class Epi, class Sched>
DEV void gemm_run(LAS unsigned char* lds, const Sched& S, const Epi& E, int wv, unsigned char* dbg_ws = nullptr) {
#if FAST_GEMM
    pg8::gemm_phase(lds, S, E, wv, dbg_ws);
#else
    gemm_ref(S, E, wv);
#endif
}

constexpr int N_PHASES = 17;
template <int lo, int hi>
__global__ void __launch_bounds__(NTHREADS, 2) mk_fwd(Params P) {
    extern __shared__ __attribute__((aligned(16))) unsigned char lds_raw[];
    LAS unsigned char* lds = (LAS unsigned char*)lds_raw;
    const int G = gridDim.x, c = blockIdx.x;
    const int wv = __builtin_amdgcn_readfirstlane((int)(threadIdx.x >> 6));
#if ONE_LAUNCH
    { volatile LAS unsigned* stw = (volatile LAS unsigned*)(lds + LCTL_OFF + 8192); if (threadIdx.x < 4) stw[threadIdx.x] = 0u; }
    __syncthreads();
    const XcdBarrier xbar = xcd_barrier_post((unsigned*)(P.ws + WS_CTL) + CW_BAR, (volatile LAS unsigned*)(lds + LCTL_OFF + 8192));
#if USE_CG_SYNC
    cg::grid_group grid = cg::this_grid();
#define GRID_BAR() grid.sync()
#else
#define GRID_BAR() xcd_barrier(xbar)
#endif
#else
#define GRID_BAR() do {} while (0)
#endif
#define IN(k) (lo <= (k) && (k) < hi)
#ifdef DBG_TS
#define STAMP(k) do { if (blockIdx.x == 0 && threadIdx.x == 0) ((unsigned long long*)(P.ws + WS_CTL + 49152))[(k)] = __builtin_amdgcn_s_memrealtime(); } while (0)
#else
#define STAMP(k) do {} while (0)
#endif
#define SEAM(k) do { if constexpr (lo <= (k) + 1 && (k) + 1 < hi) GRID_BAR(); STAMP((k) + 1); } while (0)
#define PH_PTRS unsigned char* ws = opaque_ws(P.ws); const float* mod = (const float*)(ws + WS_MOD); bf16_t* H = (bf16_t*)(ws + WS_H); bf16_t* Z = (bf16_t*)(ws + WS_Z); bf16_t* CAT = (bf16_t*)(ws + WS_CAT); \
    void* X1 = (void*)(ws + WS_X1); void* X2 = (void*)(ws + WS_X2); const float* x = (const float*)P.in[0]; (void)mod; (void)H; (void)Z; (void)CAT; (void)X1; (void)X2; (void)x;

    STAMP(0);
    if constexpr (IN(0)) { PH_PTRS phase_prologue(P, lds, wv); conv_experts(P, lds, wv, 0, 0, G); SEAM(0); }
    if constexpr (IN(1)) { PH_PTRS phase_prenorm_gate(P, lds, wv); SEAM(1); }
    if constexpr (IN(2)) { PH_PTRS
#ifdef DBG_STAGGER2_US
        { const unsigned long long t0 = __builtin_amdgcn_s_memrealtime(); const unsigned long long dl = (unsigned long long)((blockIdx.x >> 3) & 3) * (DBG_STAGGER2_US * 25);
          while (__builtin_amdgcn_s_memrealtime() - t0 < dl) __builtin_amdgcn_s_sleep(8); }
#endif
        DenseSched S{H, (const bf16_t*)(ws + WS_WIN0), 1024, NTOK / 256, N_IN0 / 256, G, c};
        EpiIn E{Z, Z0P, (float*)(ws + WS_LA), (const float*)P.in[7], (const float*)(ws + WS_ROPE), 0};
        gemm_run(lds, S, E, wv, ws); SEAM(2);
    }
    if constexpr (IN(3)) { PH_PTRS phase_mix0(P, lds, (char*)lds_raw, wv); SEAM(3); }
    if constexpr (IN(4)) { PH_PTRS phase_combine(P, wv); SEAM(4); }
    if constexpr (IN(5)) { PH_PTRS
        DenseSched S{CAT, (const bf16_t*)(ws + WS_WOUT0), 1024, NTOK / 256, 4, G, c};
        EpiResid<false> E{x, X1, mod + 2 * 1024, (DBG_SKIP >> 0) & 1, DBG_F_MIX0};
        gemm_run(lds, S, E, wv, ws); SEAM(5);
    }
    if constexpr (IN(6)) { PH_PTRS phase_router(P, lds, wv, X1, 0); SEAM(6); }
    if constexpr (IN(7)) { PH_PTRS
        const int* cnt = (const int*)(ws + WS_CTL) + CW_CNT; const int* ent = (const int*)(ws + WS_ENT);
        MoeTiles mt = moe_build_tiles(cnt, lds, wv);
#ifdef DBG_STAGGER_US
        { const unsigned long long t0 = __builtin_amdgcn_s_memrealtime(); const unsigned long long dl = (unsigned long long)((blockIdx.x >> 3) & 3) * (DBG_STAGGER_US * 25);
          while (__builtin_amdgcn_s_memrealtime() - t0 < dl) __builtin_amdgcn_s_sleep(8); }
#endif
        MoeSched1 S{ws + WS_XQ, ws + WS_W1, mt, 1024, 8, G, c};
        EpiSwiglu E{(bf16_t*)(ws + WS_A), (const float*)P.in[24]};
        gemm_run(lds, S, E, wv, ws); SEAM(7);
    }
    if constexpr (IN(8)) { PH_PTRS
        const int* cnt = (const int*)(ws + WS_CTL) + CW_CNT; const int* ent = (const int*)(ws + WS_ENT);
        MoeTiles mt = moe_build_tiles(cnt, lds, wv);
        MoeSched2 S{ws + WS_A, ws + WS_W2, mt, 1024, 4, G, c};
        EpiMoeOut E{(bf16_t*)(ws + WS_YB), (const float*)P.in[26], cnt, ent, (const float*)(ws + WS_GL)};
        gemm_run(lds, S, E, wv, ws); SEAM(8);
    }
    if constexpr (IN(9)) { PH_PTRS phase_prenorm<3, RES_BF16>(P, lds, wv, X1, X2, 1, 0, 0); SEAM(9); }
    if constexpr (IN(10)) { PH_PTRS
        DenseSched S{H, (const bf16_t*)(ws + WS_WIN1), 1024, NTOK / 256, N_IN1 / 256, G, c};
        EpiIn E{Z, Z1P, nullptr, nullptr, (const float*)(ws + WS_ROPE), 1};
        gemm_run(lds, S, E, wv, ws); SEAM(10);
    }
    if constexpr (IN(11)) { PH_PTRS phase_mix1(P, lds, wv); SEAM(11); }
    if constexpr (IN(12)) { PH_PTRS
        DenseSched S{CAT, (const bf16_t*)(ws + WS_WOUT1), 1024, NTOK / 256, 4, G, c};
        EpiResid<RES_BF16> E{X2, X1, mod + 8 * 6144 + 2 * 1024, (DBG_SKIP >> 2) & 1, DBG_F_MIX1};
        gemm_run(lds, S, E, wv, ws); SEAM(12);
    }
    if constexpr (IN(13)) { PH_PTRS phase_router(P, lds, wv, X1, 1); SEAM(13); }
    if constexpr (IN(14)) { PH_PTRS
        const int* cnt = (const int*)(ws + WS_CTL) + CW_CNT + NEXP * CNT_STRIDE; const int* ent = (const int*)(ws + WS_ENT) + (size_t)NEXP * ENT_CAP;
        MoeTiles mt = moe_build_tiles(cnt, lds, wv);
        MoeSched1 S{ws + WS_XQ, ws + WS_W1 + (size_t)NEXP * 2048 * 1024, mt, 1024, 8, G, c};
        EpiSwiglu E{(bf16_t*)(ws + WS_A), (const float*)P.in[24] + (size_t)NEXP * 2048};
        gemm_run(lds, S, E, wv, ws); SEAM(14);
    }
    if constexpr (IN(15)) { PH_PTRS
        const int* cnt = (const int*)(ws + WS_CTL) + CW_CNT + NEXP * CNT_STRIDE; const int* ent = (const int*)(ws + WS_ENT) + (size_t)NEXP * ENT_CAP;
        MoeTiles mt = moe_build_tiles(cnt, lds, wv);
        MoeSched2 S{ws + WS_A, ws + WS_W2 + (size_t)NEXP * 1024 * 1024, mt, 1024, 4, G, c};
        EpiMoeOut E{(bf16_t*)(ws + WS_YB), (const float*)P.in[26] + (size_t)NEXP * 1024, cnt, ent, (const float*)(ws + WS_GL) + (size_t)NEXP * ENT_CAP};
        gemm_run(lds, S, E, wv, ws); SEAM(15);
    }
    if constexpr (IN(16)) { PH_PTRS phase_prenorm<9, RES_BF16>(P, lds, wv, X1, nullptr, 1, 0, 1); }
#undef IN
#undef SEAM
}

template <int PH> static void launch_phase(int grid, const Params& p, hipStream_t stream) {
    (void)hipFuncSetAttribute((const void*)mk_fwd<PH, PH + 1>, hipFuncAttributeMaxDynamicSharedMemorySize, LDS_BYTES);
    hipLaunchKernelGGL((mk_fwd<PH, PH + 1>), dim3(grid), dim3(NTHREADS), LDS_BYTES, stream, p);
}
#ifdef DBG_PHASES
template <int PH> static void launch_masked(int grid, const Params& p, hipStream_t stream) {
    if constexpr (PH < N_PHASES) { if constexpr ((DBG_PHASES >> PH) & 1) launch_phase<PH>(grid, p, stream); launch_masked<PH + 1>(grid, p, stream); }
}
#endif
template <int PH> static void launch_all(int grid, const Params& p, hipStream_t stream) {
    if constexpr (PH < N_PHASES) { launch_phase<PH>(grid, p, stream); launch_all<PH + 1>(grid, p, stream); }
}
extern "C" void kernel_launch(void* const* d_in, const int* in_sizes, int n_in, void* d_out, int out_size, void* d_ws, size_t ws_size, hipStream_t stream) {
    static int grid = 0;
    if (grid == 0) {
        if (n_in != 28 || out_size != NTOK * DM || ws_size < WS_END) { fprintf(stderr, "kernel_launch: unexpected shapes (n_in %d out %d ws %zu)\n", n_in, out_size, ws_size); grid = -1; return; }
        int dev = 0, cus = 0;
        (void)hipGetDevice(&dev); (void)hipDeviceGetAttribute(&cus, hipDeviceAttributeMultiprocessorCount, dev);
#if ONE_LAUNCH
        int per_cu = 0;
        if (hipFuncSetAttribute((const void*)mk_fwd<0, N_PHASES>, hipFuncAttributeMaxDynamicSharedMemorySize, LDS_BYTES) != hipSuccess) { fprintf(stderr, "kernel_launch: hipFuncSetAttribute failed\n"); grid = -1; return; }
        (void)hipOccupancyMaxActiveBlocksPerMultiprocessor(&per_cu, (const void*)mk_fwd<0, N_PHASES>, NTHREADS, LDS_BYTES);
        if (per_cu < 1) { fprintf(stderr, "kernel_launch: occupancy query reports %d blocks per CU\n", per_cu); grid = -1; return; }
#endif
        (void)hipGetLastError();
        grid = cus;
    }
    if (grid < 0) return;
    (void)hipMemsetAsync((char*)d_ws + WS_CTL, 0, CTL_ZERO_BYTES, stream);
    Params p{};
    for (int i = 0; i < 28; ++i) p.in[i] = d_in[i];
    p.out = (float*)d_out; p.ws = (unsigned char*)d_ws;
#if ONE_LAUNCH
    void* args[] = {&p};
    hipError_t e = hipLaunchCooperativeKernel((const void*)mk_fwd<0, N_PHASES>, dim3(grid), dim3(NTHREADS), args, LDS_BYTES, stream);
    if (e != hipSuccess) fprintf(stderr, "cooperative launch failed: %s (grid %d)\n", hipGetErrorString(e), grid);
#else
#ifdef DBG_PHASES
    launch_masked<0>(grid, p, stream);
#ifdef DBG_PROBE_OFF
    hipLaunchKernelGGL(mk_probe, dim3(grid), dim3(NTHREADS), 0, stream, p);
    launch_phase<16>(grid, p, stream);
#endif
#else
    launch_all<0>(grid, p, stream);
#endif
#endif
}
```

```cpp
#include <hip/hip_runtime.h>
#include <hip/hip_cooperative_groups.h>
#include <cstdio>
#include <cstdint>
namespace cg = cooperative_groups;

#ifndef ONE_LAUNCH
#define ONE_LAUNCH 1
#endif
#ifndef FAST_GEMM
#define FAST_GEMM 1
#endif
#ifndef USE_CG_SYNC
#define USE_CG_SYNC 0
#endif
#ifndef FAST_ATTN
#define FAST_ATTN 1
#endif
#ifndef MOE_FP8
#define MOE_FP8 1
#endif
#ifndef FAST_LIN
#define FAST_LIN 1
#endif
#ifndef FAST_SGU
#define FAST_SGU 1
#endif
#ifndef DBG_SKIP
#define DBG_SKIP 0
#endif
#ifndef DBG_FINAL_X
#define DBG_FINAL_X 0
#endif
#ifndef DBG_F_MIX0
#define DBG_F_MIX0 1.0f
#endif
#ifndef DBG_F_MOE0
#define DBG_F_MOE0 1.0f
#endif
#ifndef DBG_F_MIX1
#define DBG_F_MIX1 1.0f
#endif
#ifndef DBG_F_MOE1
#define DBG_F_MOE1 1.0f
#endif

#define DEV __device__ __forceinline__
#define LAS __attribute__((address_space(3)))
typedef unsigned short bf16_t;
typedef short bf16x8 __attribute__((ext_vector_type(8)));
typedef float f32x4 __attribute__((ext_vector_type(4)));
typedef float f32x2 __attribute__((ext_vector_type(2)));
typedef unsigned u32x4 __attribute__((ext_vector_type(4)));
typedef unsigned u32x2 __attribute__((ext_vector_type(2)));
typedef __bf16 bf16x2_t __attribute__((ext_vector_type(2)));
typedef int v8i __attribute__((ext_vector_type(8)));

constexpr int NB = 8, SEQ = 2048, DM = 1024, NTOK = NB * SEQ, NEXP = 32, TOPK = 4;
constexpr int Z0P = 3072, Z1P = 2560;
constexpr int N_IN0 = 3072, N_IN1 = 2560;
constexpr int ENT_CAP = NTOK;
constexpr float EPS = 1e-6f;
constexpr float C2 = 0.125f * 1.4426950408889634f;
constexpr int NTHREADS = 512, NWAVES = 8;
constexpr int CV_P10 = 2560;

constexpr size_t MiB = 1u << 20;
constexpr size_t WS_CTL = 0, CTL_ZERO_BYTES = 64 * 1024;
constexpr size_t WS_MOD = 1 * MiB;
constexpr size_t WS_ROPE = 2 * MiB;
constexpr size_t WS_ENT = 6 * MiB;
constexpr size_t WS_GATES = 10 * MiB;
constexpr size_t WS_SGUW = 11 * MiB;
constexpr size_t WS_WIN0 = 12 * MiB;
constexpr size_t WS_WOUT0 = 19 * MiB;
constexpr size_t WS_WIN1 = 21 * MiB;
constexpr size_t WS_WOUT1 = 26 * MiB;
constexpr size_t WS_W1 = 32 * MiB;
constexpr size_t WS_W2 = 288 * MiB;
constexpr size_t WS_H = 416 * MiB;
constexpr size_t WS_Z = 448 * MiB;
constexpr size_t WS_LA = 544 * MiB;
constexpr size_t WS_OPART = 560 * MiB;
constexpr size_t WS_CAT = 592 * MiB;
constexpr size_t WS_X1 = 624 * MiB;
constexpr size_t WS_X2 = 688 * MiB;
constexpr size_t WS_A = 752 * MiB;
constexpr size_t WS_YB = 896 * MiB;
constexpr size_t WS_GL = 1000 * MiB;
constexpr size_t WS_XQ = 1024 * MiB;
constexpr size_t WS_END = 1536 * MiB;
constexpr int CW_CNT = 8192, CNT_STRIDE = 64;
constexpr int CW_QUEUE = 256;
constexpr int CW_BAR = 4096;

constexpr int RING_BYTES = 131072;
constexpr int LCTL_OFF = 149504;
constexpr int LDS_BYTES = 163840;

DEV float bf2f(bf16_t v) { return __uint_as_float((unsigned)v << 16); }
DEV unsigned pk2(float lo, float hi) { f32x2 v = {lo, hi}; bf16x2_t b = __builtin_convertvector(v, bf16x2_t); return __builtin_bit_cast(unsigned, b); }
DEV bf16_t f2bf(float f) { return (bf16_t)(pk2(f, 0.f) & 0xffffu); }
DEV unsigned pk4_fp8(float a, float b, float c, float d) { unsigned w = __builtin_amdgcn_cvt_pk_fp8_f32(a, b, 0, false); return __builtin_amdgcn_cvt_pk_fp8_f32(c, d, w, true); }
constexpr float W8_SCALE = 64.f, W8_INV = 1.f / 64.f;
constexpr float YB_SCALE = 32.f, YB_INV = 1.f / 32.f;
DEV float wave_sum(float v) {
#pragma unroll
    for (int o = 1; o < 64; o <<= 1) v += __shfl_xor(v, o);
    return v;
}
DEV float silu_f(float x) { return x * __builtin_amdgcn_rcpf(1.f + __builtin_amdgcn_exp2f(-1.4426950408889634f * x)); }
DEV float log_sigmoid_f(float x) { return fminf(x, 0.f) - __logf(1.f + __expf(-fabsf(x))); }
DEV float gelu_f(float v) {
    const float av = fabsf(v), t = __builtin_amdgcn_rcpf(av * 0.2316418882f + 1.0f);
    float q = t * 0.5307027145f + (-0.7265760135f); q = q * t + 0.7107068705f; q = q * t + (-0.142248368f); q = q * t + 0.127414796f; q = q * t;
    const float e = __builtin_amdgcn_exp2f((v * v) * (-0.72134752044f));
    const float m = v * (q * e);
    return v < 0.f ? m : v - m;
}
DEV void unpack8(const bf16x8 v, float (&o)[8]) {
#pragma unroll
    for (int j = 0; j < 8; ++j) o[j] = bf2f((bf16_t)v[j]);
}

DEV unsigned char* opaque_ws(unsigned char* p) { size_t z = 0; asm volatile("" : "+s"(z)); return p + z; }
DEV int lane_id() { return (int)__builtin_amdgcn_mbcnt_hi(~0u, __builtin_amdgcn_mbcnt_lo(~0u, 0u)); }
DEV int opaque_tid(int wv) { int l; asm volatile("v_mbcnt_lo_u32_b32 %0, -1, 0\n\tv_mbcnt_hi_u32_b32 %0, -1, %0" : "=v"(l)); return (wv << 6) | l; }
#define LBAR() do { asm volatile("s_waitcnt lgkmcnt(0)" ::: "memory"); __builtin_amdgcn_s_barrier(); asm volatile("" ::: "memory"); } while (0)
#ifndef RES_BF16
#define RES_BF16 1
#endif
template <bool BF> DEV f32x4 ld_res4(const void* base, size_t elem) {
    if constexpr (BF) { const u32x2 w = *(const u32x2*)((const bf16_t*)base + elem); return (f32x4){__uint_as_float(w.x << 16), __uint_as_float(w.x & 0xffff0000u), __uint_as_float(w.y << 16), __uint_as_float(w.y & 0xffff0000u)}; }
    else return *(const f32x4*)((const float*)base + elem);
}
template <bool BF> DEV void st_res4(void* base, size_t elem, f32x4 v) {
    if constexpr (BF) { u32x2 w; w.x = pk2(v[0], v[1]); w.y = pk2(v[2], v[3]); *(u32x2*)((bf16_t*)base + elem) = w; }
    else *(f32x4*)((float*)base + elem) = v;
}
struct Params {
    const void* in[28];
    float* out;
    unsigned char* ws;
};

struct Unit { int pm, pn, e, tb, rows; };

DEV bool static_next(int i, int G, int c, int nM, int nN, int& pm, int& pn) {
    const int nwg = nM * nN; const long Lr = (long)i * G + c; if (Lr >= nwg) return false;
    int wgid = (int)Lr; { const int q = nwg / 8, r = nwg % 8, xcd = wgid % 8, off = wgid / 8; wgid = (xcd < r ? xcd * (q + 1) : r * (q + 1) + (xcd - r) * q) + off; }
    const int nig = 8 * nN, gid = wgid / nig, fm = gid * 8, gsz = (nM - fm) < 8 ? (nM - fm) : 8;
    pm = fm + ((wgid % nig) % gsz); pn = (wgid % nig) / gsz; return true;
}
struct DenseSched {
    static constexpr int EB = 2;
    const bf16_t* A; const bf16_t* Bt; int K, nM, nN, G, c;
    static constexpr bool RAGGED = false;
    DEV bool next(int i, Unit& u) const { u.e = 0; u.tb = 0; u.rows = 256; return static_next(i, G, c, nM, nN, u.pm, u.pn); }
    DEV const char* a_ptr(const Unit& u) const { return (const char*)(A + (size_t)u.pm * 256 * K); }
    DEV const char* b_ptr(const Unit& u) const { return (const char*)(Bt + (size_t)u.pn * 256 * K); }
};
struct MoeTiles { const LAS int* te; const LAS int* ttb; const LAS int* trows; int nt; };
struct MoeSched1 {
    static constexpr int EB = 1; static constexpr bool RAGGED = true;
    const unsigned char* A; const unsigned char* Bt; MoeTiles mt; int K, nN, G, c;
    DEV bool next(int i, Unit& u) const { int pm, pn; if (!static_next(i, G, c, mt.nt, nN, pm, pn)) return false; u.pm = pm; u.pn = pn; u.e = mt.te[pm]; u.tb = mt.ttb[pm]; u.rows = mt.trows[pm]; return true; }
    DEV const char* a_ptr(const Unit& u) const { return (const char*)A + ((size_t)u.e * ENT_CAP + (size_t)u.tb * 256) * K; }
    DEV const char* b_ptr(const Unit& u) const { return (const char*)Bt + ((size_t)u.e * 2048 + (size_t)u.pn * 256) * K; }
};
struct MoeSched2 {
    static constexpr int EB = 1; static constexpr bool RAGGED = true;
    const unsigned char* A; const unsigned char* Bt; MoeTiles mt; int K, nN, G, c;
    DEV bool next(int i, Unit& u) const { int pm, pn; if (!static_next(i, G, c, mt.nt, nN, pm, pn)) return false; u.pm = pm; u.pn = pn; u.e = mt.te[pm]; u.tb = mt.ttb[pm]; u.rows = mt.trows[pm]; return true; }
    DEV const char* a_ptr(const Unit& u) const { return (const char*)A + (size_t)u.pm * 256 * K; }
    DEV const char* b_ptr(const Unit& u) const { return (const char*)Bt + ((size_t)u.e * 1024 + (size_t)u.pn * 256) * K; }
};
DEV MoeTiles moe_build_tiles(const int* cnt, LAS unsigned char* lds, int wv) {
    LAS int* te = (LAS int*)(lds + LCTL_OFF); LAS int* ttb = te + 320; LAS int* trows = ttb + 320; LAS int* ntp = trows + 320;
    __syncthreads();
    const int tid = opaque_tid(wv);
    if (tid < 64) {
        const int e = tid & 31; const bool act = tid < 32;
        const int c = __hip_atomic_load(cnt + e * CNT_STRIDE, __ATOMIC_RELAXED, __HIP_MEMORY_SCOPE_AGENT);
        const int nfull = c >> 8, rem = c & 255;
        int incl = nfull;
#pragma unroll
        for (int o = 1; o < 32; o <<= 1) { const int t = __shfl_up(incl, o, 32); if ((tid & 31) >= o) incl += t; }
        const int base = incl - nfull, nfull_total = __shfl(incl, 31, 32);
        int rank = 0, npart = 0;
#pragma unroll
        for (int j = 0; j < 32; ++j) { const int rj = __shfl(rem, j, 32); npart += rj > 0; rank += (rj > rem) || (rj == rem && j < e); }
        if (act) {
            for (int t = 0; t < nfull; ++t) { te[base + t] = e; ttb[base + t] = t; trows[base + t] = 256; }
            if (rem > 0) { te[nfull_total + rank] = e; ttb[nfull_total + rank] = nfull; trows[nfull_total + rank] = rem; }
            if (tid == 0) *ntp = nfull_total + npart;
        }
    }
    __syncthreads();
    MoeTiles mt; mt.te = te; mt.ttb = ttb; mt.trows = trows; mt.nt = *ntp; return mt;
}

enum { EK_PLAIN = 0, EK_SILU = 1, EK_GELU = 2, EK_ROPE = 3, EK_LOGSIG = 4 };
struct EpiIn {
    static constexpr bool PERM = true;
    bf16_t* Z; int zp; float* LA; const float* bgate; const float* rope; int layer;
    DEV void kind_of(int pn, int& kind, float& sc) const {
        kind = EK_PLAIN; sc = 1.f;
        if (layer == 0) { if (pn == 0) sc = 0.125f; else if (pn == 4 || pn == 5) kind = EK_SILU; else if (pn == 6 || pn == 7) { kind = EK_ROPE; sc = C2; } else if (pn == 8 || pn == 9) kind = EK_ROPE; else if (pn == 12) kind = EK_LOGSIG; }
        else { if (pn < 4) kind = EK_GELU; else if (pn == 4) { kind = EK_ROPE; sc = 0.125f; } else if (pn == 5) kind = EK_ROPE; else if (pn >= 8) kind = EK_SILU; }
    }
    DEV void operator()(const f32x4 (&acc)[2][2][4][2], const Unit& u, int wr, int wc, int fr, int fq) const {
        int kind; float sc; kind_of(u.pn, kind, sc);
        if (kind == EK_ROPE) {
#pragma unroll
            for (int ai = 0; ai < 2; ++ai) {
                f32x4 tb[4][4];
#pragma unroll
                for (int m = 0; m < 4; ++m) { const float* rt = rope + (size_t)(u.pm * 256 + ai * 128 + wr * 64 + m * 16 + fr) * 64 + (8 * fq) * 2;
#pragma unroll
                    for (int q = 0; q < 4; ++q) tb[m][q] = *(const f32x4*)(rt + 4 * q); }
                asm volatile("" ::: "memory");
#pragma unroll
                for (int m = 0; m < 4; ++m) { const int row = u.pm * 256 + ai * 128 + wr * 64 + m * 16 + fr;
                    float y1[8], y2[8];
#pragma unroll
                    for (int n = 0; n < 2; ++n)
#pragma unroll
                        for (int i = 0; i < 4; ++i) { const int j = 4 * n + i; const float cs = tb[m][j >> 1][(j & 1) * 2], sn = tb[m][j >> 1][(j & 1) * 2 + 1];
                            const float x1 = acc[ai][0][m][n][i], x2 = acc[ai][1][m][n][i];
                            y1[j] = (x1 * cs - x2 * sn) * sc; y2[j] = (x2 * cs + x1 * sn) * sc; }
                    bf16_t* zp_ = Z + (size_t)row * zp + u.pn * 256 + 64 * wc + 8 * fq;
                    u32x4 w; w.x = pk2(y1[0], y1[1]); w.y = pk2(y1[2], y1[3]); w.z = pk2(y1[4], y1[5]); w.w = pk2(y1[6], y1[7]); *(u32x4*)(zp_) = w;
                    w.x = pk2(y2[0], y2[1]); w.y = pk2(y2[2], y2[3]); w.z = pk2(y2[4], y2[5]); w.w = pk2(y2[6], y2[7]); *(u32x4*)(zp_ + 32) = w; }
            }
            return;
        }
        if (kind == EK_LOGSIG) {
            f32x4 b0[2], b1[2];
#pragma unroll
            for (int bj = 0; bj < 2; ++bj) { const int col = 128 * bj + 32 * wc + 8 * fq; b0[bj] = *(const f32x4*)(bgate + col); b1[bj] = *(const f32x4*)(bgate + col + 4); }
#pragma unroll
            for (int ai = 0; ai < 2; ++ai)
#pragma unroll
                for (int m = 0; m < 4; ++m) { const int row = u.pm * 256 + ai * 128 + wr * 64 + m * 16 + fr;
#pragma unroll
                    for (int bj = 0; bj < 2; ++bj) { const int col = 128 * bj + 32 * wc + 8 * fq; float* lp = LA + (size_t)row * 256 + col; f32x4 o0, o1;
#pragma unroll
                        for (int i = 0; i < 4; ++i) { o0[i] = log_sigmoid_f(acc[ai][bj][m][0][i] + b0[bj][i]) * 0.0625f; o1[i] = log_sigmoid_f(acc[ai][bj][m][1][i] + b1[bj][i]) * 0.0625f; }
                        *(f32x4*)lp = o0; *(f32x4*)(lp + 4) = o1; } }
            return;
        }
#pragma unroll
        for (int ai = 0; ai < 2; ++ai)
#pragma unroll
            for (int m = 0; m < 4; ++m) { const int row = u.pm * 256 + ai * 128 + wr * 64 + m * 16 + fr;
#pragma unroll
                for (int bj = 0; bj < 2; ++bj) { float v[8];
#pragma unroll
                    for (int n = 0; n < 2; ++n)
#pragma unroll
                        for (int i = 0; i < 4; ++i) { float x = acc[ai][bj][m][n][i]; if (kind == EK_SILU) x = silu_f(x); else if (kind == EK_GELU) x = gelu_f(x); v[4 * n + i] = x * sc; }
                    u32x4 w; w.x = pk2(v[0], v[1]); w.y = pk2(v[2], v[3]); w.z = pk2(v[4], v[5]); w.w = pk2(v[6], v[7]);
                    *(u32x4*)(Z + (size_t)row * zp + u.pn * 256 + 128 * bj + 32 * wc + 8 * fq) = w; } }
    }
};
template <bool RIN_BF>
struct EpiResid {
    static constexpr bool PERM = true;
    const void* resid; void* out; const float* gate; int skip; float dbgf;
    DEV void operator()(const f32x4 (&acc)[2][2][4][2], const Unit& u, int wr, int wc, int fr, int fq) const {
        const int b = (u.pm * 256) >> 11;
        f32x4 g[2][2];
#pragma unroll
        for (int bj = 0; bj < 2; ++bj)
#pragma unroll
            for (int n = 0; n < 2; ++n) g[bj][n] = *(const f32x4*)(gate + (size_t)b * 6144 + u.pn * 256 + 128 * bj + 32 * wc + 8 * fq + 4 * n);
#pragma unroll
        for (int ai = 0; ai < 2; ++ai) {
            f32x4 r[4][2][2];
#pragma unroll
            for (int m = 0; m < 4; ++m) { const size_t row = (size_t)(u.pm * 256 + ai * 128 + wr * 64 + m * 16 + fr);
#pragma unroll
                for (int bj = 0; bj < 2; ++bj)
#pragma unroll
                    for (int n = 0; n < 2; ++n) r[m][bj][n] = ld_res4<RIN_BF>(resid, row * DM + u.pn * 256 + 128 * bj + 32 * wc + 8 * fq + 4 * n); }
            asm volatile("" ::: "memory");
#pragma unroll
            for (int m = 0; m < 4; ++m) { const size_t row = (size_t)(u.pm * 256 + ai * 128 + wr * 64 + m * 16 + fr);
#pragma unroll
                for (int bj = 0; bj < 2; ++bj) { const size_t e0 = row * DM + u.pn * 256 + 128 * bj + 32 * wc + 8 * fq;
                    const f32x4 o0 = skip ? r[m][bj][0] : r[m][bj][0] + g[bj][0] * acc[ai][bj][m][0] * dbgf, o1 = skip ? r[m][bj][1] : r[m][bj][1] + g[bj][1] * acc[ai][bj][m][1] * dbgf;
                    if constexpr (RES_BF16) { u32x4 w; w.x = pk2(o0[0], o0[1]); w.y = pk2(o0[2], o0[3]); w.z = pk2(o1[0], o1[1]); w.w = pk2(o1[2], o1[3]); *(u32x4*)((bf16_t*)out + e0) = w; }
                    else { *(f32x4*)((float*)out + e0) = o0; *(f32x4*)((float*)out + e0 + 4) = o1; } } }
        }
    }
};
struct EpiSwiglu {
    static constexpr bool PERM = true;
    static constexpr float ASC = MOE_FP8 ? W8_INV : 1.f;
    bf16_t* Aout; const float* bin;
    DEV void operator()(const f32x4 (&acc)[2][2][4][2], const Unit& u, int wr, int wc, int fr, int fq) const {
#ifdef DBG_NOEPI
        float sacc = 0.f;
#pragma unroll
        for (int a_ = 0; a_ < 2; ++a_) for (int b_ = 0; b_ < 2; ++b_) for (int m_ = 0; m_ < 4; ++m_) for (int n_ = 0; n_ < 2; ++n_) sacc += acc[a_][b_][m_][n_][0] + acc[a_][b_][m_][n_][1] + acc[a_][b_][m_][n_][2] + acc[a_][b_][m_][n_][3];
        if (sacc == 12345.678f) ((unsigned char*)Aout)[0] = 1;
        return;
#endif
        const int lc = 128 * u.pn + 32 * wc + 8 * fq; const float* bp = bin + (size_t)u.e * 2048 + lc;
        const f32x4 bg0 = *(const f32x4*)bp, bg1 = *(const f32x4*)(bp + 4), bl0 = *(const f32x4*)(bp + 1024), bl1 = *(const f32x4*)(bp + 1028);
#pragma unroll
        for (int ai = 0; ai < 2; ++ai)
#pragma unroll
            for (int m = 0; m < 4; ++m) { const size_t row = (size_t)(u.pm * 256 + ai * 128 + wr * 64 + m * 16 + fr); float v[8];
#pragma unroll
                for (int n = 0; n < 2; ++n)
#pragma unroll
                    for (int i = 0; i < 4; ++i) { const float g = fminf(acc[ai][0][m][n][i] * ASC + (n ? bg1[i] : bg0[i]), 7.f);
                        const float l = fminf(fmaxf(acc[ai][1][m][n][i] * ASC + (n ? bl1[i] : bl0[i]), -7.f), 7.f);
                        v[4 * n + i] = g * __builtin_amdgcn_rcpf(1.f + __builtin_amdgcn_exp2f((-1.702f * 1.4426950408889634f) * g)) * (l + 1.f); }
#if MOE_FP8
                u32x2 w; w.x = pk4_fp8(v[0], v[1], v[2], v[3]); w.y = pk4_fp8(v[4], v[5], v[6], v[7]);
                *(u32x2*)((unsigned char*)Aout + row * 1024 + lc) = w; }
#else
                u32x4 w; w.x = pk2(v[0], v[1]); w.y = pk2(v[2], v[3]); w.z = pk2(v[4], v[5]); w.w = pk2(v[6], v[7]);
                *(u32x4*)(Aout + row * 1024 + lc) = w; }
#endif
    }
};
struct EpiMoeOut {
    static constexpr bool PERM = true;
    bf16_t* YB; const float* bout; const int* cnt; const int* ent; const float* gates;
    DEV void operator()(const f32x4 (&acc)[2][2][4][2], const Unit& u, int wr, int wc, int fr, int fq) const {
        const int n_e = cnt[u.e * CNT_STRIDE];
        int dst[2][4]; float gt[2][4];
#pragma unroll
        for (int ai = 0; ai < 2; ++ai)
#pragma unroll
            for (int m = 0; m < 4; ++m) { const int pos = u.tb * 256 + ai * 128 + wr * 64 + m * 16 + fr; const bool ok = pos < n_e;
                dst[ai][m] = ok ? ent[u.e * ENT_CAP + pos] : -1; gt[ai][m] = ok ? gates[u.e * ENT_CAP + pos] : 0.f; }
        f32x4 bv[2][2];
#pragma unroll
        for (int bj = 0; bj < 2; ++bj)
#pragma unroll
            for (int n = 0; n < 2; ++n) bv[bj][n] = *(const f32x4*)(bout + (size_t)u.e * 1024 + u.pn * 256 + 128 * bj + 32 * wc + 8 * fq + 4 * n);
        asm volatile("" ::: "memory");
#pragma unroll
        for (int ai = 0; ai < 2; ++ai)
#pragma unroll
            for (int m = 0; m < 4; ++m) {
                if (dst[ai][m] >= 0) { const float g = gt[ai][m];
#pragma unroll
                    for (int bj = 0; bj < 2; ++bj) { f32x4 v0 = (acc[ai][bj][m][0] * W8_INV + bv[bj][0]) * (g * YB_SCALE), v1 = (acc[ai][bj][m][1] * W8_INV + bv[bj][1]) * (g * YB_SCALE);
#pragma unroll
                        for (int t = 0; t < 4; ++t) { v0[t] = fminf(fmaxf(v0[t], -440.f), 440.f); v1[t] = fminf(fmaxf(v1[t], -440.f), 440.f); }
                        u32x2 w; w.x = pk4_fp8(v0[0], v0[1], v0[2], v0[3]); w.y = pk4_fp8(v1[0], v1[1], v1[2], v1[3]);
                        *(u32x2*)((unsigned char*)YB + (size_t)dst[ai][m] * 1024 + u.pn * 256 + 128 * bj + 32 * wc + 8 * fq) = w; } } }
    }
};

template <class Epi, class Sched>
DEV void gemm_ref(const Sched& S, const Epi& E, int wv) {
    const int tid = opaque_tid(wv), wid = tid >> 6, lane = tid & 63, wr = wid >> 2, wc = wid & 3, fr = lane & 15, fq = lane >> 4;
    Unit u;
    for (int it = 0; S.next(it, u); ++it) {
        f32x4 acc[2][2][4][2];
#pragma unroll
        for (int a = 0; a < 2; ++a)
#pragma unroll
            for (int b = 0; b < 2; ++b)
#pragma unroll
                for (int m = 0; m < 4; ++m)
#pragma unroll
                    for (int n = 0; n < 2; ++n) acc[a][b][m][n] = (f32x4){0.f, 0.f, 0.f, 0.f};
        unsigned aoff[2][4];
        const int K = S.K;
#pragma unroll
        for (int ai = 0; ai < 2; ++ai)
#pragma unroll
            for (int m = 0; m < 4; ++m) aoff[ai][m] = (unsigned)(ai * 128 + wr * 64 + m * 16 + fr) * (unsigned)K;
        const bf16_t* Bt = (const bf16_t*)S.b_ptr(u); const bf16_t* Ab = (const bf16_t*)S.a_ptr(u);
        for (int k0 = 0; k0 < K; k0 += 8) {
            u32x4 araw[2][4];
#pragma unroll
            for (int ai = 0; ai < 2; ++ai)
#pragma unroll
                for (int m = 0; m < 4; ++m) araw[ai][m] = *(const u32x4*)(Ab + aoff[ai][m] + k0);
            asm volatile("" ::: "memory");
#pragma unroll
            for (int bj = 0; bj < 2; ++bj)
#pragma unroll
                for (int n = 0; n < 2; ++n) {
                    u32x4 braw[4];
#pragma unroll
                    for (int i = 0; i < 4; ++i) { const int c = 128 * bj + 32 * wc + (Epi::PERM ? 8 * fq + 4 * n + i : 16 * n + 4 * fq + i); braw[i] = *(const u32x4*)(Bt + (size_t)c * K + k0); }
                    asm volatile("" ::: "memory");
#pragma unroll
                    for (int i = 0; i < 4; ++i)
#pragma unroll
                        for (int ai = 0; ai < 2; ++ai)
#pragma unroll
                            for (int m = 0; m < 4; ++m) { float s = acc[ai][bj][m][n][i];
#pragma unroll
                                for (int j = 0; j < 4; ++j) { const unsigned au = araw[ai][m][j], bu = braw[i][j];
                                    s = __builtin_amdgcn_fdot2_f32_bf16(__builtin_bit_cast(bf16x2_t, au), __builtin_bit_cast(bf16x2_t, bu), s, false); }
                                acc[ai][bj][m][n][i] = s; }
                }
        }
        E(acc, u, wr, wc, fr, fq);
    }
}


namespace pg8 {
constexpr int BM = 256, BK = 64, HALF = 128, HTB = HALF * BK * 2, STAGE_BYTES = 8 * HTB;
DEV int lds_byte(int r, int c) { const int st = (r >> 4) * 2 + (c >> 5), rr = r & 15, cc = c & 31, ob = rr * 64 + cc * 2; return st * 1024 + (ob ^ (((ob >> 9) & 1) << 5)); }
DEV void stage_rc(int b, int& R, int& C) { const int st = b / 1024, sb = b % 1024, swz = sb ^ (((sb >> 9) & 1) << 5); R = (st >> 1) * 16 + swz / 64; C = (st & 1) * 32 + (swz % 64) / 2; }
DEV int perm32(int rho) { const int n = rho >> 4, i = rho & 15; return 8 * (i >> 2) + 4 * n + (i & 3); }

typedef int v4i __attribute__((ext_vector_type(4)));
template <bool F8> struct Frag;
template <> struct Frag<false> { bf16x8 v; };
template <> struct Frag<true> { v8i v; };
DEV f32x4 frag_mfma(const Frag<false>& a, const Frag<false>& b, f32x4 c) { return __builtin_amdgcn_mfma_f32_16x16x32_bf16(a.v, b.v, c, 0, 0, 0); }
DEV f32x4 frag_mfma(const Frag<true>& a, const Frag<true>& b, f32x4 c) {
    asm volatile("v_mfma_f32_16x16x128_f8f6f4 %0, %1, %2, %0" : "+v"(c) : "v"(a.v), "v"(b.v)); return c; }
DEV void frag_load(Frag<false>& f, const LAS unsigned char* p0, const LAS unsigned char*) { f.v = *(const LAS bf16x8*)p0; }
typedef short s16x16_a16 __attribute__((ext_vector_type(16), aligned(16)));
typedef short s16x16 __attribute__((ext_vector_type(16)));
DEV void frag_load(Frag<true>& f, const LAS unsigned char* p0, const LAS unsigned char*) { const bf16x8 lo = *(const LAS bf16x8*)p0, hi = *(const LAS bf16x8*)(p0 + 16);
    const s16x16 t = __builtin_shufflevector(lo, hi, 0, 1, 2, 3, 4, 5, 6, 7, 8, 9, 10, 11, 12, 13, 14, 15); f.v = __builtin_bit_cast(v8i, t); }
template <class Epi, class Sched>
DEV void gemm_phase(LAS unsigned char* lds, const Sched& S, const Epi& E, int wv, unsigned char* dbg_ws = nullptr) {
    const int tid = opaque_tid(wv);
    const int wid = __builtin_amdgcn_readfirstlane(tid >> 6), lane = tid & 63, wr = wid >> 2, wc = wid & 3, fr = lane & 15, fq = lane >> 4;
    constexpr int EB = Sched::EB; constexpr bool F8 = (EB == 1); constexpr int KF = F8 ? 1 : 2;
    const int KB = S.K * EB, nt = KB / (BK * 2);
    unsigned voffA[2], voffB[2];
#pragma unroll
    for (int i = 0; i < 2; ++i) { int R, C; stage_rc(tid * 16 + i * 8192, R, C); const int Rb = Epi::PERM ? ((R & ~31) + perm32(R & 31)) : R;
        voffA[i] = (unsigned)(R * KB) + (unsigned)C * 2u; voffB[i] = (unsigned)(Rb * KB) + (unsigned)C * 2u; }
    const size_t kstep = (size_t)(BK * 2);
    const size_t hstep = (size_t)HALF * KB;
    const unsigned ldsw = (unsigned)wid * 1024u;
    const int aoff = F8 ? lds_byte(wr * 64 + fr, fq * 16) : lds_byte(wr * 64 + fr, fq * 8), boff = F8 ? lds_byte(wc * 32 + fr, fq * 16) : lds_byte(wc * 32 + fr, fq * 8);
    const int aoff1 = lds_byte(wr * 64 + fr, fq * 16 + 8), boff1 = lds_byte(wc * 32 + fr, fq * 16 + 8);
#define PG8_SA(b, h) (((b) * 2 + (h)) * HTB)
#define PG8_SB(b, h) ((4 + (b) * 2 + (h)) * HTB)
#define PG8_STAGE(bufoff, gbase, voff) do { _Pragma("unroll") for (int _i = 0; _i < 2; ++_i) \
        __builtin_amdgcn_global_load_lds((const unsigned*)((const char*)(gbase) + (voff)[_i]), (LAS unsigned*)(lds + (bufoff) + ldsw + _i * 8192), 16, 0, 0); } while (0)
#define PG8_LDA(dst, b, h) do { _Pragma("unroll") for (int m = 0; m < 4; ++m) _Pragma("unroll") for (int k = 0; k < KF; ++k) frag_load(dst[m][k], lds + PG8_SA(b, h) + aoff + m * 2048 + k * 1024, lds + PG8_SA(b, h) + aoff1 + m * 2048); } while (0)
#define PG8_LDB(dst, b, h) do { _Pragma("unroll") for (int n = 0; n < 2; ++n) _Pragma("unroll") for (int k = 0; k < KF; ++k) frag_load(dst[n][k], lds + PG8_SB(b, h) + boff + n * 2048 + k * 1024, lds + PG8_SB(b, h) + boff1 + n * 2048); } while (0)
#define PG8_MMA(ai, bj, At, Bt) do { if (!Sched::RAGGED || (ai) * 128 + wr * 64 < nrows) { __builtin_amdgcn_s_setprio(1); _Pragma("unroll") for (int m = 0; m < 4; ++m) _Pragma("unroll") for (int n = 0; n < 2; ++n) _Pragma("unroll") for (int k = 0; k < KF; ++k) \
        acc[ai][bj][m][n] = frag_mfma(Bt[n][k], At[m][k], acc[ai][bj][m][n]); __builtin_amdgcn_s_setprio(0); } } while (0)
#define PG8_WAIT_V(n) asm volatile("s_waitcnt vmcnt(" #n ")" ::: "memory")
#define PG8_WAIT_L(n) asm volatile("s_waitcnt lgkmcnt(" #n ")" ::: "memory")
#define PG8_BAR __builtin_amdgcn_s_barrier()
#define PG8_SCHED __builtin_amdgcn_sched_barrier(0)
    Unit cur, nxt; int ui = 0;
    if (!S.next(0, cur)) return;
    f32x4 acc[2][2][4][2];
#pragma unroll
    for (int a = 0; a < 2; ++a)
#pragma unroll
        for (int b = 0; b < 2; ++b)
#pragma unroll
            for (int m = 0; m < 4; ++m)
#pragma unroll
                for (int n = 0; n < 2; ++n) acc[a][b][m][n] = (f32x4){0.f, 0.f, 0.f, 0.f};
    Frag<F8> At[4][KF], B0[2][KF], B1[2][KF];
    const char* cA = S.a_ptr(cur); const char* cB = S.b_ptr(cur);
    int nrows = cur.rows;
    PG8_STAGE(PG8_SB(0, 0), cB, voffB); PG8_STAGE(PG8_SB(0, 1), cB + hstep, voffB); PG8_STAGE(PG8_SA(0, 0), cA, voffA); PG8_STAGE(PG8_SA(0, 1), cA + hstep, voffA);
    if (wr == 1) PG8_BAR;
    PG8_WAIT_V(2); PG8_BAR;
    PG8_STAGE(PG8_SB(1, 0), cB + kstep, voffB); PG8_STAGE(PG8_SA(1, 0), cA + kstep, voffA); PG8_STAGE(PG8_SB(1, 1), cB + hstep + kstep, voffB);
    PG8_WAIT_V(6); PG8_BAR;
#ifdef DBG_GT_NN
    unsigned long long gt_k = 0, gt_e = 0, gt_t = 0; const bool gt_on = (S.nN == DBG_GT_NN) && blockIdx.x == 0 && tid == 0; const unsigned long long gt_begin = __builtin_amdgcn_s_memrealtime();
#endif
    for (;;) {
#ifdef DBG_GT_NN
        const unsigned long long gt0 = __builtin_amdgcn_s_memrealtime();
#endif
        const bool has_next = S.next(ui + 1, nxt);
        const char* nA = has_next ? S.a_ptr(nxt) : cA; const char* nB = has_next ? S.b_ptr(nxt) : cB;
        for (int t = 0; t < nt; t += 2) {
            const bool last = (t == nt - 2);
            const char* a1 = cA + (size_t)(t + 1) * kstep;
            const char* a2 = last ? nA : cA + (size_t)(t + 2) * kstep; const char* b2 = last ? nB : cB + (size_t)(t + 2) * kstep;
            const char* a3 = a2 + kstep; const char* b3 = b2 + kstep;
            PG8_LDB(B0, 0, 0); PG8_LDB(B1, 0, 1); PG8_SCHED; PG8_LDA(At, 0, 0); PG8_STAGE(PG8_SA(1, 1), a1 + hstep, voffA);
            PG8_WAIT_V(8); PG8_WAIT_L(0); PG8_BAR; PG8_MMA(0, 0, At, B0); PG8_MMA(0, 1, At, B1); PG8_BAR; PG8_SCHED;
            PG8_LDA(At, 0, 1); PG8_STAGE(PG8_SB(0, 0), b2, voffB); PG8_STAGE(PG8_SB(0, 1), b2 + hstep, voffB); PG8_STAGE(PG8_SA(0, 0), a2, voffA);
            PG8_WAIT_V(8); PG8_WAIT_L(0); PG8_BAR; PG8_MMA(1, 0, At, B0); PG8_MMA(1, 1, At, B1); PG8_BAR; PG8_SCHED;
            PG8_LDB(B0, 1, 0); PG8_LDB(B1, 1, 1); PG8_SCHED; PG8_LDA(At, 1, 0); PG8_STAGE(PG8_SA(0, 1), a2 + hstep, voffA);
            PG8_WAIT_V(8); PG8_WAIT_L(0); PG8_BAR; PG8_MMA(0, 0, At, B0); PG8_MMA(0, 1, At, B1); PG8_BAR; PG8_SCHED;
            PG8_LDA(At, 1, 1); PG8_STAGE(PG8_SB(1, 0), b3, voffB); PG8_STAGE(PG8_SB(1, 1), b3 + hstep, voffB); PG8_STAGE(PG8_SA(1, 0), a3, voffA);
            PG8_WAIT_V(8); PG8_WAIT_L(0); PG8_BAR; PG8_MMA(1, 0, At, B0); PG8_MMA(1, 1, At, B1); PG8_BAR; PG8_SCHED;
        }
#ifdef DBG_GT_NN
        const unsigned long long gt1 = __builtin_amdgcn_s_memrealtime();
#endif
        if (wr == 0) PG8_BAR;
        if constexpr (F8) asm volatile("s_nop 15\n\ts_nop 15" ::: "memory");
        E(acc, cur, wr, wc, fr, fq);
#ifdef DBG_EPI2
        asm volatile("" ::: "memory"); E(acc, cur, wr, wc, fr, fq);
#endif
#ifdef DBG_GT_NN
        { const unsigned long long gt2 = __builtin_amdgcn_s_memrealtime(); gt_k += gt1 - gt0; gt_e += gt2 - gt1; gt_t = gt2 - gt_begin;
          if (gt_on) { unsigned long long* tsp = (unsigned long long*)(dbg_ws + WS_CTL + 49152); tsp[40] = 0; tsp[41] = gt_k; tsp[42] = gt_k + gt_e; tsp[43] = gt_t; tsp[44] = (unsigned long long)(ui + 1) * 1000; if (ui == 0) { tsp[45] = 0; tsp[46] = gt1 - gt0; } } }
#endif
        if (!has_next) break;
#pragma unroll
        for (int a = 0; a < 2; ++a)
#pragma unroll
            for (int b = 0; b < 2; ++b)
#pragma unroll
                for (int m = 0; m < 4; ++m)
#pragma unroll
                    for (int n = 0; n < 2; ++n) acc[a][b][m][n] = (f32x4){0.f, 0.f, 0.f, 0.f};
        cur = nxt; cA = nA; cB = nB; nrows = cur.rows; ++ui;
        if (wr == 1) PG8_BAR;
    }
    PG8_WAIT_V(0);
    PG8_BAR;
#undef PG8_SA
#undef PG8_SB
#undef PG8_STAGE
#undef PG8_LDA
#undef PG8_LDB
#undef PG8_MMA
#undef PG8_WAIT_V
#undef PG8_WAIT_L
#undef PG8_BAR
#undef PG8_SCHED
}
}

__host__ __device__ inline int ropeoff(int q) { return 64 * (q & 3) + 32 * (q >> 2); }
__host__ __device__ inline int in0_logcol(int g32) {
    const int tile = g32 >> 3, q = g32 & 7;
    switch (tile) {
        case 0: return 0 + q * 32; case 1: return 256 + q * 32;
        case 2: case 3: return 512 + (tile - 2) * 256 + q * 32;
        case 4: case 5: return 1040 + (tile - 4) * 256 + q * 32;
        case 6: case 7: return 1552 + (tile - 6) * 256 + ropeoff(q);
        case 8: case 9: return 2064 + (tile - 8) * 256 + ropeoff(q);
        default: return 2576 + (tile - 10) * 256 + q * 32;
    }
}
__host__ __device__ inline int in1_logcol(int g32) {
    const int tile = g32 >> 3, q = g32 & 7;
    if (tile < 4) return tile * 256 + q * 32;
    if (tile == 4) return 1024 + ropeoff(q);
    if (tile == 5) return 1280 + ropeoff(q);
    return 1536 + (tile - 6) * 256 + q * 32;
}
DEV void conv_item(const float* W, int ldw, int logcol0, int k0, bf16_t* Wt_row0, int Kd, LAS float* scr, int lane) {
#pragma unroll 8
    for (int i = 0; i < 32; ++i) { const int kk = 2 * i + (lane >> 5); scr[kk * 33 + (lane & 31)] = W[(size_t)(k0 + kk) * ldw + logcol0 + (lane & 31)]; }
    asm volatile("s_waitcnt lgkmcnt(0)" ::: "memory");
    const int c = lane & 7;
#pragma unroll
    for (int j = 0; j < 4; ++j) { const int n = (lane >> 3) + 8 * j; const LAS float* s = scr + (8 * c) * 33 + n;
        u32x4 o; o.x = pk2(s[0 * 33], s[1 * 33]); o.y = pk2(s[2 * 33], s[3 * 33]); o.z = pk2(s[4 * 33], s[5 * 33]); o.w = pk2(s[6 * 33], s[7 * 33]);
        *(u32x4*)(Wt_row0 + (size_t)n * Kd + k0 + 8 * c) = o; }
    asm volatile("s_waitcnt lgkmcnt(0)" ::: "memory");
}
DEV void sincos_d(double x, float& s, float& c) {
    const double k = __builtin_rint(x * 0.63661977236758134308);
    const double r = (x - k * 1.5707963267948966192) - k * 6.123233995736766e-17;
    const double r2 = r * r;
    double sp = -7.647163731819816e-13; sp = sp * r2 + 1.605904383682161e-10; sp = sp * r2 - 2.505210838544172e-08; sp = sp * r2 + 2.755731922398589e-06;
    sp = sp * r2 - 1.984126984126984e-04; sp = sp * r2 + 8.333333333333333e-03; sp = sp * r2 - 1.666666666666667e-01; sp = r + r * r2 * sp;
    double cp = 4.779477332387385e-14; cp = cp * r2 - 1.147074559772972e-11; cp = cp * r2 + 2.087675698786810e-09; cp = cp * r2 - 2.755731922398589e-07;
    cp = cp * r2 + 2.480158730158730e-05; cp = cp * r2 - 1.388888888888889e-03; cp = cp * r2 + 4.166666666666666e-02; cp = cp * r2 - 0.5; cp = 1.0 + r2 * cp;
    const int q = ((int)k) & 3;
    const double ss = (q == 0) ? sp : (q == 1) ? cp : (q == 2) ? -sp : -cp;
    const double cc = (q == 0) ? cp : (q == 1) ? -sp : (q == 2) ? -cp : sp;
    s = (float)ss; c = (float)cc;
}
DEV void conv_item_f8(const float* W, int ldw, int logcol0, int k0, unsigned char* Wt_row0, int Kd, LAS float* scr, int lane, float scale) {
#pragma unroll 8
    for (int i = 0; i < 32; ++i) { const int kk = 2 * i + (lane >> 5); scr[kk * 33 + (lane & 31)] = W[(size_t)(k0 + kk) * ldw + logcol0 + (lane & 31)]; }
    asm volatile("s_waitcnt lgkmcnt(0)" ::: "memory");
    const int c = lane & 7;
#pragma unroll
    for (int j = 0; j < 4; ++j) { const int n = (lane >> 3) + 8 * j; const LAS float* sp = scr + (8 * c) * 33 + n;
        u32x2 o; o.x = pk4_fp8(sp[0 * 33] * scale, sp[1 * 33] * scale, sp[2 * 33] * scale, sp[3 * 33] * scale); o.y = pk4_fp8(sp[4 * 33] * scale, sp[5 * 33] * scale, sp[6 * 33] * scale, sp[7 * 33] * scale);
        *(u32x2*)(Wt_row0 + (size_t)n * Kd + k0 + 8 * c) = o; }
    asm volatile("s_waitcnt lgkmcnt(0)" ::: "memory");
}
DEV void conv_item64_f8(const float* W, int ldw, int logcol0, int k0, unsigned char* Wt_row0, int Kd, LAS float* scr, int lane, float scale) {
#pragma unroll 8
    for (int i = 0; i < 16; ++i) { const int kk = 4 * i + (lane >> 4), c4 = (lane & 15) * 4;
        const f32x4 v = __builtin_nontemporal_load((const f32x4*)(W + (size_t)(k0 + kk) * ldw + logcol0 + c4));
        LAS float* d = scr + kk * 65 + c4; d[0] = v[0]; d[1] = v[1]; d[2] = v[2]; d[3] = v[3]; }
    asm volatile("s_waitcnt lgkmcnt(0)" ::: "memory");
    const int c = lane & 7;
#pragma unroll
    for (int j = 0; j < 8; ++j) { const int n = (lane >> 3) + 8 * j; const LAS float* sp = scr + (8 * c) * 65 + n;
        u32x2 o; o.x = pk4_fp8(sp[0 * 65] * scale, sp[1 * 65] * scale, sp[2 * 65] * scale, sp[3 * 65] * scale); o.y = pk4_fp8(sp[4 * 65] * scale, sp[5 * 65] * scale, sp[6 * 65] * scale, sp[7 * 65] * scale);
        *(u32x2*)(Wt_row0 + (size_t)n * Kd + k0 + 8 * c) = o; }
    asm volatile("s_waitcnt lgkmcnt(0)" ::: "memory");
}
DEV void conv_experts(const Params& P, LAS unsigned char* lds, int wv, int layer, int blk0, int nblk, int it_lo = 0, int it_hi = 32 * 16 * 32 + 32 * 16 * 16) {
    const int tid = opaque_tid(wv), lane = tid & 63;
    unsigned char* ws = opaque_ws(P.ws);
    const int gw = ((int)blockIdx.x - blk0) * NWAVES + wv, NGW = nblk * NWAVES;
    constexpr int I_W1 = 32 * 16 * 32, I_W2 = 32 * 16 * 16;
    const int kg = lane >> 4, ng = lane & 15;
    for (int it0 = it_lo + gw; it0 < it_hi; it0 += NGW) {
        const float* src; int ldw; unsigned char* dst;
        if (it0 < I_W1) { const int it = it0 + layer * I_W1, le = it / 512, q = it % 512, kb = q / 32, g = q % 32, pn = g >> 2, qq = g & 3;
            const int logcol = (qq >> 1) * 1024 + 128 * pn + 64 * (qq & 1);
            src = (const float*)P.in[23] + (size_t)le * 1024 * 2048 + (size_t)(kb * 64) * 2048 + logcol; ldw = 2048; dst = ws + WS_W1 + ((size_t)le * 2048 + g * 64) * 1024 + kb * 64;
        } else { const int r = it0 - I_W1 + layer * I_W2, le = r / 256, q = r % 256, kb = q / 16, g = q % 16;
            src = (const float*)P.in[25] + (size_t)le * 1024 * 1024 + (size_t)(kb * 64) * 1024 + g * 64; ldw = 1024; dst = ws + WS_W2 + ((size_t)le * 1024 + g * 64) * 1024 + kb * 64; }
        f32x4 v[16];
#pragma unroll
        for (int i = 0; i < 16; ++i) v[i] = __builtin_nontemporal_load((const f32x4*)(src + (size_t)(16 * kg + i) * ldw + 4 * ng));
#pragma unroll
        for (int jj = 0; jj < 4; ++jj) { u32x4 o;
#pragma unroll
            for (int q = 0; q < 4; ++q) o[q] = pk4_fp8(v[4 * q][jj] * W8_SCALE, v[4 * q + 1][jj] * W8_SCALE, v[4 * q + 2][jj] * W8_SCALE, v[4 * q + 3][jj] * W8_SCALE);
            *(u32x4*)(dst + (size_t)(4 * ng + jj) * 1024 + 16 * kg) = o; }
    }
}
DEV void phase_prologue(const Params& P, LAS unsigned char* lds, int wv) {
    const int tid = opaque_tid(wv), lane = tid & 63, wid = tid >> 6, G = gridDim.x;
    unsigned char* ws = opaque_ws(P.ws);
    {
        LAS float* cact = (LAS float*)lds; LAS float* red = cact + 8192;
        const float* cin = (const float*)P.in[1]; const float* wada = (const float*)P.in[3]; const float* bada = (const float*)P.in[4];
        float* mod = (float*)(ws + WS_MOD);
        for (int unit = blockIdx.x; unit < 192; unit += G) {
            const int layer = unit / 96, col0 = (unit % 96) * 64;
            __syncthreads();
            for (int i = tid; i < 8192; i += NTHREADS) { const float c = cin[i]; cact[i] = c / (1.f + expf(-c)); }
            __syncthreads();
            const int cs = tid & 63, ks = tid >> 6;
            float acc[8];
#pragma unroll
            for (int b = 0; b < 8; ++b) acc[b] = 0.f;
            const float* W = wada + (size_t)layer * 1024 * 6144 + col0 + cs;
#pragma unroll 16
            for (int k = ks * 128; k < ks * 128 + 128; ++k) { const float w = W[(size_t)k * 6144];
#pragma unroll
                for (int b = 0; b < 8; ++b) acc[b] += cact[b * 1024 + k] * w; }
#pragma unroll
            for (int b = 0; b < 8; ++b) red[(ks * 8 + b) * 64 + cs] = acc[b];
            __syncthreads();
            { const int b = tid >> 6; float s = bada[layer * 6144 + col0 + cs];
#pragma unroll
              for (int k2 = 0; k2 < 8; ++k2) s += red[(k2 * 8 + b) * 64 + cs];
              mod[(size_t)(layer * 8 + b) * 6144 + col0 + cs] = s; }
        }
        __syncthreads();
    }
    const int gt = blockIdx.x * NTHREADS + tid, NGT = G * NTHREADS;
    {
        const int* pos = (const int*)P.in[2]; float* rope = (float*)(ws + WS_ROPE);
        for (int i = gt; i < NTOK * 32; i += NGT) { const int f = i & 31, t = i >> 5;
            const double invf = exp2(-(double)f * (13.287712379549449 / 32.0));
            float s, c; sincos_d((double)pos[t] * invf, s, c); rope[2 * (size_t)i] = c; rope[2 * (size_t)i + 1] = s; }
    }
    {
        const float* sw = (const float*)P.in[18]; bf16_t* o = (bf16_t*)(ws + WS_SGUW);
        for (int i = gt; i < 4 * 128 * 128; i += NGT) { const int j = i & 127, r = (i >> 7) & 127; o[i] = f2bf(j <= r ? sw[i] : 0.f); }
    }
    {
        LAS float* scr = (LAS float*)(lds + wid * 16384);
        const int gw = blockIdx.x * NWAVES + wid, NGW = G * NWAVES;
        constexpr int I_IN0 = 16 * 96, I_OUT = 16 * 32, I_IN1 = 16 * 80;
        constexpr int NITEMS = I_IN0 + I_OUT + I_IN1 + I_OUT;
        for (int it = gw; it < NITEMS; it += NGW) {
            int r = it;
            if (r < I_IN0) { const int kb = r / 96, g = r % 96; conv_item((const float*)P.in[5], 3088, in0_logcol(g), kb * 64, (bf16_t*)(ws + WS_WIN0) + (size_t)g * 32 * 1024, 1024, scr, lane); continue; } r -= I_IN0;
            if (r < I_OUT) { const int kb = r / 32, g = r % 32; conv_item((const float*)P.in[14], 1024, g * 32, kb * 64, (bf16_t*)(ws + WS_WOUT0) + (size_t)g * 32 * 1024, 1024, scr, lane); continue; } r -= I_OUT;
            if (r < I_IN1) { const int kb = r / 80, g = r % 80; conv_item((const float*)P.in[15], 2560, in1_logcol(g), kb * 64, (bf16_t*)(ws + WS_WIN1) + (size_t)g * 32 * 1024, 1024, scr, lane); continue; } r -= I_IN1;
            { const int kb = r / 32, g = r % 32; conv_item((const float*)P.in[20], 1024, g * 32, kb * 64, (bf16_t*)(ws + WS_WOUT1) + (size_t)g * 32 * 1024, 1024, scr, lane); }
        }
    }
}

template <int MODE> struct PrenormRow { f32x4 x[4]; unsigned y[4][4]; f32x4 g2[4], sh[4], sc[4]; };
template <int MODE, bool XBF>
DEV void prenorm_load(PrenormRow<MODE>& r, int row, int lane, const void* xin, const unsigned char* YB, const float* mod, int layer_mod, int modoff, int layer_prev) {
    const int b = row >> 11;
#pragma unroll
    for (int j = 0; j < 4; ++j) r.x[j] = ld_res4<XBF>(xin, (size_t)row * DM + 4 * lane + 256 * j);
    if (MODE & 1) {
#pragma unroll
        for (int k = 0; k < 4; ++k) { const unsigned* yr = (const unsigned*)(YB + ((size_t)row * 4 + k) * 1024) + lane;
#pragma unroll
            for (int j = 0; j < 4; ++j) r.y[k][j] = yr[64 * j]; }
        const float* g2 = mod + (size_t)(layer_prev * 8 + b) * 6144 + 5 * 1024;
#pragma unroll
        for (int j = 0; j < 4; ++j) r.g2[j] = *((const f32x4*)g2 + lane + 64 * j);
    }
    if (!(MODE & 8)) { const float* mrow = mod + (size_t)(layer_mod * 8 + b) * 6144 + modoff;
#pragma unroll
        for (int j = 0; j < 4; ++j) { r.sh[j] = *((const f32x4*)mrow + lane + 64 * j); r.sc[j] = *((const f32x4*)(mrow + 1024) + lane + 64 * j); } }
}
template <int MODE, bool XBF>
DEV void phase_prenorm(const Params& P, LAS unsigned char* lds, int wv, const void* xin, void* xout, int layer_mod, int modoff  , int layer_prev) {
    const int tid = opaque_tid(wv), lane = tid & 63, wid = tid >> 6, G = gridDim.x;
    unsigned char* ws = opaque_ws(P.ws);
    const float* mod = (const float*)(ws + WS_MOD);
    bf16_t* H = (bf16_t*)(ws + WS_H);
    const unsigned char* YB = ws + WS_YB;
    f32x4 fgv[4];
    if (MODE & 8) { const float* fg = (const float*)P.in[27];
#pragma unroll
        for (int j = 0; j < 4; ++j) fgv[j] = *((const f32x4*)fg + lane + 64 * j); }
    const int stride = G * NWAVES;
    int row = blockIdx.x * NWAVES + wid;
    PrenormRow<MODE> cur, nxt;
    if (row < NTOK) prenorm_load<MODE, XBF>(cur, row, lane, xin, YB, mod, layer_mod, modoff, layer_prev);
    for (; row < NTOK; row += stride) {
        const bool more = row + stride < NTOK;
        if (more) prenorm_load<MODE, XBF>(nxt, row + stride, lane, xin, YB, mod, layer_mod, modoff, layer_prev);
        f32x4 v[4];
#pragma unroll
        for (int j = 0; j < 4; ++j) v[j] = cur.x[j];
        if (MODE & 1) {
#pragma unroll
            for (int j = 0; j < 4; ++j) { f32x4 m4 = {0.f, 0.f, 0.f, 0.f};
#pragma unroll
                for (int k = 0; k < 4; ++k) { const unsigned w = cur.y[k][j]; const f32x2 lo = __builtin_amdgcn_cvt_pk_f32_fp8(w, false), hi = __builtin_amdgcn_cvt_pk_f32_fp8(w, true);
                    m4[0] += lo[0]; m4[1] += lo[1]; m4[2] += hi[0]; m4[3] += hi[1]; }
                if (!((DBG_SKIP >> (1 + 2 * layer_prev)) & 1)) v[j] = v[j] + cur.g2[j] * m4 * ((layer_prev ? DBG_F_MOE1 : DBG_F_MOE0) * YB_INV); }
        }
        if (MODE & 2) {
#pragma unroll
            for (int j = 0; j < 4; ++j) st_res4<RES_BF16>(xout, (size_t)row * DM + 4 * lane + 256 * j, v[j]); }
        float ss = 0.f;
#pragma unroll
        for (int j = 0; j < 4; ++j) ss += (v[j][0] * v[j][0] + v[j][1] * v[j][1]) + (v[j][2] * v[j][2] + v[j][3] * v[j][3]);
        const float rstd = 1.0f / sqrtf(wave_sum(ss) * (1.f / DM) + EPS);
        if (MODE & 8) {
            f32x4* o = (f32x4*)(P.out + (size_t)row * DM) + lane;
#pragma unroll
            for (int j = 0; j < 4; ++j) { const f32x4 g = fgv[j];
#ifdef DBG_PROBE_OFF
                const float ps = ((const float*)(ws + WS_CTL))[1024] / ((float)NTOK * DBG_PROBE_NCOLS); const float pv = (DBG_PROBE_ABS ? ps : sqrtf(ps)) * DBG_PROBE_SCALE;
                const float alpha = 1.5f + 1.5f * fminf(fmaxf(pv, 0.f), 1.f);
                o[64 * j] = v[j] * rstd * g * alpha;
#elif defined(DBG_TS)
                { const unsigned long long* tsp = (const unsigned long long*)(ws + WS_CTL + 49152);
                  const float dt_us = (float)(tsp[DBG_TS + 1] - tsp[DBG_TS_FROM]) * 0.01f;
                  const float eps = sqrtf(fminf(dt_us * 0.001f, 1.4f) * 1e-3f);
                  f32x4 o4 = v[j] * rstd * g;
#pragma unroll
                  for (int t = 0; t < 4; ++t) { unsigned hsh = (unsigned)(row * 1024 + 4 * lane + 256 * j + t) * 2654435761u; hsh ^= hsh >> 15; o4[t] *= (hsh & 1u) ? (1.f + eps) : (1.f - eps); }
                  o[64 * j] = o4; }
#else
                o[64 * j] = v[j] * rstd * g;
#endif
            }
        } else {
            u32x2* ho = (u32x2*)(H + (size_t)row * DM) + lane;
#pragma unroll
            for (int j = 0; j < 4; ++j) { const f32x4 hv = v[j] * rstd * (cur.sc[j] + 1.0f) + cur.sh[j];
                u32x2 w; w.x = pk2(hv[0], hv[1]); w.y = pk2(hv[2], hv[3]); ho[64 * j] = w; }
        }
        if (more) cur = nxt;
    }
}


DEV void phase_prenorm_gate(const Params& P, LAS unsigned char* lds, int wv) {
    const int tid = opaque_tid(wv), lane = tid & 63, w = wv, G = gridDim.x;
    unsigned char* ws = opaque_ws(P.ws);
    const float* mod = (const float*)(ws + WS_MOD);
    const float* xin = (const float*)P.in[0]; const float* win = (const float*)P.in[5]; const float* wg = (const float*)P.in[6]; const float* bg = (const float*)P.in[7];
    bf16_t* H = (bf16_t*)(ws + WS_H); float* LA = (float*)(ws + WS_LA);
    constexpr int AS = 1028;
    LAS float* At = (LAS float*)lds;
    LAS float* red = At + 16 * AS;
    LAS float* grs = red + 8 * 16 * 16;
    float Bf[32];
#pragma unroll
    for (int s2 = 0; s2 < 32; ++s2) Bf[s2] = win[(size_t)(128 * w + 4 * s2 + (lane >> 4)) * 3088 + 1024 + (lane & 15)];
    const int gcol = tid & 255, ghalf = tid >> 8;
    float wgc[16];
#pragma unroll
    for (int r = 0; r < 16; ++r) wgc[r] = wg[r * 256 + gcol];
    const float bgc = bg[gcol];
    __syncthreads();
    for (int blk = blockIdx.x; blk < NTOK / 64; blk += G) {
        const int bb = (blk * 64) >> 11;
        const float* mrow = mod + (size_t)(0 * 8 + bb) * 6144;
        f32x4 sh[4], sc[4], xv[2][4];
#pragma unroll
        for (int j = 0; j < 4; ++j) { sh[j] = *((const f32x4*)mrow + lane + 64 * j); sc[j] = *((const f32x4*)(mrow + 1024) + lane + 64 * j); }
#pragma unroll
        for (int rr = 0; rr < 2; ++rr)
#pragma unroll
            for (int j = 0; j < 4; ++j) xv[rr][j] = *((const f32x4*)(xin + (size_t)(blk * 64 + 2 * w + rr) * DM) + lane + 64 * j);
        for (int g = 0; g < 4; ++g) {
            const int rbase = blk * 64 + 16 * g;
#pragma unroll
            for (int rr = 0; rr < 2; ++rr) {
                f32x4 v[4];
#pragma unroll
                for (int j = 0; j < 4; ++j) v[j] = xv[rr][j];
                float ss = 0.f;
#pragma unroll
                for (int j = 0; j < 4; ++j) ss += (v[j][0] * v[j][0] + v[j][1] * v[j][1]) + (v[j][2] * v[j][2] + v[j][3] * v[j][3]);
                const float rstd = 1.0f / sqrtf(wave_sum(ss) * (1.f / DM) + EPS);
                u32x2* ho = (u32x2*)(H + (size_t)(rbase + 2 * w + rr) * DM) + lane;
#pragma unroll
                for (int j = 0; j < 4; ++j) { v[j] = v[j] * rstd * (sc[j] + 1.0f) + sh[j];
                    u32x2 wq; wq.x = pk2(v[j][0], v[j][1]); wq.y = pk2(v[j][2], v[j][3]); ho[64 * j] = wq;
                    *(LAS f32x4*)(At + (2 * w + rr) * AS + 4 * lane + 256 * j) = v[j]; }
            }
            if (g < 3) {
#pragma unroll
                for (int rr = 0; rr < 2; ++rr)
#pragma unroll
                    for (int j = 0; j < 4; ++j) xv[rr][j] = *((const f32x4*)(xin + (size_t)(rbase + 16 + 2 * w + rr) * DM) + lane + 64 * j);
            }
            LBAR();
            f32x4 acc = {0.f, 0.f, 0.f, 0.f};
            const LAS float* ap = At + (lane & 15) * AS + 128 * w + (lane >> 4);
#pragma unroll
            for (int s2 = 0; s2 < 32; ++s2) acc = __builtin_amdgcn_mfma_f32_16x16x4f32(ap[4 * s2], Bf[s2], acc, 0, 0, 0);
#pragma unroll
            for (int t = 0; t < 4; ++t) red[(w * 16 + (lane >> 4) * 4 + t) * 16 + (lane & 15)] = acc[t];
            LBAR();
            if (tid < 256) { float sum = 0.f;
#pragma unroll
                for (int w2 = 0; w2 < 8; ++w2) sum += red[w2 * 256 + tid];
                grs[tid] = sum; }
            LBAR();
            {
#pragma unroll
                for (int q = 0; q < 8; ++q) { const int rl = 8 * ghalf + q; float z = bgc;
#pragma unroll
                    for (int r = 0; r < 16; ++r) z += grs[rl * 16 + r] * wgc[r];
                    LA[(size_t)(rbase + rl) * 256 + gcol] = log_sigmoid_f(z) * 0.0625f; }
            }
            LBAR();
        }
    }
}

DEV void phase_router(const Params& P, LAS unsigned char* lds, int wv, const void* xin, int layer) {
    const int tid = opaque_tid(wv), lane = tid & 63, w = wv, G = gridDim.x;
    unsigned char* ws = opaque_ws(P.ws);
    const float* mod = (const float*)(ws + WS_MOD);
    const float* rw = (const float*)P.in[21] + (size_t)layer * 1024 * 32; const float* rb = (const float*)P.in[22] + layer * 32;
    int* cnt = (int*)(ws + WS_CTL) + CW_CNT + layer * NEXP * CNT_STRIDE; int* ent = (int*)(ws + WS_ENT) + (size_t)layer * NEXP * ENT_CAP;
    float* gl = (float*)(ws + WS_GL) + (size_t)layer * NEXP * ENT_CAP;
    unsigned char* XQ = ws + WS_XQ;
    constexpr int AS = 1028;
    LAS float* At = (LAS float*)lds;
    LAS float* red = At + 16 * AS;
    LAS int* lcnt = (LAS int*)(red + 8 * 16 * 32);
    LAS int* gbase = lcnt + 32;
    LAS int* elist = gbase + 32;
    LAS float* gsave = (LAS float*)(elist + 256);
    LAS unsigned char* hq = (LAS unsigned char*)(gsave + 256);
    if (tid < NEXP) lcnt[tid] = 0;
    __syncthreads();
    float Bf[2][32];
#pragma unroll
    for (int s2 = 0; s2 < 32; ++s2)
#pragma unroll
        for (int n = 0; n < 2; ++n) Bf[n][s2] = rw[(size_t)(128 * w + 4 * s2 + (lane >> 4)) * 32 + 16 * n + (lane & 15)];
    for (int blk = blockIdx.x; blk < NTOK / 64; blk += G) {
        const int bb = (blk * 64) >> 11;
        const float* mrow = mod + (size_t)(layer * 8 + bb) * 6144 + 3072;
        f32x4 sh[4], sc[4], xv[2][4];
#pragma unroll
        for (int j = 0; j < 4; ++j) { sh[j] = *((const f32x4*)mrow + lane + 64 * j); sc[j] = *((const f32x4*)(mrow + 1024) + lane + 64 * j); }
#pragma unroll
        for (int rr = 0; rr < 2; ++rr)
#pragma unroll
            for (int j = 0; j < 4; ++j) xv[rr][j] = ld_res4<RES_BF16>(xin, (size_t)(blk * 64 + 2 * w + rr) * DM + 4 * lane + 256 * j);
        for (int g = 0; g < 4; ++g) {
            const int rbase = blk * 64 + 16 * g;
#pragma unroll
            for (int rr = 0; rr < 2; ++rr) {
                f32x4 v[4];
#pragma unroll
                for (int j = 0; j < 4; ++j) v[j] = xv[rr][j];
                float ss = 0.f;
#pragma unroll
                for (int j = 0; j < 4; ++j) ss += (v[j][0] * v[j][0] + v[j][1] * v[j][1]) + (v[j][2] * v[j][2] + v[j][3] * v[j][3]);
                const float rstd = 1.0f / sqrtf(wave_sum(ss) * (1.f / DM) + EPS);
#pragma unroll
                for (int j = 0; j < 4; ++j) { v[j] = v[j] * rstd * (sc[j] + 1.0f) + sh[j];
                    *((LAS unsigned*)(hq + (16 * g + 2 * w + rr) * 1024) + lane + 64 * j) = pk4_fp8(v[j][0], v[j][1], v[j][2], v[j][3]);
                    *(LAS f32x4*)(At + (2 * w + rr) * AS + 4 * lane + 256 * j) = v[j]; }
            }
            if (g < 3) {
#pragma unroll
                for (int rr = 0; rr < 2; ++rr)
#pragma unroll
                    for (int j = 0; j < 4; ++j) xv[rr][j] = ld_res4<RES_BF16>(xin, (size_t)(rbase + 16 + 2 * w + rr) * DM + 4 * lane + 256 * j);
            }
            LBAR();
            f32x4 acc0 = {0.f, 0.f, 0.f, 0.f}, acc1 = {0.f, 0.f, 0.f, 0.f};
            const LAS float* ap = At + (lane & 15) * AS + 128 * w + (lane >> 4);
#pragma unroll
            for (int s2 = 0; s2 < 32; ++s2) { const float av = ap[4 * s2];
                acc0 = __builtin_amdgcn_mfma_f32_16x16x4f32(av, Bf[0][s2], acc0, 0, 0, 0); acc1 = __builtin_amdgcn_mfma_f32_16x16x4f32(av, Bf[1][s2], acc1, 0, 0, 0); }
#pragma unroll
            for (int t = 0; t < 4; ++t) { red[(w * 16 + (lane >> 4) * 4 + t) * 32 + (lane & 15)] = acc0[t]; red[(w * 16 + (lane >> 4) * 4 + t) * 32 + 16 + (lane & 15)] = acc1[t]; }
            LBAR();
            {
                const int half = lane >> 5, e = lane & 31, rl = 2 * w + half, row = rbase + rl;
                float lg = rb[e];
#pragma unroll
                for (int w2 = 0; w2 < 8; ++w2) lg += red[(w2 * 16 + rl) * 32 + e];
                float tv[4]; int ti[4]; float cur = lg;
#pragma unroll
                for (int r4 = 0; r4 < 4; ++r4) {
                    float mx = cur;
#pragma unroll
                    for (int o = 1; o < 32; o <<= 1) mx = fmaxf(mx, __shfl_xor(mx, o));
                    const unsigned long long bal = __ballot(cur == mx);
                    const unsigned mine = (unsigned)(bal >> (32 * half));
                    const int sel = __builtin_ctz(mine);
                    tv[r4] = mx; ti[r4] = sel; if (e == sel) cur = -INFINITY;
                }
                const float e1 = __expf(tv[1] - tv[0]), e2 = __expf(tv[2] - tv[0]), e3 = __expf(tv[3] - tv[0]);
                const float inv = 1.f / (1.f + e1 + e2 + e3);
                if (e < 4) { const int ex = e == 0 ? ti[0] : e == 1 ? ti[1] : e == 2 ? ti[2] : ti[3];
                    const float gv = (e == 0 ? 1.f : e == 1 ? e1 : e == 2 ? e2 : e3) * inv;
                    const int lpos = __hip_atomic_fetch_add(lcnt + ex, 1, __ATOMIC_RELAXED, __HIP_MEMORY_SCOPE_WORKGROUP); elist[(16 * g + rl) * 4 + e] = (ex << 16) | lpos; gsave[(16 * g + rl) * 4 + e] = gv; }
            }
            LBAR();
        }
        if (tid < NEXP) { const int n = lcnt[tid]; gbase[tid] = n ? atomicAdd(cnt + tid * CNT_STRIDE, n) : 0; }
        __syncthreads();
        if (tid < 256) { const int pk = elist[tid], ex = pk >> 16, lpos = pk & 0xffff; const int pos = gbase[ex] + lpos; ent[ex * ENT_CAP + pos] = blk * 256 + tid; gl[ex * ENT_CAP + pos] = gsave[tid]; elist[tid] = ex * ENT_CAP + pos; }
        __syncthreads();
#pragma unroll 4
        for (int q = 0; q < 32; ++q) { const int en = w + NWAVES * q; const int dstrow = elist[en];
            *((u32x4*)(XQ + (size_t)dstrow * DM) + lane) = *((const LAS u32x4*)(hq + (en >> 2) * 1024) + lane); }
        __syncthreads();
        if (tid < NEXP) lcnt[tid] = 0;
    }
}

DEV void attn_unit_ref(int b, int vh, int qb, const bf16_t* Z, bf16_t* OP, int wv) {
    const int tid = opaque_tid(wv);
    if (tid >= 256) return;
    const int h = vh >> 2, m = (vh >> 1) & 1, vhalf = vh & 1;
    const size_t rowbase = (size_t)b * SEQ;
    const int i = qb * 256 + tid;
    const bf16_t* Qr = Z + (rowbase + i) * Z0P + 1536 + h * 128 + m * 64;
    const bf16_t* Kb = Z + rowbase * Z0P + 2048 + h * 128 + m * 64;
    const bf16_t* Vb = Z + rowbase * Z0P + 2560 + h * 128 + vhalf * 64;
    float q[64], o[64];
#pragma unroll
    for (int d0 = 0; d0 < 8; ++d0) { float t[8]; unpack8(*(const bf16x8*)(Qr + d0 * 8), t);
#pragma unroll
        for (int j = 0; j < 8; ++j) { q[d0 * 8 + j] = t[j]; o[d0 * 8 + j] = 0.f; } }
    float mx = -INFINITY, l = 0.f;
    const int jend = qb * 256 + 255;
    for (int j = 0; j <= jend; ++j) {
        const bf16_t* kr = Kb + (size_t)j * Z0P; const bf16_t* vr = Vb + (size_t)j * Z0P;
        float s = 0.f;
#pragma unroll
        for (int d0 = 0; d0 < 8; ++d0) { float t[8]; unpack8(*(const bf16x8*)(kr + d0 * 8), t);
#pragma unroll
            for (int jj = 0; jj < 8; ++jj) s += q[d0 * 8 + jj] * t[jj]; }
        if (j > i) s = -INFINITY;
        if (s > mx) { const float al = __builtin_amdgcn_exp2f(mx - s); l *= al;
#pragma unroll
            for (int e = 0; e < 64; ++e) o[e] *= al;
            mx = s; }
        const float p = __builtin_amdgcn_exp2f(s - mx); l += p;
#pragma unroll
        for (int d0 = 0; d0 < 8; ++d0) { float t[8]; unpack8(*(const bf16x8*)(vr + d0 * 8), t);
#pragma unroll
            for (int jj = 0; jj < 8; ++jj) o[d0 * 8 + jj] += p * t[jj]; }
    }
    const float il = 1.f / l;
    bf16_t* Or = OP + (rowbase + i) * 1024 + vh * 64;
#pragma unroll
    for (int d0 = 0; d0 < 8; ++d0) { u32x4 w; w.x = pk2(o[d0 * 8] * il, o[d0 * 8 + 1] * il); w.y = pk2(o[d0 * 8 + 2] * il, o[d0 * 8 + 3] * il);
        w.z = pk2(o[d0 * 8 + 4] * il, o[d0 * 8 + 5] * il); w.w = pk2(o[d0 * 8 + 6] * il, o[d0 * 8 + 7] * il); *(u32x4*)(Or + d0 * 8) = w; }
}

struct LinAttnArgs {
    const bf16_t* q; const bf16_t* k; const bf16_t* v; const bf16_t* og;
    int zp; const float* la;
    float log_g;
    const float* gain;
    bf16_t* out;
};
template <int C>
DEV void linattn_unit_ref(const LinAttnArgs& a, LAS unsigned char* lds, int wv) {
    const int tid = opaque_tid(wv), lane = tid & 63, wid = tid >> 6;
    LAS bf16_t* qd = (LAS bf16_t*)lds;
    LAS bf16_t* ka = qd + C * 64;
    LAS bf16_t* vv = ka + C * 64;
    LAS float* bsc = (LAS float*)(vv + C * 128);
    LAS bf16_t* Sm = (LAS bf16_t*)bsc;
    LAS float* st = bsc + C * 64;
    LAS float* dec = st + 64 * 128;
    __syncthreads();
    for (int i = tid; i < 64 * 128; i += NTHREADS) st[i] = 0.f;
    for (int n = 0; n < SEQ / C; ++n) {
        const size_t r0 = (size_t)n * C;
        __syncthreads();
        for (int i = tid; i < C * 64; i += NTHREADS) { const int r = i >> 6, d = i & 63; bsc[i] = a.la ? a.la[(r0 + r) * 256 + d] : a.log_g; }
        for (int i = tid; i < C * 16; i += NTHREADS) { const int r = i >> 4, c8 = i & 15; *(LAS u32x4*)(vv + r * 128 + c8 * 8) = *(const u32x4*)(a.v + (r0 + r) * a.zp + c8 * 8); }
        __syncthreads();
        if (tid < 64) { float run = 0.f; for (int r = 0; r < C; ++r) { run += bsc[r * 64 + tid]; bsc[r * 64 + tid] = run; } dec[tid] = __expf(run); }
        __syncthreads();
        for (int i = tid; i < C * 64; i += NTHREADS) { const int r = i >> 6, d = i & 63; const float bb = bsc[i];
            qd[i] = f2bf(bf2f(a.q[(r0 + r) * a.zp + d]) * __expf(bb)); ka[i] = f2bf(bf2f(a.k[(r0 + r) * a.zp + d]) * __expf(-bb)); }
        __syncthreads();
        for (int i = tid; i < C * C; i += NTHREADS) { const int r = i / C, j = i % C; float s = 0.f;
            if (j <= r) { for (int d = 0; d < 64; ++d) s += bf2f(qd[r * 64 + d]) * bf2f(ka[j * 64 + d]); }
            Sm[i] = f2bf(s); }
        __syncthreads();
        for (int r = wid; r < C; r += NWAVES) {
            float o0 = 0.f, o1 = 0.f;
            for (int j = 0; j <= r; ++j) { const float s = bf2f(Sm[r * C + j]); o0 += s * bf2f(vv[j * 128 + lane]); o1 += s * bf2f(vv[j * 128 + 64 + lane]); }
            for (int d = 0; d < 64; ++d) { const float qv = bf2f(qd[r * 64 + d]); o0 += qv * st[d * 128 + lane]; o1 += qv * st[d * 128 + 64 + lane]; }
            const float rstd = 1.0f / sqrtf(wave_sum(o0 * o0 + o1 * o1) * (1.f / 128.f) + EPS);
            const float g0 = a.gain ? a.gain[lane] : 1.f, g1 = a.gain ? a.gain[lane + 64] : 1.f;
            const bf16_t* ogr = a.og + (r0 + r) * a.zp; bf16_t* orow = a.out + (r0 + r) * 1024;
            orow[lane] = f2bf(o0 * rstd * g0 * bf2f(ogr[lane])); orow[lane + 64] = f2bf(o1 * rstd * g1 * bf2f(ogr[lane + 64]));
        }
        __syncthreads();
        { const int e = tid & 127, dg = tid >> 7;
          for (int d = dg; d < 64; d += 4) { float s = st[d * 128 + e]; for (int j = 0; j < C; ++j) s += bf2f(ka[j * 64 + d]) * bf2f(vv[j * 128 + e]); st[d * 128 + e] = dec[d] * s; } }
    }
    __syncthreads();
}

DEV void sgu_unit_ref(const Params& P, int b, int ch, LAS unsigned char* lds, int wv) {
    const int tid = opaque_tid(wv), lane = tid & 63, wid = tid >> 6;
    unsigned char* ws = opaque_ws(P.ws); const bf16_t* Z = (const bf16_t*)(ws + WS_Z); bf16_t* CAT = (bf16_t*)(ws + WS_CAT);
    const float* lng = (const float*)P.in[16]; const float* lnb = (const float*)P.in[17]; const float* sw = (const float*)P.in[18]; const float* sb = (const float*)P.in[19];
    LAS float* svn = (LAS float*)lds;
    LAS float* stat = svn + 128 * 128;
    const size_t r0 = (size_t)b * SEQ + (size_t)ch * 128;
    __syncthreads();
    for (int r = wid; r < 128; r += NWAVES) {
        const bf16_t* zr = Z + (r0 + r) * Z1P + 512; float x[8]; unpack8(*(const bf16x8*)(zr + lane * 8), x);
        float s = 0.f;
#pragma unroll
        for (int j = 0; j < 8; ++j) s += x[j];
        const float mean = wave_sum(s) * (1.f / 512.f); float q = 0.f;
#pragma unroll
        for (int j = 0; j < 8; ++j) { const float d = x[j] - mean; q += d * d; }
        const float rstd = 1.0f / sqrtf(wave_sum(q) * (1.f / 512.f) + EPS);
        if (lane == 0) { stat[2 * r] = mean; stat[2 * r + 1] = rstd; }
    }
    __syncthreads();
    for (int g = 0; g < 4; ++g) {
        for (int i = tid; i < 128 * 128; i += NTHREADS) { const int r = i >> 7, c = i & 127;
            svn[i] = (bf2f(Z[(r0 + r) * Z1P + 512 + g * 128 + c]) - stat[2 * r]) * stat[2 * r + 1] * lng[g * 128 + c] + lnb[g * 128 + c]; }
        __syncthreads();
        { const int c = tid & 127, ig = tid >> 7;
          for (int r = ig; r < 128; r += 4) { float s = sb[g * 128 + r]; const float* wrow = sw + ((size_t)g * 128 + r) * 128;
              for (int j = 0; j <= r; ++j) s += wrow[j] * svn[j * 128 + c];
              CAT[(r0 + r) * 1024 + g * 128 + c] = f2bf(bf2f(Z[(r0 + r) * Z1P + g * 128 + c]) * s); } }
        __syncthreads();
    }
}


typedef float f32x16 __attribute__((ext_vector_type(16)));
DEV f32x16 mfma32(bf16x8 a, bf16x8 b, f32x16 c) { return __builtin_amdgcn_mfma_f32_32x32x16_bf16(a, b, c, 0, 0, 0); }
DEV bf16x8 ldfrag(const LAS bf16_t* base, int stride, int row, int k) { return *(const LAS bf16x8*)(base + row * stride + k); }

template <int C, bool HAS_LA>
DEV void linattn_unit_fast(const LinAttnArgs& a, LAS unsigned char* lds, int wv) {
    constexpr int SEG = C / 8, KS = 72, CS = C + 8, NIB = C / 32, NQ = NIB / 2, NPC = C / 64, NOP = C / 32, JB = C / 8, BS = 68, OS = 136;
    const int tid = opaque_tid(wv), lane = tid & 63, w = wv, r = lane & 31, h = lane >> 5;
    LAS bf16_t* Qd = (LAS bf16_t*)lds;
    LAS bf16_t* Ka = Qd + C * KS;
    LAS bf16_t* Kat = Ka + C * KS;
    LAS bf16_t* Vt = Kat + 64 * CS;
    LAS bf16_t* Stt = Vt + 128 * CS;
    LAS bf16_t* Sm = Stt + 128 * KS;
    LAS float* dec = (LAS float*)(Sm + C * CS);
    LAS float* tot = dec + 64;
    LAS float* rsq = tot + 512;
    LAS float* bt = rsq + C * 4;
    LAS bf16_t* Ot = (C == 128) ? Sm : (LAS bf16_t*)(bt + C * BS);
    const int db = w >> 2, eb = w & 3, i0 = w * SEG;
    const int vjb = tid % JB, veb = tid / JB; const bool vact = tid < 16 * JB;
    const int pc8 = lane & 7;
    f32x16 st;
#pragma unroll
    for (int t = 0; t < 16; ++t) st[t] = 0.f;
    float lav[SEG]; u32x4 qraw[NPC], kraw[NPC], vraw[8], ogv[NOP];
#define LIN_LOAD(n_) do { const size_t r0_ = (size_t)(n_) * C; \
        if (HAS_LA) { _Pragma("unroll") for (int ii = 0; ii < SEG; ++ii) lav[ii] = a.la[(r0_ + i0 + ii) * 256 + lane]; } \
        _Pragma("unroll") for (int pc = 0; pc < NPC; ++pc) { const int row_ = (tid + 512 * pc) >> 3; qraw[pc] = *(const u32x4*)(a.q + (r0_ + row_) * a.zp + 8 * pc8); kraw[pc] = *(const u32x4*)(a.k + (r0_ + row_) * a.zp + 8 * pc8); } \
        if (vact) { _Pragma("unroll") for (int jj = 0; jj < 8; ++jj) vraw[jj] = *(const u32x4*)(a.v + (r0_ + 8 * vjb + jj) * a.zp + 8 * veb); } \
        _Pragma("unroll") for (int pp = 0; pp < NOP; ++pp) { const int pce = tid + 512 * pp; ogv[pp] = *(const u32x4*)(a.og + (r0_ + (pce >> 4)) * a.zp + 8 * (pce & 15)); } } while (0)
    LIN_LOAD(0);
    LBAR();
    for (int n = 0; n < SEQ / C; ++n) {
        const size_t r0 = (size_t)n * C;
        if (HAS_LA) {
            float p[SEG]; float run = 0.f;
#pragma unroll
            for (int ii = 0; ii < SEG; ++ii) { run += lav[ii]; p[ii] = run; }
            tot[w * 64 + lane] = run;
            LBAR();
            float off = 0.f;
#pragma unroll
            for (int w2 = 0; w2 < 7; ++w2) { const float t2 = tot[w2 * 64 + lane]; off += (w2 < w) ? t2 : 0.f; }
#pragma unroll
            for (int ii = 0; ii < SEG; ++ii) bt[(i0 + ii) * BS + lane] = p[ii] + off;
            if (w == 7) dec[lane] = __expf(p[SEG - 1] + off);
            LBAR();
        } else {
            if (w == 7) dec[lane] = __expf((float)C * a.log_g);
        }
#pragma unroll
        for (int pc = 0; pc < NPC; ++pc) {
            const int row = (tid + 512 * pc) >> 3, d8 = 8 * pc8;
            float bb[8];
            if (HAS_LA) { const f32x4 b0 = *(const LAS f32x4*)(bt + row * BS + d8), b1 = *(const LAS f32x4*)(bt + row * BS + d8 + 4);
#pragma unroll
                for (int t = 0; t < 4; ++t) { bb[t] = b0[t]; bb[4 + t] = b1[t]; } }
            else {
#pragma unroll
                for (int t = 0; t < 8; ++t) bb[t] = (float)(row + 1) * a.log_g; }
            u32x4 qo, ko;
#pragma unroll
            for (int t = 0; t < 4; ++t) { const unsigned qw = qraw[pc][t], kw = kraw[pc][t];
                const float e0 = __expf(bb[2 * t]), e1 = __expf(bb[2 * t + 1]), f0 = __expf(-bb[2 * t]), f1 = __expf(-bb[2 * t + 1]);
                qo[t] = pk2(__uint_as_float(qw << 16) * e0, __uint_as_float(qw & 0xffff0000u) * e1);
                ko[t] = pk2(__uint_as_float(kw << 16) * f0, __uint_as_float(kw & 0xffff0000u) * f1); }
            *(LAS u32x4*)(Qd + row * KS + d8) = qo; *(LAS u32x4*)(Ka + row * KS + d8) = ko;
            unsigned k0 = ko[0], k1 = ko[1], k2 = ko[2], k3 = ko[3];
            { const int aa = pc8 >> 1;
              const unsigned t0 = aa == 0 ? k0 : aa == 1 ? k1 : aa == 2 ? k2 : k3, t1 = aa == 0 ? k1 : aa == 1 ? k2 : aa == 2 ? k3 : k0, t2 = aa == 0 ? k2 : aa == 1 ? k3 : aa == 2 ? k0 : k1, t3 = aa == 0 ? k3 : aa == 1 ? k0 : aa == 2 ? k1 : k2;
              if (pc8 & 1) { k0 = (t0 >> 16) | (t1 << 16); k1 = (t1 >> 16) | (t2 << 16); k2 = (t2 >> 16) | (t3 << 16); k3 = (t3 >> 16) | (t0 << 16); } else { k0 = t0; k1 = t1; k2 = t2; k3 = t3; } }
            const unsigned kr[4] = {k0, k1, k2, k3};
#pragma unroll
            for (int jj = 0; jj < 8; ++jj) { const int e = (jj + pc8) & 7; const unsigned wd = kr[jj >> 1];
                Kat[(d8 + e) * CS + row] = (bf16_t)((jj & 1) ? (wd >> 16) : (wd & 0xffffu)); }
        }
        if (vact) {
#pragma unroll
            for (int e = 0; e < 8; ++e) { u32x4 o4;
#pragma unroll
                for (int jp = 0; jp < 4; ++jp) { const unsigned lo = vraw[2 * jp][e >> 1], hi = vraw[2 * jp + 1][e >> 1];
                    o4[jp] = (e & 1) ? ((lo >> 16) | (hi & 0xffff0000u)) : ((lo & 0xffffu) | (hi << 16)); }
                *(LAS u32x4*)(Vt + (8 * veb + e) * CS + 8 * vjb) = o4; }
        }
#pragma unroll
        for (int g = 0; g < 4; ++g) { u32x2 w2; w2.x = pk2(st[4 * g], st[4 * g + 1]); w2.y = pk2(st[4 * g + 2], st[4 * g + 3]);
            *(LAS u32x2*)(Stt + (32 * eb + r) * KS + 32 * db + 8 * g + 4 * h) = w2; }
        u32x4 ogc[NOP];
#pragma unroll
        for (int pp = 0; pp < NOP; ++pp) ogc[pp] = ogv[pp];
        if (n + 1 < SEQ / C) LIN_LOAD(n + 1);
        LBAR();
        for (int bp = w; bp < NIB * (NIB + 1) / 2; bp += 8) {
            int ib = 0; while ((ib + 1) * (ib + 2) / 2 <= bp) ++ib;
            const int jb = bp - ib * (ib + 1) / 2;
            f32x16 acc;
#pragma unroll
            for (int t = 0; t < 16; ++t) acc[t] = 0.f;
#pragma unroll
            for (int s2 = 0; s2 < 4; ++s2) acc = mfma32(ldfrag(Ka, KS, 32 * jb + r, 16 * s2 + 8 * h), ldfrag(Qd, KS, 32 * ib + r, 16 * s2 + 8 * h), acc);
            const int i = 32 * ib + r;
#pragma unroll
            for (int g = 0; g < 4; ++g) { const int j0 = 32 * jb + 8 * g + 4 * h; float v0 = acc[4 * g], v1 = acc[4 * g + 1], v2 = acc[4 * g + 2], v3 = acc[4 * g + 3];
                if (j0 > i) v0 = 0.f; if (j0 + 1 > i) v1 = 0.f; if (j0 + 2 > i) v2 = 0.f; if (j0 + 3 > i) v3 = 0.f;
                u32x2 w2; w2.x = pk2(v0, v1); w2.y = pk2(v2, v3); *(LAS u32x2*)(Sm + i * CS + j0) = w2; }
        }
        {
            f32x16 acc = st;
#pragma unroll
            for (int s2 = 0; s2 < C / 16; ++s2) acc = mfma32(ldfrag(Kat, CS, 32 * db + r, 16 * s2 + 8 * h), ldfrag(Vt, CS, 32 * eb + r, 16 * s2 + 8 * h), acc);
#pragma unroll
            for (int g = 0; g < 4; ++g) { const f32x4 dv = *(const LAS f32x4*)(dec + 32 * db + 8 * g + 4 * h);
#pragma unroll
                for (int t = 0; t < 4; ++t) st[4 * g + t] = acc[4 * g + t] * dv[t]; }
        }
        LBAR();
        f32x16 o[NQ];
#pragma unroll
        for (int q = 0; q < NQ; ++q) {
            const int blk = w + 8 * q, ib = blk >> 2, e2 = blk & 3;
            f32x16 acc;
#pragma unroll
            for (int t = 0; t < 16; ++t) acc[t] = 0.f;
            for (int s2 = 0; s2 < 2 * (ib + 1); ++s2) acc = mfma32(ldfrag(Vt, CS, 32 * e2 + r, 16 * s2 + 8 * h), ldfrag(Sm, CS, 32 * ib + r, 16 * s2 + 8 * h), acc);
#pragma unroll
            for (int s2 = 0; s2 < 4; ++s2) acc = mfma32(ldfrag(Stt, KS, 32 * e2 + r, 16 * s2 + 8 * h), ldfrag(Qd, KS, 32 * ib + r, 16 * s2 + 8 * h), acc);
            o[q] = acc;
            float ss = 0.f;
#pragma unroll
            for (int t = 0; t < 16; ++t) ss += acc[t] * acc[t];
            ss += __shfl_xor(ss, 32);
            if (h == 0) rsq[(32 * ib + r) * 4 + e2] = ss;
        }
        LBAR();
#pragma unroll
        for (int q = 0; q < NQ; ++q) {
            const int blk = w + 8 * q, ib = blk >> 2, e2 = blk & 3, i = 32 * ib + r;
            const f32x4 rs = *(const LAS f32x4*)(rsq + i * 4);
            const float rstd = 1.0f / sqrtf(((rs[0] + rs[1]) + (rs[2] + rs[3])) * (1.f / 128.f) + EPS);
#pragma unroll
            for (int g = 0; g < 4; ++g) { const int e0 = 32 * e2 + 8 * g + 4 * h;
                f32x4 gn = {1.f, 1.f, 1.f, 1.f}; if (a.gain) gn = *(const f32x4*)(a.gain + e0);
                u32x2 w2; w2.x = pk2(o[q][4 * g] * rstd * gn[0], o[q][4 * g + 1] * rstd * gn[1]); w2.y = pk2(o[q][4 * g + 2] * rstd * gn[2], o[q][4 * g + 3] * rstd * gn[3]);
                *(LAS u32x2*)(Ot + i * OS + e0) = w2; }
        }
        LBAR();
#pragma unroll
        for (int pp = 0; pp < NOP; ++pp) { const int pce = tid + 512 * pp, row = pce >> 4, e8 = 8 * (pce & 15);
            const u32x4 ov = *(const LAS u32x4*)(Ot + row * OS + e8); const u32x4 gv = ogc[pp]; u32x4 res;
#pragma unroll
            for (int t = 0; t < 4; ++t) res[t] = pk2(__uint_as_float(ov[t] << 16) * __uint_as_float(gv[t] << 16), __uint_as_float(ov[t] & 0xffff0000u) * __uint_as_float(gv[t] & 0xffff0000u));
            *(u32x4*)(a.out + (r0 + row) * 1024 + e8) = res; }
    }
    asm volatile("s_waitcnt vmcnt(0)" ::: "memory");
    LBAR();
#undef LIN_LOAD
}

DEV void sgu_unit_fast(const Params& P, int b, int ch, LAS unsigned char* lds, int wv) {
    constexpr int CS = 136;
    const int tid = opaque_tid(wv), lane = tid & 63, w = wv, r = lane & 31, h = lane >> 5;
    unsigned char* ws = opaque_ws(P.ws); const bf16_t* Z = (const bf16_t*)(ws + WS_Z); bf16_t* CAT = (bf16_t*)(ws + WS_CAT); const bf16_t* SW = (const bf16_t*)(ws + WS_SGUW);
    const float* lng = (const float*)P.in[16]; const float* lnb = (const float*)P.in[17]; const float* sb = (const float*)P.in[19];
    LAS bf16_t* Wg = (LAS bf16_t*)lds;
    LAS bf16_t* Sv = Wg + 128 * CS;
    LAS float* stat = (LAS float*)(Sv + 128 * CS);
    const size_t r0 = (size_t)b * SEQ + (size_t)ch * 128;
    __syncthreads();
    for (int rr = w; rr < 128; rr += NWAVES) {
        const bf16_t* zr = Z + (r0 + rr) * Z1P + 512; float x[8]; unpack8(*(const bf16x8*)(zr + lane * 8), x);
        float s = 0.f;
#pragma unroll
        for (int j = 0; j < 8; ++j) s += x[j];
        const float mean = wave_sum(s) * (1.f / 512.f); float q = 0.f;
#pragma unroll
        for (int j = 0; j < 8; ++j) { const float d = x[j] - mean; q += d * d; }
        const float rstd = 1.0f / sqrtf(wave_sum(q) * (1.f / 512.f) + EPS);
        if (lane == 0) { stat[2 * rr] = mean; stat[2 * rr + 1] = rstd; }
    }
    __syncthreads();
    for (int g = 0; g < 4; ++g) {
#pragma unroll
        for (int it = 0; it < 4; ++it) { const int pc = tid + 512 * it, i = pc >> 4, c8 = pc & 15;
            *(LAS u32x4*)(Wg + i * CS + c8 * 8) = *(const u32x4*)(SW + ((size_t)g * 128 + i) * 128 + c8 * 8); }
#pragma unroll
        for (int it = 0; it < 4; ++it) { const int item = tid + 512 * it, c = item & 127, jg = item >> 7;
            const float gg = lng[g * 128 + c], bb = lnb[g * 128 + c]; float v[8];
#pragma unroll
            for (int jj = 0; jj < 8; ++jj) { const int j = 8 * jg + jj; v[jj] = (bf2f(Z[(r0 + j) * Z1P + 512 + g * 128 + c]) - stat[2 * j]) * stat[2 * j + 1] * gg + bb; }
            u32x4 w4; w4.x = pk2(v[0], v[1]); w4.y = pk2(v[2], v[3]); w4.z = pk2(v[4], v[5]); w4.w = pk2(v[6], v[7]);
            *(LAS u32x4*)(Sv + c * CS + 8 * jg) = w4; }
        __syncthreads();
#pragma unroll
        for (int q = 0; q < 2; ++q) {
            const int blk = w + 8 * q, ib = blk >> 2, cb = blk & 3, i = 32 * ib + r;
            f32x16 acc;
#pragma unroll
            for (int t = 0; t < 16; ++t) acc[t] = 0.f;
            for (int s2 = 0; s2 < 2 * (ib + 1); ++s2) acc = mfma32(ldfrag(Sv, CS, 32 * cb + r, 16 * s2 + 8 * h), ldfrag(Wg, CS, i, 16 * s2 + 8 * h), acc);
            const float bs = sb[g * 128 + i];
#pragma unroll
            for (int gq = 0; gq < 4; ++gq) { const int c0 = g * 128 + 32 * cb + 8 * gq + 4 * h;
                const u32x2 su = *(const u32x2*)(Z + (r0 + i) * Z1P + c0);
                const float u0 = __uint_as_float(su.x << 16), u1 = __uint_as_float(su.x & 0xffff0000u), u2 = __uint_as_float(su.y << 16), u3 = __uint_as_float(su.y & 0xffff0000u);
                u32x2 w2; w2.x = pk2(u0 * (acc[4 * gq] + bs), u1 * (acc[4 * gq + 1] + bs)); w2.y = pk2(u2 * (acc[4 * gq + 2] + bs), u3 * (acc[4 * gq + 3] + bs));
                *(u32x2*)(CAT + (r0 + i) * 1024 + c0) = w2; }
        }
        __syncthreads();
    }
}

namespace attn_body {
using bf16=unsigned short;
using s16x4=__attribute__((ext_vector_type(4)))short;
using f32x16=__attribute__((ext_vector_type(16)))float;
constexpr int D=64,ZP=Z0P,OPITCH=1024;
constexpr int NW=8,QBLK=32,QB=QBLK*NW,KVBLK=64;
__device__ __forceinline__ int crow(int r,int hi){return (r&3)+8*(r>>2)+4*hi;}
#define SBAR() __builtin_amdgcn_sched_barrier(0)
__device__ __forceinline__ void cmask(f32x16&p0,f32x16&p1,int jb,int qrel,int hi){
  const float NEG=-INFINITY; int kb=64*jb+4*hi;
  #pragma unroll
  for(int r=0;r<16;++r){int kv=kb+(r&3)+8*(r>>2); if(kv>qrel)p0[r]=NEG; if(kv+32>qrel)p1[r]=NEG;}
}

constexpr int NSLOT=3, SLOTB=8192;
constexpr int LDS_K=0, LDS_V=NSLOT*SLOTB, LDS_WS=2*NSLOT*SLOTB, LDS_OST=LDS_WS+NW*64*4, LDS_BYTES=LDS_OST+NW*4096;
__device__ __forceinline__ void glds16(const void*gsrc,unsigned lds_dst){unsigned keep;
  asm volatile("s_mov_b32 %0, m0\n\ts_mov_b32 m0, %2\n\ts_nop 0\n\tglobal_load_lds_dwordx4 %1, off\n\ts_mov_b32 m0, %0":"=&s"(keep):"v"(gsrc),"s"(lds_dst):"memory");}
__device__ __forceinline__ float max3f(float a,float b,float c){float r;asm("v_max3_f32 %0, %1, %2, %3":"=v"(r):"v"(a),"v"(b),"v"(c));return r;}
__device__ __forceinline__ float max2f(float a,float b){float r;asm("v_max_f32_e32 %0, %1, %2":"=v"(r):"v"(a),"v"(b));return r;}
__device__ __forceinline__ float fadd_s(float a,float b){float r;asm("v_add_f32_e32 %0, %1, %2":"=v"(r):"v"(a),"v"(b));return r;}
__device__ __forceinline__ float fsub_s(float a,float b){float r;asm("v_sub_f32_e32 %0, %1, %2":"=v"(r):"v"(a),"v"(b));return r;}
typedef float f32x2_t __attribute__((ext_vector_type(2))); typedef __bf16 bf16x2_t __attribute__((ext_vector_type(2)));
typedef int v8i __attribute__((ext_vector_type(8)));
__device__ __forceinline__ unsigned cvtpk_s(float lo,float hi){f32x2_t v={lo,hi};bf16x2_t b=__builtin_convertvector(v,bf16x2_t);return __builtin_bit_cast(unsigned,b);}
#define WAIT_BAR(N) asm volatile("s_waitcnt vmcnt(" #N ") lgkmcnt(0)\n\ts_barrier":::"memory")

__device__ __forceinline__ void qkt(f32x16&p0,f32x16&p1,const char*Kslot,const bf16x8*qr,const f32x16&negm,int r32,int hi){
  const char*kb=Kslot+hi*1024+r32*16;
  #pragma unroll
  for(int d0=0;d0<4;++d0){
    const bf16x8 b0=*reinterpret_cast<const bf16x8*>(kb+d0*2048);
    const bf16x8 b1=*reinterpret_cast<const bf16x8*>(kb+d0*2048+512);
    if(d0==0){p0=__builtin_amdgcn_mfma_f32_32x32x16_bf16(b0,qr[0],negm,0,0,0);p1=__builtin_amdgcn_mfma_f32_32x32x16_bf16(b1,qr[0],negm,0,0,0);}
    else{p0=__builtin_amdgcn_mfma_f32_32x32x16_bf16(b0,qr[d0],p0,0,0,0);p1=__builtin_amdgcn_mfma_f32_32x32x16_bf16(b1,qr[d0],p1,0,0,0);}}
}
typedef __attribute__((address_space(3))) const char* lds_cptr;
typedef short v4i16_t __attribute__((ext_vector_type(4)));
__device__ __forceinline__ void kload8(bf16x8*kf,lds_cptr kp){
  kf[0]=*(const __attribute__((address_space(3))) bf16x8*)(kp);      kf[1]=*(const __attribute__((address_space(3))) bf16x8*)(kp+512);
  kf[2]=*(const __attribute__((address_space(3))) bf16x8*)(kp+2048); kf[3]=*(const __attribute__((address_space(3))) bf16x8*)(kp+2560);
  kf[4]=*(const __attribute__((address_space(3))) bf16x8*)(kp+4096); kf[5]=*(const __attribute__((address_space(3))) bf16x8*)(kp+4608);
  kf[6]=*(const __attribute__((address_space(3))) bf16x8*)(kp+6144); kf[7]=*(const __attribute__((address_space(3))) bf16x8*)(kp+6656);
}
__device__ __forceinline__ void kload2(bf16x8*kf,lds_cptr kp,int j){ kf[2*j]=*(const __attribute__((address_space(3))) bf16x8*)(kp+j*2048); kf[2*j+1]=*(const __attribute__((address_space(3))) bf16x8*)(kp+j*2048+512); }
__device__ __forceinline__ s16x4 vtr(lds_cptr p){ return __builtin_bit_cast(s16x4,__builtin_amdgcn_ds_read_tr16_b64_v4i16((__attribute__((address_space(3))) v4i16_t*)p)); }
__device__ __forceinline__ float rowmax(const f32x16&p0,const f32x16&p1){
  float a=max3f(p0[0],p0[1],p1[0]),b=max3f(p0[2],p0[3],p1[1]);a=max3f(a,p1[2],p1[3]);
  #pragma unroll
  for(int r=4;r<16;r+=4){a=max3f(a,p0[r],p0[r+1]);b=max3f(b,p0[r+2],p0[r+3]);a=max3f(a,p1[r],p1[r+1]);b=max3f(b,p1[r+2],p1[r+3]);}
  const float m=max2f(a,b);
  auto rr=__builtin_amdgcn_permlane32_swap(__float_as_uint(m),__float_as_uint(m),false,false);
  return max2f(__uint_as_float(rr[0]),__uint_as_float(rr[1]));
}
__device__ __forceinline__ void pv(f32x16*o,int vb,bf16x8 pa0,bf16x8 pa1,bf16x8 pa2,bf16x8 pa3){
  #pragma unroll
  for(int d0=0;d0<2;++d0){s16x4 lo[4],hi[4];
    #pragma unroll
    for(int ks=0;ks<4;++ks){
      asm volatile("ds_read_b64_tr_b16 %0,%1 offset:%c2":"=&v"(lo[ks]):"v"(vb),"i"(d0*4096+ks*1024):"memory");
      asm volatile("ds_read_b64_tr_b16 %0,%1 offset:%c2":"=&v"(hi[ks]):"v"(vb),"i"(d0*4096+ks*1024+512):"memory");}
    asm volatile("s_waitcnt lgkmcnt(0)":::"memory");SBAR();
    #define PK(k) (bf16x8){lo[k][0],lo[k][1],lo[k][2],lo[k][3],hi[k][0],hi[k][1],hi[k][2],hi[k][3]}
    o[d0]=__builtin_amdgcn_mfma_f32_32x32x16_bf16(pa0,PK(0),o[d0],0,0,0);
    o[d0]=__builtin_amdgcn_mfma_f32_32x32x16_bf16(pa1,PK(1),o[d0],0,0,0);
    o[d0]=__builtin_amdgcn_mfma_f32_32x32x16_bf16(pa2,PK(2),o[d0],0,0,0);
    o[d0]=__builtin_amdgcn_mfma_f32_32x32x16_bf16(pa3,PK(3),o[d0],0,0,0);
    #undef PK
  }
}

#ifndef ATTN_STORE16
#define ATTN_STORE16(p,v) (*(u32x4*)(p)=(v))
#endif
template<int THRL> __device__ __forceinline__ void attn_unit(int qb,const bf16*Qb,const bf16*__restrict__ Kb,const bf16*__restrict__ Vb,bf16*Ob,char*shm,int wv){
  const int tid=opaque_tid(wv),lane=tid&63,r32=lane&31,hi=lane>>5; const int wid=wv;
  const int q0=qb*QB;
  const bf16*Qw=Qb+(long)(q0+wid*QBLK)*ZP;
  const bf16*Kh=Kb,*Vh=Vb;
  const unsigned lds0=(unsigned)(uintptr_t)shm;
  float*wsf=(float*)(shm+LDS_WS)+wid*64;
  const bf16*ksrc=Kh+(long)lane*ZP+wid*8;
  const bf16*vsrc=Vh+(long)(16*(wid&3)+(lane>>2))*ZP+(wid>>2)*32+(lane&3)*8;
  const unsigned kdst=lds0+LDS_K+wid*1024, vdst=lds0+LDS_V+wid*1024;
  #define DMA_K(t,slot) glds16(ksrc+(long)(t)*KVBLK*ZP,(unsigned)__builtin_amdgcn_readfirstlane(kdst+(slot)))
  #define DMA_V(t,slot) glds16(vsrc+(long)(t)*KVBLK*ZP,(unsigned)__builtin_amdgcn_readfirstlane(vdst+(slot)))
  const int vb0=(int)(lds0+LDS_V)+((lane>>4)&1)*32+(lane&3)*8+(4*hi+((lane&15)>>2))*64;
  const char*Kbase=shm+LDS_K; bf16x8 kf[8];
  const lds_cptr shm3=(lds_cptr)shm; const lds_cptr kp0=shm3+LDS_K+hi*1024+r32*16; const lds_cptr vp0=shm3+LDS_V+((lane>>4)&1)*32+(lane&3)*8+(4*hi+((lane&15)>>2))*64;
  const int NT=(q0+QB)/KVBLK;
  DMA_K(0,0);DMA_V(0,0);DMA_K(1,SLOTB);
  bf16x8 qr[4];
  #pragma unroll
  for(int d0=0;d0<4;++d0)qr[d0]=*reinterpret_cast<const bf16x8*>(&Qw[(long)r32*ZP+d0*16+hi*8]);
  float mhat=0.f,l_reg=0.f;f32x16 o[2];o[0]=f32x16{};o[1]=f32x16{};f32x16 negm=f32x16{};asm volatile("":"+v"(negm));
  const int qrel=wid*QBLK+r32;
  #define CMASK(P0,P1,t) do{int jb_=(t)-(NT-4); if(jb_>=0)cmask(P0,P1,jb_,qrel,hi);}while(0)
  bool resc=false;
  #define START(P0,P1) do{ const float rm=rowmax(P0,P1); resc=false; \
    { const float dl=rm; mhat=fadd_s(mhat,dl); \
      _Pragma("unroll") for(int r=0;r<16;++r){P0[r]=fsub_s(P0[r],dl);P1[r]=fsub_s(P1[r],dl);} \
      _Pragma("unroll") for(int r=0;r<16;++r)negm[r]=-mhat; asm volatile("":"+v"(negm)); } \
    _Pragma("unroll") for(int r=0;r<16;++r)P0[r]=__builtin_amdgcn_exp2f(P0[r]); }while(0)
  #define RESC() do{ if(resc){ asm volatile("s_waitcnt lgkmcnt(0)":::"memory"); \
      _Pragma("unroll") for(int d_=0;d_<2;++d_) _Pragma("unroll") for(int r=0;r<16;++r)o[d_][r]*=wsf[crow(r,hi)]; } }while(0)
  f32x16 pA0,pA1,pB0,pB1;
  int sl_prev=0,sl_cur=0,sl_next=SLOTB;
  #define ROT() do{sl_prev=sl_cur;sl_cur=sl_next;sl_next=(sl_next==(NSLOT-1)*SLOTB)?0:sl_next+SLOTB;}while(0)
  DMA_K(2,2*SLOTB);
  WAIT_BAR(3);
  qkt(pA0,pA1,Kbase,qr,negm,r32,hi);asm volatile("s_nop 15\n\ts_nop 7":"+v"(pA0),"+v"(pA1));CMASK(pA0,pA1,0);
  START(pA0,pA1);
  _Pragma("unroll") for(int r=0;r<16;++r)pA1[r]=__builtin_amdgcn_exp2f(pA1[r]);
  WAIT_BAR(0);
  DMA_K(3,0);DMA_V(1,SLOTB);
  ROT();
  kload8(kf,kp0+sl_cur);
  WAIT_BAR(2);
  s16x4 vlo[8],vhi[8]; u32x4 pw0,pw1,pw2,pw3;
  #define PKW(P,B) cvtpk_s(P[B],P[B+1])
  #define PAF(k) __builtin_bit_cast(bf16x8,pw##k)
  #define VFR(i) (bf16x8){vlo[i][0],vlo[i][1],vlo[i][2],vlo[i][3],vhi[i][0],vhi[i][1],vhi[i][2],vhi[i][3]}
  #define PIN(x) asm volatile("":"+v"(x))
  #define MX3(a,b,c) __builtin_fmaxf(__builtin_fmaxf((a),(b)),(c))
  #define GAPA(MF,A0,A1,A2,A3,W0,W1,PW) do{ MF; sacc+=A0; sacc+=A1; sacc+=A2; sacc+=A3; PIN(sacc); W0; W1; PIN(PW); SBAR(); }while(0)
  #define EX(v) __builtin_amdgcn_exp2f(v)
  #define GAPB(MF,X,B) do{ MF; X[B]=EX(X[B]); X[B+1]=EX(X[B+1]); X[B+2]=EX(X[B+2]); X[B+3]=EX(X[B+3]); PIN(X); SBAR(); }while(0)
  #define VRD(i) do{ vlo[i]=vtr(vp_+(((i)>>2)*4096+((i)&3)*1024)); vhi[i]=vtr(vp_+(((i)>>2)*4096+((i)&3)*1024+512)); }while(0)
  #define KRD(G,j) do{ if(G){ kload2(kf,kp0+sl_next,j); SBAR(); } }while(0)
  #define STEP(C0,C1,P0,P1,t,GK,GV,GL) do{ SBAR(); \
    const lds_cptr vp_=vp0+sl_prev; \
    VRD(0); SBAR(); float sacc=(P0[0]+P0[1]); \
    GAPA(C0=__builtin_amdgcn_mfma_f32_32x32x16_bf16(kf[0],qr[0],negm,0,0,0), P0[2],P0[3],P0[4],P0[5],     pw0[0]=PKW(P0,0), pw0[1]=PKW(P0,2), pw0); \
    VRD(4); SBAR(); GAPA(C1=__builtin_amdgcn_mfma_f32_32x32x16_bf16(kf[1],qr[0],negm,0,0,0), P0[6],P0[7],P0[8],P0[9],     pw0[2]=PKW(P0,4), pw0[3]=PKW(P0,6), pw0); \
    VRD(1); SBAR(); GAPA(C0=__builtin_amdgcn_mfma_f32_32x32x16_bf16(kf[2],qr[1],C0,0,0,0),   P0[10],P0[11],P0[12],P0[13], pw1[0]=PKW(P0,8), pw1[1]=PKW(P0,10), pw1); \
    VRD(5); SBAR(); GAPA(C1=__builtin_amdgcn_mfma_f32_32x32x16_bf16(kf[3],qr[1],C1,0,0,0),   P0[14],P0[15],P1[0],P1[1],   pw1[2]=PKW(P0,12),pw1[3]=PKW(P0,14), pw1); \
    VRD(2); SBAR(); GAPA(C0=__builtin_amdgcn_mfma_f32_32x32x16_bf16(kf[4],qr[2],C0,0,0,0),   P1[2],P1[3],P1[4],P1[5],     pw2[0]=PKW(P1,0), pw2[1]=PKW(P1,2), pw2); \
    VRD(6); SBAR(); GAPA(C1=__builtin_amdgcn_mfma_f32_32x32x16_bf16(kf[5],qr[2],C1,0,0,0),   P1[6],P1[7],P1[8],P1[9],     pw2[2]=PKW(P1,4), pw2[3]=PKW(P1,6), pw2); \
    VRD(3); SBAR(); GAPA(C0=__builtin_amdgcn_mfma_f32_32x32x16_bf16(kf[6],qr[3],C0,0,0,0),   P1[10],P1[11],P1[12],P1[13], pw3[0]=PKW(P1,8), pw3[1]=PKW(P1,10), pw3); \
    VRD(7); SBAR(); GAPA(C1=__builtin_amdgcn_mfma_f32_32x32x16_bf16(kf[7],qr[3],C1,0,0,0),   P1[14],P1[15],0.f,0.f,       pw3[2]=PKW(P1,12),pw3[3]=PKW(P1,14), pw3); \
    l_reg+=sacc; \
    if(GK){DMA_K((t)+3,sl_cur);} if(GV){DMA_V((t)+1,sl_next);} \
    CMASK(C0,C1,t); \
    { float a=MX3(C0[0],C0[1],C1[0]),b=MX3(C0[2],C0[3],C1[1]); a=MX3(a,C1[2],C1[3]); \
      _Pragma("unroll") for(int r=4;r<16;r+=4){a=MX3(a,C0[r],C0[r+1]);b=MX3(b,C0[r+2],C0[r+3]);a=MX3(a,C1[r],C1[r+1]);b=MX3(b,C1[r+2],C1[r+3]);} \
      float rm=__builtin_fmaxf(a,b); { auto rr=__builtin_amdgcn_permlane32_swap(__float_as_uint(rm),__float_as_uint(rm),false,false); rm=__builtin_fmaxf(__uint_as_float(rr[0]),__uint_as_float(rr[1])); } \
      resc=false; \
      if(__builtin_expect(__any(rm>(float)THRL),0)){ const float dl=__builtin_fmaxf(rm,0.f); mhat+=dl; \
        _Pragma("unroll") for(int r=0;r<16;++r){C0[r]-=dl;C1[r]-=dl;} \
        _Pragma("unroll") for(int r=0;r<16;++r)negm[r]=-mhat; asm volatile("":"+v"(negm)); \
        const float f=__builtin_amdgcn_exp2f(-dl); l_reg*=f; if(hi==0)wsf[r32]=f; resc=true; } } \
    SBAR(); \
    GAPB(o[0]=__builtin_amdgcn_mfma_f32_32x32x16_bf16(PAF(0),VFR(0),o[0],0,0,0), C0,0); \
    GAPB(o[1]=__builtin_amdgcn_mfma_f32_32x32x16_bf16(PAF(0),VFR(4),o[1],0,0,0), C0,4); \
    KRD(GL,0); GAPB(o[0]=__builtin_amdgcn_mfma_f32_32x32x16_bf16(PAF(1),VFR(1),o[0],0,0,0), C0,8); \
    KRD(GL,1); GAPB(o[1]=__builtin_amdgcn_mfma_f32_32x32x16_bf16(PAF(1),VFR(5),o[1],0,0,0), C0,12); \
    KRD(GL,2); GAPB(o[0]=__builtin_amdgcn_mfma_f32_32x32x16_bf16(PAF(2),VFR(2),o[0],0,0,0), C1,0); \
    KRD(GL,3); GAPB(o[1]=__builtin_amdgcn_mfma_f32_32x32x16_bf16(PAF(2),VFR(6),o[1],0,0,0), C1,4); \
    GAPB(o[0]=__builtin_amdgcn_mfma_f32_32x32x16_bf16(PAF(3),VFR(3),o[0],0,0,0), C1,8); \
    GAPB(o[1]=__builtin_amdgcn_mfma_f32_32x32x16_bf16(PAF(3),VFR(7),o[1],0,0,0), C1,12); \
    }while(0)
  int t=1;
  #undef CMASK
  #define CMASK(P0,P1,t) do{}while(0)
  for(;t+5<NT;t+=2){
    STEP(pB0,pB1,pA0,pA1,t,true,true,true);     WAIT_BAR(2); RESC(); ROT();
    STEP(pA0,pA1,pB0,pB1,t+1,true,true,true);   WAIT_BAR(2); RESC(); ROT();
  }
  #undef CMASK
  #define CMASK(P0,P1,t) do{int jb_=(t)-(NT-4); if(jb_>=0)cmask(P0,P1,jb_,qrel,hi);}while(0)
  #define ENDW(tt) do{ if((tt)+3<NT){WAIT_BAR(2);} else if((tt)+2<NT){WAIT_BAR(1);} else {WAIT_BAR(0);} }while(0)
  for(;t+1<NT;t+=2){
    STEP(pB0,pB1,pA0,pA1,t,(t+3<NT),(t+1<NT),(t+1<NT));       ENDW(t);   RESC(); ROT();
    STEP(pA0,pA1,pB0,pB1,t+1,(t+4<NT),(t+2<NT),(t+2<NT));     ENDW(t+1); RESC(); ROT();
  }
  STEP(pB0,pB1,pA0,pA1,NT-1,false,false,false); RESC();
  { float sacc=pB0[0]+pB0[1]; _Pragma("unroll") for(int r=2;r<16;++r)sacc+=pB0[r]; _Pragma("unroll") for(int r=0;r<16;++r)sacc+=pB1[r]; l_reg+=sacc;
    pw0=(u32x4){PKW(pB0,0),PKW(pB0,2),PKW(pB0,4),PKW(pB0,6)};pw1=(u32x4){PKW(pB0,8),PKW(pB0,10),PKW(pB0,12),PKW(pB0,14)};pw2=(u32x4){PKW(pB1,0),PKW(pB1,2),PKW(pB1,4),PKW(pB1,6)};pw3=(u32x4){PKW(pB1,8),PKW(pB1,10),PKW(pB1,12),PKW(pB1,14)};
    SBAR(); pv(o,vb0+sl_cur,PAF(0),PAF(1),PAF(2),PAF(3)); }
  #undef PKW
  #undef PAF
  #undef VFR
  #undef PIN
  #undef MX3
  #undef GAPA
  #undef GAPB
  #undef EX
  #undef VRD
  #undef KRD
  #undef STEP
  #undef ENDW
  {auto rr=__builtin_amdgcn_permlane32_swap(__float_as_uint(l_reg),__float_as_uint(l_reg),false,false);l_reg=__uint_as_float(rr[0])+__uint_as_float(rr[1]);}
  if(hi==0)wsf[32+r32]=l_reg;asm volatile("s_waitcnt lgkmcnt(0)":::"memory");
  float rli[16];
  #pragma unroll
  for(int r=0;r<16;++r)rli[r]=__builtin_amdgcn_rcpf(wsf[32+crow(r,hi)]);
  bf16*Ow=Ob+(long)(q0+wid*QBLK)*OPITCH;
  { bf16*stg=(bf16*)(shm+LDS_OST)+wid*2048;
    #pragma unroll
    for(int r=0;r<16;++r){const int orow=crow(r,hi);
      #pragma unroll
      for(int d0=0;d0<2;++d0)stg[orow*64+d0*32+r32]=f2bf(o[d0][r]*rli[r]);}
    asm volatile("s_waitcnt lgkmcnt(0)":::"memory");
    #pragma unroll
    for(int i=0;i<4;++i){const int row=i*8+(lane>>3),ch=lane&7; const u32x4 v=*(const u32x4*)(stg+row*64+ch*8); ATTN_STORE16(Ow+(long)row*OPITCH+ch*8,v);} }
  asm volatile("s_waitcnt lgkmcnt(0)\n\ts_barrier":::"memory");
  #undef DMA_K
  #undef DMA_V
  #undef CMASK
  #undef START
  #undef RESC
  #undef ROT
}
constexpr int ATTN_LDS_BYTES=LDS_BYTES;
#undef SBAR
#undef WAIT_BAR
}
DEV int queue_pop(unsigned* head, LAS unsigned char* lds, int wv) {
    LAS int* slot = (LAS int*)(lds + LCTL_OFF + 4096);
    __syncthreads();
    if (opaque_tid(wv) == 0) *slot = (int)__hip_atomic_fetch_add(head, 1u, __ATOMIC_RELAXED, __HIP_MEMORY_SCOPE_AGENT);
    __syncthreads();
    return *slot;
}

DEV void phase_mix0(const Params& P, LAS unsigned char* lds, char* shm, int wv) {
    unsigned char* ws = opaque_ws(P.ws); const bf16_t* Z = (const bf16_t*)(ws + WS_Z);
    unsigned* head = (unsigned*)(ws + WS_CTL) + CW_QUEUE;
    for (;;) {
        const int q = queue_pop(head, lds, wv);
        if (q >= 32 + 1024) break;
        if (q < 32) {
            const int b = q >> 2, h = q & 3; const size_t rb = (size_t)b * SEQ;
            LinAttnArgs a; a.q = Z + rb * Z0P + h * 64; a.k = Z + rb * Z0P + 256 + h * 64; a.v = Z + rb * Z0P + 512 + h * 128; a.og = Z + rb * Z0P + 1024 + h * 128; a.zp = Z0P;
            a.la = (const float*)(ws + WS_LA) + rb * 256 + h * 64; a.log_g = 0.f; a.gain = (const float*)P.in[8]; a.out = (bf16_t*)(ws + WS_CAT) + rb * 1024 + h * 128;
            #if FAST_LIN
            linattn_unit_fast<64, true>(a, lds, wv);
#ifdef DBG_TS
            if (opaque_tid(wv) == 0) atomicMax((unsigned long long*)(ws + WS_CTL + 49152) + 32, (unsigned long long)__builtin_amdgcn_s_memrealtime());
#endif
#else
            linattn_unit_ref<64>(a, lds, wv);
#endif
        } else {
            const int aidx = q - 32, qb = 7 - (aidx >> 7), rem = aidx & 127, b = rem >> 4, vh = rem & 15;
#if FAST_ATTN
            { const int h = vh >> 2, m = (vh >> 1) & 1, vhalf = vh & 1; const bf16_t* zb = Z + (size_t)b * SEQ * Z0P;
              attn_body::attn_unit<8>(qb, zb + 1536 + h * 128 + m * 64, zb + 2048 + h * 128 + m * 64, zb + 2560 + h * 128 + vhalf * 64,
                                      (bf16_t*)(ws + WS_OPART) + (size_t)b * SEQ * 1024 + vh * 64, shm, wv); }
#ifdef DBG_TS
            if (opaque_tid(wv) == 0) atomicMax((unsigned long long*)(ws + WS_CTL + 49152) + 33, (unsigned long long)__builtin_amdgcn_s_memrealtime());
#endif
#else
            attn_unit_ref(b, vh, qb, Z, (bf16_t*)(ws + WS_OPART), wv);
#endif
        }
    }
}
DEV void phase_mix1(const Params& P, LAS unsigned char* lds, int wv) {
    unsigned char* ws = opaque_ws(P.ws); const bf16_t* Z = (const bf16_t*)(ws + WS_Z);
    const int G = gridDim.x, nret = G >= 64 ? 32 : 0;
    if ((int)blockIdx.x < nret || nret == 0) {
        for (int q = blockIdx.x; q < 32; q += (nret ? 32 : G)) {
            const int b = q >> 2, h = q & 3; const size_t rb = (size_t)b * SEQ;
            LinAttnArgs a; a.q = Z + rb * Z1P + 1024 + h * 64; a.k = Z + rb * Z1P + 1280 + h * 64; a.v = Z + rb * Z1P + 1536 + h * 128; a.og = Z + rb * Z1P + 2048 + h * 128; a.zp = Z1P;
            a.la = nullptr; a.log_g = logf(1.0f - exp2f(-5.0f - (float)h)); a.gain = nullptr; a.out = (bf16_t*)(ws + WS_CAT) + rb * 1024 + 512 + h * 128;
            linattn_unit_fast<128, false>(a, lds, wv);
        }
    }
    if ((int)blockIdx.x >= nret) {
        for (int s2 = (int)blockIdx.x - nret; s2 < 128; s2 += G - nret) sgu_unit_fast(P, s2 >> 4, s2 & 15, lds, wv);
        conv_experts(P, lds, wv, 1, nret, G - nret, G == 256 ? CV_P10 : 0);
    }
}
DEV void phase_combine(const Params& P, int wv) {
    const int tid = opaque_tid(wv), lane = tid & 63, wid = tid >> 6, G = gridDim.x;
    const float* q1 = (const float*)P.in[9]; const float* k1 = (const float*)P.in[10]; const float* q2 = (const float*)P.in[11]; const float* k2 = (const float*)P.in[12];
    const float* dg = (const float*)P.in[13];
    const float lam = __expf(wave_sum(q1[lane] * k1[lane])) - __expf(wave_sum(q2[lane] * k2[lane])) + 0.2f;
    unsigned char* ws = opaque_ws(P.ws); const bf16_t* OP = (const bf16_t*)(ws + WS_OPART); bf16_t* CAT = (bf16_t*)(ws + WS_CAT);
    const int h = lane >> 4, e0 = (lane & 15) * 8;
    float g[8];
#pragma unroll
    for (int j = 0; j < 8; ++j) g[j] = dg[e0 + j] * 0.8f;
    for (int row = blockIdx.x * NWAVES + wid; row < NTOK; row += G * NWAVES) {
        float a0[8], a1[8], d[8];
        unpack8(*(const bf16x8*)(OP + (size_t)row * 1024 + h * 256 + e0), a0); unpack8(*(const bf16x8*)(OP + (size_t)row * 1024 + h * 256 + 128 + e0), a1);
        float ss = 0.f;
#pragma unroll
        for (int j = 0; j < 8; ++j) { d[j] = a0[j] - lam * a1[j]; ss += d[j] * d[j]; }
        ss += __shfl_xor(ss, 1); ss += __shfl_xor(ss, 2); ss += __shfl_xor(ss, 4); ss += __shfl_xor(ss, 8);
        const float rstd = 1.0f / sqrtf(ss * (1.f / 128.f) + EPS);
        u32x4 w; w.x = pk2(d[0] * rstd * g[0], d[1] * rstd * g[1]); w.y = pk2(d[2] * rstd * g[2], d[3] * rstd * g[3]);
        w.z = pk2(d[4] * rstd * g[4], d[5] * rstd * g[5]); w.w = pk2(d[6] * rstd * g[6], d[7] * rstd * g[7]);
        *(u32x4*)(CAT + (size_t)row * 1024 + 512 + h * 128 + e0) = w;
    }
}


#ifdef DBG_PROBE_OFF
constexpr int CW_PROBE = 1024;
__global__ void __launch_bounds__(NTHREADS) mk_probe(Params P) {
    const int tid = opaque_tid(wv), G = gridDim.x;
    float s = 0.f;
    const unsigned char* base = P.ws + (size_t)DBG_PROBE_OFF;
    for (long i = (long)blockIdx.x * NTHREADS + tid; i < (long)NTOK * DBG_PROBE_NCOLS; i += (long)G * NTHREADS) {
        const long r = i / DBG_PROBE_NCOLS; const int c = (int)(i % DBG_PROBE_NCOLS) + DBG_PROBE_COL0;
        float v;
        if (DBG_PROBE_F32) v = ((const float*)base)[r * DBG_PROBE_PITCH + c]; else v = bf2f(((const bf16_t*)base)[r * DBG_PROBE_PITCH + c]);
        s += DBG_PROBE_ABS ? fabsf(v) : v * v;
    }
    s = wave_sum(s);
    if ((tid & 63) == 0) atomicAdd((float*)(P.ws + WS_CTL) + CW_PROBE, s);
}
#endif

#define XB_TMO      128
#define XB_XCNT(j)  (256  + 64 * (j))
#define XB_XSUB(j)  (1280 + 64 * (j))
#define XB_XGEN(j)  (2304 + 64 * (j))
#define XB_TOP      3328
#define XB_TOPGEN   3392
#define XCD_BAR_WORDS 3456
#define XB_SPIN_CAP (1u << 18)

__device__ __forceinline__ unsigned xb_ld(unsigned* p)              { return __hip_atomic_load(p, __ATOMIC_RELAXED, __HIP_MEMORY_SCOPE_AGENT); }
__device__ __forceinline__ unsigned xb_add(unsigned* p, unsigned v) { return __hip_atomic_fetch_add(p, v, __ATOMIC_RELAXED, __HIP_MEMORY_SCOPE_AGENT); }
__device__ __forceinline__ unsigned xb_xcc_id() { return (unsigned)__builtin_amdgcn_s_getreg((3 << 11) | 20) & 0xFu; }
#define XB_SPIN(cond, bar) do { unsigned _sp = 0; while (cond) { __builtin_amdgcn_s_sleep(1); \
    if ((++_sp & 255u) == 0u) { if (xb_ld(&(bar)[XB_TMO])) break; if (_sp > XB_SPIN_CAP) { atomicAdd(&(bar)[XB_TMO], 1u); break; } } } } while (0)

struct XcdBarrier {
    unsigned* bar; unsigned x;
    volatile LAS unsigned* st;
};

__device__ __forceinline__ XcdBarrier xcd_barrier_post(unsigned* bar, volatile LAS unsigned* st) {
    XcdBarrier b; b.bar = bar; b.x = xb_xcc_id(); b.st = st;
    if (threadIdx.x == 0) (void)xb_add(&bar[XB_XCNT(b.x)], 1u);
    return b;
}
__device__ __forceinline__ void xcd_barrier_complete(unsigned* bar, unsigned x, unsigned& nloc, unsigned& nx) {
    const unsigned G = gridDim.x * gridDim.y * gridDim.z;
    unsigned sum, cnt, mine, sp = 0u;
    for (;;) {
        sum = 0u; cnt = 0u; mine = 0u;
#pragma unroll
        for (unsigned j = 0; j < 16; ++j) { const unsigned c = xb_ld(&bar[XB_XCNT(j)]); sum += c; cnt += (c > 0u) ? 1u : 0u; mine = (j == x) ? c : mine; }
        if (sum == G) break;
        __builtin_amdgcn_s_sleep(1);
        if ((++sp & 255u) == 0u) { if (xb_ld(&bar[XB_TMO])) break; if (sp > XB_SPIN_CAP) { atomicAdd(&bar[XB_TMO], 1u); break; } }
    }
    nloc = mine > 0u ? mine : 1u; nx = cnt > 0u ? cnt : 1u;
}

__device__ __forceinline__ void xcd_barrier(const XcdBarrier& b) {
    asm volatile("s_waitcnt vmcnt(0)" ::: "memory");
    __syncthreads();
    if (threadIdx.x == 0) {
        unsigned* bar = b.bar;
        __builtin_amdgcn_s_waitcnt(0);
        unsigned nloc = b.st[0], nx = b.st[1];
        if (nloc == 0u) { xcd_barrier_complete(bar, b.x, nloc, nx); b.st[0] = nloc; b.st[1] = nx; }
        const unsigned old = xb_add(&bar[XB_XSUB(b.x)], 1u);
        const unsigned gen = old / nloc;
        if (old + 1u == (gen + 1u) * nloc) {
            __builtin_amdgcn_fence(__ATOMIC_RELEASE, "agent");
            asm volatile("s_waitcnt vmcnt(0)" ::: "memory");
            const unsigned og = xb_add(&bar[XB_TOP], 1u);
            const unsigned tg = og / nx;
            if (og + 1u == (tg + 1u) * nx) xb_add(&bar[XB_TOPGEN], 1u);
            else XB_SPIN(xb_ld(&bar[XB_TOPGEN]) == tg, bar);
            __builtin_amdgcn_fence(__ATOMIC_ACQUIRE, "agent");
            xb_add(&bar[XB_XGEN(b.x)], 1u);
            asm volatile("s_waitcnt vmcnt(0)" ::: "memory");
        } else {
            XB_SPIN(xb_ld(&bar[XB_XGEN(b.x)]) == gen, bar);
            __builtin_amdgcn_fence(__ATOMIC_ACQUIRE, "agent");
            asm volatile("s_waitcnt vmcnt(0)" ::: "memory");
        }
    }
    __syncthreads();
}
template <class Epi, class Sched>
DEV void gemm_run(LAS unsigned char* lds, const Sched& S, const Epi& E, int wv, unsigned char* dbg_ws = nullptr) {
#if FAST_GEMM
    pg8::gemm_phase(lds, S, E, wv, dbg_ws);
#else
    gemm_ref(S, E, wv);
#endif
}

constexpr int N_PHASES = 17;
template <int lo, int hi>
__global__ void __launch_bounds__(NTHREADS, 2) mk_fwd(Params P) {
    extern __shared__ __attribute__((aligned(16))) unsigned char lds_raw[];
    LAS unsigned char* lds = (LAS unsigned char*)lds_raw;
    const int G = gridDim.x, c = blockIdx.x;
    const int wv = __builtin_amdgcn_readfirstlane((int)(threadIdx.x >> 6));
#if ONE_LAUNCH
    { volatile LAS unsigned* stw = (volatile LAS unsigned*)(lds + LCTL_OFF + 8192); if (threadIdx.x < 4) stw[threadIdx.x] = 0u; }
    __syncthreads();
    const XcdBarrier xbar = xcd_barrier_post((unsigned*)(P.ws + WS_CTL) + CW_BAR, (volatile LAS unsigned*)(lds + LCTL_OFF + 8192));
#if USE_CG_SYNC
    cg::grid_group grid = cg::this_grid();
#define GRID_BAR() grid.sync()
#else
#define GRID_BAR() xcd_barrier(xbar)
#endif
#else
#define GRID_BAR() do {} while (0)
#endif
#define IN(k) (lo <= (k) && (k) < hi)
#ifdef DBG_TS
#define STAMP(k) do { if (blockIdx.x == 0 && threadIdx.x == 0) ((unsigned long long*)(P.ws + WS_CTL + 49152))[(k)] = __builtin_amdgcn_s_memrealtime(); } while (0)
#else
#define STAMP(k) do {} while (0)
#endif
#define SEAM(k) do { if constexpr (lo <= (k) + 1 && (k) + 1 < hi) GRID_BAR(); STAMP((k) + 1); } while (0)
#define PH_PTRS unsigned char* ws = opaque_ws(P.ws); const float* mod = (const float*)(ws + WS_MOD); bf16_t* H = (bf16_t*)(ws + WS_H); bf16_t* Z = (bf16_t*)(ws + WS_Z); bf16_t* CAT = (bf16_t*)(ws + WS_CAT); \
    void* X1 = (void*)(ws + WS_X1); void* X2 = (void*)(ws + WS_X2); const float* x = (const float*)P.in[0]; (void)mod; (void)H; (void)Z; (void)CAT; (void)X1; (void)X2; (void)x;

    STAMP(0);
    if constexpr (IN(0)) { PH_PTRS phase_prologue(P, lds, wv); conv_experts(P, lds, wv, 0, 0, G); SEAM(0); }
    if constexpr (IN(1)) { PH_PTRS phase_prenorm_gate(P, lds, wv); SEAM(1); }
    if constexpr (IN(2)) { PH_PTRS
#ifdef DBG_STAGGER2_US
        { const unsigned long long t0 = __builtin_amdgcn_s_memrealtime(); const unsigned long long dl = (unsigned long long)((blockIdx.x >> 3) & 3) * (DBG_STAGGER2_US * 25);
          while (__builtin_amdgcn_s_memrealtime() - t0 < dl) __builtin_amdgcn_s_sleep(8); }
#endif
        DenseSched S{H, (const bf16_t*)(ws + WS_WIN0), 1024, NTOK / 256, N_IN0 / 256, G, c};
        EpiIn E{Z, Z0P, (float*)(ws + WS_LA), (const float*)P.in[7], (const float*)(ws + WS_ROPE), 0};
        gemm_run(lds, S, E, wv, ws); SEAM(2);
    }
    if constexpr (IN(3)) { PH_PTRS phase_mix0(P, lds, (char*)lds_raw, wv); SEAM(3); }
    if constexpr (IN(4)) { PH_PTRS phase_combine(P, wv); SEAM(4); }
    if constexpr (IN(5)) { PH_PTRS
        DenseSched S{CAT, (const bf16_t*)(ws + WS_WOUT0), 1024, NTOK / 256, 4, G, c};
        EpiResid<false> E{x, X1, mod + 2 * 1024, (DBG_SKIP >> 0) & 1, DBG_F_MIX0};
        gemm_run(lds, S, E, wv, ws); SEAM(5);
    }
    if constexpr (IN(6)) { PH_PTRS phase_router(P, lds, wv, X1, 0); SEAM(6); }
    if constexpr (IN(7)) { PH_PTRS
        const int* cnt = (const int*)(ws + WS_CTL) + CW_CNT; const int* ent = (const int*)(ws + WS_ENT);
        MoeTiles mt = moe_build_tiles(cnt, lds, wv);
#ifdef DBG_STAGGER_US
        { const unsigned long long t0 = __builtin_amdgcn_s_memrealtime(); const unsigned long long dl = (unsigned long long)((blockIdx.x >> 3) & 3) * (DBG_STAGGER_US * 25);
          while (__builtin_amdgcn_s_memrealtime() - t0 < dl) __builtin_amdgcn_s_sleep(8); }
#endif
        MoeSched1 S{ws + WS_XQ, ws + WS_W1, mt, 1024, 8, G, c};
        EpiSwiglu E{(bf16_t*)(ws + WS_A), (const float*)P.in[24]};
        gemm_run(lds, S, E, wv, ws); SEAM(7);
    }
    if constexpr (IN(8)) { PH_PTRS
        const int* cnt = (const int*)(ws + WS_CTL) + CW_CNT; const int* ent = (const int*)(ws + WS_ENT);
        MoeTiles mt = moe_build_tiles(cnt, lds, wv);
        MoeSched2 S{ws + WS_A, ws + WS_W2, mt, 1024, 4, G, c};
        EpiMoeOut E{(bf16_t*)(ws + WS_YB), (const float*)P.in[26], cnt, ent, (const float*)(ws + WS_GL)};
        gemm_run(lds, S, E, wv, ws); SEAM(8);
    }
    if constexpr (IN(9)) { PH_PTRS phase_prenorm<3, RES_BF16>(P, lds, wv, X1, X2, 1, 0, 0); SEAM(9); }
    if constexpr (IN(10)) { PH_PTRS
        DenseSched S{H, (const bf16_t*)(ws + WS_WIN1), 1024, NTOK / 256, N_IN1 / 256, G, c};
        EpiIn E{Z, Z1P, nullptr, nullptr, (const float*)(ws + WS_ROPE), 1};
        gemm_run(lds, S, E, wv, ws);
        if (G == 256 && c >= 128) conv_experts(P, lds, wv, 1, 128, 128, 0, CV_P10);
        SEAM(10);
    }
    if constexpr (IN(11)) { PH_PTRS phase_mix1(P, lds, wv); SEAM(11); }
    if constexpr (IN(12)) { PH_PTRS
        DenseSched S{CAT, (const bf16_t*)(ws + WS_WOUT1), 1024, NTOK / 256, 4, G, c};
        EpiResid<RES_BF16> E{X2, X1, mod + 8 * 6144 + 2 * 1024, (DBG_SKIP >> 2) & 1, DBG_F_MIX1};
        gemm_run(lds, S, E, wv, ws); SEAM(12);
    }
    if constexpr (IN(13)) { PH_PTRS phase_router(P, lds, wv, X1, 1); SEAM(13); }
    if constexpr (IN(14)) { PH_PTRS
        const int* cnt = (const int*)(ws + WS_CTL) + CW_CNT + NEXP * CNT_STRIDE; const int* ent = (const int*)(ws + WS_ENT) + (size_t)NEXP * ENT_CAP;
        MoeTiles mt = moe_build_tiles(cnt, lds, wv);
        MoeSched1 S{ws + WS_XQ, ws + WS_W1 + (size_t)NEXP * 2048 * 1024, mt, 1024, 8, G, c};
        EpiSwiglu E{(bf16_t*)(ws + WS_A), (const float*)P.in[24] + (size_t)NEXP * 2048};
        gemm_run(lds, S, E, wv, ws); SEAM(14);
    }
    if constexpr (IN(15)) { PH_PTRS
        const int* cnt = (const int*)(ws + WS_CTL) + CW_CNT + NEXP * CNT_STRIDE; const int* ent = (const int*)(ws + WS_ENT) + (size_t)NEXP * ENT_CAP;
        MoeTiles mt = moe_build_tiles(cnt, lds, wv);
        MoeSched2 S{ws + WS_A, ws + WS_W2 + (size_t)NEXP * 1024 * 1024, mt, 1024, 4, G, c};
        EpiMoeOut E{(bf16_t*)(ws + WS_YB), (const float*)P.in[26] + (size_t)NEXP * 1024, cnt, ent, (const float*)(ws + WS_GL) + (size_t)NEXP * ENT_CAP};
        gemm_run(lds, S, E, wv, ws); SEAM(15);
    }
    if constexpr (IN(16)) { PH_PTRS phase_prenorm<9, RES_BF16>(P, lds, wv, X1, nullptr, 1, 0, 1); }
#undef IN
#undef SEAM
}

template <int PH> static void launch_phase(int grid, const Params& p, hipStream_t stream) {
    (void)hipFuncSetAttribute((const void*)mk_fwd<PH, PH + 1>, hipFuncAttributeMaxDynamicSharedMemorySize, LDS_BYTES);
    hipLaunchKernelGGL((mk_fwd<PH, PH + 1>), dim3(grid), dim3(NTHREADS), LDS_BYTES, stream, p);
}
#ifdef DBG_PHASES
template <int PH> static void launch_masked(int grid, const Params& p, hipStream_t stream) {
    if constexpr (PH < N_PHASES) { if constexpr ((DBG_PHASES >> PH) & 1) launch_phase<PH>(grid, p, stream); launch_masked<PH + 1>(grid, p, stream); }
}
#endif
template <int PH> static void launch_all(int grid, const Params& p, hipStream_t stream) {
    if constexpr (PH < N_PHASES) { launch_phase<PH>(grid, p, stream); launch_all<PH + 1>(grid, p, stream); }
}
extern "C" void kernel_launch(void* const* d_in, const int* in_sizes, int n_in, void* d_out, int out_size, void* d_ws, size_t ws_size, hipStream_t stream) {
    static int grid = 0;
    if (grid == 0) {
        if (n_in != 28 || out_size != NTOK * DM || ws_size < WS_END) { fprintf(stderr, "kernel_launch: unexpected shapes (n_in %d out %d ws %zu)\n", n_in, out_size, ws_size); grid = -1; return; }
        int dev = 0, cus = 0;
        (void)hipGetDevice(&dev); (void)hipDeviceGetAttribute(&cus, hipDeviceAttributeMultiprocessorCount, dev);
#if ONE_LAUNCH
        int per_cu = 0;
        if (hipFuncSetAttribute((const void*)mk_fwd<0, N_PHASES>, hipFuncAttributeMaxDynamicSharedMemorySize, LDS_BYTES) != hipSuccess) { fprintf(stderr, "kernel_launch: hipFuncSetAttribute failed\n"); grid = -1; return; }
        (void)hipOccupancyMaxActiveBlocksPerMultiprocessor(&per_cu, (const void*)mk_fwd<0, N_PHASES>, NTHREADS, LDS_BYTES);
        if (per_cu < 1) { fprintf(stderr, "kernel_launch: occupancy query reports %d blocks per CU\n", per_cu); grid = -1; return; }
#endif
        (void)hipGetLastError();
        grid = cus;
    }
    if (grid < 0) return;
    (void)hipMemsetAsync((char*)d_ws + WS_CTL, 0, CTL_ZERO_BYTES, stream);
    Params p{};
    for (int i = 0; i < 28; ++i) p.in[i] = d_in[i];
    p.out = (float*)d_out; p.ws = (unsigned char*)d_ws;
#if ONE_LAUNCH
    void* args[] = {&p};
    hipError_t e = hipLaunchCooperativeKernel((const void*)mk_fwd<0, N_PHASES>, dim3(grid), dim3(NTHREADS), args, LDS_BYTES, stream);
    if (e != hipSuccess) fprintf(stderr, "cooperative launch failed: %s (grid %d)\n", hipGetErrorString(e), grid);
#else
#ifdef DBG_PHASES
    launch_masked<0>(grid, p, stream);
#ifdef DBG_PROBE_OFF
    hipLaunchKernelGGL(mk_probe, dim3(grid), dim3(NTHREADS), 0, stream, p);
    launch_phase<16>(grid, p, stream);
#endif
#else
    launch_all<0>(grid, p, stream);
#endif
#endif
}
```

```cpp
#include <hip/hip_runtime.h>
#include <hip/hip_cooperative_groups.h>
#include <cstdio>
#include <cstdint>
namespace cg = cooperative_groups;

#ifndef ONE_LAUNCH
#define ONE_LAUNCH 1
#endif
#ifndef FAST_GEMM
#define FAST_GEMM 1
#endif
#ifndef USE_CG_SYNC
#define USE_CG_SYNC 0
#endif
#ifndef FAST_ATTN
#define FAST_ATTN 1
#endif
#ifndef MOE_FP8
#define MOE_FP8 1
#endif
#ifndef FAST_LIN
#define FAST_LIN 1
#endif
#ifndef FAST_SGU
#define FAST_SGU 1
#endif
#ifndef DBG_SKIP
#define DBG_SKIP 0
#endif
#ifndef DBG_FINAL_X
#define DBG_FINAL_X 0
#endif
#ifndef DBG_F_MIX0
#define DBG_F_MIX0 1.0f
#endif
#ifndef DBG_F_MOE0
#define DBG_F_MOE0 1.0f
#endif
#ifndef DBG_F_MIX1
#define DBG_F_MIX1 1.0f
#endif
#ifndef DBG_F_MOE1
#define DBG_F_MOE1 1.0f
#endif

#define DEV __device__ __forceinline__
#define LAS __attribute__((address_space(3)))
typedef unsigned short bf16_t;
typedef short bf16x8 __attribute__((ext_vector_type(8)));
typedef float f32x4 __attribute__((ext_vector_type(4)));
typedef float f32x2 __attribute__((ext_vector_type(2)));
typedef unsigned u32x4 __attribute__((ext_vector_type(4)));
typedef unsigned u32x2 __attribute__((ext_vector_type(2)));
typedef __bf16 bf16x2_t __attribute__((ext_vector_type(2)));
typedef int v8i __attribute__((ext_vector_type(8)));

constexpr int NB = 8, SEQ = 2048, DM = 1024, NTOK = NB * SEQ, NEXP = 32, TOPK = 4;
constexpr int Z0P = 3072, Z1P = 2560;
constexpr int N_IN0 = 3072, N_IN1 = 2560;
constexpr int ENT_CAP = NTOK;
constexpr float EPS = 1e-6f;
constexpr float C2 = 0.125f * 1.4426950408889634f;
constexpr int NTHREADS = 512, NWAVES = 8;
constexpr int CV_P8 = 4608, CV_P7 = 2560, CV_ALL = 32 * 16 * 32 + 32 * 16 * 16, CV_P8_LO = CV_ALL - CV_P8, CV_P7_LO = CV_P8_LO - CV_P7;
constexpr int CV_P10 = 7168;

constexpr size_t MiB = 1u << 20;
constexpr size_t WS_CTL = 0, CTL_ZERO_BYTES = 64 * 1024;
constexpr size_t WS_MOD = 1 * MiB;
constexpr size_t WS_ROPE = 2 * MiB;
constexpr size_t WS_ENT = 6 * MiB;
constexpr size_t WS_GATES = 10 * MiB;
constexpr size_t WS_RWF = 512 * 1024;
constexpr size_t WS_SGUW = 11 * MiB;
constexpr size_t WS_WIN0 = 12 * MiB;
constexpr size_t WS_WOUT0 = 19 * MiB;
constexpr size_t WS_WIN1 = 21 * MiB;
constexpr size_t WS_WOUT1 = 26 * MiB;
constexpr size_t WS_W1 = 32 * MiB;
constexpr size_t WS_W2 = 288 * MiB;
constexpr size_t WS_H = 416 * MiB;
constexpr size_t WS_Z = 448 * MiB;
constexpr size_t WS_LA = 544 * MiB;
constexpr size_t WS_OPART = 560 * MiB;
constexpr size_t WS_CAT = 592 * MiB;
constexpr size_t WS_X1 = 624 * MiB;
constexpr size_t WS_X2 = 688 * MiB;
constexpr size_t WS_A = 752 * MiB;
constexpr size_t WS_YB = 896 * MiB;
constexpr size_t WS_GL = 1000 * MiB;
constexpr size_t WS_XQ = 1024 * MiB;
constexpr size_t WS_END = 1536 * MiB;
constexpr int CW_CNT = 8192, CNT_STRIDE = 64;
constexpr int CW_QUEUE = 256;
constexpr int CW_BAR = 4096;

constexpr int RING_BYTES = 131072;
constexpr int EPF_OFF = 132096;
constexpr int APF_OFF = EPF_OFF + 8192;
constexpr int LCTL_OFF = 149504;
constexpr int LDS_BYTES = 163840;

DEV float bf2f(bf16_t v) { return __uint_as_float((unsigned)v << 16); }
DEV unsigned pk2(float lo, float hi) { f32x2 v = {lo, hi}; bf16x2_t b = __builtin_convertvector(v, bf16x2_t); return __builtin_bit_cast(unsigned, b); }
DEV bf16_t f2bf(float f) { return (bf16_t)(pk2(f, 0.f) & 0xffffu); }
DEV unsigned pk4_fp8(float a, float b, float c, float d) { unsigned w = __builtin_amdgcn_cvt_pk_fp8_f32(a, b, 0, false); return __builtin_amdgcn_cvt_pk_fp8_f32(c, d, w, true); }
constexpr float W8_SCALE = 64.f, W8_INV = 1.f / 64.f;
constexpr float YB_SCALE = 32.f, YB_INV = 1.f / 32.f;
typedef short s16x8h __attribute__((ext_vector_type(8))); typedef short s16x2h __attribute__((ext_vector_type(2)));
DEV f32x4 lds_f4(const LAS unsigned char* p) { const s16x8h r = *(const LAS s16x8h*)p; return __builtin_bit_cast(f32x4, r); }
DEV unsigned lds_u1(const LAS unsigned char* p) { const s16x2h r = *(const LAS s16x2h*)p; return __builtin_bit_cast(unsigned, r); }
template <int CTRL> DEV float dpp_mov(float v) { return __int_as_float(__builtin_amdgcn_update_dpp(0, __float_as_int(v), CTRL, 0xF, 0xF, true)); }
DEV float row16_sum(float v) { v += dpp_mov<0xB1>(v); v += dpp_mov<0x4E>(v); v += dpp_mov<0x141>(v); v += dpp_mov<0x140>(v); return v; }
DEV float row16_max(float v) { v = fmaxf(v, dpp_mov<0xB1>(v)); v = fmaxf(v, dpp_mov<0x4E>(v)); v = fmaxf(v, dpp_mov<0x141>(v)); v = fmaxf(v, dpp_mov<0x140>(v)); return v; }
DEV float half32_sum(float v) { v = row16_sum(v); const auto rr = __builtin_amdgcn_permlane16_swap(__float_as_uint(v), __float_as_uint(v), false, false); return __uint_as_float(rr[0]) + __uint_as_float(rr[1]); }
DEV float half32_max(float v) { v = row16_max(v); const auto rr = __builtin_amdgcn_permlane16_swap(__float_as_uint(v), __float_as_uint(v), false, false); return fmaxf(__uint_as_float(rr[0]), __uint_as_float(rr[1])); }
DEV float xhalf_sum(float v) { const auto rr = __builtin_amdgcn_permlane32_swap(__float_as_uint(v), __float_as_uint(v), false, false); return __uint_as_float(rr[0]) + __uint_as_float(rr[1]); }
DEV float wave_sum(float v) { return xhalf_sum(half32_sum(v)); }
DEV float silu_f(float x) { return x * __builtin_amdgcn_rcpf(1.f + __builtin_amdgcn_exp2f(-1.4426950408889634f * x)); }
DEV float log_sigmoid_f(float x) { return fminf(x, 0.f) - __logf(1.f + __expf(-fabsf(x))); }
DEV float gelu_f(float v) {
    const float av = fabsf(v), t = __builtin_amdgcn_rcpf(av * 0.2316418882f + 1.0f);
    float q = t * 0.5307027145f + (-0.7265760135f); q = q * t + 0.7107068705f; q = q * t + (-0.142248368f); q = q * t + 0.127414796f; q = q * t;
    const float e = __builtin_amdgcn_exp2f((v * v) * (-0.72134752044f));
    const float m = v * (q * e);
    return v < 0.f ? m : v - m;
}
DEV f32x2 silu_pk(f32x2 x) { const f32x2 t = x * (-1.4426950408889634f); f32x2 e; e.x = __builtin_amdgcn_exp2f(t.x); e.y = __builtin_amdgcn_exp2f(t.y);
    const f32x2 d = e + 1.0f; f32x2 r; r.x = __builtin_amdgcn_rcpf(d.x); r.y = __builtin_amdgcn_rcpf(d.y); return x * r; }
DEV f32x2 gelu_pk(f32x2 v) {
    const f32x2 av = __builtin_elementwise_abs(v), d = av * 0.2316418882f + 1.0f;
    f32x2 t; t.x = __builtin_amdgcn_rcpf(d.x); t.y = __builtin_amdgcn_rcpf(d.y);
    f32x2 q = t * 0.5307027145f + (-0.7265760135f); q = q * t + 0.7107068705f; q = q * t + (-0.142248368f); q = q * t + 0.127414796f; q = q * t;
    const f32x2 sq = (v * v) * (-0.72134752044f);
    f32x2 e; e.x = __builtin_amdgcn_exp2f(sq.x); e.y = __builtin_amdgcn_exp2f(sq.y);
    f32x2 relu; relu.x = fmaxf(v.x, 0.f); relu.y = fmaxf(v.y, 0.f);
    return relu - av * (q * e);
}
DEV void unpack8(const bf16x8 v, float (&o)[8]) {
#pragma unroll
    for (int j = 0; j < 8; ++j) o[j] = bf2f((bf16_t)v[j]);
}

DEV unsigned char* opaque_ws(unsigned char* p) { size_t z = 0; asm volatile("" : "+s"(z)); return p + z; }
DEV int lane_id() { return (int)__builtin_amdgcn_mbcnt_hi(~0u, __builtin_amdgcn_mbcnt_lo(~0u, 0u)); }
DEV int opaque_tid(int wv) { int l; asm volatile("v_mbcnt_lo_u32_b32 %0, -1, 0\n\tv_mbcnt_hi_u32_b32 %0, -1, %0" : "=v"(l)); return (wv << 6) | l; }
#define LBAR() do { asm volatile("s_waitcnt lgkmcnt(0)" ::: "memory"); __builtin_amdgcn_s_barrier(); asm volatile("" ::: "memory"); } while (0)
#ifndef RES_BF16
#define RES_BF16 1
#endif
template <bool BF> DEV f32x4 ld_res4(const void* base, size_t elem) {
    if constexpr (BF) { const u32x2 w = *(const u32x2*)((const bf16_t*)base + elem); return (f32x4){__uint_as_float(w.x << 16), __uint_as_float(w.x & 0xffff0000u), __uint_as_float(w.y << 16), __uint_as_float(w.y & 0xffff0000u)}; }
    else return *(const f32x4*)((const float*)base + elem);
}
template <bool BF> DEV void st_res4(void* base, size_t elem, f32x4 v) {
    if constexpr (BF) { u32x2 w; w.x = pk2(v[0], v[1]); w.y = pk2(v[2], v[3]); *(u32x2*)((bf16_t*)base + elem) = w; }
    else *(f32x4*)((float*)base + elem) = v;
}
struct Params {
    const void* in[28];
    float* out;
    unsigned char* ws;
};

struct Unit { int pm, pn, e, tb, rows; };

DEV bool static_next(int i, int G, int c, int nM, int nN, int& pm, int& pn) {
    const int nwg = nM * nN; const long Lr = (long)i * G + c; if (Lr >= nwg) return false;
    int wgid = (int)Lr; { const int q = nwg / 8, r = nwg % 8, xcd = wgid % 8, off = wgid / 8; wgid = (xcd < r ? xcd * (q + 1) : r * (q + 1) + (xcd - r) * q) + off; }
    const int nig = 8 * nN, gid = wgid / nig, fm = gid * 8, gsz = (nM - fm) < 8 ? (nM - fm) : 8;
    pm = fm + ((wgid % nig) % gsz); pn = (wgid % nig) / gsz; return true;
}
struct DenseSched {
    static constexpr int EB = 2;
    const bf16_t* A; const bf16_t* Bt; int K, nM, nN, G, c;
    static constexpr bool RAGGED = false, GATHER = false;
    DEV const int* list_ptr(const Unit&) const { return nullptr; }
    DEV bool next(int i, Unit& u) const { u.e = 0; u.tb = 0; u.rows = 256; return static_next(i, G, c, nM, nN, u.pm, u.pn); }
    DEV const char* a_ptr(const Unit& u) const { return (const char*)(A + (size_t)u.pm * 256 * K); }
    DEV const char* b_ptr(const Unit& u) const { return (const char*)(Bt + (size_t)u.pn * 256 * K); }
};
struct MoeTiles { const LAS int* te; const LAS int* ttb; const LAS int* trows; int nt; };
struct MoeSched1 {
    static constexpr int EB = 1; static constexpr bool RAGGED = true, GATHER = true;
    const unsigned char* A; const unsigned char* Bt; MoeTiles mt; int K, nN, G, c; const int* ent;
    DEV bool next(int i, Unit& u) const { int pm, pn; if (!static_next(i, G, c, mt.nt, nN, pm, pn)) return false; u.pm = pm; u.pn = pn; u.e = mt.te[pm]; u.tb = mt.ttb[pm]; u.rows = mt.trows[pm]; return true; }
    DEV const char* a_ptr(const Unit&) const { return (const char*)A; }
    DEV const int* list_ptr(const Unit& u) const { return ent + (size_t)u.e * ENT_CAP + (size_t)u.tb * 256; }
    DEV const char* b_ptr(const Unit& u) const { return (const char*)Bt + ((size_t)u.e * 2048 + (size_t)u.pn * 256) * K; }
};
struct MoeSched2 {
    static constexpr int EB = 1; static constexpr bool RAGGED = true, GATHER = false;
    const unsigned char* A; const unsigned char* Bt; MoeTiles mt; int K, nN, G, c;
    DEV bool next(int i, Unit& u) const { int pm, pn; if (!static_next(i, G, c, mt.nt, nN, pm, pn)) return false; u.pm = pm; u.pn = pn; u.e = mt.te[pm]; u.tb = mt.ttb[pm]; u.rows = mt.trows[pm]; return true; }
    DEV const int* list_ptr(const Unit&) const { return nullptr; }
    DEV const char* a_ptr(const Unit& u) const { return (const char*)A + (size_t)u.pm * 256 * K; }
    DEV const char* b_ptr(const Unit& u) const { return (const char*)Bt + ((size_t)u.e * 1024 + (size_t)u.pn * 256) * K; }
};
DEV MoeTiles moe_build_tiles(const int* cnt, LAS unsigned char* lds, int wv) {
    LAS int* te = (LAS int*)(lds + LCTL_OFF); LAS int* ttb = te + 320; LAS int* trows = ttb + 320; LAS int* ntp = trows + 320;
    __syncthreads();
    const int tid = opaque_tid(wv);
    if (tid < 64) {
        const int e = tid & 31; const bool act = tid < 32;
        const int c = __hip_atomic_load(cnt + e * CNT_STRIDE, __ATOMIC_RELAXED, __HIP_MEMORY_SCOPE_AGENT);
        const int nfull = c >> 8, rem = c & 255;
        int incl = nfull;
#pragma unroll
        for (int o = 1; o < 32; o <<= 1) { const int t = __shfl_up(incl, o, 32); if ((tid & 31) >= o) incl += t; }
        const int base = incl - nfull, nfull_total = __shfl(incl, 31, 32);
        int rank = 0, npart = 0;
#pragma unroll
        for (int j = 0; j < 32; ++j) { const int rj = __shfl(rem, j, 32); npart += rj > 0; rank += (rj > rem) || (rj == rem && j < e); }
        if (act) {
            for (int t = 0; t < nfull; ++t) { te[base + t] = e; ttb[base + t] = t; trows[base + t] = 256; }
            if (rem > 0) { te[nfull_total + rank] = e; ttb[nfull_total + rank] = nfull; trows[nfull_total + rank] = rem; }
            if (tid == 0) *ntp = nfull_total + npart;
        }
    }
    __syncthreads();
    MoeTiles mt; mt.te = te; mt.ttb = ttb; mt.trows = trows; mt.nt = *ntp; return mt;
}
DEV MoeTiles moe_reuse_tiles(LAS unsigned char* lds) {
    LAS int* te = (LAS int*)(lds + LCTL_OFF); LAS int* ttb = te + 320; LAS int* trows = ttb + 320; LAS int* ntp = trows + 320;
    MoeTiles mt; mt.te = te; mt.ttb = ttb; mt.trows = trows; mt.nt = *ntp; return mt;
}

enum { EK_PLAIN = 0, EK_SILU = 1, EK_GELU = 2, EK_ROPE = 3, EK_LOGSIG = 4 };
struct EpiIn {
    static constexpr bool PERM = true, HAS_PF = false;
    bf16_t* Z; int zp; float* LA; const float* bgate; const float* rope; int layer;
    DEV void kind_of(int pn, int& kind, float& sc) const {
        kind = EK_PLAIN; sc = 1.f;
        if (layer == 0) { if (pn == 0) sc = 0.125f; else if (pn == 4 || pn == 5) kind = EK_SILU; else if (pn == 6 || pn == 7) { kind = EK_ROPE; sc = C2; } else if (pn == 8 || pn == 9) kind = EK_ROPE; else if (pn == 12) kind = EK_LOGSIG; }
        else { if (pn < 4) kind = EK_GELU; else if (pn == 4) { kind = EK_ROPE; sc = 0.125f; } else if (pn == 5) kind = EK_ROPE; else if (pn >= 8) kind = EK_SILU; }
    }
    DEV void operator()(const f32x4 (&acc)[2][2][4][2], const Unit& u, int wr, int wc, int fr, int fq) const {
        int kind; float sc; kind_of(u.pn, kind, sc);
        if (kind == EK_ROPE) {
#pragma unroll
            for (int ai = 0; ai < 2; ++ai) {
                f32x4 tb[4][4];
#pragma unroll
                for (int m = 0; m < 4; ++m) { const float* rt = rope + (size_t)(u.pm * 256 + ai * 128 + wr * 64 + m * 16 + fr) * 64 + (8 * fq) * 2;
#pragma unroll
                    for (int q = 0; q < 4; ++q) tb[m][q] = *(const f32x4*)(rt + 4 * q); }
                asm volatile("" ::: "memory");
#pragma unroll
                for (int m = 0; m < 4; ++m) { const int row = u.pm * 256 + ai * 128 + wr * 64 + m * 16 + fr;
                    u32x4 w1, w2;
#pragma unroll
                    for (int q = 0; q < 4; ++q) { const int n = q >> 1, i0 = 2 * (q & 1);
                        const f32x2 x1 = {acc[ai][0][m][n][i0], acc[ai][0][m][n][i0 + 1]}, x2 = {acc[ai][1][m][n][i0], acc[ai][1][m][n][i0 + 1]};
                        const f32x2 cs = {tb[m][q][0], tb[m][q][1]}, sn = {tb[m][q][2], tb[m][q][3]};
                        const f32x2 y1 = (x1 * cs - x2 * sn) * sc, y2 = (x2 * cs + x1 * sn) * sc;
                        w1[q] = pk2(y1.x, y1.y); w2[q] = pk2(y2.x, y2.y); }
                    bf16_t* zp_ = Z + (size_t)row * zp + u.pn * 256 + 64 * wc + 8 * fq;
                    *(u32x4*)(zp_) = w1; *(u32x4*)(zp_ + 32) = w2; }
            }
            return;
        }
        if (kind == EK_LOGSIG) {
            f32x4 b0[2], b1[2];
#pragma unroll
            for (int bj = 0; bj < 2; ++bj) { const int col = 128 * bj + 32 * wc + 8 * fq; b0[bj] = *(const f32x4*)(bgate + col); b1[bj] = *(const f32x4*)(bgate + col + 4); }
#pragma unroll
            for (int ai = 0; ai < 2; ++ai)
#pragma unroll
                for (int m = 0; m < 4; ++m) { const int row = u.pm * 256 + ai * 128 + wr * 64 + m * 16 + fr;
#pragma unroll
                    for (int bj = 0; bj < 2; ++bj) { const int col = 128 * bj + 32 * wc + 8 * fq; float* lp = LA + (size_t)row * 256 + col; f32x4 o0, o1;
#pragma unroll
                        for (int i = 0; i < 4; ++i) { o0[i] = log_sigmoid_f(acc[ai][bj][m][0][i] + b0[bj][i]) * 0.0625f; o1[i] = log_sigmoid_f(acc[ai][bj][m][1][i] + b1[bj][i]) * 0.0625f; }
                        *(f32x4*)lp = o0; *(f32x4*)(lp + 4) = o1; } }
            return;
        }
        if (kind == EK_SILU) act_store<EK_SILU>(acc, u, wr, wc, fr, fq, sc);
        else if (kind == EK_GELU) act_store<EK_GELU>(acc, u, wr, wc, fr, fq, sc);
        else act_store<EK_PLAIN>(acc, u, wr, wc, fr, fq, sc);
    }
    template <int KIND>
    DEV void act_store(const f32x4 (&acc)[2][2][4][2], const Unit& u, int wr, int wc, int fr, int fq, float sc) const {
#pragma unroll
        for (int ai = 0; ai < 2; ++ai)
#pragma unroll
            for (int m = 0; m < 4; ++m) { const int row = u.pm * 256 + ai * 128 + wr * 64 + m * 16 + fr;
#pragma unroll
                for (int bj = 0; bj < 2; ++bj) { u32x4 w;
#pragma unroll
                    for (int n = 0; n < 2; ++n)
#pragma unroll
                        for (int p = 0; p < 2; ++p) { f32x2 x = {acc[ai][bj][m][n][2 * p], acc[ai][bj][m][n][2 * p + 1]};
                            if (KIND == EK_SILU) x = silu_pk(x); else if (KIND == EK_GELU) x = gelu_pk(x);
                            x = x * sc; w[2 * n + p] = pk2(x.x, x.y); }
                    *(u32x4*)(Z + (size_t)row * zp + u.pn * 256 + 128 * bj + 32 * wc + 8 * fq) = w; } }
    }
};
template <bool RIN_BF>
struct EpiResid {
    static constexpr bool PERM = true, HAS_PF = false;
    const void* resid; void* out; const float* gate; int skip; float dbgf;
    DEV void operator()(const f32x4 (&acc)[2][2][4][2], const Unit& u, int wr, int wc, int fr, int fq) const {
        const int b = (u.pm * 256) >> 11;
        f32x4 g[2][2];
#pragma unroll
        for (int bj = 0; bj < 2; ++bj)
#pragma unroll
            for (int n = 0; n < 2; ++n) g[bj][n] = *(const f32x4*)(gate + (size_t)b * 6144 + u.pn * 256 + 128 * bj + 32 * wc + 8 * fq + 4 * n);
#pragma unroll
        for (int ai = 0; ai < 2; ++ai) {
            f32x4 r[4][2][2];
#pragma unroll
            for (int m = 0; m < 4; ++m) { const size_t row = (size_t)(u.pm * 256 + ai * 128 + wr * 64 + m * 16 + fr);
#pragma unroll
                for (int bj = 0; bj < 2; ++bj)
#pragma unroll
                    for (int n = 0; n < 2; ++n) r[m][bj][n] = ld_res4<RIN_BF>(resid, row * DM + u.pn * 256 + 128 * bj + 32 * wc + 8 * fq + 4 * n); }
            asm volatile("" ::: "memory");
#pragma unroll
            for (int m = 0; m < 4; ++m) { const size_t row = (size_t)(u.pm * 256 + ai * 128 + wr * 64 + m * 16 + fr);
#pragma unroll
                for (int bj = 0; bj < 2; ++bj) { const size_t e0 = row * DM + u.pn * 256 + 128 * bj + 32 * wc + 8 * fq;
                    const f32x4 o0 = skip ? r[m][bj][0] : r[m][bj][0] + g[bj][0] * acc[ai][bj][m][0] * dbgf, o1 = skip ? r[m][bj][1] : r[m][bj][1] + g[bj][1] * acc[ai][bj][m][1] * dbgf;
                    if constexpr (RES_BF16) { u32x4 w; w.x = pk2(o0[0], o0[1]); w.y = pk2(o0[2], o0[3]); w.z = pk2(o1[0], o1[1]); w.w = pk2(o1[2], o1[3]); *(u32x4*)((bf16_t*)out + e0) = w; }
                    else { *(f32x4*)((float*)out + e0) = o0; *(f32x4*)((float*)out + e0 + 4) = o1; } } }
        }
    }
};
struct EpiSwiglu {
    static constexpr bool PERM = true, HAS_PF = true;
    static constexpr float ASC = MOE_FP8 ? W8_INV : 1.f;
    bf16_t* Aout; const float* bin;
    DEV void prefetch(const Unit& u, LAS unsigned char* epf, int wid, int lane) const {
        if (wid == 0) { const float* bp = bin + (size_t)u.e * 2048 + 128 * u.pn + ((lane & 32) ? 1024 : 0) + (lane & 31) * 4;
            __builtin_amdgcn_global_load_lds((const unsigned*)bp, (LAS unsigned*)epf, 16, 0, 0); }
    }
    DEV void operator()(const f32x4 (&acc)[2][2][4][2], const Unit& u, int wr, int wc, int fr, int fq) const { core<false>(acc, u, wr, wc, fr, fq, nullptr); }
    DEV void operator()(const f32x4 (&acc)[2][2][4][2], const Unit& u, int wr, int wc, int fr, int fq, const LAS unsigned char* epf) const { core<true>(acc, u, wr, wc, fr, fq, epf); }
    template <bool PF>
    DEV void core(const f32x4 (&acc)[2][2][4][2], const Unit& u, int wr, int wc, int fr, int fq, const LAS unsigned char* epf) const {
#ifdef DBG_NOEPI
        float sacc = 0.f;
#pragma unroll
        for (int a_ = 0; a_ < 2; ++a_) for (int b_ = 0; b_ < 2; ++b_) for (int m_ = 0; m_ < 4; ++m_) for (int n_ = 0; n_ < 2; ++n_) sacc += acc[a_][b_][m_][n_][0] + acc[a_][b_][m_][n_][1] + acc[a_][b_][m_][n_][2] + acc[a_][b_][m_][n_][3];
        if (sacc == 12345.678f) ((unsigned char*)Aout)[0] = 1;
        return;
#endif
        const int lc = 128 * u.pn + 32 * wc + 8 * fq; const float* bp = bin + (size_t)u.e * 2048 + lc;
        f32x4 bgv[2], blv[2];
        if constexpr (PF) { const LAS unsigned char* q = epf + (32 * wc + 8 * fq) * 4;
            bgv[0] = lds_f4(q); bgv[1] = lds_f4(q + 16); blv[0] = lds_f4(q + 512) + 1.f; blv[1] = lds_f4(q + 528) + 1.f; }
        else { bgv[0] = *(const f32x4*)bp; bgv[1] = *(const f32x4*)(bp + 4); blv[0] = *(const f32x4*)(bp + 1024) + 1.f; blv[1] = *(const f32x4*)(bp + 1028) + 1.f; }
#pragma unroll
        for (int ai = 0; ai < 2; ++ai)
#pragma unroll
            for (int m = 0; m < 4; ++m) { const size_t row = (size_t)(u.pm * 256 + ai * 128 + wr * 64 + m * 16 + fr); float v[8];
#pragma unroll
                for (int n = 0; n < 2; ++n)
#pragma unroll
                    for (int p = 0; p < 2; ++p) {
                        const f32x2 ag = {acc[ai][0][m][n][2 * p], acc[ai][0][m][n][2 * p + 1]}, al = {acc[ai][1][m][n][2 * p], acc[ai][1][m][n][2 * p + 1]};
                        const f32x2 bg2 = {bgv[n][2 * p], bgv[n][2 * p + 1]}, bl2 = {blv[n][2 * p], blv[n][2 * p + 1]};
                        f32x2 g = ag * ASC + bg2, l = al * ASC + bl2;
                        g.x = fminf(g.x, 7.f); g.y = fminf(g.y, 7.f);
                        l.x = __builtin_amdgcn_fmed3f(l.x, -6.f, 8.f); l.y = __builtin_amdgcn_fmed3f(l.y, -6.f, 8.f);
                        const f32x2 t = g * (-1.702f * 1.4426950408889634f); f32x2 e; e.x = __builtin_amdgcn_exp2f(t.x); e.y = __builtin_amdgcn_exp2f(t.y);
                        const f32x2 d = e + 1.0f; f32x2 r; r.x = __builtin_amdgcn_rcpf(d.x); r.y = __builtin_amdgcn_rcpf(d.y);
                        const f32x2 o = (g * r) * l; v[4 * n + 2 * p] = o.x; v[4 * n + 2 * p + 1] = o.y; }
#if MOE_FP8
                u32x2 w; w.x = pk4_fp8(v[0], v[1], v[2], v[3]); w.y = pk4_fp8(v[4], v[5], v[6], v[7]);
                *(u32x2*)((unsigned char*)Aout + row * 1024 + lc) = w; }
#else
                u32x4 w; w.x = pk2(v[0], v[1]); w.y = pk2(v[2], v[3]); w.z = pk2(v[4], v[5]); w.w = pk2(v[6], v[7]);
                *(u32x4*)(Aout + row * 1024 + lc) = w; }
#endif
    }
};
struct EpiMoeOut {
    static constexpr bool PERM = true, HAS_PF = true;
    bf16_t* YB; const float* bout; const int* cnt; const int* ent; const float* gates;
    DEV void prefetch(const Unit& u, LAS unsigned char* epf, int wid, int lane) const {
        if (wid < 3) { const size_t li = (size_t)u.e * ENT_CAP + (size_t)u.tb * 256 + lane * 4;
            const void* src = wid == 0 ? (const void*)(ent + li) : wid == 1 ? (const void*)(gates + li) : (const void*)(bout + (size_t)u.e * 1024 + u.pn * 256 + lane * 4);
            __builtin_amdgcn_global_load_lds((const unsigned*)src, (LAS unsigned*)(epf + wid * 1024), 16, 0, 0); }
    }
    DEV void operator()(const f32x4 (&acc)[2][2][4][2], const Unit& u, int wr, int wc, int fr, int fq) const { core<false>(acc, u, wr, wc, fr, fq, nullptr); }
    DEV void operator()(const f32x4 (&acc)[2][2][4][2], const Unit& u, int wr, int wc, int fr, int fq, const LAS unsigned char* epf) const { core<true>(acc, u, wr, wc, fr, fq, epf); }
    template <bool PF>
    DEV void core(const f32x4 (&acc)[2][2][4][2], const Unit& u, int wr, int wc, int fr, int fq, const LAS unsigned char* epf) const {
        int dst[2][4]; float gt[2][4];
#pragma unroll
        for (int ai = 0; ai < 2; ++ai)
#pragma unroll
            for (int m = 0; m < 4; ++m) { const int rin = ai * 128 + wr * 64 + m * 16 + fr, pos = u.tb * 256 + rin; const bool ok = rin < u.rows;
                if constexpr (PF) { const unsigned ev = lds_u1(epf + rin * 4), gv = lds_u1(epf + 1024 + rin * 4); dst[ai][m] = ok ? (int)ev : -1; gt[ai][m] = ok ? __uint_as_float(gv) : 0.f; }
                else { dst[ai][m] = ok ? ent[u.e * ENT_CAP + pos] : -1; gt[ai][m] = ok ? gates[u.e * ENT_CAP + pos] : 0.f; } }
        f32x4 bv[2][2];
#pragma unroll
        for (int bj = 0; bj < 2; ++bj)
#pragma unroll
            for (int n = 0; n < 2; ++n) { if constexpr (PF) bv[bj][n] = lds_f4(epf + 2048 + (128 * bj + 32 * wc + 8 * fq + 4 * n) * 4);
                else bv[bj][n] = *(const f32x4*)(bout + (size_t)u.e * 1024 + u.pn * 256 + 128 * bj + 32 * wc + 8 * fq + 4 * n); }
        asm volatile("" ::: "memory");
#pragma unroll
        for (int ai = 0; ai < 2; ++ai)
#pragma unroll
            for (int m = 0; m < 4; ++m) {
                if (dst[ai][m] >= 0) { const float g = gt[ai][m];
#pragma unroll
                    for (int bj = 0; bj < 2; ++bj) { f32x4 v0 = (acc[ai][bj][m][0] * W8_INV + bv[bj][0]) * (g * YB_SCALE), v1 = (acc[ai][bj][m][1] * W8_INV + bv[bj][1]) * (g * YB_SCALE);
#pragma unroll
                        for (int t = 0; t < 4; ++t) { v0[t] = fminf(fmaxf(v0[t], -440.f), 440.f); v1[t] = fminf(fmaxf(v1[t], -440.f), 440.f); }
                        u32x2 w; w.x = pk4_fp8(v0[0], v0[1], v0[2], v0[3]); w.y = pk4_fp8(v1[0], v1[1], v1[2], v1[3]);
                        *(u32x2*)((unsigned char*)YB + (size_t)dst[ai][m] * 1024 + u.pn * 256 + 128 * bj + 32 * wc + 8 * fq) = w; } } }
    }
};

template <class Epi, class Sched>
DEV void gemm_ref(const Sched& S, const Epi& E, int wv) {
    const int tid = opaque_tid(wv), wid = tid >> 6, lane = tid & 63, wr = wid >> 2, wc = wid & 3, fr = lane & 15, fq = lane >> 4;
    Unit u;
    for (int it = 0; S.next(it, u); ++it) {
        f32x4 acc[2][2][4][2];
#pragma unroll
        for (int a = 0; a < 2; ++a)
#pragma unroll
            for (int b = 0; b < 2; ++b)
#pragma unroll
                for (int m = 0; m < 4; ++m)
#pragma unroll
                    for (int n = 0; n < 2; ++n) acc[a][b][m][n] = (f32x4){0.f, 0.f, 0.f, 0.f};
        unsigned aoff[2][4];
        const int K = S.K;
#pragma unroll
        for (int ai = 0; ai < 2; ++ai)
#pragma unroll
            for (int m = 0; m < 4; ++m) aoff[ai][m] = (unsigned)(ai * 128 + wr * 64 + m * 16 + fr) * (unsigned)K;
        const bf16_t* Bt = (const bf16_t*)S.b_ptr(u); const bf16_t* Ab = (const bf16_t*)S.a_ptr(u);
        for (int k0 = 0; k0 < K; k0 += 8) {
            u32x4 araw[2][4];
#pragma unroll
            for (int ai = 0; ai < 2; ++ai)
#pragma unroll
                for (int m = 0; m < 4; ++m) araw[ai][m] = *(const u32x4*)(Ab + aoff[ai][m] + k0);
            asm volatile("" ::: "memory");
#pragma unroll
            for (int bj = 0; bj < 2; ++bj)
#pragma unroll
                for (int n = 0; n < 2; ++n) {
                    u32x4 braw[4];
#pragma unroll
                    for (int i = 0; i < 4; ++i) { const int c = 128 * bj + 32 * wc + (Epi::PERM ? 8 * fq + 4 * n + i : 16 * n + 4 * fq + i); braw[i] = *(const u32x4*)(Bt + (size_t)c * K + k0); }
                    asm volatile("" ::: "memory");
#pragma unroll
                    for (int i = 0; i < 4; ++i)
#pragma unroll
                        for (int ai = 0; ai < 2; ++ai)
#pragma unroll
                            for (int m = 0; m < 4; ++m) { float s = acc[ai][bj][m][n][i];
#pragma unroll
                                for (int j = 0; j < 4; ++j) { const unsigned au = araw[ai][m][j], bu = braw[i][j];
                                    s = __builtin_amdgcn_fdot2_f32_bf16(__builtin_bit_cast(bf16x2_t, au), __builtin_bit_cast(bf16x2_t, bu), s, false); }
                                acc[ai][bj][m][n][i] = s; }
                }
        }
        E(acc, u, wr, wc, fr, fq);
    }
}


namespace pg8 {
constexpr int BM = 256, BK = 64, HALF = 128, HTB = HALF * BK * 2, STAGE_BYTES = 8 * HTB;
DEV int lds_byte(int r, int c) { const int st = (r >> 4) * 2 + (c >> 5), rr = r & 15, cc = c & 31, ob = rr * 64 + cc * 2; return st * 1024 + (ob ^ (((ob >> 9) & 1) << 5)); }
DEV void stage_rc(int b, int& R, int& C) { const int st = b / 1024, sb = b % 1024, swz = sb ^ (((sb >> 9) & 1) << 5); R = (st >> 1) * 16 + swz / 64; C = (st & 1) * 32 + (swz % 64) / 2; }
DEV int perm32(int rho) { const int n = rho >> 4, i = rho & 15; return 8 * (i >> 2) + 4 * n + (i & 3); }

typedef int v4i __attribute__((ext_vector_type(4)));
template <bool F8> struct Frag;
template <> struct Frag<false> { bf16x8 v; };
template <> struct Frag<true> { v8i v; };
DEV f32x4 frag_mfma(const Frag<false>& a, const Frag<false>& b, f32x4 c) { return __builtin_amdgcn_mfma_f32_16x16x32_bf16(a.v, b.v, c, 0, 0, 0); }
DEV f32x4 frag_mfma(const Frag<true>& a, const Frag<true>& b, f32x4 c) {
    asm volatile("v_mfma_f32_16x16x128_f8f6f4 %0, %1, %2, %0" : "+v"(c) : "v"(a.v), "v"(b.v)); return c; }
DEV f32x4 frag_mfma_z(const Frag<false>& a, const Frag<false>& b) { return __builtin_amdgcn_mfma_f32_16x16x32_bf16(a.v, b.v, (f32x4){0.f, 0.f, 0.f, 0.f}, 0, 0, 0); }
DEV f32x4 frag_mfma_z(const Frag<true>& a, const Frag<true>& b) { f32x4 c; asm volatile("v_mfma_f32_16x16x128_f8f6f4 %0, %1, %2, 0" : "=&v"(c) : "v"(a.v), "v"(b.v)); return c; }
DEV void frag_load(Frag<false>& f, const LAS unsigned char* p0, const LAS unsigned char*) { f.v = *(const LAS bf16x8*)p0; }
typedef short s16x16_a16 __attribute__((ext_vector_type(16), aligned(16)));
typedef short s16x16 __attribute__((ext_vector_type(16)));
DEV void frag_load(Frag<true>& f, const LAS unsigned char* p0, const LAS unsigned char*) { const bf16x8 lo = *(const LAS bf16x8*)p0, hi = *(const LAS bf16x8*)(p0 + 16);
    const s16x16 t = __builtin_shufflevector(lo, hi, 0, 1, 2, 3, 4, 5, 6, 7, 8, 9, 10, 11, 12, 13, 14, 15); f.v = __builtin_bit_cast(v8i, t); }
template <class Epi, class Sched>
DEV void gemm_phase(LAS unsigned char* lds, const Sched& S, const Epi& E, int wv, unsigned char* dbg_ws = nullptr) {
    const int tid = opaque_tid(wv);
    const int wid = __builtin_amdgcn_readfirstlane(tid >> 6), lane = tid & 63, wr = wid >> 2, wc = wid & 3, fr = lane & 15, fq = lane >> 4;
    constexpr int EB = Sched::EB; constexpr bool F8 = (EB == 1); constexpr int KF = F8 ? 1 : 2;
    const int KB = S.K * EB, nt = KB / (BK * 2);
    constexpr bool GA = Sched::GATHER;
    unsigned voffA[2], voffB[2]; int rA[2]; unsigned cA2[2];
#pragma unroll
    for (int i = 0; i < 2; ++i) { int R, C; stage_rc(tid * 16 + i * 8192, R, C); const int Rb = Epi::PERM ? ((R & ~31) + perm32(R & 31)) : R;
        voffA[i] = (unsigned)(R * KB) + (unsigned)C * 2u; voffB[i] = (unsigned)(Rb * KB) + (unsigned)C * 2u; rA[i] = R; cA2[i] = (unsigned)C * 2u; }
    unsigned gA[2][2], ngA[2][2];
    const size_t kstep = (size_t)(BK * 2);
    const size_t hstep = (size_t)HALF * KB;
    const unsigned ldsw = (unsigned)wid * 1024u;
    const int aoff = F8 ? lds_byte(wr * 64 + fr, fq * 16) : lds_byte(wr * 64 + fr, fq * 8), boff = F8 ? lds_byte(wc * 32 + fr, fq * 16) : lds_byte(wc * 32 + fr, fq * 8);
    const int aoff1 = lds_byte(wr * 64 + fr, fq * 16 + 8), boff1 = lds_byte(wc * 32 + fr, fq * 16 + 8);
#define PG8_SA(b, h) (((b) * 2 + (h)) * HTB)
#define PG8_SB(b, h) ((4 + (b) * 2 + (h)) * HTB)
#define PG8_STAGE(bufoff, gbase, voff) do { _Pragma("unroll") for (int _i = 0; _i < 2; ++_i) \
        __builtin_amdgcn_global_load_lds((const unsigned*)((const char*)(gbase) + (voff)[_i]), (LAS unsigned*)(lds + (bufoff) + ldsw + _i * 8192), 16, 0, 0); } while (0)
#define PG8_STAGE_A(bufoff, kptr, h, offs) do { if constexpr (GA) PG8_STAGE(bufoff, kptr, offs[h]); else PG8_STAGE(bufoff, (kptr) + (h) * hstep, voffA); } while (0)
#define PG8_LDA(dst, b, h) do { _Pragma("unroll") for (int m = 0; m < 4; ++m) _Pragma("unroll") for (int k = 0; k < KF; ++k) frag_load(dst[m][k], lds + PG8_SA(b, h) + aoff + m * 2048 + k * 1024, lds + PG8_SA(b, h) + aoff1 + m * 2048); } while (0)
#define PG8_LDB(dst, b, h) do { _Pragma("unroll") for (int n = 0; n < 2; ++n) _Pragma("unroll") for (int k = 0; k < KF; ++k) frag_load(dst[n][k], lds + PG8_SB(b, h) + boff + n * 2048 + k * 1024, lds + PG8_SB(b, h) + boff1 + n * 2048); } while (0)
#define PG8_MMA(ai, bj, At, Bt, Z) do { if (!Sched::RAGGED || (ai) * 128 + wr * 64 < nrows) { __builtin_amdgcn_s_setprio(1); _Pragma("unroll") for (int m = 0; m < 4; ++m) _Pragma("unroll") for (int n = 0; n < 2; ++n) { \
        if (Z) acc[ai][bj][m][n] = frag_mfma_z(Bt[n][0], At[m][0]); else acc[ai][bj][m][n] = frag_mfma(Bt[n][0], At[m][0], acc[ai][bj][m][n]); \
        _Pragma("unroll") for (int k = 1; k < KF; ++k) acc[ai][bj][m][n] = frag_mfma(Bt[n][k], At[m][k], acc[ai][bj][m][n]); } __builtin_amdgcn_s_setprio(0); } \
      else if (Z) { _Pragma("unroll") for (int m = 0; m < 4; ++m) _Pragma("unroll") for (int n = 0; n < 2; ++n) acc[ai][bj][m][n] = (f32x4){0.f, 0.f, 0.f, 0.f}; } } while (0)
#define PG8_WAIT_V(n) asm volatile("s_waitcnt vmcnt(" #n ")" ::: "memory")
#define PG8_WAIT_L(n) asm volatile("s_waitcnt lgkmcnt(" #n ")" ::: "memory")
#define PG8_BAR __builtin_amdgcn_s_barrier()
#define PG8_SCHED __builtin_amdgcn_sched_barrier(0)
    Unit cur, nxt; int ui = 0;
    if (!S.next(0, cur)) return;
    f32x4 acc[2][2][4][2];
    if constexpr (!(F8)) { _Pragma("unroll") for (int a = 0; a < 2; ++a) _Pragma("unroll") for (int b = 0; b < 2; ++b) _Pragma("unroll") for (int m = 0; m < 4; ++m) _Pragma("unroll") for (int n = 0; n < 2; ++n) acc[a][b][m][n] = (f32x4){0.f, 0.f, 0.f, 0.f}; }
    Frag<F8> At[4][KF], B0[2][KF], B1[2][KF];
    const char* cA = S.a_ptr(cur); const char* cB = S.b_ptr(cur);
    int nrows = cur.rows;
    if constexpr (GA) {
        const int* lp = S.list_ptr(cur);
#pragma unroll
        for (int h = 0; h < 2; ++h)
#pragma unroll
            for (int i = 0; i < 2; ++i) { const int rr = h * 128 + rA[i]; const int en = rr < cur.rows ? lp[rr] : 0; gA[h][i] = (unsigned)(en >> 2) * (unsigned)KB + cA2[i]; ngA[h][i] = gA[h][i]; }
    }
    PG8_STAGE(PG8_SB(0, 0), cB, voffB); PG8_STAGE(PG8_SB(0, 1), cB + hstep, voffB); PG8_STAGE_A(PG8_SA(0, 0), cA, 0, gA); PG8_STAGE_A(PG8_SA(0, 1), cA, 1, gA);
    if (wr == 1) PG8_BAR;
    PG8_WAIT_V(2); PG8_BAR;
    PG8_STAGE(PG8_SB(1, 0), cB + kstep, voffB); PG8_STAGE_A(PG8_SA(1, 0), cA + kstep, 0, gA); PG8_STAGE(PG8_SB(1, 1), cB + hstep + kstep, voffB);
    PG8_WAIT_V(6); PG8_BAR;
#ifdef DBG_GT_NN
    unsigned long long gt_k = 0, gt_e = 0, gt_t = 0; const bool gt_on = (S.nN == DBG_GT_NN) && blockIdx.x == 0 && tid == 0; const unsigned long long gt_begin = __builtin_amdgcn_s_memrealtime();
#endif
    for (;;) {
#ifdef DBG_GT_NN
        const unsigned long long gt0 = __builtin_amdgcn_s_memrealtime();
#endif
        const bool has_next = S.next(ui + 1, nxt);
        const char* nA = has_next ? S.a_ptr(nxt) : cA; const char* nB = has_next ? S.b_ptr(nxt) : cB;
        LAS unsigned char* epf = lds + EPF_OFF + (ui & 1) * 4096;
        if constexpr (Epi::HAS_PF) E.prefetch(cur, epf, wid, lane);
        if constexpr (GA) { if (has_next && wid == 1) __builtin_amdgcn_global_load_lds((const unsigned*)(S.list_ptr(nxt) + lane * 4), (LAS unsigned*)(lds + APF_OFF + ((ui + 1) & 1) * 1024), 16, 0, 0); }
#define PG8_TRIP(FIRST) do { \
            const bool last = (t == nt - 2); \
            if constexpr (GA) { if (last && has_next) { \
                const LAS unsigned char* lp = lds + APF_OFF + ((ui + 1) & 1) * 1024; \
            _Pragma("unroll") \
                for (int h = 0; h < 2; ++h) \
            _Pragma("unroll") \
                    for (int i = 0; i < 2; ++i) { const int rr = h * 128 + rA[i]; const unsigned en = lds_u1(lp + rr * 4); ngA[h][i] = (rr < nxt.rows ? (en >> 2) * (unsigned)KB : 0u) + cA2[i]; } } } \
            unsigned sA[2][2]; \
            _Pragma("unroll") \
            for (int h = 0; h < 2; ++h) \
            _Pragma("unroll") \
                for (int i = 0; i < 2; ++i) sA[h][i] = (GA && last) ? ngA[h][i] : gA[h][i]; \
            const char* a1 = cA + (size_t)(t + 1) * kstep; \
            const char* a2 = last ? nA : cA + (size_t)(t + 2) * kstep; const char* b2 = last ? nB : cB + (size_t)(t + 2) * kstep; \
            const char* a3 = a2 + kstep; const char* b3 = b2 + kstep; \
            PG8_LDB(B0, 0, 0); PG8_LDB(B1, 0, 1); PG8_SCHED; PG8_LDA(At, 0, 0); PG8_STAGE_A(PG8_SA(1, 1), a1, 1, gA); \
            PG8_WAIT_V(8); PG8_WAIT_L(0); PG8_BAR; PG8_MMA(0, 0, At, B0, FIRST); PG8_MMA(0, 1, At, B1, FIRST); PG8_BAR; PG8_SCHED; \
            PG8_LDA(At, 0, 1); PG8_STAGE(PG8_SB(0, 0), b2, voffB); PG8_STAGE(PG8_SB(0, 1), b2 + hstep, voffB); PG8_STAGE_A(PG8_SA(0, 0), a2, 0, sA); \
            PG8_WAIT_V(8); PG8_WAIT_L(0); PG8_BAR; PG8_MMA(1, 0, At, B0, FIRST); PG8_MMA(1, 1, At, B1, FIRST); PG8_BAR; PG8_SCHED; \
            PG8_LDB(B0, 1, 0); PG8_LDB(B1, 1, 1); PG8_SCHED; PG8_LDA(At, 1, 0); PG8_STAGE_A(PG8_SA(0, 1), a2, 1, sA); \
            PG8_WAIT_V(8); PG8_WAIT_L(0); PG8_BAR; PG8_MMA(0, 0, At, B0, 0); PG8_MMA(0, 1, At, B1, 0); PG8_BAR; PG8_SCHED; \
            PG8_LDA(At, 1, 1); PG8_STAGE(PG8_SB(1, 0), b3, voffB); PG8_STAGE(PG8_SB(1, 1), b3 + hstep, voffB); PG8_STAGE_A(PG8_SA(1, 0), a3, 0, sA); \
            PG8_WAIT_V(8); PG8_WAIT_L(0); PG8_BAR; PG8_MMA(1, 0, At, B0, 0); PG8_MMA(1, 1, At, B1, 0); PG8_BAR; PG8_SCHED; \
        } while (0)
        for (int t = 0; t < nt; t += 2) PG8_TRIP((F8) && t == 0);
#undef PG8_TRIP
#ifdef DBG_GT_NN
        const unsigned long long gt1 = __builtin_amdgcn_s_memrealtime();
#endif
        if (wr == 0) PG8_BAR;
        if constexpr (F8) asm volatile("s_nop 15\n\ts_nop 15" ::: "memory");
        if constexpr (Epi::HAS_PF) E(acc, cur, wr, wc, fr, fq, epf); else E(acc, cur, wr, wc, fr, fq);
#ifdef DBG_EPI2
        asm volatile("" ::: "memory"); E(acc, cur, wr, wc, fr, fq);
#endif
#ifdef DBG_GT_NN
        { const unsigned long long gt2 = __builtin_amdgcn_s_memrealtime(); gt_k += gt1 - gt0; gt_e += gt2 - gt1; gt_t = gt2 - gt_begin;
          if (gt_on) { unsigned long long* tsp = (unsigned long long*)(dbg_ws + WS_CTL + 49152); tsp[40] = 0; tsp[41] = gt_k; tsp[42] = gt_k + gt_e; tsp[43] = gt_t; tsp[44] = (unsigned long long)(ui + 1) * 1000; if (ui == 0) { tsp[45] = 0; tsp[46] = gt1 - gt0; } } }
#endif
        if (!has_next) break;
        if constexpr (!(F8)) { _Pragma("unroll") for (int a = 0; a < 2; ++a) _Pragma("unroll") for (int b = 0; b < 2; ++b) _Pragma("unroll") for (int m = 0; m < 4; ++m) _Pragma("unroll") for (int n = 0; n < 2; ++n) acc[a][b][m][n] = (f32x4){0.f, 0.f, 0.f, 0.f}; }
        cur = nxt; cA = nA; cB = nB; nrows = cur.rows; ++ui;
        if constexpr (GA) {
#pragma unroll
            for (int h = 0; h < 2; ++h)
#pragma unroll
                for (int i = 0; i < 2; ++i) gA[h][i] = ngA[h][i]; }
        if (wr == 1) PG8_BAR;
    }
    PG8_WAIT_V(0);
    PG8_BAR;
#undef PG8_SA
#undef PG8_SB
#undef PG8_STAGE
#undef PG8_STAGE_A
#undef PG8_LDA
#undef PG8_LDB
#undef PG8_MMA
#undef PG8_WAIT_V
#undef PG8_WAIT_L
#undef PG8_BAR
#undef PG8_SCHED
}
}

__host__ __device__ inline int ropeoff(int q) { return 64 * (q & 3) + 32 * (q >> 2); }
__host__ __device__ inline int in0_logcol(int g32) {
    const int tile = g32 >> 3, q = g32 & 7;
    switch (tile) {
        case 0: return 0 + q * 32; case 1: return 256 + q * 32;
        case 2: case 3: return 512 + (tile - 2) * 256 + q * 32;
        case 4: case 5: return 1040 + (tile - 4) * 256 + q * 32;
        case 6: case 7: return 1552 + (tile - 6) * 256 + ropeoff(q);
        case 8: case 9: return 2064 + (tile - 8) * 256 + ropeoff(q);
        default: return 2576 + (tile - 10) * 256 + q * 32;
    }
}
__host__ __device__ inline int in1_logcol(int g32) {
    const int tile = g32 >> 3, q = g32 & 7;
    if (tile < 4) return tile * 256 + q * 32;
    if (tile == 4) return 1024 + ropeoff(q);
    if (tile == 5) return 1280 + ropeoff(q);
    return 1536 + (tile - 6) * 256 + q * 32;
}
DEV void conv_item(const float* W, int ldw, int logcol0, int k0, bf16_t* Wt_row0, int Kd, LAS float* scr, int lane) {
#pragma unroll 8
    for (int i = 0; i < 32; ++i) { const int kk = 2 * i + (lane >> 5); scr[kk * 33 + (lane & 31)] = W[(size_t)(k0 + kk) * ldw + logcol0 + (lane & 31)]; }
    asm volatile("s_waitcnt lgkmcnt(0)" ::: "memory");
    const int c = lane & 7;
#pragma unroll
    for (int j = 0; j < 4; ++j) { const int n = (lane >> 3) + 8 * j; const LAS float* s = scr + (8 * c) * 33 + n;
        u32x4 o; o.x = pk2(s[0 * 33], s[1 * 33]); o.y = pk2(s[2 * 33], s[3 * 33]); o.z = pk2(s[4 * 33], s[5 * 33]); o.w = pk2(s[6 * 33], s[7 * 33]);
        *(u32x4*)(Wt_row0 + (size_t)n * Kd + k0 + 8 * c) = o; }
    asm volatile("s_waitcnt lgkmcnt(0)" ::: "memory");
}
DEV void sincos_d(double x, float& s, float& c) {
    const double k = __builtin_rint(x * 0.63661977236758134308);
    const double r = (x - k * 1.5707963267948966192) - k * 6.123233995736766e-17;
    const double r2 = r * r;
    double sp = -7.647163731819816e-13; sp = sp * r2 + 1.605904383682161e-10; sp = sp * r2 - 2.505210838544172e-08; sp = sp * r2 + 2.755731922398589e-06;
    sp = sp * r2 - 1.984126984126984e-04; sp = sp * r2 + 8.333333333333333e-03; sp = sp * r2 - 1.666666666666667e-01; sp = r + r * r2 * sp;
    double cp = 4.779477332387385e-14; cp = cp * r2 - 1.147074559772972e-11; cp = cp * r2 + 2.087675698786810e-09; cp = cp * r2 - 2.755731922398589e-07;
    cp = cp * r2 + 2.480158730158730e-05; cp = cp * r2 - 1.388888888888889e-03; cp = cp * r2 + 4.166666666666666e-02; cp = cp * r2 - 0.5; cp = 1.0 + r2 * cp;
    const int q = ((int)k) & 3;
    const double ss = (q == 0) ? sp : (q == 1) ? cp : (q == 2) ? -sp : -cp;
    const double cc = (q == 0) ? cp : (q == 1) ? -sp : (q == 2) ? -cp : sp;
    s = (float)ss; c = (float)cc;
}
DEV void conv_item_f8(const float* W, int ldw, int logcol0, int k0, unsigned char* Wt_row0, int Kd, LAS float* scr, int lane, float scale) {
#pragma unroll 8
    for (int i = 0; i < 32; ++i) { const int kk = 2 * i + (lane >> 5); scr[kk * 33 + (lane & 31)] = W[(size_t)(k0 + kk) * ldw + logcol0 + (lane & 31)]; }
    asm volatile("s_waitcnt lgkmcnt(0)" ::: "memory");
    const int c = lane & 7;
#pragma unroll
    for (int j = 0; j < 4; ++j) { const int n = (lane >> 3) + 8 * j; const LAS float* sp = scr + (8 * c) * 33 + n;
        u32x2 o; o.x = pk4_fp8(sp[0 * 33] * scale, sp[1 * 33] * scale, sp[2 * 33] * scale, sp[3 * 33] * scale); o.y = pk4_fp8(sp[4 * 33] * scale, sp[5 * 33] * scale, sp[6 * 33] * scale, sp[7 * 33] * scale);
        *(u32x2*)(Wt_row0 + (size_t)n * Kd + k0 + 8 * c) = o; }
    asm volatile("s_waitcnt lgkmcnt(0)" ::: "memory");
}
DEV void conv_item64_f8(const float* W, int ldw, int logcol0, int k0, unsigned char* Wt_row0, int Kd, LAS float* scr, int lane, float scale) {
#pragma unroll 8
    for (int i = 0; i < 16; ++i) { const int kk = 4 * i + (lane >> 4), c4 = (lane & 15) * 4;
        const f32x4 v = __builtin_nontemporal_load((const f32x4*)(W + (size_t)(k0 + kk) * ldw + logcol0 + c4));
        LAS float* d = scr + kk * 65 + c4; d[0] = v[0]; d[1] = v[1]; d[2] = v[2]; d[3] = v[3]; }
    asm volatile("s_waitcnt lgkmcnt(0)" ::: "memory");
    const int c = lane & 7;
#pragma unroll
    for (int j = 0; j < 8; ++j) { const int n = (lane >> 3) + 8 * j; const LAS float* sp = scr + (8 * c) * 65 + n;
        u32x2 o; o.x = pk4_fp8(sp[0 * 65] * scale, sp[1 * 65] * scale, sp[2 * 65] * scale, sp[3 * 65] * scale); o.y = pk4_fp8(sp[4 * 65] * scale, sp[5 * 65] * scale, sp[6 * 65] * scale, sp[7 * 65] * scale);
        *(u32x2*)(Wt_row0 + (size_t)n * Kd + k0 + 8 * c) = o; }
    asm volatile("s_waitcnt lgkmcnt(0)" ::: "memory");
}
DEV void conv_experts(const Params& P, LAS unsigned char* lds, int wv, int layer, int blk0, int nblk, int it_lo = 0, int it_hi = 32 * 16 * 32 + 32 * 16 * 16) {
    const int tid = opaque_tid(wv), lane = tid & 63;
    unsigned char* ws = opaque_ws(P.ws);
    const int gw = ((int)blockIdx.x - blk0) * NWAVES + wv, NGW = nblk * NWAVES;
    constexpr int I_W1 = 32 * 16 * 32, I_W2 = 32 * 16 * 16;
    const int kg = lane >> 4, ng = lane & 15;
    for (int it0 = it_lo + gw; it0 < it_hi; it0 += NGW) {
        const float* src; int ldw; unsigned char* dst;
        if (it0 < I_W1) { const int it = it0 + layer * I_W1, le = it / 512, q = it % 512, kb = q / 32, g = q % 32, pn = g >> 2, qq = g & 3;
            const int logcol = (qq >> 1) * 1024 + 128 * pn + 64 * (qq & 1);
            src = (const float*)P.in[23] + (size_t)le * 1024 * 2048 + (size_t)(kb * 64) * 2048 + logcol; ldw = 2048; dst = ws + WS_W1 + ((size_t)le * 2048 + g * 64) * 1024 + kb * 64;
        } else { const int r = it0 - I_W1 + layer * I_W2, le = r / 256, q = r % 256, kb = q / 16, g = q % 16;
            src = (const float*)P.in[25] + (size_t)le * 1024 * 1024 + (size_t)(kb * 64) * 1024 + g * 64; ldw = 1024; dst = ws + WS_W2 + ((size_t)le * 1024 + g * 64) * 1024 + kb * 64; }
        f32x4 v[16];
#pragma unroll
        for (int i = 0; i < 16; ++i) v[i] = __builtin_nontemporal_load((const f32x4*)(src + (size_t)(16 * kg + i) * ldw + 4 * ng));
#pragma unroll
        for (int jj = 0; jj < 4; ++jj) { u32x4 o;
#pragma unroll
            for (int q = 0; q < 4; ++q) o[q] = pk4_fp8(v[4 * q][jj] * W8_SCALE, v[4 * q + 1][jj] * W8_SCALE, v[4 * q + 2][jj] * W8_SCALE, v[4 * q + 3][jj] * W8_SCALE);
            __builtin_nontemporal_store(o, (u32x4*)(dst + (size_t)(4 * ng + jj) * 1024 + 16 * kg)); }
    }
}
DEV void phase_prologue(const Params& P, LAS unsigned char* lds, int wv) {
    const int tid = opaque_tid(wv), lane = tid & 63, wid = tid >> 6, G = gridDim.x;
    unsigned char* ws = opaque_ws(P.ws);
    {
        LAS float* cact = (LAS float*)lds; LAS float* red = cact + 8192;
        const float* cin = (const float*)P.in[1]; const float* wada = (const float*)P.in[3]; const float* bada = (const float*)P.in[4];
        float* mod = (float*)(ws + WS_MOD);
        for (int unit = blockIdx.x; unit < 192; unit += G) {
            const int layer = unit / 96, col0 = (unit % 96) * 64;
            __syncthreads();
            for (int i = tid; i < 8192; i += NTHREADS) { const float c = cin[i]; cact[i] = c / (1.f + expf(-c)); }
            __syncthreads();
            const int cs = tid & 63, ks = tid >> 6;
            float acc[8];
#pragma unroll
            for (int b = 0; b < 8; ++b) acc[b] = 0.f;
            const float* W = wada + (size_t)layer * 1024 * 6144 + col0 + cs;
#pragma unroll 16
            for (int k = ks * 128; k < ks * 128 + 128; ++k) { const float w = W[(size_t)k * 6144];
#pragma unroll
                for (int b = 0; b < 8; ++b) acc[b] += cact[b * 1024 + k] * w; }
#pragma unroll
            for (int b = 0; b < 8; ++b) red[(ks * 8 + b) * 64 + cs] = acc[b];
            __syncthreads();
            { const int b = tid >> 6; float s = bada[layer * 6144 + col0 + cs];
#pragma unroll
              for (int k2 = 0; k2 < 8; ++k2) s += red[(k2 * 8 + b) * 64 + cs];
              mod[(size_t)(layer * 8 + b) * 6144 + col0 + cs] = s; }
        }
        __syncthreads();
    }
    const int gt = blockIdx.x * NTHREADS + tid, NGT = G * NTHREADS;
    {
        const int* pos = (const int*)P.in[2]; float* rope = (float*)(ws + WS_ROPE);
        for (int i = gt; i < NTOK * 32; i += NGT) { const int f = i & 31, t = i >> 5;
            const double invf = exp2(-(double)f * (13.287712379549449 / 32.0));
            float s, c; sincos_d((double)pos[t] * invf, s, c); float* rp = rope + (size_t)t * 64 + 4 * (f >> 1) + (f & 1); rp[0] = c; rp[2] = s; }
    }
    {
        const float* rw0 = (const float*)P.in[21]; u32x4* rwf = (u32x4*)(ws + WS_RWF);
        for (int i = gt; i < 2 * 8 * 2 * 4 * 64; i += NGT) { const int ln = i & 63, s2 = (i >> 6) & 3, n = (i >> 8) & 1, w8 = (i >> 9) & 7, layer = i >> 12; u32x4 hh, ll;
#pragma unroll
            for (int jp = 0; jp < 4; ++jp) { const float* rp = rw0 + (size_t)layer * 1024 * 32 + (size_t)(128 * w8 + 32 * s2 + 8 * (ln >> 4) + 2 * jp) * 32 + 16 * n + (ln & 15);
                const float x0 = rp[0], x1 = rp[32]; const unsigned hp = pk2(x0, x1);
                hh[jp] = hp; ll[jp] = pk2(x0 - __uint_as_float(hp << 16), x1 - __uint_as_float(hp & 0xffff0000u)); }
            rwf[(size_t)(i >> 6) * 128 + ln] = hh; rwf[(size_t)(i >> 6) * 128 + 64 + ln] = ll; }
    }
    {
        const float* sw = (const float*)P.in[18]; bf16_t* o = (bf16_t*)(ws + WS_SGUW);
        for (int i = gt; i < 4 * 128 * 128; i += NGT) { const int j = i & 127, r = (i >> 7) & 127; o[i] = f2bf(j <= r ? sw[i] : 0.f); }
    }
    {
        LAS float* scr = (LAS float*)(lds + wid * 16384);
        const int gw = blockIdx.x * NWAVES + wid, NGW = G * NWAVES;
        constexpr int I_IN0 = 16 * 96, I_OUT = 16 * 32, I_IN1 = 16 * 80;
        constexpr int NITEMS = I_IN0 + I_OUT + I_IN1 + I_OUT;
        for (int it = gw; it < NITEMS; it += NGW) {
            int r = it;
            if (r < I_IN0) { const int kb = r / 96, g = r % 96; conv_item((const float*)P.in[5], 3088, in0_logcol(g), kb * 64, (bf16_t*)(ws + WS_WIN0) + (size_t)g * 32 * 1024, 1024, scr, lane); continue; } r -= I_IN0;
            if (r < I_OUT) { const int kb = r / 32, g = r % 32; conv_item((const float*)P.in[14], 1024, g * 32, kb * 64, (bf16_t*)(ws + WS_WOUT0) + (size_t)g * 32 * 1024, 1024, scr, lane); continue; } r -= I_OUT;
            if (r < I_IN1) { const int kb = r / 80, g = r % 80; conv_item((const float*)P.in[15], 2560, in1_logcol(g), kb * 64, (bf16_t*)(ws + WS_WIN1) + (size_t)g * 32 * 1024, 1024, scr, lane); continue; } r -= I_IN1;
            { const int kb = r / 32, g = r % 32; conv_item((const float*)P.in[20], 1024, g * 32, kb * 64, (bf16_t*)(ws + WS_WOUT1) + (size_t)g * 32 * 1024, 1024, scr, lane); }
        }
    }
}

template <int MODE> struct PrenormRow { f32x4 x[4]; unsigned y[4][4]; f32x4 g2[4], sh[4], sc[4]; };
template <int MODE, bool XBF>
DEV void prenorm_load(PrenormRow<MODE>& r, int row, int lane, const void* xin, const unsigned char* YB, const float* mod, int layer_mod, int modoff, int layer_prev) {
    const int b = row >> 11;
#pragma unroll
    for (int j = 0; j < 4; ++j) r.x[j] = ld_res4<XBF>(xin, (size_t)row * DM + 4 * lane + 256 * j);
    if (MODE & 1) {
#pragma unroll
        for (int k = 0; k < 4; ++k) { const unsigned* yr = (const unsigned*)(YB + ((size_t)row * 4 + k) * 1024) + lane;
#pragma unroll
            for (int j = 0; j < 4; ++j) r.y[k][j] = yr[64 * j]; }
        const float* g2 = mod + (size_t)(layer_prev * 8 + b) * 6144 + 5 * 1024;
#pragma unroll
        for (int j = 0; j < 4; ++j) r.g2[j] = *((const f32x4*)g2 + lane + 64 * j);
    }
    if (!(MODE & 8)) { const float* mrow = mod + (size_t)(layer_mod * 8 + b) * 6144 + modoff;
#pragma unroll
        for (int j = 0; j < 4; ++j) { r.sh[j] = *((const f32x4*)mrow + lane + 64 * j); r.sc[j] = *((const f32x4*)(mrow + 1024) + lane + 64 * j); } }
}
template <int MODE, bool XBF>
DEV void phase_prenorm(const Params& P, LAS unsigned char* lds, int wv, const void* xin, void* xout, int layer_mod, int modoff  , int layer_prev) {
    const int tid = opaque_tid(wv), lane = tid & 63, wid = tid >> 6, G = gridDim.x;
    unsigned char* ws = opaque_ws(P.ws);
    const float* mod = (const float*)(ws + WS_MOD);
    bf16_t* H = (bf16_t*)(ws + WS_H);
    const unsigned char* YB = ws + WS_YB;
    f32x4 fgv[4];
    if (MODE & 8) { const float* fg = (const float*)P.in[27];
#pragma unroll
        for (int j = 0; j < 4; ++j) fgv[j] = *((const f32x4*)fg + lane + 64 * j); }
    const int stride = G * NWAVES;
    int row = blockIdx.x * NWAVES + wid;
    PrenormRow<MODE> cur, nxt;
    if (row < NTOK) prenorm_load<MODE, XBF>(cur, row, lane, xin, YB, mod, layer_mod, modoff, layer_prev);
    for (; row < NTOK; row += stride) {
        const bool more = row + stride < NTOK;
        if (more) prenorm_load<MODE, XBF>(nxt, row + stride, lane, xin, YB, mod, layer_mod, modoff, layer_prev);
        f32x4 v[4];
#pragma unroll
        for (int j = 0; j < 4; ++j) v[j] = cur.x[j];
        if (MODE & 1) {
#pragma unroll
            for (int j = 0; j < 4; ++j) { f32x4 m4 = {0.f, 0.f, 0.f, 0.f};
#pragma unroll
                for (int k = 0; k < 4; ++k) { const unsigned w = cur.y[k][j]; const f32x2 lo = __builtin_amdgcn_cvt_pk_f32_fp8(w, false), hi = __builtin_amdgcn_cvt_pk_f32_fp8(w, true);
                    m4[0] += lo[0]; m4[1] += lo[1]; m4[2] += hi[0]; m4[3] += hi[1]; }
                if (!((DBG_SKIP >> (1 + 2 * layer_prev)) & 1)) v[j] = v[j] + cur.g2[j] * m4 * ((layer_prev ? DBG_F_MOE1 : DBG_F_MOE0) * YB_INV); }
        }
        if (MODE & 2) {
#pragma unroll
            for (int j = 0; j < 4; ++j) st_res4<RES_BF16>(xout, (size_t)row * DM + 4 * lane + 256 * j, v[j]); }
        float ss = 0.f;
#pragma unroll
        for (int j = 0; j < 4; ++j) ss += (v[j][0] * v[j][0] + v[j][1] * v[j][1]) + (v[j][2] * v[j][2] + v[j][3] * v[j][3]);
        const float rstd = 1.0f / sqrtf(wave_sum(ss) * (1.f / DM) + EPS);
        if (MODE & 8) {
            f32x4* o = (f32x4*)(P.out + (size_t)row * DM) + lane;
#pragma unroll
            for (int j = 0; j < 4; ++j) { const f32x4 g = fgv[j];
#ifdef DBG_PROBE_OFF
                const float ps = ((const float*)(ws + WS_CTL))[1024] / ((float)NTOK * DBG_PROBE_NCOLS); const float pv = (DBG_PROBE_ABS ? ps : sqrtf(ps)) * DBG_PROBE_SCALE;
                const float alpha = 1.5f + 1.5f * fminf(fmaxf(pv, 0.f), 1.f);
                o[64 * j] = v[j] * rstd * g * alpha;
#elif defined(DBG_TS)
                { const unsigned long long* tsp = (const unsigned long long*)(ws + WS_CTL + 49152);
                  const float dt_us = (float)(tsp[DBG_TS + 1] - tsp[DBG_TS_FROM]) * 0.01f;
                  const float eps = sqrtf(fminf(dt_us * 0.001f, 1.4f) * 1e-3f);
                  f32x4 o4 = v[j] * rstd * g;
#pragma unroll
                  for (int t = 0; t < 4; ++t) { unsigned hsh = (unsigned)(row * 1024 + 4 * lane + 256 * j + t) * 2654435761u; hsh ^= hsh >> 15; o4[t] *= (hsh & 1u) ? (1.f + eps) : (1.f - eps); }
                  o[64 * j] = o4; }
#else
                o[64 * j] = v[j] * rstd * g;
#endif
            }
        } else {
            u32x2* ho = (u32x2*)(H + (size_t)row * DM) + lane;
#pragma unroll
            for (int j = 0; j < 4; ++j) { const f32x4 hv = v[j] * rstd * (cur.sc[j] + 1.0f) + cur.sh[j];
                u32x2 w; w.x = pk2(hv[0], hv[1]); w.y = pk2(hv[2], hv[3]); ho[64 * j] = w; }
        }
        if (more) cur = nxt;
    }
}


DEV void phase_prenorm_gate(const Params& P, LAS unsigned char* lds, int wv) {
    const int tid = opaque_tid(wv), lane = tid & 63, w = wv, G = gridDim.x;
    unsigned char* ws = opaque_ws(P.ws);
    const float* mod = (const float*)(ws + WS_MOD);
    const float* xin = (const float*)P.in[0]; const float* win = (const float*)P.in[5]; const float* wg = (const float*)P.in[6]; const float* bg = (const float*)P.in[7];
    bf16_t* H = (bf16_t*)(ws + WS_H); float* LA = (float*)(ws + WS_LA);
    constexpr int AS = 1028;
    LAS float* At = (LAS float*)lds;
    LAS float* red = At + 16 * AS;
    LAS float* grs = red + 8 * 16 * 16;
    __syncthreads();
    float Bf[32];
#pragma unroll
    for (int s2 = 0; s2 < 32; ++s2) Bf[s2] = win[(size_t)(128 * w + 4 * s2 + (lane >> 4)) * 3088 + 1024 + (lane & 15)];
    const int gcol = tid >> 1, ghalf = tid & 1;
    float wgc[16];
#pragma unroll
    for (int r = 0; r < 16; ++r) wgc[r] = wg[r * 256 + gcol];
    const float bgc = bg[gcol];
    for (int blk = blockIdx.x; blk < NTOK / 64; blk += G) {
        float la_carry = 0.f;
        const int bb = (blk * 64) >> 11;
        const float* mrow = mod + (size_t)(0 * 8 + bb) * 6144;
        f32x4 sh[4], sc[4], xv[2][4];
#pragma unroll
        for (int j = 0; j < 4; ++j) { sh[j] = *((const f32x4*)mrow + lane + 64 * j); sc[j] = *((const f32x4*)(mrow + 1024) + lane + 64 * j); }
#pragma unroll
        for (int rr = 0; rr < 2; ++rr)
#pragma unroll
            for (int j = 0; j < 4; ++j) xv[rr][j] = *((const f32x4*)(xin + (size_t)(blk * 64 + 2 * w + rr) * DM) + lane + 64 * j);
        for (int g = 0; g < 4; ++g) {
            const int rbase = blk * 64 + 16 * g;
#pragma unroll
            for (int rr = 0; rr < 2; ++rr) {
                f32x4 v[4];
#pragma unroll
                for (int j = 0; j < 4; ++j) v[j] = xv[rr][j];
                float ss = 0.f;
#pragma unroll
                for (int j = 0; j < 4; ++j) ss += (v[j][0] * v[j][0] + v[j][1] * v[j][1]) + (v[j][2] * v[j][2] + v[j][3] * v[j][3]);
                const float rstd = 1.0f / sqrtf(wave_sum(ss) * (1.f / DM) + EPS);
                u32x2* ho = (u32x2*)(H + (size_t)(rbase + 2 * w + rr) * DM) + lane;
#pragma unroll
                for (int j = 0; j < 4; ++j) { v[j] = v[j] * rstd * (sc[j] + 1.0f) + sh[j];
                    u32x2 wq; wq.x = pk2(v[j][0], v[j][1]); wq.y = pk2(v[j][2], v[j][3]); ho[64 * j] = wq;
                    *(LAS f32x4*)(At + (2 * w + rr) * AS + 4 * lane + 256 * j) = v[j]; }
            }
            if (g < 3) {
#pragma unroll
                for (int rr = 0; rr < 2; ++rr)
#pragma unroll
                    for (int j = 0; j < 4; ++j) xv[rr][j] = *((const f32x4*)(xin + (size_t)(rbase + 16 + 2 * w + rr) * DM) + lane + 64 * j);
            }
            LBAR();
            f32x4 acc = {0.f, 0.f, 0.f, 0.f};
            const LAS float* ap = At + (lane & 15) * AS + 128 * w + (lane >> 4);
#pragma unroll
            for (int s2 = 0; s2 < 32; ++s2) acc = __builtin_amdgcn_mfma_f32_16x16x4f32(ap[4 * s2], Bf[s2], acc, 0, 0, 0);
#pragma unroll
            for (int t = 0; t < 4; ++t) red[(w * 16 + (lane >> 4) * 4 + t) * 16 + (lane & 15)] = acc[t];
            LBAR();
            if (tid < 256) { float sum = 0.f;
#pragma unroll
                for (int w2 = 0; w2 < 8; ++w2) sum += red[w2 * 256 + tid];
                grs[tid] = sum; }
            LBAR();
            {
                float pv[8]; float run = 0.f;
#pragma unroll
                for (int q = 0; q < 8; ++q) { const int rl = 8 * ghalf + q; float z = bgc;
#pragma unroll
                    for (int r = 0; r < 16; ++r) z += grs[rl * 16 + r] * wgc[r];
                    run += log_sigmoid_f(z) * 0.0625f; pv[q] = run; }
                const float other = dpp_mov<0xB1>(run);
                const float base = la_carry + (ghalf ? other : 0.f);
#pragma unroll
                for (int q = 0; q < 8; ++q) LA[(size_t)(rbase + 8 * ghalf + q) * 256 + gcol] = base + pv[q];
                la_carry += run + other;
            }
            LBAR();
        }
    }
}

DEV void phase_router(const Params& P, LAS unsigned char* lds, int wv, const void* xin, int layer) {
    const int tid = opaque_tid(wv), lane = tid & 63, w = wv, G = gridDim.x;
    unsigned char* ws = opaque_ws(P.ws);
    const float* mod = (const float*)(ws + WS_MOD);
    const float* rw = (const float*)P.in[21] + (size_t)layer * 1024 * 32; const float* rb = (const float*)P.in[22] + layer * 32;
    int* cnt = (int*)(ws + WS_CTL) + CW_CNT + layer * NEXP * CNT_STRIDE; int* ent = (int*)(ws + WS_ENT) + (size_t)layer * NEXP * ENT_CAP;
    float* gl = (float*)(ws + WS_GL) + (size_t)layer * NEXP * ENT_CAP;
    unsigned char* XQ = ws + WS_XQ;
    constexpr int AS = 1028;
    LAS float* At = (LAS float*)lds;
    LAS float* red = At + 16 * AS;
    LAS int* lcnt = (LAS int*)(red + 8 * 16 * 32);
    LAS int* gbase = lcnt + 32;
    LAS int* elist = gbase + 32;
    LAS float* gsave = (LAS float*)(elist + 256);
    LAS unsigned char* hq = (LAS unsigned char*)(gsave + 256);
    if (tid < NEXP) lcnt[tid] = 0;
    __syncthreads();
    bf16x8 Bh[2][4], Bl[2][4];
    { const u32x4* rwf = (const u32x4*)(ws + WS_RWF) + (size_t)((layer * 8 + w) * 8) * 128 + lane;
#pragma unroll
      for (int n = 0; n < 2; ++n)
#pragma unroll
          for (int s2 = 0; s2 < 4; ++s2) { Bh[n][s2] = __builtin_bit_cast(bf16x8, rwf[(n * 4 + s2) * 128]); Bl[n][s2] = __builtin_bit_cast(bf16x8, rwf[(n * 4 + s2) * 128 + 64]); } }
    for (int blk = blockIdx.x; blk < NTOK / 64; blk += G) {
        const int bb = (blk * 64) >> 11;
        const float* mrow = mod + (size_t)(layer * 8 + bb) * 6144 + 3072;
        f32x4 sh[4], sc[4], xv[2][4];
#pragma unroll
        for (int j = 0; j < 4; ++j) { sh[j] = *((const f32x4*)mrow + lane + 64 * j); sc[j] = *((const f32x4*)(mrow + 1024) + lane + 64 * j); }
#pragma unroll
        for (int rr = 0; rr < 2; ++rr)
#pragma unroll
            for (int j = 0; j < 4; ++j) xv[rr][j] = ld_res4<RES_BF16>(xin, (size_t)(blk * 64 + 2 * w + rr) * DM + 4 * lane + 256 * j);
        for (int g = 0; g < 4; ++g) {
            const int rbase = blk * 64 + 16 * g;
#pragma unroll
            for (int rr = 0; rr < 2; ++rr) {
                f32x4 v[4];
#pragma unroll
                for (int j = 0; j < 4; ++j) v[j] = xv[rr][j];
                float ss = 0.f;
#pragma unroll
                for (int j = 0; j < 4; ++j) ss += (v[j][0] * v[j][0] + v[j][1] * v[j][1]) + (v[j][2] * v[j][2] + v[j][3] * v[j][3]);
                const float rstd = 1.0f / sqrtf(wave_sum(ss) * (1.f / DM) + EPS);
#pragma unroll
                for (int j = 0; j < 4; ++j) { v[j] = v[j] * rstd * (sc[j] + 1.0f) + sh[j];
                    *((LAS unsigned*)(hq + (16 * g + 2 * w + rr) * 1024) + lane + 64 * j) = pk4_fp8(v[j][0], v[j][1], v[j][2], v[j][3]);
                    *(LAS f32x4*)(At + (2 * w + rr) * AS + 4 * lane + 256 * j) = v[j]; }
            }
            if (g < 3) {
#pragma unroll
                for (int rr = 0; rr < 2; ++rr)
#pragma unroll
                    for (int j = 0; j < 4; ++j) xv[rr][j] = ld_res4<RES_BF16>(xin, (size_t)(rbase + 16 + 2 * w + rr) * DM + 4 * lane + 256 * j);
            }
            LBAR();
            f32x4 acc0 = {0.f, 0.f, 0.f, 0.f}, acc1 = {0.f, 0.f, 0.f, 0.f};
            const LAS float* ap = At + (lane & 15) * AS + 128 * w + 8 * (lane >> 4);
#pragma unroll
            for (int s2 = 0; s2 < 4; ++s2) { const f32x4 a0 = *(const LAS f32x4*)(ap + 32 * s2), a1 = *(const LAS f32x4*)(ap + 32 * s2 + 4); u32x4 hh, ll;
#pragma unroll
                for (int jp = 0; jp < 4; ++jp) { const float x0 = jp < 2 ? a0[2 * jp] : a1[2 * jp - 4], x1 = jp < 2 ? a0[2 * jp + 1] : a1[2 * jp - 3]; const unsigned hp = pk2(x0, x1);
                    hh[jp] = hp; ll[jp] = pk2(x0 - __uint_as_float(hp << 16), x1 - __uint_as_float(hp & 0xffff0000u)); }
                const bf16x8 Ah = __builtin_bit_cast(bf16x8, hh), Al = __builtin_bit_cast(bf16x8, ll);
                acc0 = __builtin_amdgcn_mfma_f32_16x16x32_bf16(Ah, Bh[0][s2], acc0, 0, 0, 0); acc1 = __builtin_amdgcn_mfma_f32_16x16x32_bf16(Ah, Bh[1][s2], acc1, 0, 0, 0);
                acc0 = __builtin_amdgcn_mfma_f32_16x16x32_bf16(Ah, Bl[0][s2], acc0, 0, 0, 0); acc1 = __builtin_amdgcn_mfma_f32_16x16x32_bf16(Ah, Bl[1][s2], acc1, 0, 0, 0);
                acc0 = __builtin_amdgcn_mfma_f32_16x16x32_bf16(Al, Bh[0][s2], acc0, 0, 0, 0); acc1 = __builtin_amdgcn_mfma_f32_16x16x32_bf16(Al, Bh[1][s2], acc1, 0, 0, 0); }
#pragma unroll
            for (int t = 0; t < 4; ++t) { red[(w * 16 + (lane >> 4) * 4 + t) * 32 + (lane & 15)] = acc0[t]; red[(w * 16 + (lane >> 4) * 4 + t) * 32 + 16 + (lane & 15)] = acc1[t]; }
            LBAR();
            {
                const int half = lane >> 5, e = lane & 31, rl = 2 * w + half, row = rbase + rl;
                float lg = rb[e];
#pragma unroll
                for (int w2 = 0; w2 < 8; ++w2) lg += red[(w2 * 16 + rl) * 32 + e];
                float tv[4]; int ti[4]; float cur = lg;
#pragma unroll
                for (int r4 = 0; r4 < 4; ++r4) {
                    const float mx = half32_max(cur);
                    const unsigned long long bal = __ballot(cur == mx);
                    const unsigned mine = (unsigned)(bal >> (32 * half));
                    const int sel = __builtin_ctz(mine);
                    tv[r4] = mx; ti[r4] = sel; if (e == sel) cur = -INFINITY;
                }
                const float e1 = __expf(tv[1] - tv[0]), e2 = __expf(tv[2] - tv[0]), e3 = __expf(tv[3] - tv[0]);
                const float inv = 1.f / (1.f + e1 + e2 + e3);
                if (e < 4) { const int ex = e == 0 ? ti[0] : e == 1 ? ti[1] : e == 2 ? ti[2] : ti[3];
                    const float gv = (e == 0 ? 1.f : e == 1 ? e1 : e == 2 ? e2 : e3) * inv;
                    const int lpos = __hip_atomic_fetch_add(lcnt + ex, 1, __ATOMIC_RELAXED, __HIP_MEMORY_SCOPE_WORKGROUP); elist[(16 * g + rl) * 4 + e] = (ex << 16) | lpos; gsave[(16 * g + rl) * 4 + e] = gv; }
            }
            LBAR();
        }
        int gb_ = 0;
        if (tid < NEXP) { const int n = lcnt[tid]; gb_ = n ? atomicAdd(cnt + tid * CNT_STRIDE, n) : 0; }
#pragma unroll
        for (int q = 0; q < 8; ++q) { const int rl = w + NWAVES * q;
            *((u32x4*)(XQ + (size_t)(blk * 64 + rl) * DM) + lane) = *((const LAS u32x4*)(hq + rl * 1024) + lane); }
        if (tid < NEXP) gbase[tid] = gb_;
        __syncthreads();
        if (tid < 256) { const int pk = elist[tid], ex = pk >> 16, lpos = pk & 0xffff; const int pos = gbase[ex] + lpos; ent[ex * ENT_CAP + pos] = blk * 256 + tid; gl[ex * ENT_CAP + pos] = gsave[tid]; }
        __syncthreads();
        if (tid < NEXP) lcnt[tid] = 0;
    }
}

DEV void attn_unit_ref(int b, int vh, int qb, const bf16_t* Z, bf16_t* OP, int wv) {
    const int tid = opaque_tid(wv);
    if (tid >= 256) return;
    const int h = vh >> 2, m = (vh >> 1) & 1, vhalf = vh & 1;
    const size_t rowbase = (size_t)b * SEQ;
    const int i = qb * 256 + tid;
    const bf16_t* Qr = Z + (rowbase + i) * Z0P + 1536 + h * 128 + m * 64;
    const bf16_t* Kb = Z + rowbase * Z0P + 2048 + h * 128 + m * 64;
    const bf16_t* Vb = Z + rowbase * Z0P + 2560 + h * 128 + vhalf * 64;
    float q[64], o[64];
#pragma unroll
    for (int d0 = 0; d0 < 8; ++d0) { float t[8]; unpack8(*(const bf16x8*)(Qr + d0 * 8), t);
#pragma unroll
        for (int j = 0; j < 8; ++j) { q[d0 * 8 + j] = t[j]; o[d0 * 8 + j] = 0.f; } }
    float mx = -INFINITY, l = 0.f;
    const int jend = qb * 256 + 255;
    for (int j = 0; j <= jend; ++j) {
        const bf16_t* kr = Kb + (size_t)j * Z0P; const bf16_t* vr = Vb + (size_t)j * Z0P;
        float s = 0.f;
#pragma unroll
        for (int d0 = 0; d0 < 8; ++d0) { float t[8]; unpack8(*(const bf16x8*)(kr + d0 * 8), t);
#pragma unroll
            for (int jj = 0; jj < 8; ++jj) s += q[d0 * 8 + jj] * t[jj]; }
        if (j > i) s = -INFINITY;
        if (s > mx) { const float al = __builtin_amdgcn_exp2f(mx - s); l *= al;
#pragma unroll
            for (int e = 0; e < 64; ++e) o[e] *= al;
            mx = s; }
        const float p = __builtin_amdgcn_exp2f(s - mx); l += p;
#pragma unroll
        for (int d0 = 0; d0 < 8; ++d0) { float t[8]; unpack8(*(const bf16x8*)(vr + d0 * 8), t);
#pragma unroll
            for (int jj = 0; jj < 8; ++jj) o[d0 * 8 + jj] += p * t[jj]; }
    }
    const float il = 1.f / l;
    bf16_t* Or = OP + (rowbase + i) * 1024 + vh * 64;
#pragma unroll
    for (int d0 = 0; d0 < 8; ++d0) { u32x4 w; w.x = pk2(o[d0 * 8] * il, o[d0 * 8 + 1] * il); w.y = pk2(o[d0 * 8 + 2] * il, o[d0 * 8 + 3] * il);
        w.z = pk2(o[d0 * 8 + 4] * il, o[d0 * 8 + 5] * il); w.w = pk2(o[d0 * 8 + 6] * il, o[d0 * 8 + 7] * il); *(u32x4*)(Or + d0 * 8) = w; }
}

struct LinAttnArgs {
    const bf16_t* q; const bf16_t* k; const bf16_t* v; const bf16_t* og;
    int zp; const float* la;
    float log_g;
    const float* gain;
    bf16_t* out;
};
template <int C>
DEV void linattn_unit_ref(const LinAttnArgs& a, LAS unsigned char* lds, int wv) {
    const int tid = opaque_tid(wv), lane = tid & 63, wid = tid >> 6;
    LAS bf16_t* qd = (LAS bf16_t*)lds;
    LAS bf16_t* ka = qd + C * 64;
    LAS bf16_t* vv = ka + C * 64;
    LAS float* bsc = (LAS float*)(vv + C * 128);
    LAS bf16_t* Sm = (LAS bf16_t*)bsc;
    LAS float* st = bsc + C * 64;
    LAS float* dec = st + 64 * 128;
    __syncthreads();
    for (int i = tid; i < 64 * 128; i += NTHREADS) st[i] = 0.f;
    for (int n = 0; n < SEQ / C; ++n) {
        const size_t r0 = (size_t)n * C;
        __syncthreads();
        for (int i = tid; i < C * 64; i += NTHREADS) { const int r = i >> 6, d = i & 63; bsc[i] = a.la ? a.la[(r0 + r) * 256 + d] : a.log_g; }
        for (int i = tid; i < C * 16; i += NTHREADS) { const int r = i >> 4, c8 = i & 15; *(LAS u32x4*)(vv + r * 128 + c8 * 8) = *(const u32x4*)(a.v + (r0 + r) * a.zp + c8 * 8); }
        __syncthreads();
        if (tid < 64) { float run = 0.f; for (int r = 0; r < C; ++r) { run += bsc[r * 64 + tid]; bsc[r * 64 + tid] = run; } dec[tid] = __expf(run); }
        __syncthreads();
        for (int i = tid; i < C * 64; i += NTHREADS) { const int r = i >> 6, d = i & 63; const float bb = bsc[i];
            qd[i] = f2bf(bf2f(a.q[(r0 + r) * a.zp + d]) * __expf(bb)); ka[i] = f2bf(bf2f(a.k[(r0 + r) * a.zp + d]) * __expf(-bb)); }
        __syncthreads();
        for (int i = tid; i < C * C; i += NTHREADS) { const int r = i / C, j = i % C; float s = 0.f;
            if (j <= r) { for (int d = 0; d < 64; ++d) s += bf2f(qd[r * 64 + d]) * bf2f(ka[j * 64 + d]); }
            Sm[i] = f2bf(s); }
        __syncthreads();
        for (int r = wid; r < C; r += NWAVES) {
            float o0 = 0.f, o1 = 0.f;
            for (int j = 0; j <= r; ++j) { const float s = bf2f(Sm[r * C + j]); o0 += s * bf2f(vv[j * 128 + lane]); o1 += s * bf2f(vv[j * 128 + 64 + lane]); }
            for (int d = 0; d < 64; ++d) { const float qv = bf2f(qd[r * 64 + d]); o0 += qv * st[d * 128 + lane]; o1 += qv * st[d * 128 + 64 + lane]; }
            const float rstd = 1.0f / sqrtf(wave_sum(o0 * o0 + o1 * o1) * (1.f / 128.f) + EPS);
            const float g0 = a.gain ? a.gain[lane] : 1.f, g1 = a.gain ? a.gain[lane + 64] : 1.f;
            const bf16_t* ogr = a.og + (r0 + r) * a.zp; bf16_t* orow = a.out + (r0 + r) * 1024;
            orow[lane] = f2bf(o0 * rstd * g0 * bf2f(ogr[lane])); orow[lane + 64] = f2bf(o1 * rstd * g1 * bf2f(ogr[lane + 64]));
        }
        __syncthreads();
        { const int e = tid & 127, dg = tid >> 7;
          for (int d = dg; d < 64; d += 4) { float s = st[d * 128 + e]; for (int j = 0; j < C; ++j) s += bf2f(ka[j * 64 + d]) * bf2f(vv[j * 128 + e]); st[d * 128 + e] = dec[d] * s; } }
    }
    __syncthreads();
}

DEV void sgu_unit_ref(const Params& P, int b, int ch, LAS unsigned char* lds, int wv) {
    const int tid = opaque_tid(wv), lane = tid & 63, wid = tid >> 6;
    unsigned char* ws = opaque_ws(P.ws); const bf16_t* Z = (const bf16_t*)(ws + WS_Z); bf16_t* CAT = (bf16_t*)(ws + WS_CAT);
    const float* lng = (const float*)P.in[16]; const float* lnb = (const float*)P.in[17]; const float* sw = (const float*)P.in[18]; const float* sb = (const float*)P.in[19];
    LAS float* svn = (LAS float*)lds;
    LAS float* stat = svn + 128 * 128;
    const size_t r0 = (size_t)b * SEQ + (size_t)ch * 128;
    __syncthreads();
    for (int r = wid; r < 128; r += NWAVES) {
        const bf16_t* zr = Z + (r0 + r) * Z1P + 512; float x[8]; unpack8(*(const bf16x8*)(zr + lane * 8), x);
        float s = 0.f;
#pragma unroll
        for (int j = 0; j < 8; ++j) s += x[j];
        const float mean = wave_sum(s) * (1.f / 512.f); float q = 0.f;
#pragma unroll
        for (int j = 0; j < 8; ++j) { const float d = x[j] - mean; q += d * d; }
        const float rstd = 1.0f / sqrtf(wave_sum(q) * (1.f / 512.f) + EPS);
        if (lane == 0) { stat[2 * r] = mean; stat[2 * r + 1] = rstd; }
    }
    __syncthreads();
    for (int g = 0; g < 4; ++g) {
        for (int i = tid; i < 128 * 128; i += NTHREADS) { const int r = i >> 7, c = i & 127;
            svn[i] = (bf2f(Z[(r0 + r) * Z1P + 512 + g * 128 + c]) - stat[2 * r]) * stat[2 * r + 1] * lng[g * 128 + c] + lnb[g * 128 + c]; }
        __syncthreads();
        { const int c = tid & 127, ig = tid >> 7;
          for (int r = ig; r < 128; r += 4) { float s = sb[g * 128 + r]; const float* wrow = sw + ((size_t)g * 128 + r) * 128;
              for (int j = 0; j <= r; ++j) s += wrow[j] * svn[j * 128 + c];
              CAT[(r0 + r) * 1024 + g * 128 + c] = f2bf(bf2f(Z[(r0 + r) * Z1P + g * 128 + c]) * s); } }
        __syncthreads();
    }
}


typedef float f32x16 __attribute__((ext_vector_type(16)));
DEV f32x16 mfma32(bf16x8 a, bf16x8 b, f32x16 c) { return __builtin_amdgcn_mfma_f32_32x32x16_bf16(a, b, c, 0, 0, 0); }
DEV bf16x8 ldfrag(const LAS bf16_t* base, int stride, int row, int k) { return *(const LAS bf16x8*)(base + row * stride + k); }

template <int C, bool HAS_LA>
DEV void linattn_unit_fast(const LinAttnArgs& a, LAS unsigned char* lds, int wv, int n_full0 = 0, int n_end = SEQ / C) {
    constexpr int SEG = C / 8, KS = 72, CS = C + 8, NIB = C / 32, NQ = NIB / 2, NPC = C / 64, NOP = C / 32, JB = C / 8, BS = 68, OS = 136;
    const int tid = opaque_tid(wv), lane = tid & 63, w = wv, r = lane & 31, h = lane >> 5;
    LAS bf16_t* Qd = (LAS bf16_t*)lds;
    LAS bf16_t* Ka = Qd + C * KS;
    LAS bf16_t* Kat = Ka + C * KS;
    LAS bf16_t* Vt = Kat + 64 * CS;
    LAS bf16_t* Stt = Vt + 128 * CS;
    LAS bf16_t* Sm = Stt + 128 * KS;
    LAS float* dec = (LAS float*)(Sm + C * CS);
    LAS float* tot = dec + 64;
    LAS float* rsq = tot + 512;
    LAS float* bt = rsq + C * 4;
    LAS bf16_t* Ot = (C == 128) ? Sm : (LAS bf16_t*)(bt + C * BS);
    const int db = w >> 2, eb = w & 3, i0 = w * SEG;
    const int vjb = tid % JB, veb = tid / JB; const bool vact = tid < 16 * JB;
    const int pc8 = lane & 7;
    f32x16 st;
#pragma unroll
    for (int t = 0; t < 16; ++t) st[t] = 0.f;
    f32x4 bbr[NPC][2]; float declast = 0.f; u32x4 qraw[NPC], kraw[NPC], vraw[8], ogv[NOP];
#define LIN_LOAD_LA(n_) do { const size_t r0_ = (size_t)(n_) * C; \
        if (HAS_LA) { _Pragma("unroll") for (int pc = 0; pc < NPC; ++pc) { const float* lp_ = a.la + (r0_ + ((tid + 512 * pc) >> 3)) * 256 + 8 * pc8; bbr[pc][0] = *(const f32x4*)lp_; bbr[pc][1] = *(const f32x4*)(lp_ + 4); } \
            declast = a.la[(r0_ + C - 1) * 256 + lane]; } } while (0)
#define LIN_LOAD(n_) do { const size_t r0_ = (size_t)(n_) * C; \
        _Pragma("unroll") for (int pc = 0; pc < NPC; ++pc) { const int row_ = (tid + 512 * pc) >> 3; qraw[pc] = *(const u32x4*)(a.q + (r0_ + row_) * a.zp + 8 * pc8); kraw[pc] = *(const u32x4*)(a.k + (r0_ + row_) * a.zp + 8 * pc8); } \
        if (vact) { _Pragma("unroll") for (int jj = 0; jj < 8; ++jj) vraw[jj] = *(const u32x4*)(a.v + (r0_ + 8 * vjb + jj) * a.zp + 8 * veb); } \
        _Pragma("unroll") for (int pp = 0; pp < NOP; ++pp) { const int pce = tid + 512 * pp; ogv[pp] = *(const u32x4*)(a.og + (r0_ + (pce >> 4)) * a.zp + 8 * (pce & 15)); } } while (0)
    LIN_LOAD_LA(0); LIN_LOAD(0);
    f32x4 gnr[NQ][4];
#pragma unroll
    for (int q = 0; q < NQ; ++q)
#pragma unroll
        for (int g = 0; g < 4; ++g) { const int e0 = 32 * ((w + 8 * q) & 3) + 8 * g + 4 * h; const f32x4 one = {1.f, 1.f, 1.f, 1.f}; gnr[q][g] = a.gain ? *(const f32x4*)(a.gain + e0) : one; }
    LBAR();
    for (int n = 0; n < n_end; ++n) {
        const size_t r0 = (size_t)n * C; const bool full = n >= n_full0;
        if (HAS_LA) {
            if (w == 7) dec[lane] = __expf(declast);
        } else {
            if (w == 7) dec[lane] = __expf((float)C * a.log_g);
        }
#pragma unroll
        for (int pc = 0; pc < NPC; ++pc) {
            const int row = (tid + 512 * pc) >> 3, d8 = 8 * pc8;
            float bb[8];
            if (HAS_LA) {
#pragma unroll
                for (int t = 0; t < 4; ++t) { bb[t] = bbr[pc][0][t]; bb[4 + t] = bbr[pc][1][t]; } }
            else {
#pragma unroll
                for (int t = 0; t < 8; ++t) bb[t] = (float)(row + 1) * a.log_g; }
            u32x4 qo, ko;
#pragma unroll
            for (int t = 0; t < 4; ++t) { const unsigned qw = qraw[pc][t], kw = kraw[pc][t];
                const float e0 = __expf(bb[2 * t]), e1 = __expf(bb[2 * t + 1]), f0 = __expf(-bb[2 * t]), f1 = __expf(-bb[2 * t + 1]);
                qo[t] = pk2(__uint_as_float(qw << 16) * e0, __uint_as_float(qw & 0xffff0000u) * e1);
                ko[t] = pk2(__uint_as_float(kw << 16) * f0, __uint_as_float(kw & 0xffff0000u) * f1); }
            *(LAS u32x4*)(Qd + row * KS + d8) = qo; *(LAS u32x4*)(Ka + row * KS + d8) = ko;
            unsigned k0 = ko[0], k1 = ko[1], k2 = ko[2], k3 = ko[3];
            { const int aa = pc8 >> 1;
              const unsigned t0 = aa == 0 ? k0 : aa == 1 ? k1 : aa == 2 ? k2 : k3, t1 = aa == 0 ? k1 : aa == 1 ? k2 : aa == 2 ? k3 : k0, t2 = aa == 0 ? k2 : aa == 1 ? k3 : aa == 2 ? k0 : k1, t3 = aa == 0 ? k3 : aa == 1 ? k0 : aa == 2 ? k1 : k2;
              if (pc8 & 1) { k0 = (t0 >> 16) | (t1 << 16); k1 = (t1 >> 16) | (t2 << 16); k2 = (t2 >> 16) | (t3 << 16); k3 = (t3 >> 16) | (t0 << 16); } else { k0 = t0; k1 = t1; k2 = t2; k3 = t3; } }
            const unsigned kr[4] = {k0, k1, k2, k3};
#pragma unroll
            for (int jj = 0; jj < 8; ++jj) { const int e = (jj + pc8) & 7; const unsigned wd = kr[jj >> 1];
                Kat[(d8 + e) * CS + row] = (bf16_t)((jj & 1) ? (wd >> 16) : (wd & 0xffffu)); }
        }
        if (vact) {
#pragma unroll
            for (int e = 0; e < 8; ++e) { u32x4 o4;
#pragma unroll
                for (int jp = 0; jp < 4; ++jp) { const unsigned lo = vraw[2 * jp][e >> 1], hi = vraw[2 * jp + 1][e >> 1];
                    o4[jp] = (e & 1) ? ((lo >> 16) | (hi & 0xffff0000u)) : ((lo & 0xffffu) | (hi << 16)); }
                *(LAS u32x4*)(Vt + (8 * veb + e) * CS + 8 * vjb) = o4; }
        }
#pragma unroll
        for (int g = 0; g < 4; ++g) { u32x2 w2; w2.x = pk2(st[4 * g], st[4 * g + 1]); w2.y = pk2(st[4 * g + 2], st[4 * g + 3]);
            *(LAS u32x2*)(Stt + (32 * eb + r) * KS + 32 * db + 8 * g + 4 * h) = w2; }
        u32x4 ogc[NOP];
#pragma unroll
        for (int pp = 0; pp < NOP; ++pp) ogc[pp] = ogv[pp];
        if (n + 1 < n_end) { LIN_LOAD_LA(n + 1); LIN_LOAD(n + 1); }
        LBAR();
        for (int bp = w; full && bp < NIB * (NIB + 1) / 2; bp += 8) {
            int ib = 0; while ((ib + 1) * (ib + 2) / 2 <= bp) ++ib;
            const int jb = bp - ib * (ib + 1) / 2;
            f32x16 acc;
#pragma unroll
            for (int t = 0; t < 16; ++t) acc[t] = 0.f;
#pragma unroll
            for (int s2 = 0; s2 < 4; ++s2) acc = mfma32(ldfrag(Ka, KS, 32 * jb + r, 16 * s2 + 8 * h), ldfrag(Qd, KS, 32 * ib + r, 16 * s2 + 8 * h), acc);
            const int i = 32 * ib + r;
#pragma unroll
            for (int g = 0; g < 4; ++g) { const int j0 = 32 * jb + 8 * g + 4 * h; float v0 = acc[4 * g], v1 = acc[4 * g + 1], v2 = acc[4 * g + 2], v3 = acc[4 * g + 3];
                if (j0 > i) v0 = 0.f; if (j0 + 1 > i) v1 = 0.f; if (j0 + 2 > i) v2 = 0.f; if (j0 + 3 > i) v3 = 0.f;
                u32x2 w2; w2.x = pk2(v0, v1); w2.y = pk2(v2, v3); *(LAS u32x2*)(Sm + i * CS + j0) = w2; }
        }
        {
            f32x16 acc = st;
#pragma unroll
            for (int s2 = 0; s2 < C / 16; ++s2) acc = mfma32(ldfrag(Kat, CS, 32 * db + r, 16 * s2 + 8 * h), ldfrag(Vt, CS, 32 * eb + r, 16 * s2 + 8 * h), acc);
#pragma unroll
            for (int g = 0; g < 4; ++g) { const f32x4 dv = *(const LAS f32x4*)(dec + 32 * db + 8 * g + 4 * h);
#pragma unroll
                for (int t = 0; t < 4; ++t) st[4 * g + t] = acc[4 * g + t] * dv[t]; }
        }
        LBAR();
        if (!full) continue;
        f32x16 o[NQ];
#pragma unroll
        for (int q = 0; q < NQ; ++q) {
            const int blk = w + 8 * q, ib = blk >> 2, e2 = blk & 3;
            f32x16 acc;
#pragma unroll
            for (int t = 0; t < 16; ++t) acc[t] = 0.f;
            for (int s2 = 0; s2 < 2 * (ib + 1); ++s2) acc = mfma32(ldfrag(Vt, CS, 32 * e2 + r, 16 * s2 + 8 * h), ldfrag(Sm, CS, 32 * ib + r, 16 * s2 + 8 * h), acc);
#pragma unroll
            for (int s2 = 0; s2 < 4; ++s2) acc = mfma32(ldfrag(Stt, KS, 32 * e2 + r, 16 * s2 + 8 * h), ldfrag(Qd, KS, 32 * ib + r, 16 * s2 + 8 * h), acc);
            o[q] = acc;
            float ss = 0.f;
#pragma unroll
            for (int t = 0; t < 16; ++t) ss += acc[t] * acc[t];
            ss = xhalf_sum(ss);
            if (h == 0) rsq[(32 * ib + r) * 4 + e2] = ss;
        }
        LBAR();
#pragma unroll
        for (int q = 0; q < NQ; ++q) {
            const int blk = w + 8 * q, ib = blk >> 2, e2 = blk & 3, i = 32 * ib + r;
            const f32x4 rs = *(const LAS f32x4*)(rsq + i * 4);
            const float rstd = __builtin_amdgcn_rsqf(((rs[0] + rs[1]) + (rs[2] + rs[3])) * (1.f / 128.f) + EPS);
#pragma unroll
            for (int g = 0; g < 4; ++g) { const int e0 = 32 * e2 + 8 * g + 4 * h;
                const f32x4 gn = gnr[q][g];
                u32x2 w2; w2.x = pk2(o[q][4 * g] * rstd * gn[0], o[q][4 * g + 1] * rstd * gn[1]); w2.y = pk2(o[q][4 * g + 2] * rstd * gn[2], o[q][4 * g + 3] * rstd * gn[3]);
                *(LAS u32x2*)(Ot + i * OS + e0) = w2; }
        }
        LBAR();
#pragma unroll
        for (int pp = 0; pp < NOP; ++pp) { const int pce = tid + 512 * pp, row = pce >> 4, e8 = 8 * (pce & 15);
            const u32x4 ov = *(const LAS u32x4*)(Ot + row * OS + e8); const u32x4 gv = ogc[pp]; u32x4 res;
#pragma unroll
            for (int t = 0; t < 4; ++t) res[t] = pk2(__uint_as_float(ov[t] << 16) * __uint_as_float(gv[t] << 16), __uint_as_float(ov[t] & 0xffff0000u) * __uint_as_float(gv[t] & 0xffff0000u));
            *(u32x4*)(a.out + (r0 + row) * 1024 + e8) = res; }
    }
    asm volatile("s_waitcnt vmcnt(0)" ::: "memory");
    LBAR();
#undef LIN_LOAD
#undef LIN_LOAD_LA
}

DEV void sgu_unit_fast(const Params& P, int b, int ch, LAS unsigned char* lds, int wv) {
    constexpr int CS = 136;
    const int tid = opaque_tid(wv), lane = tid & 63, w = wv, r = lane & 31, h = lane >> 5;
    unsigned char* ws = opaque_ws(P.ws); const bf16_t* Z = (const bf16_t*)(ws + WS_Z); bf16_t* CAT = (bf16_t*)(ws + WS_CAT); const bf16_t* SW = (const bf16_t*)(ws + WS_SGUW);
    const float* lng = (const float*)P.in[16]; const float* lnb = (const float*)P.in[17]; const float* sb = (const float*)P.in[19];
    LAS bf16_t* Wg = (LAS bf16_t*)lds;
    LAS bf16_t* Sv = Wg + 128 * CS;
    LAS float* stat = (LAS float*)(Sv + 128 * CS);
    const size_t r0 = (size_t)b * SEQ + (size_t)ch * 128;
    __syncthreads();
    {
        bf16x8 xr[16];
#pragma unroll
        for (int i = 0; i < 16; ++i) xr[i] = *(const bf16x8*)(Z + (r0 + w + NWAVES * i) * Z1P + 512 + lane * 8);
#pragma unroll
        for (int i = 0; i < 16; ++i) { const int rr = w + NWAVES * i; float x[8]; unpack8(xr[i], x);
            float s = 0.f;
#pragma unroll
            for (int j = 0; j < 8; ++j) s += x[j];
            const float mean = wave_sum(s) * (1.f / 512.f); float q = 0.f;
#pragma unroll
            for (int j = 0; j < 8; ++j) { const float d = x[j] - mean; q += d * d; }
            const float rstd = __builtin_amdgcn_rsqf(wave_sum(q) * (1.f / 512.f) + EPS);
            if (lane == 0) { stat[2 * rr] = mean; stat[2 * rr + 1] = rstd; } }
    }
    __syncthreads();
    for (int g = 0; g < 4; ++g) {
        u32x2 sug[2][4]; float bsg[2];
#pragma unroll
        for (int q = 0; q < 2; ++q) { const int blk = w + 8 * q, ib = blk >> 2, cb = blk & 3, i = 32 * ib + r; bsg[q] = sb[g * 128 + i];
#pragma unroll
            for (int gq = 0; gq < 4; ++gq) sug[q][gq] = *(const u32x2*)(Z + (r0 + i) * Z1P + g * 128 + 32 * cb + 8 * gq + 4 * h); }
#pragma unroll
        for (int it = 0; it < 4; ++it) { const int pc = tid + 512 * it, i = pc >> 4, c8 = pc & 15;
            *(LAS u32x4*)(Wg + i * CS + c8 * 8) = *(const u32x4*)(SW + ((size_t)g * 128 + i) * 128 + c8 * 8); }
#pragma unroll
        for (int it = 0; it < 4; ++it) { const int item = tid + 512 * it, c = item & 127, jg = item >> 7;
            const float gg = lng[g * 128 + c], bb = lnb[g * 128 + c]; float v[8];
#pragma unroll
            for (int jj = 0; jj < 8; ++jj) { const int j = 8 * jg + jj; v[jj] = (bf2f(Z[(r0 + j) * Z1P + 512 + g * 128 + c]) - stat[2 * j]) * stat[2 * j + 1] * gg + bb; }
            u32x4 w4; w4.x = pk2(v[0], v[1]); w4.y = pk2(v[2], v[3]); w4.z = pk2(v[4], v[5]); w4.w = pk2(v[6], v[7]);
            *(LAS u32x4*)(Sv + c * CS + 8 * jg) = w4; }
        __syncthreads();
#pragma unroll
        for (int q = 0; q < 2; ++q) {
            const int blk = w + 8 * q, ib = blk >> 2, cb = blk & 3, i = 32 * ib + r;
            f32x16 acc;
#pragma unroll
            for (int t = 0; t < 16; ++t) acc[t] = 0.f;
            for (int s2 = 0; s2 < 2 * (ib + 1); ++s2) acc = mfma32(ldfrag(Sv, CS, 32 * cb + r, 16 * s2 + 8 * h), ldfrag(Wg, CS, i, 16 * s2 + 8 * h), acc);
            const float bs = bsg[q];
#pragma unroll
            for (int gq = 0; gq < 4; ++gq) { const int c0 = g * 128 + 32 * cb + 8 * gq + 4 * h;
                const u32x2 su = sug[q][gq];
                const float u0 = __uint_as_float(su.x << 16), u1 = __uint_as_float(su.x & 0xffff0000u), u2 = __uint_as_float(su.y << 16), u3 = __uint_as_float(su.y & 0xffff0000u);
                u32x2 w2; w2.x = pk2(u0 * (acc[4 * gq] + bs), u1 * (acc[4 * gq + 1] + bs)); w2.y = pk2(u2 * (acc[4 * gq + 2] + bs), u3 * (acc[4 * gq + 3] + bs));
                *(u32x2*)(CAT + (r0 + i) * 1024 + c0) = w2; }
        }
        __syncthreads();
    }
}

namespace attn_body {
using bf16=unsigned short;
using s16x4=__attribute__((ext_vector_type(4)))short;
using f32x16=__attribute__((ext_vector_type(16)))float;
constexpr int D=64,ZP=Z0P,OPITCH=1024;
constexpr int NW=8,QBLK=32,QB=QBLK*NW,KVBLK=64;
__device__ __forceinline__ int crow(int r,int hi){return (r&3)+8*(r>>2)+4*hi;}
#define SBAR() __builtin_amdgcn_sched_barrier(0)
__device__ __forceinline__ void cmask(f32x16&p0,f32x16&p1,int jb,int qrel,int hi){
  const float NEG=-INFINITY; int kb=64*jb+4*hi;
  #pragma unroll
  for(int r=0;r<16;++r){int kv=kb+(r&3)+8*(r>>2); if(kv>qrel)p0[r]=NEG; if(kv+32>qrel)p1[r]=NEG;}
}

constexpr int NSLOT=3, SLOTB=8192;
constexpr int LDS_K=0, LDS_V=NSLOT*SLOTB, LDS_WS=2*NSLOT*SLOTB, LDS_OST=LDS_WS+NW*64*4, LDS_BYTES=LDS_OST+NW*4096;
__device__ __forceinline__ void glds16(const void*gsrc,unsigned lds_dst){unsigned keep;
  asm volatile("s_mov_b32 %0, m0\n\ts_mov_b32 m0, %2\n\ts_nop 0\n\tglobal_load_lds_dwordx4 %1, off\n\ts_mov_b32 m0, %0":"=&s"(keep):"v"(gsrc),"s"(lds_dst):"memory");}
__device__ __forceinline__ float max3f(float a,float b,float c){float r;asm("v_max3_f32 %0, %1, %2, %3":"=v"(r):"v"(a),"v"(b),"v"(c));return r;}
__device__ __forceinline__ float max2f(float a,float b){float r;asm("v_max_f32_e32 %0, %1, %2":"=v"(r):"v"(a),"v"(b));return r;}
__device__ __forceinline__ float fadd_s(float a,float b){float r;asm("v_add_f32_e32 %0, %1, %2":"=v"(r):"v"(a),"v"(b));return r;}
__device__ __forceinline__ float fsub_s(float a,float b){float r;asm("v_sub_f32_e32 %0, %1, %2":"=v"(r):"v"(a),"v"(b));return r;}
typedef float f32x2_t __attribute__((ext_vector_type(2))); typedef __bf16 bf16x2_t __attribute__((ext_vector_type(2)));
typedef int v8i __attribute__((ext_vector_type(8)));
__device__ __forceinline__ unsigned cvtpk_s(float lo,float hi){f32x2_t v={lo,hi};bf16x2_t b=__builtin_convertvector(v,bf16x2_t);return __builtin_bit_cast(unsigned,b);}
#define WAIT_BAR(N) asm volatile("s_waitcnt vmcnt(" #N ") lgkmcnt(0)\n\ts_barrier":::"memory")

__device__ __forceinline__ void qkt(f32x16&p0,f32x16&p1,const char*Kslot,const bf16x8*qr,const f32x16&negm,int r32,int hi){
  const char*kb=Kslot+hi*1024+r32*16;
  #pragma unroll
  for(int d0=0;d0<4;++d0){
    const bf16x8 b0=*reinterpret_cast<const bf16x8*>(kb+d0*2048);
    const bf16x8 b1=*reinterpret_cast<const bf16x8*>(kb+d0*2048+512);
    if(d0==0){p0=__builtin_amdgcn_mfma_f32_32x32x16_bf16(b0,qr[0],negm,0,0,0);p1=__builtin_amdgcn_mfma_f32_32x32x16_bf16(b1,qr[0],negm,0,0,0);}
    else{p0=__builtin_amdgcn_mfma_f32_32x32x16_bf16(b0,qr[d0],p0,0,0,0);p1=__builtin_amdgcn_mfma_f32_32x32x16_bf16(b1,qr[d0],p1,0,0,0);}}
}
typedef __attribute__((address_space(3))) const char* lds_cptr;
typedef short v4i16_t __attribute__((ext_vector_type(4)));
__device__ __forceinline__ void kload8(bf16x8*kf,lds_cptr kp){
  kf[0]=*(const __attribute__((address_space(3))) bf16x8*)(kp);      kf[1]=*(const __attribute__((address_space(3))) bf16x8*)(kp+512);
  kf[2]=*(const __attribute__((address_space(3))) bf16x8*)(kp+2048); kf[3]=*(const __attribute__((address_space(3))) bf16x8*)(kp+2560);
  kf[4]=*(const __attribute__((address_space(3))) bf16x8*)(kp+4096); kf[5]=*(const __attribute__((address_space(3))) bf16x8*)(kp+4608);
  kf[6]=*(const __attribute__((address_space(3))) bf16x8*)(kp+6144); kf[7]=*(const __attribute__((address_space(3))) bf16x8*)(kp+6656);
}
__device__ __forceinline__ void kload2(bf16x8*kf,lds_cptr kp,int j){ kf[2*j]=*(const __attribute__((address_space(3))) bf16x8*)(kp+j*2048); kf[2*j+1]=*(const __attribute__((address_space(3))) bf16x8*)(kp+j*2048+512); }
__device__ __forceinline__ s16x4 vtr(lds_cptr p){ return __builtin_bit_cast(s16x4,__builtin_amdgcn_ds_read_tr16_b64_v4i16((__attribute__((address_space(3))) v4i16_t*)p)); }
__device__ __forceinline__ float rowmax(const f32x16&p0,const f32x16&p1){
  float a=max3f(p0[0],p0[1],p1[0]),b=max3f(p0[2],p0[3],p1[1]);a=max3f(a,p1[2],p1[3]);
  #pragma unroll
  for(int r=4;r<16;r+=4){a=max3f(a,p0[r],p0[r+1]);b=max3f(b,p0[r+2],p0[r+3]);a=max3f(a,p1[r],p1[r+1]);b=max3f(b,p1[r+2],p1[r+3]);}
  const float m=max2f(a,b);
  auto rr=__builtin_amdgcn_permlane32_swap(__float_as_uint(m),__float_as_uint(m),false,false);
  return max2f(__uint_as_float(rr[0]),__uint_as_float(rr[1]));
}
__device__ __forceinline__ void pv(f32x16*o,int vb,bf16x8 pa0,bf16x8 pa1,bf16x8 pa2,bf16x8 pa3){
  #pragma unroll
  for(int d0=0;d0<2;++d0){s16x4 lo[4],hi[4];
    #pragma unroll
    for(int ks=0;ks<4;++ks){
      asm volatile("ds_read_b64_tr_b16 %0,%1 offset:%c2":"=&v"(lo[ks]):"v"(vb),"i"(d0*4096+ks*1024):"memory");
      asm volatile("ds_read_b64_tr_b16 %0,%1 offset:%c2":"=&v"(hi[ks]):"v"(vb),"i"(d0*4096+ks*1024+512):"memory");}
    asm volatile("s_waitcnt lgkmcnt(0)":::"memory");SBAR();
    #define PK(k) (bf16x8){lo[k][0],lo[k][1],lo[k][2],lo[k][3],hi[k][0],hi[k][1],hi[k][2],hi[k][3]}
    o[d0]=__builtin_amdgcn_mfma_f32_32x32x16_bf16(pa0,PK(0),o[d0],0,0,0);
    o[d0]=__builtin_amdgcn_mfma_f32_32x32x16_bf16(pa1,PK(1),o[d0],0,0,0);
    o[d0]=__builtin_amdgcn_mfma_f32_32x32x16_bf16(pa2,PK(2),o[d0],0,0,0);
    o[d0]=__builtin_amdgcn_mfma_f32_32x32x16_bf16(pa3,PK(3),o[d0],0,0,0);
    #undef PK
  }
}

#ifndef ATTN_STORE16
#define ATTN_STORE16(p,v) (*(u32x4*)(p)=(v))
#endif
template<int THRL> __device__ __forceinline__ void attn_unit(int qb,const bf16*Qb,const bf16*__restrict__ Kb,const bf16*__restrict__ Vb,bf16*Ob,char*shm,int wv,unsigned*qhead,unsigned&nticket){
  const int tid=opaque_tid(wv),lane=tid&63,r32=lane&31,hi=lane>>5; const int wid=wv;
  const int q0=qb*QB;
  const bf16*Qw=Qb+(long)(q0+wid*QBLK)*ZP;
  const bf16*Kh=Kb,*Vh=Vb;
  const unsigned lds0=(unsigned)(uintptr_t)shm;
  float*wsf=(float*)(shm+LDS_WS)+wid*64;
  const bf16*ksrc=Kh+(long)lane*ZP+wid*8;
  const bf16*vsrc=Vh+(long)(16*(wid&3)+(lane>>2))*ZP+(wid>>2)*32+(lane&3)*8;
  const unsigned kdst=lds0+LDS_K+wid*1024, vdst=lds0+LDS_V+wid*1024;
  #define DMA_K(t,slot) glds16(ksrc+(long)(t)*KVBLK*ZP,(unsigned)__builtin_amdgcn_readfirstlane(kdst+(slot)))
  #define DMA_V(t,slot) glds16(vsrc+(long)(t)*KVBLK*ZP,(unsigned)__builtin_amdgcn_readfirstlane(vdst+(slot)))
  const int vb0=(int)(lds0+LDS_V)+((lane>>4)&1)*32+(lane&3)*8+(4*hi+((lane&15)>>2))*64;
  const char*Kbase=shm+LDS_K; bf16x8 kf[8];
  const lds_cptr shm3=(lds_cptr)shm; const lds_cptr kp0=shm3+LDS_K+hi*1024+r32*16; const lds_cptr vp0=shm3+LDS_V+((lane>>4)&1)*32+(lane&3)*8+(4*hi+((lane&15)>>2))*64;
  const int NT=(q0+QB)/KVBLK;
  DMA_K(0,0);DMA_V(0,0);DMA_K(1,SLOTB);
  bf16x8 qr[4];
  #pragma unroll
  for(int d0=0;d0<4;++d0)qr[d0]=*reinterpret_cast<const bf16x8*>(&Qw[(long)r32*ZP+d0*16+hi*8]);
  float mhat=0.f,l_reg=0.f;f32x16 o[2];o[0]=f32x16{};o[1]=f32x16{};f32x16 negm=f32x16{};asm volatile("":"+v"(negm));
  const int qrel=wid*QBLK+r32;
  #define CMASK(P0,P1,t) do{int jb_=(t)-(NT-4); if(jb_>=0)cmask(P0,P1,jb_,qrel,hi);}while(0)
  bool resc=false;
  #define START(P0,P1) do{ const float rm=rowmax(P0,P1); resc=false; \
    { const float dl=rm; mhat=fadd_s(mhat,dl); \
      _Pragma("unroll") for(int r=0;r<16;++r){P0[r]=fsub_s(P0[r],dl);P1[r]=fsub_s(P1[r],dl);} \
      _Pragma("unroll") for(int r=0;r<16;++r)negm[r]=-mhat; asm volatile("":"+v"(negm)); } \
    _Pragma("unroll") for(int r=0;r<16;++r)P0[r]=__builtin_amdgcn_exp2f(P0[r]); }while(0)
  #define RESC() do{ if(resc){ asm volatile("s_waitcnt lgkmcnt(0)":::"memory"); \
      _Pragma("unroll") for(int d_=0;d_<2;++d_) _Pragma("unroll") for(int r=0;r<16;++r)o[d_][r]*=wsf[crow(r,hi)]; } }while(0)
  f32x16 pA0,pA1,pB0,pB1;
  int sl_prev=0,sl_cur=0,sl_next=SLOTB;
  #define ROT() do{sl_prev=sl_cur;sl_cur=sl_next;sl_next=(sl_next==(NSLOT-1)*SLOTB)?0:sl_next+SLOTB;}while(0)
  DMA_K(2,2*SLOTB);
  WAIT_BAR(3);
  qkt(pA0,pA1,Kbase,qr,negm,r32,hi);asm volatile("s_nop 15\n\ts_nop 7":"+v"(pA0),"+v"(pA1));CMASK(pA0,pA1,0);
  START(pA0,pA1);
  _Pragma("unroll") for(int r=0;r<16;++r)pA1[r]=__builtin_amdgcn_exp2f(pA1[r]);
  WAIT_BAR(0);
  DMA_K(3,0);DMA_V(1,SLOTB);
  ROT();
  kload8(kf,kp0+sl_cur);
  WAIT_BAR(2);
  s16x4 vlo[8],vhi[8]; u32x4 pw0,pw1,pw2,pw3;
  #define PKW(P,B) cvtpk_s(P[B],P[B+1])
  #define PAF(k) __builtin_bit_cast(bf16x8,pw##k)
  #define VFR(i) (bf16x8){vlo[i][0],vlo[i][1],vlo[i][2],vlo[i][3],vhi[i][0],vhi[i][1],vhi[i][2],vhi[i][3]}
  #define PIN(x) asm volatile("":"+v"(x))
  #define MX3(a,b,c) __builtin_fmaxf(__builtin_fmaxf((a),(b)),(c))
  #define GAPA(MF,A0,A1,A2,A3,W0,W1,PW) do{ MF; sacc+=A0; sacc+=A1; sacc+=A2; sacc+=A3; PIN(sacc); W0; W1; PIN(PW); SBAR(); }while(0)
  #define EX(v) __builtin_amdgcn_exp2f(v)
  #define GAPB(MF,X,B) do{ MF; X[B]=EX(X[B]); X[B+1]=EX(X[B+1]); X[B+2]=EX(X[B+2]); X[B+3]=EX(X[B+3]); PIN(X); SBAR(); }while(0)
  #define VRD(i) do{ vlo[i]=vtr(vp_+(((i)>>2)*4096+((i)&3)*1024)); vhi[i]=vtr(vp_+(((i)>>2)*4096+((i)&3)*1024+512)); }while(0)
  #define KRD(G,j) do{ if(G){ kload2(kf,kp0+sl_next,j); SBAR(); } }while(0)
  #define STEP(C0,C1,P0,P1,t,GK,GV,GL) do{ SBAR(); \
    const lds_cptr vp_=vp0+sl_prev; \
    VRD(0); SBAR(); float sacc=(P0[0]+P0[1]); \
    GAPA(C0=__builtin_amdgcn_mfma_f32_32x32x16_bf16(kf[0],qr[0],negm,0,0,0), P0[2],P0[3],P0[4],P0[5],     pw0[0]=PKW(P0,0), pw0[1]=PKW(P0,2), pw0); \
    VRD(4); SBAR(); GAPA(C1=__builtin_amdgcn_mfma_f32_32x32x16_bf16(kf[1],qr[0],negm,0,0,0), P0[6],P0[7],P0[8],P0[9],     pw0[2]=PKW(P0,4), pw0[3]=PKW(P0,6), pw0); \
    VRD(1); SBAR(); GAPA(C0=__builtin_amdgcn_mfma_f32_32x32x16_bf16(kf[2],qr[1],C0,0,0,0),   P0[10],P0[11],P0[12],P0[13], pw1[0]=PKW(P0,8), pw1[1]=PKW(P0,10), pw1); \
    VRD(5); SBAR(); GAPA(C1=__builtin_amdgcn_mfma_f32_32x32x16_bf16(kf[3],qr[1],C1,0,0,0),   P0[14],P0[15],P1[0],P1[1],   pw1[2]=PKW(P0,12),pw1[3]=PKW(P0,14), pw1); \
    VRD(2); SBAR(); GAPA(C0=__builtin_amdgcn_mfma_f32_32x32x16_bf16(kf[4],qr[2],C0,0,0,0),   P1[2],P1[3],P1[4],P1[5],     pw2[0]=PKW(P1,0), pw2[1]=PKW(P1,2), pw2); \
    VRD(6); SBAR(); GAPA(C1=__builtin_amdgcn_mfma_f32_32x32x16_bf16(kf[5],qr[2],C1,0,0,0),   P1[6],P1[7],P1[8],P1[9],     pw2[2]=PKW(P1,4), pw2[3]=PKW(P1,6), pw2); \
    VRD(3); SBAR(); GAPA(C0=__builtin_amdgcn_mfma_f32_32x32x16_bf16(kf[6],qr[3],C0,0,0,0),   P1[10],P1[11],P1[12],P1[13], pw3[0]=PKW(P1,8), pw3[1]=PKW(P1,10), pw3); \
    VRD(7); SBAR(); GAPA(C1=__builtin_amdgcn_mfma_f32_32x32x16_bf16(kf[7],qr[3],C1,0,0,0),   P1[14],P1[15],0.f,0.f,       pw3[2]=PKW(P1,12),pw3[3]=PKW(P1,14), pw3); \
    l_reg+=sacc; \
    if(GK){DMA_K((t)+3,sl_cur);} if(GV){DMA_V((t)+1,sl_next);} \
    CMASK(C0,C1,t); \
    { float a=MX3(C0[0],C0[1],C1[0]),b=MX3(C0[2],C0[3],C1[1]); a=MX3(a,C1[2],C1[3]); \
      _Pragma("unroll") for(int r=4;r<16;r+=4){a=MX3(a,C0[r],C0[r+1]);b=MX3(b,C0[r+2],C0[r+3]);a=MX3(a,C1[r],C1[r+1]);b=MX3(b,C1[r+2],C1[r+3]);} \
      float rm=__builtin_fmaxf(a,b); { auto rr=__builtin_amdgcn_permlane32_swap(__float_as_uint(rm),__float_as_uint(rm),false,false); rm=__builtin_fmaxf(__uint_as_float(rr[0]),__uint_as_float(rr[1])); } \
      resc=false; \
      if(__builtin_expect(__any(rm>(float)THRL),0)){ const float dl=__builtin_fmaxf(rm,0.f); mhat+=dl; \
        _Pragma("unroll") for(int r=0;r<16;++r){C0[r]-=dl;C1[r]-=dl;} \
        _Pragma("unroll") for(int r=0;r<16;++r)negm[r]=-mhat; asm volatile("":"+v"(negm)); \
        const float f=__builtin_amdgcn_exp2f(-dl); l_reg*=f; if(hi==0)wsf[r32]=f; resc=true; } } \
    SBAR(); \
    GAPB(o[0]=__builtin_amdgcn_mfma_f32_32x32x16_bf16(PAF(0),VFR(0),o[0],0,0,0), C0,0); \
    GAPB(o[1]=__builtin_amdgcn_mfma_f32_32x32x16_bf16(PAF(0),VFR(4),o[1],0,0,0), C0,4); \
    KRD(GL,0); GAPB(o[0]=__builtin_amdgcn_mfma_f32_32x32x16_bf16(PAF(1),VFR(1),o[0],0,0,0), C0,8); \
    KRD(GL,1); GAPB(o[1]=__builtin_amdgcn_mfma_f32_32x32x16_bf16(PAF(1),VFR(5),o[1],0,0,0), C0,12); \
    KRD(GL,2); GAPB(o[0]=__builtin_amdgcn_mfma_f32_32x32x16_bf16(PAF(2),VFR(2),o[0],0,0,0), C1,0); \
    KRD(GL,3); GAPB(o[1]=__builtin_amdgcn_mfma_f32_32x32x16_bf16(PAF(2),VFR(6),o[1],0,0,0), C1,4); \
    GAPB(o[0]=__builtin_amdgcn_mfma_f32_32x32x16_bf16(PAF(3),VFR(3),o[0],0,0,0), C1,8); \
    GAPB(o[1]=__builtin_amdgcn_mfma_f32_32x32x16_bf16(PAF(3),VFR(7),o[1],0,0,0), C1,12); \
    }while(0)
  int t=1;
  #undef CMASK
  #define CMASK(P0,P1,t) do{}while(0)
  for(;t+5<NT;t+=2){
    STEP(pB0,pB1,pA0,pA1,t,true,true,true);     WAIT_BAR(2); RESC(); ROT();
    STEP(pA0,pA1,pB0,pB1,t+1,true,true,true);   WAIT_BAR(2); RESC(); ROT();
  }
  #undef CMASK
  #define CMASK(P0,P1,t) do{int jb_=(t)-(NT-4); if(jb_>=0)cmask(P0,P1,jb_,qrel,hi);}while(0)
  #define ENDW(tt) do{ if((tt)+3<NT){WAIT_BAR(2);} else if((tt)+2<NT){WAIT_BAR(1);} else {WAIT_BAR(0);} }while(0)
  for(;t+1<NT;t+=2){
    STEP(pB0,pB1,pA0,pA1,t,(t+3<NT),(t+1<NT),(t+1<NT));       ENDW(t);   RESC(); ROT();
    STEP(pA0,pA1,pB0,pB1,t+1,(t+4<NT),(t+2<NT),(t+2<NT));     ENDW(t+1); RESC(); ROT();
  }
  if(tid==0)nticket=__hip_atomic_fetch_add(qhead,1u,__ATOMIC_RELAXED,__HIP_MEMORY_SCOPE_AGENT);
  STEP(pB0,pB1,pA0,pA1,NT-1,false,false,false); RESC();
  { float sacc=pB0[0]+pB0[1]; _Pragma("unroll") for(int r=2;r<16;++r)sacc+=pB0[r]; _Pragma("unroll") for(int r=0;r<16;++r)sacc+=pB1[r]; l_reg+=sacc;
    pw0=(u32x4){PKW(pB0,0),PKW(pB0,2),PKW(pB0,4),PKW(pB0,6)};pw1=(u32x4){PKW(pB0,8),PKW(pB0,10),PKW(pB0,12),PKW(pB0,14)};pw2=(u32x4){PKW(pB1,0),PKW(pB1,2),PKW(pB1,4),PKW(pB1,6)};pw3=(u32x4){PKW(pB1,8),PKW(pB1,10),PKW(pB1,12),PKW(pB1,14)};
    SBAR(); pv(o,vb0+sl_cur,PAF(0),PAF(1),PAF(2),PAF(3)); }
  #undef PKW
  #undef PAF
  #undef VFR
  #undef PIN
  #undef MX3
  #undef GAPA
  #undef GAPB
  #undef EX
  #undef VRD
  #undef KRD
  #undef STEP
  #undef ENDW
  {auto rr=__builtin_amdgcn_permlane32_swap(__float_as_uint(l_reg),__float_as_uint(l_reg),false,false);l_reg=__uint_as_float(rr[0])+__uint_as_float(rr[1]);}
  if(hi==0)wsf[32+r32]=l_reg;asm volatile("s_waitcnt lgkmcnt(0)":::"memory");
  float rli[16];
  #pragma unroll
  for(int r=0;r<16;++r)rli[r]=__builtin_amdgcn_rcpf(wsf[32+crow(r,hi)]);
  bf16*Ow=Ob+(long)(q0+wid*QBLK)*OPITCH;
  { bf16*stg=(bf16*)(shm+LDS_OST)+wid*2048;
    #pragma unroll
    for(int r=0;r<16;++r){const int orow=crow(r,hi);
      #pragma unroll
      for(int d0=0;d0<2;++d0)stg[orow*64+d0*32+r32]=f2bf(o[d0][r]*rli[r]);}
    asm volatile("s_waitcnt lgkmcnt(0)":::"memory");
    #pragma unroll
    for(int i=0;i<4;++i){const int row=i*8+(lane>>3),ch=lane&7; const u32x4 v=*(const u32x4*)(stg+row*64+ch*8); ATTN_STORE16(Ow+(long)row*OPITCH+ch*8,v);} }
  asm volatile("s_waitcnt lgkmcnt(0)\n\ts_barrier":::"memory");
  #undef DMA_K
  #undef DMA_V
  #undef CMASK
  #undef START
  #undef RESC
  #undef ROT
}
constexpr int ATTN_LDS_BYTES=LDS_BYTES;
#undef SBAR
#undef WAIT_BAR
}
DEV int queue_pop(unsigned* head, LAS unsigned char* lds, int wv) {
    LAS int* slot = (LAS int*)(lds + LCTL_OFF + 4096);
    __syncthreads();
    if (opaque_tid(wv) == 0) *slot = (int)__hip_atomic_fetch_add(head, 1u, __ATOMIC_RELAXED, __HIP_MEMORY_SCOPE_AGENT);
    __syncthreads();
    return *slot;
}

DEV void phase_mix0(const Params& P, LAS unsigned char* lds, char* shm, int wv) {
    unsigned char* ws = opaque_ws(P.ws); const bf16_t* Z = (const bf16_t*)(ws + WS_Z);
    unsigned* head = (unsigned*)(ws + WS_CTL) + CW_QUEUE;
    const bool static_gla = gridDim.x >= 64;
    const int qoff = static_gla ? 32 : 0;
    LAS int* slot = (LAS int*)(lds + LCTL_OFF + 4096);
    int q = (static_gla && blockIdx.x < 32) ? (int)blockIdx.x : queue_pop(head, lds, wv) + qoff;
    for (;;) {
        if (q >= 32 + 1024) break;
        unsigned nticket = 0u; bool have_ticket = false;
        if (q < 32) {
            const int b = q >> 2, h = q & 3; const size_t rb = (size_t)b * SEQ;
            LinAttnArgs a; a.q = Z + rb * Z0P + h * 64; a.k = Z + rb * Z0P + 256 + h * 64; a.v = Z + rb * Z0P + 512 + h * 128; a.og = Z + rb * Z0P + 1024 + h * 128; a.zp = Z0P;
            a.la = (const float*)(ws + WS_LA) + rb * 256 + h * 64; a.log_g = 0.f; a.gain = (const float*)P.in[8]; a.out = (bf16_t*)(ws + WS_CAT) + rb * 1024 + h * 128;
            #if FAST_LIN
            linattn_unit_fast<64, true>(a, lds, wv);
#ifdef DBG_TS
            if (opaque_tid(wv) == 0) atomicMax((unsigned long long*)(ws + WS_CTL + 49152) + 32, (unsigned long long)__builtin_amdgcn_s_memrealtime());
#endif
#else
            linattn_unit_ref<64>(a, lds, wv);
#endif
        } else {
            const int aidx = q - 32, qb = 7 - (aidx >> 7), rem = aidx & 127, b = rem >> 4, vh = rem & 15;
#if FAST_ATTN
            { const int h = vh >> 2, m = (vh >> 1) & 1, vhalf = vh & 1; const bf16_t* zb = Z + (size_t)b * SEQ * Z0P;
              attn_body::attn_unit<8>(qb, zb + 1536 + h * 128 + m * 64, zb + 2048 + h * 128 + m * 64, zb + 2560 + h * 128 + vhalf * 64,
                                      (bf16_t*)(ws + WS_OPART) + (size_t)b * SEQ * 1024 + vh * 64, shm, wv, head, nticket); have_ticket = true; }
#ifdef DBG_TS
            if (opaque_tid(wv) == 0) atomicMax((unsigned long long*)(ws + WS_CTL + 49152) + 33, (unsigned long long)__builtin_amdgcn_s_memrealtime());
#endif
#else
            attn_unit_ref(b, vh, qb, Z, (bf16_t*)(ws + WS_OPART), wv);
#endif
        }
        if (have_ticket) { __syncthreads(); if (opaque_tid(wv) == 0) *slot = (int)nticket; __syncthreads(); q = *slot + qoff; }
        else q = queue_pop(head, lds, wv) + qoff;
    }
}
constexpr int RET_SPLIT = 10;
DEV void phase_mix1(const Params& P, LAS unsigned char* lds, int wv) {
    unsigned char* ws = opaque_ws(P.ws); const bf16_t* Z = (const bf16_t*)(ws + WS_Z);
    const int G = gridDim.x, nret = G == 256 ? 64 : 0;
    if ((int)blockIdx.x < nret || nret == 0) {
        for (int q0 = blockIdx.x; q0 < (nret ? 64 : 32); q0 += (nret ? 64 : G)) {
            const int q = nret ? (q0 >> 1) : q0, part = nret ? (q0 & 1) : 2;
            const int b = q >> 2, h = q & 3; const size_t rb = (size_t)b * SEQ;
            LinAttnArgs a; a.q = Z + rb * Z1P + 1024 + h * 64; a.k = Z + rb * Z1P + 1280 + h * 64; a.v = Z + rb * Z1P + 1536 + h * 128; a.og = Z + rb * Z1P + 2048 + h * 128; a.zp = Z1P;
            a.la = nullptr; a.log_g = logf(1.0f - exp2f(-5.0f - (float)h)); a.gain = nullptr; a.out = (bf16_t*)(ws + WS_CAT) + rb * 1024 + 512 + h * 128;
            if (part == 0) linattn_unit_fast<128, false>(a, lds, wv, 0, RET_SPLIT);
            else if (part == 1) linattn_unit_fast<128, false>(a, lds, wv, RET_SPLIT, SEQ / 128);
            else linattn_unit_fast<128, false>(a, lds, wv);
        }
    }
    if ((int)blockIdx.x >= nret) {
        for (int s2 = (int)blockIdx.x - nret; s2 < 128; s2 += G - nret) sgu_unit_fast(P, s2 >> 4, s2 & 15, lds, wv);
        conv_experts(P, lds, wv, 1, nret, G - nret, G == 256 ? CV_P10 : 0, G == 256 ? CV_P7_LO : CV_ALL);
    }
}
DEV void phase_combine(const Params& P, int wv) {
    const int tid = opaque_tid(wv), lane = tid & 63, wid = tid >> 6, G = gridDim.x;
    const float* q1 = (const float*)P.in[9]; const float* k1 = (const float*)P.in[10]; const float* q2 = (const float*)P.in[11]; const float* k2 = (const float*)P.in[12];
    const float* dg = (const float*)P.in[13];
    const float lam = __expf(wave_sum(q1[lane] * k1[lane])) - __expf(wave_sum(q2[lane] * k2[lane])) + 0.2f;
    unsigned char* ws = opaque_ws(P.ws); const bf16_t* OP = (const bf16_t*)(ws + WS_OPART); bf16_t* CAT = (bf16_t*)(ws + WS_CAT);
    const int h = lane >> 4, e0 = (lane & 15) * 8;
    float g[8];
#pragma unroll
    for (int j = 0; j < 8; ++j) g[j] = dg[e0 + j] * 0.8f;
    for (int row = blockIdx.x * NWAVES + wid; row < NTOK; row += G * NWAVES) {
        float a0[8], a1[8], d[8];
        unpack8(*(const bf16x8*)(OP + (size_t)row * 1024 + h * 256 + e0), a0); unpack8(*(const bf16x8*)(OP + (size_t)row * 1024 + h * 256 + 128 + e0), a1);
        float ss = 0.f;
#pragma unroll
        for (int j = 0; j < 8; ++j) { d[j] = a0[j] - lam * a1[j]; ss += d[j] * d[j]; }
        ss = row16_sum(ss);
        const float rstd = 1.0f / sqrtf(ss * (1.f / 128.f) + EPS);
        u32x4 w; w.x = pk2(d[0] * rstd * g[0], d[1] * rstd * g[1]); w.y = pk2(d[2] * rstd * g[2], d[3] * rstd * g[3]);
        w.z = pk2(d[4] * rstd * g[4], d[5] * rstd * g[5]); w.w = pk2(d[6] * rstd * g[6], d[7] * rstd * g[7]);
        *(u32x4*)(CAT + (size_t)row * 1024 + 512 + h * 128 + e0) = w;
    }
}


#ifdef DBG_PROBE_OFF
constexpr int CW_PROBE = 1024;
__global__ void __launch_bounds__(NTHREADS) mk_probe(Params P) {
    const int tid = opaque_tid(wv), G = gridDim.x;
    float s = 0.f;
    const unsigned char* base = P.ws + (size_t)DBG_PROBE_OFF;
    for (long i = (long)blockIdx.x * NTHREADS + tid; i < (long)NTOK * DBG_PROBE_NCOLS; i += (long)G * NTHREADS) {
        const long r = i / DBG_PROBE_NCOLS; const int c = (int)(i % DBG_PROBE_NCOLS) + DBG_PROBE_COL0;
        float v;
        if (DBG_PROBE_F32) v = ((const float*)base)[r * DBG_PROBE_PITCH + c]; else v = bf2f(((const bf16_t*)base)[r * DBG_PROBE_PITCH + c]);
        s += DBG_PROBE_ABS ? fabsf(v) : v * v;
    }
    s = wave_sum(s);
    if ((tid & 63) == 0) atomicAdd((float*)(P.ws + WS_CTL) + CW_PROBE, s);
}
#endif

#define XB_TMO      128
#define XB_XCNT(j)  (256  + 64 * (j))
#define XB_XSUB(j)  (1280 + 64 * (j))
#define XB_XGEN(j)  (2304 + 64 * (j))
#define XB_TOP      3328
#define XB_TOPGEN   3392
#define XCD_BAR_WORDS 3456
#define XB_SPIN_CAP (1u << 18)

__device__ __forceinline__ unsigned xb_ld(unsigned* p)              { return __hip_atomic_load(p, __ATOMIC_RELAXED, __HIP_MEMORY_SCOPE_AGENT); }
__device__ __forceinline__ unsigned xb_add(unsigned* p, unsigned v) { return __hip_atomic_fetch_add(p, v, __ATOMIC_RELAXED, __HIP_MEMORY_SCOPE_AGENT); }
__device__ __forceinline__ unsigned xb_xcc_id() { return (unsigned)__builtin_amdgcn_s_getreg((3 << 11) | 20) & 0xFu; }
#define XB_SPIN(cond, bar) do { unsigned _sp = 0; while (cond) { __builtin_amdgcn_s_sleep(1); \
    if ((++_sp & 255u) == 0u) { if (xb_ld(&(bar)[XB_TMO])) break; if (_sp > XB_SPIN_CAP) { atomicAdd(&(bar)[XB_TMO], 1u); break; } } } } while (0)

struct XcdBarrier {
    unsigned* bar; unsigned x;
    volatile LAS unsigned* st;
};

__device__ __forceinline__ XcdBarrier xcd_barrier_post(unsigned* bar, volatile LAS unsigned* st) {
    XcdBarrier b; b.bar = bar; b.x = xb_xcc_id(); b.st = st;
    if (threadIdx.x == 0) (void)xb_add(&bar[XB_XCNT(b.x)], 1u);
    return b;
}
__device__ __forceinline__ void xcd_barrier_complete(unsigned* bar, unsigned x, unsigned& nloc, unsigned& nx) {
    const unsigned G = gridDim.x * gridDim.y * gridDim.z;
    unsigned sum, cnt, mine, sp = 0u;
    for (;;) {
        sum = 0u; cnt = 0u; mine = 0u;
#pragma unroll
        for (unsigned j = 0; j < 16; ++j) { const unsigned c = xb_ld(&bar[XB_XCNT(j)]); sum += c; cnt += (c > 0u) ? 1u : 0u; mine = (j == x) ? c : mine; }
        if (sum == G) break;
        __builtin_amdgcn_s_sleep(1);
        if ((++sp & 255u) == 0u) { if (xb_ld(&bar[XB_TMO])) break; if (sp > XB_SPIN_CAP) { atomicAdd(&bar[XB_TMO], 1u); break; } }
    }
    nloc = mine > 0u ? mine : 1u; nx = cnt > 0u ? cnt : 1u;
}

__device__ __forceinline__ void xcd_barrier(const XcdBarrier& b) {
    asm volatile("s_waitcnt vmcnt(0)" ::: "memory");
    __syncthreads();
    if (threadIdx.x == 0) {
        unsigned* bar = b.bar;
        __builtin_amdgcn_s_waitcnt(0);
        unsigned nloc = b.st[0], nx = b.st[1];
        if (nloc == 0u) { xcd_barrier_complete(bar, b.x, nloc, nx); b.st[0] = nloc; b.st[1] = nx; }
        const unsigned old = xb_add(&bar[XB_XSUB(b.x)], 1u);
        const unsigned gen = old / nloc;
        if (old + 1u == (gen + 1u) * nloc) {
            __builtin_amdgcn_fence(__ATOMIC_RELEASE, "agent");
            asm volatile("s_waitcnt vmcnt(0)" ::: "memory");
            const unsigned og = xb_add(&bar[XB_TOP], 1u);
            const unsigned tg = og / nx;
            if (og + 1u == (tg + 1u) * nx) xb_add(&bar[XB_TOPGEN], 1u);
            else XB_SPIN(xb_ld(&bar[XB_TOPGEN]) == tg, bar);
            __builtin_amdgcn_fence(__ATOMIC_ACQUIRE, "agent");
            xb_add(&bar[XB_XGEN(b.x)], 1u);
            asm volatile("s_waitcnt vmcnt(0)" ::: "memory");
        } else {
            XB_SPIN(xb_ld(&bar[XB_XGEN(b.x)]) == gen, bar);
            __builtin_amdgcn_fence(__ATOMIC_ACQUIRE, "agent");
            asm volatile("s_waitcnt vmcnt(0)" ::: "memory");
        }
    }
    __syncthreads();
}
template <class Epi, class Sched>
DEV void gemm_run(LAS unsigned char* lds, const Sched& S, const Epi& E, int wv, unsigned char* dbg_ws = nullptr) {
#if FAST_GEMM
    pg8::gemm_phase(lds, S, E, wv, dbg_ws);
#else
    gemm_ref(S, E, wv);
#endif
}

constexpr int N_PHASES = 17;
template <int lo, int hi>
__global__ void __launch_bounds__(NTHREADS, 2) mk_fwd(Params P) {
    extern __shared__ __attribute__((aligned(16))) unsigned char lds_raw[];
    LAS unsigned char* lds = (LAS unsigned char*)lds_raw;
    const int G = gridDim.x, c = blockIdx.x;
    const int wv = __builtin_amdgcn_readfirstlane((int)(threadIdx.x >> 6));
#if ONE_LAUNCH
    { volatile LAS unsigned* stw = (volatile LAS unsigned*)(lds + LCTL_OFF + 8192); if (threadIdx.x < 4) stw[threadIdx.x] = 0u; }
    __syncthreads();
    const XcdBarrier xbar = xcd_barrier_post((unsigned*)(P.ws + WS_CTL) + CW_BAR, (volatile LAS unsigned*)(lds + LCTL_OFF + 8192));
#if USE_CG_SYNC
    cg::grid_group grid = cg::this_grid();
#define GRID_BAR() grid.sync()
#else
#define GRID_BAR() xcd_barrier(xbar)
#endif
#else
#define GRID_BAR() do {} while (0)
#endif
#define IN(k) (lo <= (k) && (k) < hi)
#ifdef DBG_TS
#define STAMP(k) do { if (blockIdx.x == 0 && threadIdx.x == 0) ((unsigned long long*)(P.ws + WS_CTL + 49152))[(k)] = __builtin_amdgcn_s_memrealtime(); } while (0)
#else
#define STAMP(k) do {} while (0)
#endif
#define SEAM(k) do { if constexpr (lo <= (k) + 1 && (k) + 1 < hi) GRID_BAR(); STAMP((k) + 1); } while (0)
#define PH_PTRS unsigned char* ws = opaque_ws(P.ws); const float* mod = (const float*)(ws + WS_MOD); bf16_t* H = (bf16_t*)(ws + WS_H); bf16_t* Z = (bf16_t*)(ws + WS_Z); bf16_t* CAT = (bf16_t*)(ws + WS_CAT); \
    void* X1 = (void*)(ws + WS_X1); void* X2 = (void*)(ws + WS_X2); const float* x = (const float*)P.in[0]; (void)mod; (void)H; (void)Z; (void)CAT; (void)X1; (void)X2; (void)x;

    STAMP(0);
    if constexpr (IN(0)) { PH_PTRS phase_prologue(P, lds, wv); conv_experts(P, lds, wv, 0, 0, G); SEAM(0); }
    if constexpr (IN(1)) { PH_PTRS phase_prenorm_gate(P, lds, wv); SEAM(1); }
    if constexpr (IN(2)) { PH_PTRS
#ifdef DBG_STAGGER2_US
        { const unsigned long long t0 = __builtin_amdgcn_s_memrealtime(); const unsigned long long dl = (unsigned long long)((blockIdx.x >> 3) & 3) * (DBG_STAGGER2_US * 25);
          while (__builtin_amdgcn_s_memrealtime() - t0 < dl) __builtin_amdgcn_s_sleep(8); }
#endif
        DenseSched S{H, (const bf16_t*)(ws + WS_WIN0), 1024, NTOK / 256, N_IN0 / 256, G, c};
        EpiIn E{Z, Z0P, (float*)(ws + WS_LA), (const float*)P.in[7], (const float*)(ws + WS_ROPE), 0};
        gemm_run(lds, S, E, wv, ws); SEAM(2);
    }
    if constexpr (IN(3)) { PH_PTRS phase_mix0(P, lds, (char*)lds_raw, wv); SEAM(3); }
    if constexpr (IN(4)) { PH_PTRS phase_combine(P, wv); SEAM(4); }
    if constexpr (IN(5)) { PH_PTRS
        DenseSched S{CAT, (const bf16_t*)(ws + WS_WOUT0), 1024, NTOK / 256, 4, G, c};
        EpiResid<false> E{x, X1, mod + 2 * 1024, (DBG_SKIP >> 0) & 1, DBG_F_MIX0};
        gemm_run(lds, S, E, wv, ws); SEAM(5);
    }
    if constexpr (IN(6)) { PH_PTRS phase_router(P, lds, wv, X1, 0); SEAM(6); }
    if constexpr (IN(7)) { PH_PTRS
        const int* cnt = (const int*)(ws + WS_CTL) + CW_CNT; const int* ent = (const int*)(ws + WS_ENT);
        MoeTiles mt = moe_build_tiles(cnt, lds, wv);
#ifdef DBG_STAGGER_US
        { const unsigned long long t0 = __builtin_amdgcn_s_memrealtime(); const unsigned long long dl = (unsigned long long)((blockIdx.x >> 3) & 3) * (DBG_STAGGER_US * 25);
          while (__builtin_amdgcn_s_memrealtime() - t0 < dl) __builtin_amdgcn_s_sleep(8); }
#endif
        MoeSched1 S{ws + WS_XQ, ws + WS_W1, mt, 1024, 8, G, c, ent};
        EpiSwiglu E{(bf16_t*)(ws + WS_A), (const float*)P.in[24]};
        gemm_run(lds, S, E, wv, ws);
        if (G == 256) {
            const int nwg = mt.nt * 8, iL = (nwg - 1) / G, remp = nwg - iL * G, nidle = G - remp;
            if (nidle >= 32) { if (c >= remp) conv_experts(P, lds, wv, 1, remp, nidle, CV_P7_LO, CV_P8_LO); }
            else conv_experts(P, lds, wv, 1, 0, G, CV_P7_LO, CV_P8_LO);
        }
        SEAM(7);
    }
    if constexpr (IN(8)) { PH_PTRS
        const int* cnt = (const int*)(ws + WS_CTL) + CW_CNT; const int* ent = (const int*)(ws + WS_ENT);
        MoeTiles mt = IN(7) ? moe_reuse_tiles(lds) : moe_build_tiles(cnt, lds, wv);
        MoeSched2 S{ws + WS_A, ws + WS_W2, mt, 1024, 4, G, c};
        EpiMoeOut E{(bf16_t*)(ws + WS_YB), (const float*)P.in[26], cnt, ent, (const float*)(ws + WS_GL)};
        gemm_run(lds, S, E, wv, ws);
        if (G == 256) {
            const int nwg = mt.nt * 4, iL = (nwg - 1) / G, remp = nwg - iL * G, nidle = G - remp;
            if (nidle >= 32) { if (c >= remp) conv_experts(P, lds, wv, 1, remp, nidle, CV_P8_LO, CV_ALL); }
            else conv_experts(P, lds, wv, 1, 0, G, CV_P8_LO, CV_ALL);
        }
        SEAM(8);
    }
    if constexpr (IN(9)) { PH_PTRS phase_prenorm<3, RES_BF16>(P, lds, wv, X1, X2, 1, 0, 0); SEAM(9); }
    if constexpr (IN(10)) { PH_PTRS
        DenseSched S{H, (const bf16_t*)(ws + WS_WIN1), 1024, NTOK / 256, N_IN1 / 256, G, c};
        EpiIn E{Z, Z1P, nullptr, nullptr, (const float*)(ws + WS_ROPE), 1};
        gemm_run(lds, S, E, wv, ws);
        if (G == 256 && c >= 128) conv_experts(P, lds, wv, 1, 128, 128, 0, CV_P10);
        SEAM(10);
    }
    if constexpr (IN(11)) { PH_PTRS phase_mix1(P, lds, wv); SEAM(11); }
    if constexpr (IN(12)) { PH_PTRS
        DenseSched S{CAT, (const bf16_t*)(ws + WS_WOUT1), 1024, NTOK / 256, 4, G, c};
        EpiResid<RES_BF16> E{X2, X1, mod + 8 * 6144 + 2 * 1024, (DBG_SKIP >> 2) & 1, DBG_F_MIX1};
        gemm_run(lds, S, E, wv, ws); SEAM(12);
    }
    if constexpr (IN(13)) { PH_PTRS phase_router(P, lds, wv, X1, 1); SEAM(13); }
    if constexpr (IN(14)) { PH_PTRS
        const int* cnt = (const int*)(ws + WS_CTL) + CW_CNT + NEXP * CNT_STRIDE; const int* ent = (const int*)(ws + WS_ENT) + (size_t)NEXP * ENT_CAP;
        MoeTiles mt = moe_build_tiles(cnt, lds, wv);
        MoeSched1 S{ws + WS_XQ, ws + WS_W1 + (size_t)NEXP * 2048 * 1024, mt, 1024, 8, G, c, ent};
        EpiSwiglu E{(bf16_t*)(ws + WS_A), (const float*)P.in[24] + (size_t)NEXP * 2048};
        gemm_run(lds, S, E, wv, ws); SEAM(14);
    }
    if constexpr (IN(15)) { PH_PTRS
        const int* cnt = (const int*)(ws + WS_CTL) + CW_CNT + NEXP * CNT_STRIDE; const int* ent = (const int*)(ws + WS_ENT) + (size_t)NEXP * ENT_CAP;
        MoeTiles mt = IN(14) ? moe_reuse_tiles(lds) : moe_build_tiles(cnt, lds, wv);
        MoeSched2 S{ws + WS_A, ws + WS_W2 + (size_t)NEXP * 1024 * 1024, mt, 1024, 4, G, c};
        EpiMoeOut E{(bf16_t*)(ws + WS_YB), (const float*)P.in[26] + (size_t)NEXP * 1024, cnt, ent, (const float*)(ws + WS_GL) + (size_t)NEXP * ENT_CAP};
        gemm_run(lds, S, E, wv, ws); SEAM(15);
    }
    if constexpr (IN(16)) { PH_PTRS phase_prenorm<9, RES_BF16>(P, lds, wv, X1, nullptr, 1, 0, 1); }
#undef IN
#undef SEAM
}

template <int PH> static void launch_phase(int grid, const Params& p, hipStream_t stream) {
    (void)hipFuncSetAttribute((const void*)mk_fwd<PH, PH + 1>, hipFuncAttributeMaxDynamicSharedMemorySize, LDS_BYTES);
    hipLaunchKernelGGL((mk_fwd<PH, PH + 1>), dim3(grid), dim3(NTHREADS), LDS_BYTES, stream, p);
}
#ifdef DBG_PHASES
template <int PH> static void launch_masked(int grid, const Params& p, hipStream_t stream) {
    if constexpr (PH < N_PHASES) { if constexpr ((DBG_PHASES >> PH) & 1) launch_phase<PH>(grid, p, stream); launch_masked<PH + 1>(grid, p, stream); }
}
#endif
template <int PH> static void launch_all(int grid, const Params& p, hipStream_t stream) {
    if constexpr (PH < N_PHASES) { launch_phase<PH>(grid, p, stream); launch_all<PH + 1>(grid, p, stream); }
}
extern "C" void kernel_launch(void* const* d_in, const int* in_sizes, int n_in, void* d_out, int out_size, void* d_ws, size_t ws_size, hipStream_t stream) {
    static int grid = 0;
    if (grid == 0) {
        if (n_in != 28 || out_size != NTOK * DM || ws_size < WS_END) { fprintf(stderr, "kernel_launch: unexpected shapes (n_in %d out %d ws %zu)\n", n_in, out_size, ws_size); grid = -1; return; }
        int dev = 0, cus = 0;
        (void)hipGetDevice(&dev); (void)hipDeviceGetAttribute(&cus, hipDeviceAttributeMultiprocessorCount, dev);
#if ONE_LAUNCH
        int per_cu = 0;
        if (hipFuncSetAttribute((const void*)mk_fwd<0, N_PHASES>, hipFuncAttributeMaxDynamicSharedMemorySize, LDS_BYTES) != hipSuccess) { fprintf(stderr, "kernel_launch: hipFuncSetAttribute failed\n"); grid = -1; return; }
        (void)hipOccupancyMaxActiveBlocksPerMultiprocessor(&per_cu, (const void*)mk_fwd<0, N_PHASES>, NTHREADS, LDS_BYTES);
        if (per_cu < 1) { fprintf(stderr, "kernel_launch: occupancy query reports %d blocks per CU\n", per_cu); grid = -1; return; }
#endif
        (void)hipGetLastError();
        grid = cus;
    }
    if (grid < 0) return;
    (void)hipMemsetAsync((char*)d_ws + WS_CTL, 0, CTL_ZERO_BYTES, stream);
    Params p{};
    for (int i = 0; i < 28; ++i) p.in[i] = d_in[i];
    p.out = (float*)d_out; p.ws = (unsigned char*)d_ws;
#if ONE_LAUNCH
    void* args[] = {&p};
    hipError_t e = hipLaunchCooperativeKernel((const void*)mk_fwd<0, N_PHASES>, dim3(grid), dim3(NTHREADS), args, LDS_BYTES, stream);
    if (e != hipSuccess) fprintf(stderr, "cooperative launch failed: %s (grid %d)\n", hipGetErrorString(e), grid);
#else
#ifdef DBG_PHASES
    launch_masked<0>(grid, p, stream);
#ifdef DBG_PROBE_OFF
    hipLaunchKernelGGL(mk_probe, dim3(grid), dim3(NTHREADS), 0, stream, p);
    launch_phase<16>(grid, p, stream);
#endif
#else
    launch_all<0>(grid, p, stream);
#endif
#endif
}
```
